# Optimizing an MI355X kernel written in HIP

```python
import jax, jax.numpy as jnp
from jax import lax
import numpy as np

D_MODEL = 1024
BATCH = 8
SEQ = 2048
DEPTH = 2
DEC_BATCH = 32
DEC_SEQ = 4
PAST_LEN = 8192
PAGE_SIZE = 128

D_MIX = D_MODEL
D_GROUP = D_MIX // 4
HEAD_DIM = 64
N_HEADS = D_GROUP // HEAD_DIM
GLA_DK = HEAD_DIM // 2
GLA_DV = HEAD_DIM
GLA_RANK = 16
GLA_TAU = 16.0
GLA_CHUNK = 64
SGU_CHUNK = 128
FOX_BLOCK = 128
FOX_BF_INIT = 7.0
CONV_WIDTH = 31
FFN_CONV_WIDTH = 3
D_FF = 2688
ALPHA = (2 * DEPTH) ** 0.25
BETA = (8 * DEPTH) ** -0.25
EPS = 1e-5
F32 = jnp.float32
IN_SPLIT = (N_HEADS * GLA_DK, N_HEADS * GLA_DK, N_HEADS * GLA_DV, N_HEADS * GLA_DV, GLA_RANK,
            D_GROUP, D_GROUP,
            D_GROUP, D_GROUP, D_GROUP, N_HEADS,
            2 * D_GROUP)
D_IN = sum(IN_SPLIT)

kernel_name = 'hybrid_gla_sgu_fox_conformer_decode_step'


def _layer_norm(x, g, b):
    xf = x.astype(F32)
    mu = jnp.mean(xf, -1, keepdims=True)
    var = jnp.mean(jnp.square(xf - mu), -1, keepdims=True)
    return ((xf - mu) * lax.rsqrt(var + EPS) * g + b).astype(x.dtype)


def _group_layer_norm(x, g, b, groups):
    shp = x.shape
    xg = x.reshape(*shp[:-1], groups, shp[-1] // groups)
    return _layer_norm(xg, g.reshape(groups, -1), b.reshape(groups, -1)).reshape(shp)


def _causal_dwconv(x, buf, w, b):
    xx = jnp.concatenate([buf.astype(x.dtype), x], axis=1)
    y = lax.conv_general_dilated(xx, w[:, None, :].astype(xx.dtype), window_strides=(1,), padding='VALID',
                                 dimension_numbers=('NWC', 'WIO', 'NWC'), feature_group_count=x.shape[-1])
    return y + b, xx[:, -(w.shape[0] - 1):]


def _gla(q, k, v, log_a, s0, chunk):
    B, T, H, _ = q.shape
    n = T // chunk

    def rs(t):
        return t.astype(F32).reshape(B, n, chunk, H, -1).transpose(1, 0, 3, 2, 4)

    qc, kc, vc = rs(q), rs(k), rs(v)
    gc = jnp.cumsum(rs(log_a), axis=3)
    causal = jnp.tril(jnp.ones((chunk, chunk), bool))

    def step(S, inp):
        qi, ki, vi, gi = inp
        diff = gi[..., :, None, :] - gi[..., None, :, :]
        decay = jnp.exp(jnp.where(causal[:, :, None], diff, -jnp.inf))
        attn = jnp.einsum('bhtd,bhsd,bhtsd->bhts', qi, ki, decay)
        o = jnp.einsum('bhtd,bhde->bhte', qi * jnp.exp(gi), S) + jnp.einsum('bhts,bhse->bhte', attn, vi)
        g_last = gi[..., -1:, :]
        S = S * jnp.exp(g_last[..., 0, :])[..., None] + jnp.einsum('bhsd,bhse->bhde', ki * jnp.exp(g_last - gi), vi)
        return S, o

    S, o = lax.scan(step, s0.astype(F32), (qc, kc, vc, gc))
    return o.transpose(1, 0, 3, 2, 4).reshape(B, T, H, -1), S


def _sgu(u, v, w_s, b_s, chunk):
    B, T, _ = u.shape
    n = T // chunk
    w = jnp.tril(w_s[:, :chunk, :chunk])
    vc = v.reshape(B, n, chunk, N_HEADS, -1)
    mixed = jnp.einsum('gts,bnsgc->bntgc', w, vc) + b_s[:, :chunk].T[None, None, :, :, None]
    return u * mixed.reshape(B, T, -1)


def _fox_prompt(q, k, v, logf):
    B, T, H, D = q.shape
    dcum = jnp.cumsum(logf, axis=1).transpose(0, 2, 1)
    key_pos = jnp.arange(T)
    scale = D ** -0.5

    def block(i):
        start = i * FOX_BLOCK
        q_blk = lax.dynamic_slice_in_dim(q, start, FOX_BLOCK, axis=1)
        d_blk = lax.dynamic_slice_in_dim(dcum, start, FOX_BLOCK, axis=2)
        s = jnp.einsum('bqhd,bkhd->bhqk', q_blk, k, preferred_element_type=F32) * scale
        s = s + d_blk[..., :, None] - dcum[..., None, :]
        q_pos = start + jnp.arange(FOX_BLOCK)
        s = jnp.where(key_pos[None, :] <= q_pos[:, None], s, -jnp.inf)
        p = jax.nn.softmax(s, axis=-1)
        return jnp.einsum('bhqk,bkhd->bqhd', p.astype(v.dtype), v)

    o = lax.map(block, jnp.arange(T // FOX_BLOCK))
    return o.transpose(1, 0, 2, 3, 4).reshape(B, T, H, D)


def _fox_sample(q, k, v, logf, k_past, v_past, logf_past):
    B, S, H, D = q.shape
    P = k_past.shape[1]
    lp = logf_past.astype(F32)
    suffix = lax.cumsum(lp, axis=1, reverse=True) - lp
    d_new = jnp.cumsum(logf, axis=1)
    key_bias = jnp.concatenate([suffix, -d_new], axis=1).transpose(0, 2, 1)
    k_all = jnp.concatenate([k_past.astype(k.dtype), k], axis=1)
    v_all = jnp.concatenate([v_past.astype(v.dtype), v], axis=1)
    s = jnp.einsum('bqhd,bkhd->bhqk', q, k_all, preferred_element_type=F32) * D ** -0.5
    s = s + d_new.transpose(0, 2, 1)[..., :, None] + key_bias[..., None, :]
    key_pos = jnp.arange(P + S)
    q_pos = P + jnp.arange(S)
    s = jnp.where(key_pos[None, :] <= q_pos[:, None], s, -jnp.inf)
    p = jax.nn.softmax(s, axis=-1)
    return jnp.einsum('bhqk,bkhd->bqhd', p.astype(v_all.dtype), v_all)


def _mixer(x, p, gla_s0, conv_buf, fox_past, chunk_a, chunk_b):
    B, T, _ = x.shape
    h = jnp.einsum('btd,de->bte', x, p['w_in'])
    points = [int(c) for c in np.cumsum(IN_SPLIT)[:-1]]
    (a_q, a_k, a_v, a_g, a_lr, b_u, b_v, c_q, c_k, c_v, c_f, d_in) = jnp.split(h, points, axis=-1)
    q = a_q.reshape(B, T, N_HEADS, GLA_DK) * GLA_DK ** -0.5
    k = a_k.reshape(B, T, N_HEADS, GLA_DK)
    v = a_v.reshape(B, T, N_HEADS, GLA_DV)
    log_a = jax.nn.log_sigmoid((jnp.einsum('btr,re->bte', a_lr, p['gla_w_a']) + p['gla_b_a']).astype(F32)) / GLA_TAU
    o_a, gla_state = _gla(q, k, v, log_a.reshape(B, T, N_HEADS, GLA_DK), gla_s0, chunk_a)
    o_a = o_a * lax.rsqrt(jnp.mean(jnp.square(o_a), -1, keepdims=True) + EPS)
    y_a = (o_a.reshape(B, T, -1) * p['gla_norm_g']).astype(x.dtype) * jax.nn.silu(a_g)
    v_ln = _group_layer_norm(b_v, p['sgu_ln_g'], p['sgu_ln_b'], N_HEADS)
    y_b = _sgu(b_u, v_ln, p['sgu_w'], p['sgu_b'], chunk_b)
    fq = c_q.reshape(B, T, N_HEADS, HEAD_DIM)
    fk = c_k.reshape(B, T, N_HEADS, HEAD_DIM)
    fv = c_v.reshape(B, T, N_HEADS, HEAD_DIM)
    logf = jax.nn.log_sigmoid((c_f + p['fox_b_f']).astype(F32))
    if fox_past is None:
        o_c = _fox_prompt(fq, fk, fv, logf)
    else:
        o_c = _fox_sample(fq, fk, fv, logf, *fox_past)
    y_c = o_c.reshape(B, T, -1)
    glu = d_in[..., :D_GROUP] * jax.nn.sigmoid(d_in[..., D_GROUP:])
    conv_out, conv_state = _causal_dwconv(glu, conv_buf, p['conv_w'], p['conv_b'])
    y_d = jax.nn.silu(_group_layer_norm(conv_out, p['conv_norm_g'], p['conv_norm_b'], N_HEADS))
    y = jnp.concatenate([y_a, y_b, y_c.astype(x.dtype), y_d], axis=-1)
    out = jnp.einsum('bte,ed->btd', y, p['w_o'])
    return out, (fk, fv, logf, gla_state, conv_state, v_ln)


def _ffn(x, p, buf):
    h = jnp.einsum('btd,df->btf', x, p['ffn_w_up'])
    gate, val = h[..., :D_FF], h[..., D_FF:]
    gate_c, new_buf = _causal_dwconv(gate, buf, p['ffn_conv_w'], p['ffn_conv_b'])
    return jnp.einsum('btf,fd->btd', jax.nn.silu(gate_c) * val, p['ffn_w_down']), new_buf


def _layer(x, p, gla_s0, conv_buf, ffn_buf, fox_past, chunk_a, chunk_b):
    m, st = _mixer(x, p, gla_s0, conv_buf, fox_past, chunk_a, chunk_b)
    x = _layer_norm(ALPHA * x + m, p['ln1_g'], p['ln1_b'])
    f, ffn_state = _ffn(x, p, ffn_buf)
    x = _layer_norm(ALPHA * x + f, p['ln2_g'], p['ln2_b'])
    return x, st + (ffn_state,)


def _gather_pages(pool, page_table):
    g = pool[page_table]
    return g.reshape(page_table.shape[0], -1, *pool.shape[2:])


def _stack(states, i):
    return jnp.stack([s[i] for s in states])


def setup_inputs(seed: int = 0) -> dict:
    key = jax.random.key(seed)
    ks = iter(jax.random.split(key, 48))

    def nrm(shape, scale):
        return jax.random.normal(next(ks), shape, F32) * scale

    n_pages = PAST_LEN // PAGE_SIZE
    n_used = DEC_BATCH * n_pages
    n_pool = n_used + n_used // 4
    return {
        'x_prompt': nrm((BATCH, SEQ, D_MODEL), 1.0),
        'x_sample': nrm((DEC_BATCH, DEC_SEQ, D_MODEL), 1.0),
        'cache_fox_k': nrm((DEPTH, n_pool, PAGE_SIZE, N_HEADS, HEAD_DIM), 1.0),
        'cache_fox_v': nrm((DEPTH, n_pool, PAGE_SIZE, N_HEADS, HEAD_DIM), 1.0),
        'cache_fox_logf': jax.nn.log_sigmoid(FOX_BF_INIT + nrm((DEPTH, n_pool, PAGE_SIZE, N_HEADS), 0.5)),
        'state_gla': nrm((DEPTH, DEC_BATCH, N_HEADS, GLA_DK, GLA_DV), 1.0),
        'state_conv': nrm((DEPTH, DEC_BATCH, CONV_WIDTH - 1, D_GROUP), 0.5),
        'state_ffn_conv': nrm((DEPTH, DEC_BATCH, FFN_CONV_WIDTH - 1, D_FF), 1.0),
        'page_table': jax.random.permutation(next(ks), n_pool)[:n_used].reshape(DEC_BATCH, n_pages).astype(jnp.int32),
        'w_in': nrm((DEPTH, D_MODEL, D_IN), D_MODEL ** -0.5),
        'gla_w_a': nrm((DEPTH, GLA_RANK, N_HEADS * GLA_DK), GLA_RANK ** -0.5),
        'gla_b_a': nrm((DEPTH, N_HEADS * GLA_DK), 0.1),
        'gla_norm_g': 1.0 + nrm((DEPTH, N_HEADS * GLA_DV), 0.1),
        'sgu_ln_g': 1.0 + nrm((DEPTH, D_GROUP), 0.1),
        'sgu_ln_b': nrm((DEPTH, D_GROUP), 0.01),
        'sgu_w': nrm((DEPTH, N_HEADS, SGU_CHUNK, SGU_CHUNK), SGU_CHUNK ** -0.5),
        'sgu_b': 1.0 + nrm((DEPTH, N_HEADS, SGU_CHUNK), 0.1),
        'fox_b_f': FOX_BF_INIT + nrm((DEPTH, N_HEADS), 0.5),
        'conv_w': nrm((DEPTH, CONV_WIDTH, D_GROUP), CONV_WIDTH ** -0.5),
        'conv_b': nrm((DEPTH, D_GROUP), 0.01),
        'conv_norm_g': 1.0 + nrm((DEPTH, D_GROUP), 0.1),
        'conv_norm_b': nrm((DEPTH, D_GROUP), 0.01),
        'w_o': nrm((DEPTH, D_MIX, D_MODEL), BETA * D_MIX ** -0.5),
        'ln1_g': 1.0 + nrm((DEPTH, D_MODEL), 0.1),
        'ln1_b': nrm((DEPTH, D_MODEL), 0.01),
        'ffn_w_up': nrm((DEPTH, D_MODEL, 2 * D_FF), D_MODEL ** -0.5),
        'ffn_conv_w': nrm((DEPTH, FFN_CONV_WIDTH, D_FF), FFN_CONV_WIDTH ** -0.5),
        'ffn_conv_b': nrm((DEPTH, D_FF), 0.01),
        'ffn_w_down': nrm((DEPTH, D_FF, D_MODEL), BETA * D_FF ** -0.5),
        'ln2_g': 1.0 + nrm((DEPTH, D_MODEL), 0.1),
        'ln2_b': nrm((DEPTH, D_MODEL), 0.01),
    }


def reference(x_prompt, x_sample, cache_fox_k, cache_fox_v, cache_fox_logf, state_gla, state_conv,
              state_ffn_conv, page_table, w_in, gla_w_a, gla_b_a, gla_norm_g, sgu_ln_g, sgu_ln_b, sgu_w,
              sgu_b, fox_b_f, conv_w, conv_b, conv_norm_g, conv_norm_b, w_o, ln1_g, ln1_b, ffn_w_up,
              ffn_conv_w, ffn_conv_b, ffn_w_down, ln2_g, ln2_b):
    B = x_prompt.shape[0]
    S = x_sample.shape[1]
    xp, xs = x_prompt, x_sample
    st_p, st_s = [], []
    for l in range(DEPTH):
        p = dict(w_in=w_in[l], gla_w_a=gla_w_a[l], gla_b_a=gla_b_a[l], gla_norm_g=gla_norm_g[l],
                 sgu_ln_g=sgu_ln_g[l], sgu_ln_b=sgu_ln_b[l], sgu_w=sgu_w[l], sgu_b=sgu_b[l],
                 fox_b_f=fox_b_f[l], conv_w=conv_w[l], conv_b=conv_b[l], conv_norm_g=conv_norm_g[l],
                 conv_norm_b=conv_norm_b[l], w_o=w_o[l], ln1_g=ln1_g[l], ln1_b=ln1_b[l],
                 ffn_w_up=ffn_w_up[l], ffn_conv_w=ffn_conv_w[l], ffn_conv_b=ffn_conv_b[l],
                 ffn_w_down=ffn_w_down[l], ln2_g=ln2_g[l], ln2_b=ln2_b[l])
        xp, sp = _layer(xp, p,
                        jnp.zeros((B, N_HEADS, GLA_DK, GLA_DV), F32),
                        jnp.zeros((B, CONV_WIDTH - 1, D_GROUP), xp.dtype),
                        jnp.zeros((B, FFN_CONV_WIDTH - 1, D_FF), xp.dtype),
                        None, GLA_CHUNK, SGU_CHUNK)
        fox_past = (_gather_pages(cache_fox_k[l], page_table),
                    _gather_pages(cache_fox_v[l], page_table),
                    _gather_pages(cache_fox_logf[l], page_table))
        xs, ss = _layer(xs, p, state_gla[l], state_conv[l], state_ffn_conv[l], fox_past, S, S)
        st_p.append(sp)
        st_s.append(ss)
    p_fox_k, p_fox_v, p_fox_logf = _stack(st_p, 0), _stack(st_p, 1), _stack(st_p, 2)
    p_gla, p_conv, p_ffn_conv = _stack(st_p, 3), _stack(st_p, 4), _stack(st_p, 6)
    s_fox_k, s_fox_v, s_fox_logf = _stack(st_s, 0), _stack(st_s, 1), _stack(st_s, 2)
    s_gla, s_conv, s_sgu_v, s_ffn_conv = _stack(st_s, 3), _stack(st_s, 4), _stack(st_s, 5), _stack(st_s, 6)
    return (xp, xs, p_fox_k, p_fox_v, p_fox_logf, p_gla, p_conv, p_ffn_conv,
            s_fox_k, s_fox_v, s_fox_logf, s_gla, s_conv, s_ffn_conv, s_sgu_v)
```

```cpp
#include <hip/hip_runtime.h>
#include <cstdio>
#include <cstdint>
__device__ __forceinline__ int ltid() { int t = threadIdx.x; asm volatile("" : "+v"(t)); return t; }
__device__ __forceinline__ int lbid() { int t = blockIdx.x; asm volatile("" : "+s"(t)); return t; }
__device__ __forceinline__ int lgrid() { int t = gridDim.x; asm volatile("" : "+s"(t)); return t; }
namespace pg8 {
#define PG8_LAS __attribute__((address_space(3)))
typedef unsigned short bf16_t;
typedef short bf16x8 __attribute__((ext_vector_type(8)));
typedef float f32x4 __attribute__((ext_vector_type(4)));
typedef unsigned u32x4 __attribute__((ext_vector_type(4)));
constexpr int BM = 256, BK = 64, HALF = 128, HTB = HALF * BK * 2  , STAGE_BYTES = 8 * HTB, NXCD = 8, WGM = 8;

__host__ __device__ __forceinline__ int lds_byte(int r, int c) { const int st = (r >> 4) * 2 + (c >> 5), rr = r & 15, cc = c & 31, ob = rr * 64 + cc * 2; return st * 1024 + (ob ^ (((ob >> 9) & 1) << 5)); }
__host__ __device__ __forceinline__ void stage_rc(int b, int& R, int& C) { const int st = b / 1024, sb = b % 1024, swz = sb ^ (((sb >> 9) & 1) << 5); R = (st >> 1) * 16 + swz / 64; C = (st & 1) * 32 + (swz % 64) / 2; }
__host__ __device__ __forceinline__ int perm32(int rho) { const int n = rho >> 4, i = rho & 15; return 8 * (i >> 2) + 4 * n + (i & 3); }

struct Unit { int pm, pn; };
struct Gemm { const bf16_t* A; const bf16_t* Bt; int M, N, K; };

struct StaticOrder {
    int nM, nN, nwg, G, c;
    __host__ __device__ void init(int M, int N, int G_, int c_) { nM = M / BM; nN = N / BM; nwg = nM * nN; G = G_; c = c_; }
    __host__ __device__ bool next(int i, Unit& u) const {
        const long L = (long)i * G + c; if (L >= nwg) return false;
        int wgid = (int)L; { const int q = nwg / NXCD, r = nwg % NXCD, xcd = wgid % NXCD, off = wgid / NXCD; wgid = (xcd < r ? xcd * (q + 1) : r * (q + 1) + (xcd - r) * q) + off; }
        const int nig = WGM * nN, gid = wgid / nig, fm = gid * WGM, gsz = (nM - fm) < WGM ? (nM - fm) : WGM;
        u.pm = fm + ((wgid % nig) % gsz); u.pn = (wgid % nig) / gsz; return true;
    }
    __device__ __forceinline__ void a_ready(const Unit&) const {}
    __device__ __forceinline__ void done(const Unit&) const {}
};

__device__ __forceinline__ unsigned cvt_pk_bf16(float lo, float hi) { unsigned r; asm volatile("v_cvt_pk_bf16_f32 %0, %1, %2" : "=v"(r) : "v"(lo), "v"(hi)); return r; }
typedef float f32x2 __attribute__((ext_vector_type(2)));

struct EpiBf16 {
    static constexpr bool PERM = true, AFTER_DRAIN = false;
    bf16_t* O; int ldc;
    __device__ __forceinline__ void operator()(const f32x4 (&acc)[2][2][4][2], const Unit& u, int wr, int wc, int fr, int fq) const {
        const int row0 = u.pm * BM + wr * 64 + fr; const int col0 = u.pn * BM + wc * 32 + 8 * fq;
#pragma unroll
        for (int ai = 0; ai < 2; ++ai)
#pragma unroll
            for (int m = 0; m < 4; ++m) { bf16_t* rowp = O + (size_t)(row0 + ai * HALF + m * 16) * ldc + col0;
#pragma unroll
                for (int bj = 0; bj < 2; ++bj) { const f32x4 v0 = acc[ai][bj][m][0], v1 = acc[ai][bj][m][1];
                    u32x4 w; w.x = cvt_pk_bf16(v0[0], v0[1]); w.y = cvt_pk_bf16(v0[2], v0[3]); w.z = cvt_pk_bf16(v1[0], v1[1]); w.w = cvt_pk_bf16(v1[2], v1[3]);
                    *(u32x4*)(rowp + bj * HALF) = w; } }
    }
};
struct EpiIn {
    static constexpr bool PERM = true, AFTER_DRAIN = false;
    bf16_t* H; float* lrf; float* out; int layer;
    static constexpr int ldc = 2816, pm_sample = 64; static constexpr float qscale = 0.125f * 1.4426950408889634f;
    static constexpr size_t O_PFK = 16908288, O_PFV = O_PFK + 8388608, O_SFK = 34156544, O_SFV = O_SFK + 65536;
    __device__ __forceinline__ void operator()(const f32x4 (&acc)[2][2][4][2], const Unit& u, int wr, int wc, int fr, int fq) const {
        const int row0 = u.pm * BM + wr * 64 + fr; const int col0 = u.pn * BM + wc * 32 + 8 * fq;
        const float sc = (u.pn == 5) ? qscale : 1.f;
#pragma unroll
        for (int ai = 0; ai < 2; ++ai)
#pragma unroll
            for (int m = 0; m < 4; ++m) { bf16_t* rowp = H + (size_t)(row0 + ai * HALF + m * 16) * ldc + col0;
#pragma unroll
                for (int bj = 0; bj < 2; ++bj) { const f32x4 v0 = acc[ai][bj][m][0] * sc, v1 = acc[ai][bj][m][1] * sc;
                    u32x4 w; w.x = cvt_pk_bf16(v0[0], v0[1]); w.y = cvt_pk_bf16(v0[2], v0[3]); w.z = cvt_pk_bf16(v1[0], v1[1]); w.w = cvt_pk_bf16(v1[2], v1[3]);
                    *(u32x4*)(rowp + bj * HALF) = w; } }
        if (u.pn == 6 || u.pn == 7) {
            const int lcol0 = wc * 32 + 8 * fq;
#pragma unroll
            for (int ai = 0; ai < 2; ++ai) {
                float* dst; int rbase;
                if (u.pm < pm_sample) { dst = out + ((u.pn == 6) ? O_PFK : O_PFV) + (size_t)layer * (16384 * 256); rbase = u.pm * BM; }
                else { if (ai == 1) continue; dst = out + ((u.pn == 6) ? O_SFK : O_SFV) + (size_t)layer * (128 * 256); rbase = 0; }
#pragma unroll
                for (int m = 0; m < 4; ++m) { float* rowp = dst + (size_t)(rbase + wr * 64 + fr + ai * HALF + m * 16) * 256 + lcol0;
#pragma unroll
                    for (int bj = 0; bj < 2; ++bj) { *(f32x4*)(rowp + bj * HALF) = acc[ai][bj][m][0]; *(f32x4*)(rowp + bj * HALF + 4) = acc[ai][bj][m][1]; } }
            }
        }
        if (u.pn == 10 && wc == 0) {
#pragma unroll
            for (int ai = 0; ai < 2; ++ai)
#pragma unroll
                for (int m = 0; m < 4; ++m) { float* rowp = lrf + (size_t)(row0 + ai * HALF + m * 16) * 32 + 8 * fq;
                    *(f32x4*)(rowp) = acc[ai][0][m][0]; *(f32x4*)(rowp + 4) = acc[ai][0][m][1]; }
        }
    }
};
struct EpiRes {
    static constexpr bool PERM = false, AFTER_DRAIN = false;
    const float* R; float* Z; int ldc; float alpha;
    __device__ __forceinline__ void operator()(const f32x4 (&acc)[2][2][4][2], const Unit& u, int wr, int wc, int fr, int fq) const {
        const int row0 = u.pm * BM + wr * 64 + fr; const int col0 = u.pn * BM + wc * 32 + 4 * fq;
#pragma unroll
        for (int ai = 0; ai < 2; ++ai)
#pragma unroll
            for (int m = 0; m < 4; ++m) { const size_t off = (size_t)(row0 + ai * HALF + m * 16) * ldc + col0;
#pragma unroll
                for (int bj = 0; bj < 2; ++bj)
#pragma unroll
                    for (int n = 0; n < 2; ++n) { const f32x4 r = *(const f32x4*)(R + off + bj * HALF + n * 16); *(f32x4*)(Z + off + bj * HALF + n * 16) = r * alpha + acc[ai][bj][m][n]; } }
    }
};

template <class Epi, class Sched, bool ALIGN_EPI = false, bool SP2 = false>
__device__ __forceinline__ void gemm_phase(PG8_LAS unsigned char* lds, const Gemm g, const Sched& S, const Epi& E) {
    const int tid = ltid(), wid = __builtin_amdgcn_readfirstlane(tid >> 6), lane = tid & 63, wr = wid >> 2, wc = wid & 3, fr = lane & 15, fq = lane >> 4;
    const int K = g.K, nt = K / BK;
    unsigned voffA[2], voffB[2];
#pragma unroll
    for (int i = 0; i < 2; ++i) { int R, C; stage_rc(tid * 16 + i * 8192, R, C); const int Rb = Epi::PERM ? ((R & ~31) + perm32(R & 31)) : R;
        voffA[i] = (unsigned)(R * K + C) * 2u; voffB[i] = (unsigned)(Rb * K + C) * 2u; }
    const size_t kstep = (size_t)(BK * 2);
    const size_t hstep = (size_t)HALF * K * 2;
    const size_t tstep = 2 * hstep;
    const unsigned ldsw = (unsigned)wid * 1024u;
    const int aoff = lds_byte(wr * 64 + fr, fq * 8), boff = lds_byte(wc * 32 + fr, fq * 8);
#define PG8_SA(b, h) (((b) * 2 + (h)) * HTB)
#define PG8_SB(b, h) ((4 + (b) * 2 + (h)) * HTB)
#define PG8_STAGE(bufoff, gbase, voff) do { _Pragma("unroll") for (int _i = 0; _i < 2; ++_i) \
        __builtin_amdgcn_global_load_lds((const unsigned*)((const char*)(gbase) + (voff)[_i]), (PG8_LAS unsigned*)(lds + (bufoff) + ldsw + _i * 8192), 16, 0, 0); } while (0)
#define PG8_LDA(dst, b, h) do { _Pragma("unroll") for (int m = 0; m < 4; ++m) _Pragma("unroll") for (int k = 0; k < 2; ++k) dst[m][k] = *(const PG8_LAS bf16x8*)(lds + PG8_SA(b, h) + aoff + m * 2048 + k * 1024); } while (0)
#define PG8_LDB(dst, b, h) do { _Pragma("unroll") for (int n = 0; n < 2; ++n) _Pragma("unroll") for (int k = 0; k < 2; ++k) dst[n][k] = *(const PG8_LAS bf16x8*)(lds + PG8_SB(b, h) + boff + n * 2048 + k * 1024); } while (0)
#define PG8_MMA(ai, bj, At, Bt) do { __builtin_amdgcn_s_setprio(1); _Pragma("unroll") for (int m = 0; m < 4; ++m) _Pragma("unroll") for (int n = 0; n < 2; ++n) _Pragma("unroll") for (int k = 0; k < 2; ++k) \
        acc[ai][bj][m][n] = __builtin_amdgcn_mfma_f32_16x16x32_bf16(Bt[n][k], At[m][k], acc[ai][bj][m][n], 0, 0, 0); __builtin_amdgcn_s_setprio(0); } while (0)
#define PG8_WAIT_V(n) asm volatile("s_waitcnt vmcnt(" #n ")" ::: "memory")
#define PG8_WAIT_L(n) asm volatile("s_waitcnt lgkmcnt(" #n ")" ::: "memory")
#define PG8_BAR __builtin_amdgcn_s_barrier()
#define PG8_SCHED __builtin_amdgcn_sched_barrier(0)
    Unit cur, nxt; int ui = 0;
    if (!S.next(0, cur)) return;
    f32x4 acc[2][2][4][2];
#pragma unroll
    for (int a = 0; a < 2; ++a)
#pragma unroll
        for (int b = 0; b < 2; ++b)
#pragma unroll
            for (int m = 0; m < 4; ++m)
#pragma unroll
                for (int n = 0; n < 2; ++n) acc[a][b][m][n] = (f32x4){0.f, 0.f, 0.f, 0.f};
    bf16x8 At[4][2], B0[2][2], B1[2][2];
    const char* cA = (const char*)g.A + (size_t)cur.pm * tstep; const char* cB = (const char*)g.Bt + (size_t)cur.pn * tstep;
    S.a_ready(cur);
    if constexpr (SP2) {
        PG8_STAGE(PG8_SB(0, 0), cB, voffB); PG8_STAGE(PG8_SB(0, 1), cB + hstep, voffB); PG8_STAGE(PG8_SA(0, 0), cA, voffA); PG8_STAGE(PG8_SA(0, 1), cA + hstep, voffA);
        if (wr == 1) PG8_BAR;
        PG8_WAIT_V(2); PG8_BAR;
        PG8_STAGE(PG8_SB(1, 0), cB + kstep, voffB); PG8_STAGE(PG8_SA(1, 0), cA + kstep, voffA); PG8_STAGE(PG8_SB(1, 1), cB + hstep + kstep, voffB);
        PG8_WAIT_V(6); PG8_BAR;
    } else {
        PG8_STAGE(PG8_SB(0, 0), cB, voffB); PG8_STAGE(PG8_SA(0, 0), cA, voffA); PG8_STAGE(PG8_SB(0, 1), cB + hstep, voffB); PG8_STAGE(PG8_SA(0, 1), cA + hstep, voffA);
        if (wr == 1) PG8_BAR;
        PG8_WAIT_V(4); PG8_BAR;
        PG8_STAGE(PG8_SB(1, 0), cB + kstep, voffB); PG8_STAGE(PG8_SA(1, 0), cA + kstep, voffA); PG8_STAGE(PG8_SB(1, 1), cB + hstep + kstep, voffB);
        PG8_WAIT_V(6); PG8_BAR;
    }
    for (;;) {
        const bool has_next = S.next(ui + 1, nxt);
        const char* nA = has_next ? (const char*)g.A + (size_t)nxt.pm * tstep : cA; const char* nB = has_next ? (const char*)g.Bt + (size_t)nxt.pn * tstep : cB;
        for (int t = 0; t < nt; t += 2) {
            const bool last = (t == nt - 2);
            const char* a1 = cA + (size_t)(t + 1) * kstep;
            const char* a2 = last ? nA : cA + (size_t)(t + 2) * kstep; const char* b2 = last ? nB : cB + (size_t)(t + 2) * kstep;
            const char* a3 = a2 + kstep; const char* b3 = b2 + kstep;
            if (last && has_next) S.a_ready(nxt);
            if constexpr (SP2) {
            PG8_LDB(B0, 0, 0); PG8_LDB(B1, 0, 1); PG8_SCHED; PG8_LDA(At, 0, 0); PG8_STAGE(PG8_SA(1, 1), a1 + hstep, voffA);
            PG8_WAIT_V(8); PG8_WAIT_L(0); PG8_BAR; PG8_MMA(0, 0, At, B0); PG8_MMA(0, 1, At, B1); PG8_BAR; PG8_SCHED;
            PG8_LDA(At, 0, 1); PG8_STAGE(PG8_SB(0, 0), b2, voffB); PG8_STAGE(PG8_SB(0, 1), b2 + hstep, voffB); PG8_STAGE(PG8_SA(0, 0), a2, voffA);
            PG8_WAIT_V(8); PG8_WAIT_L(0); PG8_BAR; PG8_MMA(1, 0, At, B0); PG8_MMA(1, 1, At, B1); PG8_BAR; PG8_SCHED;
            PG8_LDB(B0, 1, 0); PG8_LDB(B1, 1, 1); PG8_SCHED; PG8_LDA(At, 1, 0); PG8_STAGE(PG8_SA(0, 1), a2 + hstep, voffA);
            PG8_WAIT_V(8); PG8_WAIT_L(0); PG8_BAR; PG8_MMA(0, 0, At, B0); PG8_MMA(0, 1, At, B1); PG8_BAR; PG8_SCHED;
            PG8_LDA(At, 1, 1); PG8_STAGE(PG8_SB(1, 0), b3, voffB); PG8_STAGE(PG8_SB(1, 1), b3 + hstep, voffB); PG8_STAGE(PG8_SA(1, 0), a3, voffA);
            PG8_WAIT_V(8); PG8_WAIT_L(0); PG8_BAR; PG8_MMA(1, 0, At, B0); PG8_MMA(1, 1, At, B1); PG8_BAR; PG8_SCHED;
            } else {
            PG8_LDB(B0, 0, 0); PG8_SCHED; PG8_LDA(At, 0, 0); PG8_STAGE(PG8_SA(1, 1), a1 + hstep, voffA);
            PG8_WAIT_L(8); PG8_BAR; PG8_WAIT_L(0); PG8_MMA(0, 0, At, B0); PG8_BAR; PG8_SCHED;
            PG8_LDB(B1, 0, 1); PG8_STAGE(PG8_SB(0, 0), b2, voffB);
            PG8_BAR; PG8_WAIT_L(0); PG8_MMA(0, 1, At, B1); PG8_BAR;
            PG8_LDA(At, 0, 1); PG8_STAGE(PG8_SA(0, 0), a2, voffA);
            PG8_BAR; PG8_WAIT_L(0); PG8_MMA(1, 0, At, B0); PG8_BAR; PG8_SCHED;
            PG8_STAGE(PG8_SB(0, 1), b2 + hstep, voffB);
            PG8_WAIT_V(6); PG8_BAR; PG8_MMA(1, 1, At, B1); PG8_BAR;
            PG8_LDB(B0, 1, 0); PG8_SCHED; PG8_LDA(At, 1, 0); PG8_STAGE(PG8_SA(0, 1), a2 + hstep, voffA);
            PG8_WAIT_L(8); PG8_BAR; PG8_WAIT_L(0); PG8_MMA(0, 0, At, B0); PG8_BAR; PG8_SCHED;
            PG8_LDB(B1, 1, 1); PG8_STAGE(PG8_SB(1, 0), b3, voffB);
            PG8_BAR; PG8_WAIT_L(0); PG8_MMA(0, 1, At, B1); PG8_BAR;
            PG8_LDA(At, 1, 1); PG8_STAGE(PG8_SA(1, 0), a3, voffA);
            PG8_BAR; PG8_WAIT_L(0); PG8_MMA(1, 0, At, B0); PG8_BAR; PG8_SCHED;
            PG8_STAGE(PG8_SB(1, 1), b3 + hstep, voffB);
            PG8_WAIT_V(6); PG8_BAR; PG8_MMA(1, 1, At, B1); PG8_BAR;
            }
        }
        if constexpr (ALIGN_EPI) { if (wr == 0) PG8_BAR; }
        if constexpr (!Epi::AFTER_DRAIN) { E(acc, cur, wr, wc, fr, fq); S.done(cur); }
        if (!has_next) break;
#pragma unroll
        for (int a = 0; a < 2; ++a)
#pragma unroll
            for (int b = 0; b < 2; ++b)
#pragma unroll
                for (int m = 0; m < 4; ++m)
#pragma unroll
                    for (int n = 0; n < 2; ++n) acc[a][b][m][n] = (f32x4){0.f, 0.f, 0.f, 0.f};
        cur = nxt; cA = nA; cB = nB; ++ui;
        if constexpr (ALIGN_EPI) { if (wr == 1) PG8_BAR; }
    }
    PG8_WAIT_V(0);
    if constexpr (!ALIGN_EPI) { if (wr == 0) PG8_BAR; }
    PG8_BAR;
    if constexpr (Epi::AFTER_DRAIN) { E.fused(acc, cur, wr, wc, fr, fq, lds, wid, lane); S.done(cur); }
#undef PG8_SA
#undef PG8_SB
#undef PG8_STAGE
#undef PG8_LDA
#undef PG8_LDB
#undef PG8_MMA
#undef PG8_WAIT_V
#undef PG8_WAIT_L
#undef PG8_BAR
#undef PG8_SCHED
}
}

#ifndef PG8_SP2
#define PG8_SP2 true
#endif

#include <hip/hip_bf16.h>
#include <cmath>
namespace attn_body {
using bf16=__hip_bfloat16;
using bf16x8=__attribute__((ext_vector_type(8)))short;
using s16x4=__attribute__((ext_vector_type(4)))short;
using f32x16=__attribute__((ext_vector_type(16)))float;
using u32x4=__attribute__((ext_vector_type(4)))unsigned;
constexpr int BATCH=8,NHEAD=4,SEQ=2048,D=64,DM=2816,DMO=1024;
constexpr int NW=8,QBLK=32,QB=QBLK*NW,KVBLK=64,NQB=SEQ/QB;
constexpr int ATTN_PITCH=DM, ATTN_UNIT_ROWS=QB;
__device__ __forceinline__ int crow(int r,int hi){return (r&3)+8*(r>>2)+4*hi;}
#define SBAR() __builtin_amdgcn_sched_barrier(0)
__device__ __forceinline__ void cmask(f32x16&p0,f32x16&p1,int jb,int qrel,int hi){
  const float NEG=-INFINITY; int kb=64*jb+4*hi;
  #pragma unroll
  for(int r=0;r<16;++r){int kv=kb+(r&3)+8*(r>>2); if(kv>qrel)p0[r]=NEG; if(kv+32>qrel)p1[r]=NEG;}
}

constexpr int NSLOT=3, SLOTB=8192;
constexpr int LDS_K=0, LDS_V=NSLOT*SLOTB, LDS_WS=2*NSLOT*SLOTB, LDS_OST=LDS_WS+NW*64*4, LDS_KB=LDS_OST+NW*4096, LDS_BYTES=LDS_KB+SEQ*4;
constexpr float C2=0.125f*1.4426950408889634f;
__device__ __forceinline__ void glds16(const void*gsrc,unsigned lds_dst){unsigned keep;
  asm volatile("s_mov_b32 %0, m0\n\ts_mov_b32 m0, %2\n\ts_nop 0\n\tglobal_load_lds_dwordx4 %1, off\n\ts_mov_b32 m0, %0":"=&s"(keep):"v"(gsrc),"s"(lds_dst):"memory");}
__device__ __forceinline__ float max3f(float a,float b,float c){float r;asm("v_max3_f32 %0, %1, %2, %3":"=v"(r):"v"(a),"v"(b),"v"(c));return r;}
__device__ __forceinline__ float max2f(float a,float b){float r;asm("v_max_f32_e32 %0, %1, %2":"=v"(r):"v"(a),"v"(b));return r;}
__device__ __forceinline__ float fadd_s(float a,float b){float r;asm("v_add_f32_e32 %0, %1, %2":"=v"(r):"v"(a),"v"(b));return r;}
__device__ __forceinline__ float fsub_s(float a,float b){float r;asm("v_sub_f32_e32 %0, %1, %2":"=v"(r):"v"(a),"v"(b));return r;}
typedef float f32x2_t __attribute__((ext_vector_type(2))); typedef __bf16 bf16x2_t __attribute__((ext_vector_type(2)));
__device__ __forceinline__ unsigned cvtpk_s(float lo,float hi){f32x2_t v={lo,hi};bf16x2_t b=__builtin_convertvector(v,bf16x2_t);return __builtin_bit_cast(unsigned,b);}
#define WAIT_BAR(N) asm volatile("s_waitcnt vmcnt(" #N ") lgkmcnt(0)\n\ts_barrier":::"memory")

__device__ __forceinline__ void qkt(f32x16&p0,f32x16&p1,const char*Kslot,const bf16x8*qr,const f32x16&c0,const f32x16&c1,int r32,int hi){
  const char*kb=Kslot+hi*1024+r32*16;
  #pragma unroll
  for(int d0=0;d0<4;++d0){
    const bf16x8 b0=*reinterpret_cast<const bf16x8*>(kb+d0*2048);
    const bf16x8 b1=*reinterpret_cast<const bf16x8*>(kb+d0*2048+512);
    if(d0==0){p0=__builtin_amdgcn_mfma_f32_32x32x16_bf16(b0,qr[0],c0,0,0,0);p1=__builtin_amdgcn_mfma_f32_32x32x16_bf16(b1,qr[0],c1,0,0,0);}
    else{p0=__builtin_amdgcn_mfma_f32_32x32x16_bf16(b0,qr[d0],p0,0,0,0);p1=__builtin_amdgcn_mfma_f32_32x32x16_bf16(b1,qr[d0],p1,0,0,0);}}
}
typedef __attribute__((address_space(3))) const char* lds_cptr;
typedef short v4i16_t __attribute__((ext_vector_type(4)));
__device__ __forceinline__ void kload8(bf16x8*kf,lds_cptr kp){
  kf[0]=*(const __attribute__((address_space(3))) bf16x8*)(kp);      kf[1]=*(const __attribute__((address_space(3))) bf16x8*)(kp+512);
  kf[2]=*(const __attribute__((address_space(3))) bf16x8*)(kp+2048); kf[3]=*(const __attribute__((address_space(3))) bf16x8*)(kp+2560);
  kf[4]=*(const __attribute__((address_space(3))) bf16x8*)(kp+4096); kf[5]=*(const __attribute__((address_space(3))) bf16x8*)(kp+4608);
  kf[6]=*(const __attribute__((address_space(3))) bf16x8*)(kp+6144); kf[7]=*(const __attribute__((address_space(3))) bf16x8*)(kp+6656);
}
__device__ __forceinline__ void kload2(bf16x8*kf,lds_cptr kp,int j){ kf[2*j]=*(const __attribute__((address_space(3))) bf16x8*)(kp+j*2048); kf[2*j+1]=*(const __attribute__((address_space(3))) bf16x8*)(kp+j*2048+512); }
__device__ __forceinline__ s16x4 vtr(lds_cptr p){ return __builtin_bit_cast(s16x4,__builtin_amdgcn_ds_read_tr16_b64_v4i16((__attribute__((address_space(3))) v4i16_t*)p)); }
__device__ __forceinline__ float rowmax(const f32x16&p0,const f32x16&p1){
  float a=max3f(p0[0],p0[1],p1[0]),b=max3f(p0[2],p0[3],p1[1]);a=max3f(a,p1[2],p1[3]);
  #pragma unroll
  for(int r=4;r<16;r+=4){a=max3f(a,p0[r],p0[r+1]);b=max3f(b,p0[r+2],p0[r+3]);a=max3f(a,p1[r],p1[r+1]);b=max3f(b,p1[r+2],p1[r+3]);}
  const float m=max2f(a,b);
  auto rr=__builtin_amdgcn_permlane32_swap(__float_as_uint(m),__float_as_uint(m),false,false);
  return max2f(__uint_as_float(rr[0]),__uint_as_float(rr[1]));
}
__device__ __forceinline__ void pv(f32x16*o,int vb,bf16x8 pa0,bf16x8 pa1,bf16x8 pa2,bf16x8 pa3){
  #pragma unroll
  for(int d0=0;d0<2;++d0){s16x4 lo[4],hi[4];
    #pragma unroll
    for(int ks=0;ks<4;++ks){
      asm volatile("ds_read_b64_tr_b16 %0,%1 offset:%c2":"=&v"(lo[ks]):"v"(vb),"i"(d0*4096+ks*1024):"memory");
      asm volatile("ds_read_b64_tr_b16 %0,%1 offset:%c2":"=&v"(hi[ks]):"v"(vb),"i"(d0*4096+ks*1024+512):"memory");}
    asm volatile("s_waitcnt lgkmcnt(0)":::"memory");SBAR();
    #define PK(k) (bf16x8){lo[k][0],lo[k][1],lo[k][2],lo[k][3],hi[k][0],hi[k][1],hi[k][2],hi[k][3]}
    o[d0]=__builtin_amdgcn_mfma_f32_32x32x16_bf16(pa0,PK(0),o[d0],0,0,0);
    o[d0]=__builtin_amdgcn_mfma_f32_32x32x16_bf16(pa1,PK(1),o[d0],0,0,0);
    o[d0]=__builtin_amdgcn_mfma_f32_32x32x16_bf16(pa2,PK(2),o[d0],0,0,0);
    o[d0]=__builtin_amdgcn_mfma_f32_32x32x16_bf16(pa3,PK(3),o[d0],0,0,0);
    #undef PK
  }
}

#ifndef ATTN_STORE16
#define ATTN_STORE16(p,v) (*(u32x4*)(p)=(v))
#endif
template<int THRL> __device__ __forceinline__ void attn_unit(int b,int h,int qb,const bf16*Q,const bf16*__restrict__ K,const bf16*__restrict__ V,bf16*O,const float*__restrict__ KBg,char*shm){
  const int tid=ltid(),lane=tid&63,r32=lane&31,hi=lane>>5; const int wid=__builtin_amdgcn_readfirstlane(tid>>6);
  const long rowbase=(long)b*SEQ; const int q0=qb*QB;
  const bf16*Qw=Q+(rowbase+q0+wid*QBLK)*DM+h*D;
  const bf16*Kh=K+rowbase*DM+h*D,*Vh=V+rowbase*DM+h*D;
  const lds_cptr shm3=(lds_cptr)shm;
  const unsigned lds0=(unsigned)(uintptr_t)shm;
  float*wsf=(float*)(shm+LDS_WS)+wid*64;
  const bf16*ksrc=Kh+(long)lane*DM+wid*8;
  const bf16*vsrc=Vh+(long)(16*(wid&3)+(lane>>2))*DM+(wid>>2)*32+(lane&3)*8;
  const unsigned kdst=lds0+LDS_K+wid*1024, vdst=lds0+LDS_V+wid*1024;
  #define DMA_K(t,slot) glds16(ksrc+(long)(t)*KVBLK*DM,(unsigned)__builtin_amdgcn_readfirstlane(kdst+(slot)))
  #define DMA_V(t,slot) glds16(vsrc+(long)(t)*KVBLK*DM,(unsigned)__builtin_amdgcn_readfirstlane(vdst+(slot)))
  const int vb0=(int)(lds0+LDS_V)+((lane>>4)&1)*32+(lane&3)*8+(4*hi+((lane&15)>>2))*64;
  const char*Kbase=shm+LDS_K; bf16x8 kf[8];
  const lds_cptr kp0=shm3+LDS_K+hi*1024+r32*16; const lds_cptr vp0=shm3+LDS_V+((lane>>4)&1)*32+(lane&3)*8+(4*hi+((lane&15)>>2))*64;
  const int NT=(q0+QB)/KVBLK;
  { typedef float f32x4_t __attribute__((ext_vector_type(4))); const int i4=tid*4; if(i4<q0+QB){ const f32x4_t kv=*(const f32x4_t*)(KBg+((long)(b*NHEAD+h))*SEQ+i4); *(__attribute__((address_space(3))) f32x4_t*)((lds_cptr)shm+LDS_KB+i4*4)=kv; } }
  typedef float kb4_t __attribute__((ext_vector_type(4))); const __attribute__((address_space(3))) kb4_t* kbp=(const __attribute__((address_space(3))) kb4_t*)(shm3+LDS_KB)+hi;
  DMA_K(0,0);DMA_V(0,0);DMA_K(1,SLOTB);
  bf16x8 qr[4];
  #pragma unroll
  for(int d0=0;d0<4;++d0)qr[d0]=*reinterpret_cast<const bf16x8*>(&Qw[(long)r32*DM+d0*16+hi*8]);
  float mhat=0.f,l_reg=0.f;f32x16 o[2];o[0]=f32x16{};o[1]=f32x16{};float nm=0.f;asm volatile("":"+v"(nm));
  #define NBIAS(N0,N1,t) do{ _Pragma("unroll") for(int g_=0;g_<4;++g_){ const kb4_t a_=kbp[16*(t)+2*g_], b_=kbp[16*(t)+2*g_+8]; \
      _Pragma("unroll") for(int i_=0;i_<4;++i_){ N0[4*g_+i_]=a_[i_]+nm; N1[4*g_+i_]=b_[i_]+nm; } } }while(0)
  const int qrel=wid*QBLK+r32;
  #define CMASK(P0,P1,t) do{int jb_=(t)-(NT-4); if(jb_>=0)cmask(P0,P1,jb_,qrel,hi);}while(0)
  bool resc=false;
  #define START(P0,P1) do{ const float rm=rowmax(P0,P1); resc=false; \
    { const float dl=rm; mhat=fadd_s(mhat,dl); \
      _Pragma("unroll") for(int r=0;r<16;++r){P0[r]=fsub_s(P0[r],dl);P1[r]=fsub_s(P1[r],dl);} \
      nm=-mhat; asm volatile("":"+v"(nm)); } \
    _Pragma("unroll") for(int r=0;r<16;++r)P0[r]=__builtin_amdgcn_exp2f(P0[r]); }while(0)
  #define RESC() do{ if(resc){ asm volatile("s_waitcnt lgkmcnt(0)":::"memory"); \
      _Pragma("unroll") for(int d_=0;d_<2;++d_) _Pragma("unroll") for(int r=0;r<16;++r)o[d_][r]*=wsf[crow(r,hi)]; } }while(0)
  f32x16 pA0,pA1,pB0,pB1;
  int sl_prev=0,sl_cur=0,sl_next=SLOTB;
  #define ROT() do{sl_prev=sl_cur;sl_cur=sl_next;sl_next=(sl_next==(NSLOT-1)*SLOTB)?0:sl_next+SLOTB;}while(0)
  DMA_K(2,2*SLOTB);
  WAIT_BAR(3);
  { f32x16 c0_,c1_; NBIAS(c0_,c1_,0); qkt(pA0,pA1,Kbase,qr,c0_,c1_,r32,hi); } asm volatile("s_nop 15\n\ts_nop 7":"+v"(pA0),"+v"(pA1));CMASK(pA0,pA1,0);
  START(pA0,pA1);
  _Pragma("unroll") for(int r=0;r<16;++r)pA1[r]=__builtin_amdgcn_exp2f(pA1[r]);
  WAIT_BAR(0);
  DMA_K(3,0);DMA_V(1,SLOTB);
  ROT();
  kload8(kf,kp0+sl_cur);
  WAIT_BAR(2);
  s16x4 vlo[8],vhi[8]; u32x4 pw0,pw1,pw2,pw3;
  #define PKW(P,B) cvtpk_s(P[B],P[B+1])
  #define PAF(k) __builtin_bit_cast(bf16x8,pw##k)
  #define VFR(i) (bf16x8){vlo[i][0],vlo[i][1],vlo[i][2],vlo[i][3],vhi[i][0],vhi[i][1],vhi[i][2],vhi[i][3]}
  #define PIN(x) asm volatile("":"+v"(x))
  #define MX3(a,b,c) __builtin_fmaxf(__builtin_fmaxf((a),(b)),(c))
  #define GAPA(MF,A0,A1,A2,A3,W0,W1,PW) do{ MF; sacc+=A0; sacc+=A1; sacc+=A2; sacc+=A3; PIN(sacc); W0; W1; PIN(PW); SBAR(); }while(0)
  #define EX(v) __builtin_amdgcn_exp2f(v)
  #define GAPB(MF,X,B) do{ MF; X[B]=EX(X[B]); X[B+1]=EX(X[B+1]); X[B+2]=EX(X[B+2]); X[B+3]=EX(X[B+3]); PIN(X); SBAR(); }while(0)
  #define VRD(i) do{ vlo[i]=vtr(vp_+(((i)>>2)*4096+((i)&3)*1024)); vhi[i]=vtr(vp_+(((i)>>2)*4096+((i)&3)*1024+512)); }while(0)
  #define KRD(G,j) do{ if(G){ kload2(kf,kp0+sl_next,j); SBAR(); } }while(0)
  #define STEP(C0,C1,P0,P1,t,GK,GV,GL) do{ SBAR(); \
    const lds_cptr vp_=vp0+sl_prev; \
    NBIAS(C0,C1,t); SBAR(); \
    VRD(0); SBAR(); float sacc=(P0[0]+P0[1]); \
    GAPA(C0=__builtin_amdgcn_mfma_f32_32x32x16_bf16(kf[0],qr[0],C0,0,0,0), P0[2],P0[3],P0[4],P0[5],     pw0[0]=PKW(P0,0), pw0[1]=PKW(P0,2), pw0); \
    VRD(4); SBAR(); GAPA(C1=__builtin_amdgcn_mfma_f32_32x32x16_bf16(kf[1],qr[0],C1,0,0,0), P0[6],P0[7],P0[8],P0[9],     pw0[2]=PKW(P0,4), pw0[3]=PKW(P0,6), pw0); \
    VRD(1); SBAR(); GAPA(C0=__builtin_amdgcn_mfma_f32_32x32x16_bf16(kf[2],qr[1],C0,0,0,0),   P0[10],P0[11],P0[12],P0[13], pw1[0]=PKW(P0,8), pw1[1]=PKW(P0,10), pw1); \
    VRD(5); SBAR(); GAPA(C1=__builtin_amdgcn_mfma_f32_32x32x16_bf16(kf[3],qr[1],C1,0,0,0),   P0[14],P0[15],P1[0],P1[1],   pw1[2]=PKW(P0,12),pw1[3]=PKW(P0,14), pw1); \
    VRD(2); SBAR(); GAPA(C0=__builtin_amdgcn_mfma_f32_32x32x16_bf16(kf[4],qr[2],C0,0,0,0),   P1[2],P1[3],P1[4],P1[5],     pw2[0]=PKW(P1,0), pw2[1]=PKW(P1,2), pw2); \
    VRD(6); SBAR(); GAPA(C1=__builtin_amdgcn_mfma_f32_32x32x16_bf16(kf[5],qr[2],C1,0,0,0),   P1[6],P1[7],P1[8],P1[9],     pw2[2]=PKW(P1,4), pw2[3]=PKW(P1,6), pw2); \
    VRD(3); SBAR(); GAPA(C0=__builtin_amdgcn_mfma_f32_32x32x16_bf16(kf[6],qr[3],C0,0,0,0),   P1[10],P1[11],P1[12],P1[13], pw3[0]=PKW(P1,8), pw3[1]=PKW(P1,10), pw3); \
    VRD(7); SBAR(); GAPA(C1=__builtin_amdgcn_mfma_f32_32x32x16_bf16(kf[7],qr[3],C1,0,0,0),   P1[14],P1[15],0.f,0.f,       pw3[2]=PKW(P1,12),pw3[3]=PKW(P1,14), pw3); \
    l_reg+=sacc; \
    if(GK){DMA_K((t)+3,sl_cur);} if(GV){DMA_V((t)+1,sl_next);} \
    CMASK(C0,C1,t); \
    { float a=MX3(C0[0],C0[1],C1[0]),b=MX3(C0[2],C0[3],C1[1]); a=MX3(a,C1[2],C1[3]); \
      _Pragma("unroll") for(int r=4;r<16;r+=4){a=MX3(a,C0[r],C0[r+1]);b=MX3(b,C0[r+2],C0[r+3]);a=MX3(a,C1[r],C1[r+1]);b=MX3(b,C1[r+2],C1[r+3]);} \
      float rm=__builtin_fmaxf(a,b); { auto rr=__builtin_amdgcn_permlane32_swap(__float_as_uint(rm),__float_as_uint(rm),false,false); rm=__builtin_fmaxf(__uint_as_float(rr[0]),__uint_as_float(rr[1])); } \
      resc=false; \
      if(__builtin_expect(__any(rm>(float)THRL),0)){ const float dl=__builtin_fmaxf(rm,0.f); mhat+=dl; \
        _Pragma("unroll") for(int r=0;r<16;++r){C0[r]-=dl;C1[r]-=dl;} \
        nm=-mhat; asm volatile("":"+v"(nm)); \
        const float f=__builtin_amdgcn_exp2f(-dl); l_reg*=f; if(hi==0)wsf[r32]=f; resc=true; } } \
    SBAR(); \
    GAPB(o[0]=__builtin_amdgcn_mfma_f32_32x32x16_bf16(PAF(0),VFR(0),o[0],0,0,0), C0,0); \
    GAPB(o[1]=__builtin_amdgcn_mfma_f32_32x32x16_bf16(PAF(0),VFR(4),o[1],0,0,0), C0,4); \
    KRD(GL,0); GAPB(o[0]=__builtin_amdgcn_mfma_f32_32x32x16_bf16(PAF(1),VFR(1),o[0],0,0,0), C0,8); \
    KRD(GL,1); GAPB(o[1]=__builtin_amdgcn_mfma_f32_32x32x16_bf16(PAF(1),VFR(5),o[1],0,0,0), C0,12); \
    KRD(GL,2); GAPB(o[0]=__builtin_amdgcn_mfma_f32_32x32x16_bf16(PAF(2),VFR(2),o[0],0,0,0), C1,0); \
    KRD(GL,3); GAPB(o[1]=__builtin_amdgcn_mfma_f32_32x32x16_bf16(PAF(2),VFR(6),o[1],0,0,0), C1,4); \
    GAPB(o[0]=__builtin_amdgcn_mfma_f32_32x32x16_bf16(PAF(3),VFR(3),o[0],0,0,0), C1,8); \
    GAPB(o[1]=__builtin_amdgcn_mfma_f32_32x32x16_bf16(PAF(3),VFR(7),o[1],0,0,0), C1,12); \
    }while(0)
  int t=1;
  #undef CMASK
  #define CMASK(P0,P1,t) do{}while(0)
  for(;t+5<NT;t+=2){
    STEP(pB0,pB1,pA0,pA1,t,true,true,true);     WAIT_BAR(2); RESC(); ROT();
    STEP(pA0,pA1,pB0,pB1,t+1,true,true,true);   WAIT_BAR(2); RESC(); ROT();
  }
  #undef CMASK
  #define CMASK(P0,P1,t) do{int jb_=(t)-(NT-4); if(jb_>=0)cmask(P0,P1,jb_,qrel,hi);}while(0)
  #define ENDW(tt) do{ if((tt)+3<NT){WAIT_BAR(2);} else if((tt)+2<NT){WAIT_BAR(1);} else {WAIT_BAR(0);} }while(0)
  for(;t+1<NT;t+=2){
    STEP(pB0,pB1,pA0,pA1,t,(t+3<NT),(t+1<NT),(t+1<NT));       ENDW(t);   RESC(); ROT();
    STEP(pA0,pA1,pB0,pB1,t+1,(t+4<NT),(t+2<NT),(t+2<NT));     ENDW(t+1); RESC(); ROT();
  }
  STEP(pB0,pB1,pA0,pA1,NT-1,false,false,false); RESC();
  { float sacc=pB0[0]+pB0[1]; _Pragma("unroll") for(int r=2;r<16;++r)sacc+=pB0[r]; _Pragma("unroll") for(int r=0;r<16;++r)sacc+=pB1[r]; l_reg+=sacc;
    pw0=(u32x4){PKW(pB0,0),PKW(pB0,2),PKW(pB0,4),PKW(pB0,6)};pw1=(u32x4){PKW(pB0,8),PKW(pB0,10),PKW(pB0,12),PKW(pB0,14)};pw2=(u32x4){PKW(pB1,0),PKW(pB1,2),PKW(pB1,4),PKW(pB1,6)};pw3=(u32x4){PKW(pB1,8),PKW(pB1,10),PKW(pB1,12),PKW(pB1,14)};
    SBAR(); pv(o,vb0+sl_cur,PAF(0),PAF(1),PAF(2),PAF(3)); }
  #undef PKW
  #undef PAF
  #undef VFR
  #undef PIN
  #undef MX3
  #undef GAPA
  #undef GAPB
  #undef EX
  #undef VRD
  #undef KRD
  #undef STEP
  #undef ENDW
  {auto rr=__builtin_amdgcn_permlane32_swap(__float_as_uint(l_reg),__float_as_uint(l_reg),false,false);l_reg=__uint_as_float(rr[0])+__uint_as_float(rr[1]);}
  if(hi==0)wsf[32+r32]=l_reg;asm volatile("s_waitcnt lgkmcnt(0)":::"memory");
  float rli[16];
  #pragma unroll
  for(int r=0;r<16;++r)rli[r]=__builtin_amdgcn_rcpf(wsf[32+crow(r,hi)]);
  bf16*Ow=O+(rowbase+q0+wid*QBLK)*DMO+h*D;
  { bf16*stg=(bf16*)(shm+LDS_OST)+wid*2048;
    #pragma unroll
    for(int r=0;r<16;++r){const int orow=crow(r,hi);
      #pragma unroll
      for(int d0=0;d0<2;++d0)stg[orow*64+d0*32+r32]=__float2bfloat16(o[d0][r]*rli[r]);}
    asm volatile("s_waitcnt lgkmcnt(0)":::"memory");
    #pragma unroll
    for(int i=0;i<4;++i){const int row=i*8+(lane>>3),ch=lane&7; const u32x4 v=*(const u32x4*)(stg+row*64+ch*8); ATTN_STORE16(Ow+(long)row*DMO+ch*8,v);} }
  asm volatile("s_waitcnt lgkmcnt(0)\n\ts_barrier":::"memory");
  #undef NBIAS
  #undef DMA_K
  #undef DMA_V
  #undef CMASK
  #undef START
  #undef RESC
  #undef ROT
}
constexpr int ATTN_LDS_BYTES=LDS_BYTES;
struct AttnTensors { const bf16* Q; const bf16* K; const bf16* V; bf16* O; const float* KB; };
struct AttnUnit { int bh; int qb; };
struct StaticOrder {
  int vcu;
  __device__ __forceinline__ explicit StaticOrder(int grid,int block):vcu((block%8)*(grid/8)+block/8){}
  __device__ __forceinline__ bool next(int i,AttnUnit&u)const{ if(i>=4)return false; const int s=vcu&7; u.bh=vcu>>3; u.qb=(i==0)?s:(i==1)?15-s:(i==2)?16+s:31-s; return true; }
  __device__ __forceinline__ void a_ready(const AttnUnit&)const{}
  __device__ __forceinline__ void done(const AttnUnit&)const{}
};
template<class Sched,int THRL=8> __device__ __forceinline__ void attn_phase(char*lds,const AttnTensors&T,const Sched&S){
  AttnUnit u;
  for(int i=0;S.next(i,u);++i){ S.a_ready(u); attn_unit<THRL>(u.bh/NHEAD,u.bh%NHEAD,u.qb,T.Q,T.K,T.V,T.O,T.KB,lds); S.done(u); }
}
#undef SBAR
#undef WAIT_BAR
}

#define GAS __attribute__((address_space(1)))
#define LAS __attribute__((address_space(3)))
typedef unsigned short bf16;
typedef unsigned v4u __attribute__((ext_vector_type(4)));
typedef float f32x4 __attribute__((ext_vector_type(4)));
typedef short bf16x8 __attribute__((ext_vector_type(8)));
typedef GAS unsigned gu32;
typedef GAS unsigned long long gu64;
#define RLX_AGENT __ATOMIC_RELAXED, __HIP_MEMORY_SCOPE_AGENT
#define LDS_WAIT() asm volatile("s_waitcnt lgkmcnt(0)" ::: "memory")
#define VM_WAIT() asm volatile("s_waitcnt vmcnt(0)" ::: "memory")
__device__ __forceinline__ unsigned long long rt() { return __builtin_amdgcn_s_memrealtime(); }
__device__ __forceinline__ unsigned f2bf(float f) { unsigned u = __builtin_bit_cast(unsigned, f); return (u + 0x7fffu + ((u >> 16) & 1u)) >> 16; }
__device__ __forceinline__ unsigned pk2(float lo, float hi) { return f2bf(lo) | (f2bf(hi) << 16); }

#define XB_TMO      128
#define XB_XCNT(j)  (256  + 64 * (j))
#define XB_XSUB(j)  (1280 + 64 * (j))
#define XB_XGEN(j)  (2304 + 64 * (j))
#define XB_TOP      3328
#define XB_TOPGEN   3392
#define XCD_BAR_WORDS 3456
#define XB_SPIN_CAP (1u << 18)

__device__ __forceinline__ unsigned xb_ld(unsigned* p)              { return __hip_atomic_load(p, __ATOMIC_RELAXED, __HIP_MEMORY_SCOPE_AGENT); }
__device__ __forceinline__ unsigned xb_add(unsigned* p, unsigned v) { return __hip_atomic_fetch_add(p, v, __ATOMIC_RELAXED, __HIP_MEMORY_SCOPE_AGENT); }
__device__ __forceinline__ unsigned xb_xcc_id() { return (unsigned)__builtin_amdgcn_s_getreg((3 << 11) | 20) & 0xFu; }
#define XB_SPIN(cond, bar) do { unsigned _sp = 0; while (cond) { __builtin_amdgcn_s_sleep(1); \
    if ((++_sp & 255u) == 0u) { if (xb_ld(&(bar)[XB_TMO])) break; if (_sp > XB_SPIN_CAP) { atomicAdd(&(bar)[XB_TMO], 1u); break; } } } } while (0)

struct XcdBarrier {
    unsigned* bar; unsigned x;
    volatile LAS unsigned* st;
};

__device__ __forceinline__ XcdBarrier xcd_barrier_post(unsigned* bar, volatile LAS unsigned* st) {
    XcdBarrier b; b.bar = bar; b.x = xb_xcc_id(); b.st = st;
    if (ltid() == 0) (void)xb_add(&bar[XB_XCNT(b.x)], 1u);
    return b;
}
__device__ __forceinline__ void xcd_barrier_complete(unsigned* bar, unsigned x, unsigned& nloc, unsigned& nx) {
    const unsigned G = lgrid();
    unsigned sum, cnt, mine, sp = 0u;
    for (;;) {
        sum = 0u; cnt = 0u; mine = 0u;
#pragma unroll
        for (unsigned j = 0; j < 16; ++j) { const unsigned c = xb_ld(&bar[XB_XCNT(j)]); sum += c; cnt += (c > 0u) ? 1u : 0u; mine = (j == x) ? c : mine; }
        if (sum == G) break;
        __builtin_amdgcn_s_sleep(1);
        if ((++sp & 255u) == 0u) { if (xb_ld(&bar[XB_TMO])) break; if (sp > XB_SPIN_CAP) { atomicAdd(&bar[XB_TMO], 1u); break; } }
    }
    nloc = mine > 0u ? mine : 1u; nx = cnt > 0u ? cnt : 1u;
}

__device__ __forceinline__ void xcd_barrier(const XcdBarrier& b) {
    asm volatile("s_waitcnt vmcnt(0)" ::: "memory");
    __syncthreads();
    if (ltid() == 0) {
        unsigned* bar = b.bar;
        __builtin_amdgcn_s_waitcnt(0);
        unsigned nloc = b.st[0], nx = b.st[1];
        if (nloc == 0u) { xcd_barrier_complete(bar, b.x, nloc, nx); b.st[0] = nloc; b.st[1] = nx; }
        const unsigned old = xb_add(&bar[XB_XSUB(b.x)], 1u);
        const unsigned gen = old / nloc;
        if (old + 1u == (gen + 1u) * nloc) {
            __builtin_amdgcn_fence(__ATOMIC_RELEASE, "agent");
            asm volatile("s_waitcnt vmcnt(0)" ::: "memory");
            const unsigned og = xb_add(&bar[XB_TOP], 1u);
            const unsigned tg = og / nx;
            if (og + 1u == (tg + 1u) * nx) xb_add(&bar[XB_TOPGEN], 1u);
            else XB_SPIN(xb_ld(&bar[XB_TOPGEN]) == tg, bar);
            __builtin_amdgcn_fence(__ATOMIC_ACQUIRE, "agent");
            xb_add(&bar[XB_XGEN(b.x)], 1u);
            asm volatile("s_waitcnt vmcnt(0)" ::: "memory");
        } else {
            XB_SPIN(xb_ld(&bar[XB_XGEN(b.x)]) == gen, bar);
            __builtin_amdgcn_fence(__ATOMIC_ACQUIRE, "agent");
            asm volatile("s_waitcnt vmcnt(0)" ::: "memory");
        }
    }
    __syncthreads();
}

constexpr int NWAVES = 8;
#ifndef MK_PER_PHASE
#define MK_PER_PHASE 0
#endif
namespace P {
constexpr int BATCH = 8, SEQ = 2048, DM = 1024, DEPTH = 2, DECB = 32, DECS = 4, PAST = 8192, PAGE = 128, NPAGES = 64, NPOOL = 2560;
constexpr int NH = 4, HD = 64, DG = 256, GDK = 32, GDV = 64, RANK = 16, DFF = 2688, CW = 31, DIN = 2580;
constexpr int MPR = BATCH * SEQ, MS = DECB * DECS, MREAL = MPR + MS, MP = 16640;
constexpr int NIN = 2816, NUP = 2 * DFF;
constexpr int HC_AQ = 0, HC_AK = 128, HC_AV = 256, HC_AG = 512, HC_BU = 768, HC_BV = 1024, HC_CQ = 1280, HC_CK = 1536, HC_CV = 1792, HC_D1 = 2048, HC_D2 = 2304, HC_LR = 2560, HC_CF = 2576;
constexpr float ALPHA = 1.4142135623730951f;
constexpr float EPS = 1e-5f, LOG2E = 1.4426950408889634f;
constexpr float QSCALE = 0.125f * 1.4426950408889634f;
constexpr size_t O_YP = 0, O_YS = O_YP + (size_t)MPR * DM, O_PFK = O_YS + (size_t)MS * DM, O_PFV = O_PFK + (size_t)DEPTH * MPR * 256, O_PFL = O_PFV + (size_t)DEPTH * MPR * 256,
    O_PGLA = O_PFL + (size_t)DEPTH * MPR * 4, O_PCONV = O_PGLA + (size_t)DEPTH * BATCH * NH * GDK * GDV, O_PFFN = O_PCONV + (size_t)DEPTH * BATCH * 30 * DG,
    O_SFK = O_PFFN + (size_t)DEPTH * BATCH * 2 * DFF, O_SFV = O_SFK + (size_t)DEPTH * MS * 256, O_SFL = O_SFV + (size_t)DEPTH * MS * 256, O_SGLA = O_SFL + (size_t)DEPTH * MS * 4,
    O_SCONV = O_SGLA + (size_t)DEPTH * DECB * NH * GDK * GDV, O_SFFN = O_SCONV + (size_t)DEPTH * DECB * 30 * DG, O_SSGU = O_SFFN + (size_t)DEPTH * DECB * 2 * DFF,
    O_END = O_SSGU + (size_t)DEPTH * MS * DG;
static_assert(O_END == 35714048, "output size");
enum { I_XP = 0, I_XS, I_CK, I_CV, I_CL, I_SGLA, I_SCONV, I_SFFN, I_PT, I_WIN, I_GWA, I_GBA, I_GNG, I_SLG, I_SLB, I_SW, I_SB, I_FBF, I_CVW, I_CVB, I_CNG, I_CNB, I_WO, I_L1G, I_L1B,
       I_WUP, I_FCW, I_FCB, I_WDN, I_L2G, I_L2B, N_IN };
constexpr size_t MiB = 1u << 20;
constexpr size_t WS_CTL = 0, CTL_ZERO_BYTES = 1 * MiB;
constexpr size_t WS_WIN = 2 * MiB, SZ_WIN = (size_t)NIN * DM * 2;
constexpr size_t WS_WO = WS_WIN + 2 * SZ_WIN, SZ_WO = (size_t)DM * DM * 2;
constexpr size_t WS_WUP = WS_WO + 2 * SZ_WO, SZ_WUP = (size_t)NUP * DM * 2;
constexpr size_t WS_WDN = WS_WUP + 2 * SZ_WUP, SZ_WDN = (size_t)DM * DFF * 2;
constexpr size_t WS_PS = WS_WDN + 2 * SZ_WDN;
constexpr size_t WS_LRF = WS_PS + 1 * MiB;
constexpr size_t WS_KBIAS = WS_LRF + 3 * MiB;
constexpr size_t WS_DELTA = WS_KBIAS + 1 * MiB;
constexpr size_t WS_GAMMA = WS_DELTA + 8 * MiB;
constexpr size_t WS_PART = WS_GAMMA + 1 * MiB;
constexpr size_t WS_ML = WS_PART + 8 * MiB;
constexpr size_t WS_XF = WS_ML + 1 * MiB, SZ_F32 = (size_t)MP * DM * 4, SZ_B16 = (size_t)MP * DM * 2;
constexpr size_t WS_XB = WS_XF + SZ_F32;
constexpr size_t WS_H = WS_XB + SZ_B16;
constexpr size_t WS_Y = WS_H + (size_t)MP * NIN * 2;
constexpr size_t WS_Z = WS_Y + SZ_B16;
constexpr size_t WS_X1F = WS_Z + SZ_F32;
constexpr size_t WS_X1B = WS_X1F + SZ_F32;
constexpr size_t WS_G = WS_X1B + SZ_B16;
constexpr size_t WS_ACT = WS_G + (size_t)MP * NUP * 2;
constexpr size_t WS_END = WS_ACT + (size_t)MP * DFF * 2;
static_assert(WS_PS % 256 == 0 && WS_XF % 256 == 0 && WS_H % 256 == 0 && WS_G % 256 == 0 && WS_ACT % 256 == 0, "alignment");
constexpr int CW_BAR = 4096;
constexpr int CW_Q = 16384;
constexpr int PH_PER_LAYER = 9, N_PHASES = 1 + DEPTH * PH_PER_LAYER;
constexpr int RING_BYTES = 131072, MISC_OFF = RING_BYTES + 320, LDS_BYTES = 147456;
}

struct Args { const float* p[P::N_IN + 2]; int ph_lo, ph_hi; };
#define AIN(k) (A.p[(k) + z])
#define AOUT ((float*)A.p[P::N_IN + z])
#define AWS ((unsigned char*)A.p[P::N_IN + 1 + z])
#define OPAQUE_ZERO() ({ int z_ = 0; asm volatile("" : "+s"(z_)); z_; })
static_assert(sizeof(Args) == (P::N_IN + 2) * 8 + 8, "Args has no padding");

struct Frame {
    LAS unsigned char* lds; volatile LAS unsigned* MISC; gu32* ctl; int tid, lane, wave, vcu, G;
};

__device__ __forceinline__ float bflo(unsigned u) { return __uint_as_float(u << 16); }
__device__ __forceinline__ float bfhi(unsigned u) { return __uint_as_float(u & 0xffff0000u); }
__device__ __forceinline__ float bf1(bf16 v) { return __uint_as_float((unsigned)v << 16); }
__device__ __forceinline__ void unpack8(const v4u w, float (&f)[8]) { f[0] = bflo(w.x); f[1] = bfhi(w.x); f[2] = bflo(w.y); f[3] = bfhi(w.y); f[4] = bflo(w.z); f[5] = bfhi(w.z); f[6] = bflo(w.w); f[7] = bfhi(w.w); }
__device__ __forceinline__ v4u pack8(const float (&f)[8]) { v4u w; w.x = pk2(f[0], f[1]); w.y = pk2(f[2], f[3]); w.z = pk2(f[4], f[5]); w.w = pk2(f[6], f[7]); return w; }
__device__ __forceinline__ float logsig(float x) { return fminf(x, 0.f) - log1pf(expf(-fabsf(x))); }
__device__ __forceinline__ float sigm(float x) { return 1.f / (1.f + expf(-x)); }
__device__ __forceinline__ float silu(float x) { return x / (1.f + expf(-x)); }
__device__ __forceinline__ float wave_sum(float v) {
#pragma unroll
    for (int o = 1; o < 64; o <<= 1) v += __shfl_xor(v, o);
    return v;
}
__device__ __forceinline__ int q_next(Frame& F, gu32* head) {
    __syncthreads();
    if (F.tid == 0) F.MISC[0] = __hip_atomic_fetch_add(head, 1u, RLX_AGENT);
    __syncthreads();
    return (int)F.MISC[0];
}

__device__ __forceinline__ int win_src(int n) {
    if (n < 768) return n;
    if (n < 2048) return n + 16;
    if (n < 2560) return n + 20;
    if (n < 2576) return n - 1792;
    if (n < 2580) return n - 512;
    return -1;
}
template <int MODE>
__device__ __forceinline__ void p0_transpose_item(const float* W, int K, int N, int NT, bf16* WT, LAS float* scr, int item, int lane) {
    const int nblk = NT / 32, kb = item / nblk, nb = item % nblk, k0 = 64 * kb, n0 = 32 * nb;
    const int ncol = n0 + (lane & 31); const int src = MODE == 1 ? win_src(ncol) : ncol;
#pragma unroll 8
    for (int i = 0; i < 32; ++i) { const int kk = 2 * i + (lane >> 5); scr[kk * 33 + (lane & 31)] = src >= 0 ? W[(size_t)(k0 + kk) * N + src] : 0.f; }
    LDS_WAIT(); asm volatile("" ::: "memory");
    const int c = lane & 7;
#pragma unroll
    for (int j = 0; j < 4; ++j) { const int n = (lane >> 3) + 8 * j; const LAS float* s = scr + (8 * c) * 33 + n;
        v4u o; o.x = pk2(s[0 * 33], s[1 * 33]); o.y = pk2(s[2 * 33], s[3 * 33]); o.z = pk2(s[4 * 33], s[5 * 33]); o.w = pk2(s[6 * 33], s[7 * 33]);
        *(GAS v4u*)(WT + (size_t)(n0 + n) * K + k0 + 8 * c) = o; }
    LDS_WAIT(); asm volatile("" ::: "memory");
}
__device__ __forceinline__ void p0_prologue(const Args& A, const int z, Frame& F) {
    using namespace P;
    LAS float* scr = (LAS float*)(F.lds + F.wave * 16384);
    const int gw = F.vcu * NWAVES + F.wave, NGW = F.G * NWAVES;
    constexpr int I_IN = (DM / 64) * (NIN / 32), I_O = (DM / 64) * (DM / 32), I_UP = (DM / 64) * (NUP / 32), I_DN = (DFF / 64) * (DM / 32), I_LAYER = I_IN + I_O + I_UP + I_DN;
    for (int it = gw; it < DEPTH * I_LAYER; it += NGW) {
        const int l = it / I_LAYER; int r = it % I_LAYER;
        if (r < I_IN) { p0_transpose_item<1>(AIN(I_WIN) + (size_t)l * DM * DIN, DM, DIN, NIN, (bf16*)(AWS + WS_WIN + l * SZ_WIN), scr, r, F.lane); continue; } r -= I_IN;
        if (r < I_O) { p0_transpose_item<0>(AIN(I_WO) + (size_t)l * DM * DM, DM, DM, DM, (bf16*)(AWS + WS_WO + l * SZ_WO), scr, r, F.lane); continue; } r -= I_O;
        if (r < I_UP) { p0_transpose_item<0>(AIN(I_WUP) + (size_t)l * DM * NUP, DM, NUP, NUP, (bf16*)(AWS + WS_WUP + l * SZ_WUP), scr, r, F.lane); continue; } r -= I_UP;
        p0_transpose_item<0>(AIN(I_WDN) + (size_t)l * DFF * DM, DFF, DM, DM, (bf16*)(AWS + WS_WDN + l * SZ_WDN), scr, r, F.lane);
    }
    float* XF = (float*)(AWS + WS_XF); bf16* XB = (bf16*)(AWS + WS_XB);
    for (int m = gw; m < MP; m += NGW) {
        const float* src = m < MPR ? AIN(I_XP) + (size_t)m * DM : (m < MREAL ? AIN(I_XS) + (size_t)(m - MPR) * DM : nullptr);
#pragma unroll
        for (int j = 0; j < 4; ++j) { const int c = 4 * F.lane + 256 * j; f32x4 v = src ? *(const GAS f32x4*)(src + c) : (f32x4){0.f, 0.f, 0.f, 0.f};
            *(GAS f32x4*)(XF + (size_t)m * DM + c) = v;
            *(GAS unsigned long long*)(XB + (size_t)m * DM + c) = (unsigned long long)pk2(v.x, v.y) | ((unsigned long long)pk2(v.z, v.w) << 32); }
    }
    float* PS = (float*)(AWS + WS_PS); const int* pt = (const int*)AIN(I_PT);
    for (int it = gw; it < DEPTH * DECB * NPAGES; it += NGW) {
        const int l = it / (DECB * NPAGES), bp = it % (DECB * NPAGES); const int page = pt[bp];
        const float* Lp = AIN(I_CL) + ((size_t)(l * NPOOL + page) * PAGE) * 4;
        f32x4 a = *(const GAS f32x4*)(Lp + 4 * F.lane), b = *(const GAS f32x4*)(Lp + 4 * (F.lane + 64)); a = a + b;
        a.x = wave_sum(a.x); a.y = wave_sum(a.y); a.z = wave_sum(a.z); a.w = wave_sum(a.w);
        if (F.lane == 0) *(GAS f32x4*)(PS + (size_t)it * 4) = a;
    }
}

namespace GL {
constexpr int G = 0, T = G + 64 * 33, WA = T + 256, BA = WA + 512, QT = BA + 32, KT = QT + 64 * 33, VV = KT + 32 * 68, SS = VV + 64 * 64, AT = SS + 32 * 64, END = AT + 64 * 68;
static_assert(END * 4 <= P::RING_BYTES, "GLA LDS");
}
__device__ __forceinline__ void gla_g64(const Args& A, const int z, Frame& F, int l, int m0, int h, LAS float* L) {
    using namespace P;
    const float* LRF = (const float*)(AWS + WS_LRF);
    { const int r = F.tid >> 5, d = F.tid & 31; L[GL::WA + F.tid] = AIN(I_GWA)[(size_t)l * RANK * 128 + r * 128 + 32 * h + d]; }
    if (F.tid < 32) L[GL::BA + F.tid] = AIN(I_GBA)[l * 128 + 32 * h + F.tid];
    __syncthreads();
    float loc[8]; const int d = F.tid & 31, seg = (F.tid >> 5) & 7;
    if (F.tid < 256) {
        float run = 0.f;
#pragma unroll
        for (int i = 0; i < 8; ++i) { const float* lr = LRF + (size_t)(m0 + 8 * seg + i) * 32; float s = L[GL::BA + d];
#pragma unroll
            for (int r = 0; r < 16; ++r) s += lr[r] * L[GL::WA + r * 32 + d];
            run += logsig(s) * (1.f / 16.f); loc[i] = run; }
        L[GL::T + seg * 32 + d] = run;
    }
    __syncthreads();
    if (F.tid < 256) {
        float off = 0.f;
        for (int s = 0; s < seg; ++s) off += L[GL::T + s * 32 + d];
#pragma unroll
        for (int i = 0; i < 8; ++i) L[GL::G + (8 * seg + i) * 33 + d] = off + loc[i];
    }
    __syncthreads();
}
__device__ __forceinline__ void gla_local_item(const Args& A, const int z, Frame& F, int l, int item) {
    using namespace P;
    LAS float* L = (LAS float*)F.lds; const bf16* H = (const bf16*)(AWS + WS_H);
    const int bh = item >> 5, c = item & 31, b = bh >> 2, h = bh & 3, m0 = b * SEQ + 64 * c;
    gla_g64(A, z, F, l, m0, h, L);
    { const int s = F.tid >> 3, d4 = (F.tid & 7) * 4; const unsigned long long w = *(const GAS unsigned long long*)(H + (size_t)(m0 + s) * NIN + HC_AK + 32 * h + d4);
      const unsigned lo = (unsigned)w, hi = (unsigned)(w >> 32); const float kv[4] = {bflo(lo), bfhi(lo), bflo(hi), bfhi(hi)};
#pragma unroll
      for (int i = 0; i < 4; ++i) L[GL::QT + s * 33 + d4 + i] = kv[i] * expf(L[GL::G + 63 * 33 + d4 + i] - L[GL::G + s * 33 + d4 + i]);
      const int e8 = (F.tid & 7) * 8; const v4u vw = *(const GAS v4u*)(H + (size_t)(m0 + s) * NIN + HC_AV + 64 * h + e8); float vf[8]; unpack8(vw, vf);
#pragma unroll
      for (int i = 0; i < 8; ++i) L[GL::VV + s * 64 + e8 + i] = vf[i]; }
    __syncthreads();
    { const int d = F.tid >> 4, e4 = (F.tid & 15) * 4; f32x4 acc = {0.f, 0.f, 0.f, 0.f};
      for (int s = 0; s < 64; ++s) { const float kh = L[GL::QT + s * 33 + d]; const f32x4 v = *(const LAS f32x4*)(L + GL::VV + s * 64 + e4); acc = acc + v * kh; }
      *(GAS f32x4*)((float*)(AWS + WS_DELTA) + (size_t)item * 2048 + d * 64 + e4) = acc; }
    if (F.tid < 32) ((float*)(AWS + WS_GAMMA))[(size_t)item * 32 + F.tid] = expf(L[GL::G + 63 * 33 + F.tid]);
}
__device__ __forceinline__ void gla_out_item(const Args& A, const int z, Frame& F, int l, int item) {
    using namespace P;
    LAS float* L = (LAS float*)F.lds; const bf16* H = (const bf16*)(AWS + WS_H); bf16* Y = (bf16*)(AWS + WS_Y);
    const int bh = item >> 5, c = item & 31, b = bh >> 2, h = bh & 3, m0 = b * SEQ + 64 * c;
    gla_g64(A, z, F, l, m0, h, L);
    { const int s = F.tid >> 3, d4 = (F.tid & 7) * 4;
      const unsigned long long wq = *(const GAS unsigned long long*)(H + (size_t)(m0 + s) * NIN + HC_AQ + 32 * h + d4);
      const unsigned long long wk = *(const GAS unsigned long long*)(H + (size_t)(m0 + s) * NIN + HC_AK + 32 * h + d4);
      const float qv[4] = {bflo((unsigned)wq), bfhi((unsigned)wq), bflo((unsigned)(wq >> 32)), bfhi((unsigned)(wq >> 32))};
      const float kv[4] = {bflo((unsigned)wk), bfhi((unsigned)wk), bflo((unsigned)(wk >> 32)), bfhi((unsigned)(wk >> 32))};
#pragma unroll
      for (int i = 0; i < 4; ++i) { const float g = L[GL::G + s * 33 + d4 + i];
          L[GL::QT + s * 33 + d4 + i] = qv[i] * 0.17677669529663687f * expf(g);
          L[GL::KT + (d4 + i) * 68 + s] = kv[i] * expf(-g); }
      const int e8 = (F.tid & 7) * 8; const v4u vw = *(const GAS v4u*)(H + (size_t)(m0 + s) * NIN + HC_AV + 64 * h + e8); float vf[8]; unpack8(vw, vf);
#pragma unroll
      for (int i = 0; i < 8; ++i) L[GL::VV + s * 64 + e8 + i] = vf[i]; }
    { const int d = F.tid >> 4, e4 = (F.tid & 15) * 4; f32x4 S = {0.f, 0.f, 0.f, 0.f};
      const float* DL = (const float*)(AWS + WS_DELTA) + (size_t)(bh * 32) * 2048 + d * 64 + e4; const float* GM = (const float*)(AWS + WS_GAMMA) + (size_t)(bh * 32) * 32 + d;
      for (int j = 0; j < c; ++j) { const float gm = GM[j * 32]; const f32x4 dl = *(const GAS f32x4*)(DL + (size_t)j * 2048); S = S * gm + dl; }
      *(LAS f32x4*)(L + GL::SS + d * 64 + e4) = S;
      if (c == 31) { const float gm = GM[31 * 32]; const f32x4 dl = *(const GAS f32x4*)(DL + (size_t)31 * 2048); const f32x4 Sf = S * gm + dl;
          *(GAS f32x4*)(AOUT + O_PGLA + ((size_t)(l * BATCH + b) * NH + h) * 2048 + d * 64 + e4) = Sf; } }
    __syncthreads();
    { const int t = F.tid >> 3, s8 = (F.tid & 7) * 8; float a[8];
#pragma unroll
      for (int i = 0; i < 8; ++i) a[i] = 0.f;
      for (int d = 0; d < 32; ++d) { const float qv = L[GL::QT + t * 33 + d]; const f32x4 k0 = *(const LAS f32x4*)(L + GL::KT + d * 68 + s8), k1 = *(const LAS f32x4*)(L + GL::KT + d * 68 + s8 + 4);
          a[0] += qv * k0.x; a[1] += qv * k0.y; a[2] += qv * k0.z; a[3] += qv * k0.w; a[4] += qv * k1.x; a[5] += qv * k1.y; a[6] += qv * k1.z; a[7] += qv * k1.w; }
#pragma unroll
      for (int i = 0; i < 8; ++i) L[GL::AT + t * 68 + s8 + i] = (s8 + i <= t) ? a[i] : 0.f; }
    __syncthreads();
    { const int t = F.tid >> 3, e8 = (F.tid & 7) * 8; float o[8];
#pragma unroll
      for (int i = 0; i < 8; ++i) o[i] = 0.f;
      for (int s = 0; s < 64; ++s) { const float av = L[GL::AT + t * 68 + s]; const f32x4 v0 = *(const LAS f32x4*)(L + GL::VV + s * 64 + e8), v1 = *(const LAS f32x4*)(L + GL::VV + s * 64 + e8 + 4);
          o[0] += av * v0.x; o[1] += av * v0.y; o[2] += av * v0.z; o[3] += av * v0.w; o[4] += av * v1.x; o[5] += av * v1.y; o[6] += av * v1.z; o[7] += av * v1.w; }
      for (int d = 0; d < 32; ++d) { const float qv = L[GL::QT + t * 33 + d]; const f32x4 v0 = *(const LAS f32x4*)(L + GL::SS + d * 64 + e8), v1 = *(const LAS f32x4*)(L + GL::SS + d * 64 + e8 + 4);
          o[0] += qv * v0.x; o[1] += qv * v0.y; o[2] += qv * v0.z; o[3] += qv * v0.w; o[4] += qv * v1.x; o[5] += qv * v1.y; o[6] += qv * v1.z; o[7] += qv * v1.w; }
      float ss = 0.f;
#pragma unroll
      for (int i = 0; i < 8; ++i) ss += o[i] * o[i];
      ss += __shfl_xor(ss, 1); ss += __shfl_xor(ss, 2); ss += __shfl_xor(ss, 4);
      const float rn = 1.f / sqrtf(ss * (1.f / 64.f) + EPS);
      const v4u gw = *(const GAS v4u*)(H + (size_t)(m0 + t) * NIN + HC_AG + 64 * h + e8); float gf[8]; unpack8(gw, gf);
      const float* ng = AIN(I_GNG) + l * 256 + 64 * h + e8; float y[8];
#pragma unroll
      for (int i = 0; i < 8; ++i) y[i] = o[i] * rn * ng[i] * silu(gf[i]);
      *(GAS v4u*)(Y + (size_t)(m0 + t) * DM + 64 * h + e8) = pack8(y); }
}

__device__ __forceinline__ void fox_cumsum_wave(const Args& A, const int z, Frame& F, int l, int bh) {
    using namespace P;
    const float* LRF = (const float*)(AWS + WS_LRF); float* KB = (float*)(AWS + WS_KBIAS);
    const int b = bh >> 2, h = bh & 3; const float bf = AIN(I_FBF)[l * 4 + h];
    float lf[32]; float run = 0.f;
#pragma unroll
    for (int i = 0; i < 32; ++i) { const int t = 32 * F.lane + i; const size_t m = (size_t)b * SEQ + t; lf[i] = logsig(LRF[m * 32 + 16 + h] + bf);
        AOUT[O_PFL + ((size_t)l * MPR + m) * 4 + h] = lf[i]; run += lf[i]; }
    float incl = run;
#pragma unroll
    for (int o = 1; o < 64; o <<= 1) { const float v = __shfl_up(incl, o); if (F.lane >= o) incl += v; }
    float acc = incl - run;
#pragma unroll
    for (int i = 0; i < 32; ++i) { acc += lf[i]; KB[(size_t)bh * SEQ + 32 * F.lane + i] = -acc * LOG2E; }
}

__device__ __forceinline__ void conv_item(const Args& A, const int z, Frame& F, int l, int item) {
    using namespace P;
    LAS float* GLU = (LAS float*)F.lds; LAS float* CO = GLU + 62 * 256;
    const bf16* H = (const bf16*)(AWS + WS_H); bf16* Y = (bf16*)(AWS + WS_Y);
    const int b = item >> 6, t0 = (item & 63) * 32;
    for (int idx = F.tid; idx < 62 * 32; idx += 512) {
        const int rr = idx >> 5, c8 = (idx & 31) * 8, t = t0 - 30 + rr; float g[8];
        if (t >= 0) { const size_t m = (size_t)b * SEQ + t; float d1[8], d2[8]; unpack8(*(const GAS v4u*)(H + m * NIN + HC_D1 + c8), d1); unpack8(*(const GAS v4u*)(H + m * NIN + HC_D2 + c8), d2);
#pragma unroll
            for (int i = 0; i < 8; ++i) g[i] = d1[i] * sigm(d2[i]);
            if (t >= SEQ - 30) { float* o = AOUT + O_PCONV + ((size_t)(l * BATCH + b) * 30 + (t - (SEQ - 30))) * DG + c8; *(GAS f32x4*)o = (f32x4){g[0], g[1], g[2], g[3]}; *(GAS f32x4*)(o + 4) = (f32x4){g[4], g[5], g[6], g[7]}; }
        } else {
#pragma unroll
            for (int i = 0; i < 8; ++i) g[i] = 0.f; }
        *(LAS f32x4*)(GLU + rr * 256 + c8) = (f32x4){g[0], g[1], g[2], g[3]}; *(LAS f32x4*)(GLU + rr * 256 + c8 + 4) = (f32x4){g[4], g[5], g[6], g[7]};
    }
    __syncthreads();
    { const int c = F.tid & 255, half = F.tid >> 8; float w[31], win[46]; const float* cw = AIN(I_CVW) + (size_t)l * CW * DG + c;
#pragma unroll
      for (int j = 0; j < 31; ++j) w[j] = cw[j * DG];
#pragma unroll
      for (int j = 0; j < 46; ++j) win[j] = GLU[(half * 16 + j) * 256 + c];
      const float cb = AIN(I_CVB)[l * DG + c];
#pragma unroll
      for (int i = 0; i < 16; ++i) { float s = cb;
#pragma unroll
          for (int j = 0; j < 31; ++j) s += w[j] * win[i + j];
          CO[(half * 16 + i) * 256 + c] = s; } }
    __syncthreads();
    { const float* ng = AIN(I_CNG) + l * DG + 4 * F.lane; const float* nb = AIN(I_CNB) + l * DG + 4 * F.lane;
      const f32x4 g4 = *(const GAS f32x4*)ng, b4 = *(const GAS f32x4*)nb;
#pragma unroll
      for (int k = 0; k < 4; ++k) { const int tok = 4 * F.wave + k; const f32x4 x = *(const LAS f32x4*)(CO + tok * 256 + 4 * F.lane);
          float s = (x.x + x.y) + (x.z + x.w); s += __shfl_xor(s, 1); s += __shfl_xor(s, 2); s += __shfl_xor(s, 4); s += __shfl_xor(s, 8);
          const float mean = s * (1.f / 64.f); const f32x4 dx = x - mean; float q = (dx.x * dx.x + dx.y * dx.y) + (dx.z * dx.z + dx.w * dx.w);
          q += __shfl_xor(q, 1); q += __shfl_xor(q, 2); q += __shfl_xor(q, 4); q += __shfl_xor(q, 8);
          const float rstd = 1.f / sqrtf(q * (1.f / 64.f) + EPS); const f32x4 yv = dx * rstd * g4 + b4;
          *(GAS unsigned long long*)(Y + (size_t)(b * SEQ + t0 + tok) * DM + 768 + 4 * F.lane) = (unsigned long long)pk2(silu(yv.x), silu(yv.y)) | ((unsigned long long)pk2(silu(yv.z), silu(yv.w)) << 32); } }
}

__device__ __forceinline__ void sgu_item(const Args& A, const int z, Frame& F, int l, int item) {
    using namespace P;
    LAS float* WL = (LAS float*)F.lds; LAS float* VL = WL + 128 * 129;
    const bf16* H = (const bf16*)(AWS + WS_H); bf16* Y = (bf16*)(AWS + WS_Y);
    const int g = item & 3, bn = item >> 2, b = bn >> 4, n = bn & 15, m0 = b * SEQ + 128 * n;
    const float* Wg = AIN(I_SW) + ((size_t)(l * NH + g)) * 128 * 128;
    for (int idx = F.tid; idx < 128 * 32; idx += 512) { const int t = idx >> 5, s4 = (idx & 31) * 4; const f32x4 w = *(const GAS f32x4*)(Wg + t * 128 + s4);
        WL[t * 129 + s4 + 0] = (s4 + 0 <= t) ? w.x : 0.f; WL[t * 129 + s4 + 1] = (s4 + 1 <= t) ? w.y : 0.f; WL[t * 129 + s4 + 2] = (s4 + 2 <= t) ? w.z : 0.f; WL[t * 129 + s4 + 3] = (s4 + 3 <= t) ? w.w : 0.f; }
    { const int t = F.tid >> 2, q = F.tid & 3; float x[16]; const bf16* src = H + (size_t)(m0 + t) * NIN + HC_BV + 64 * g + 16 * q;
      { float a[8], c[8]; unpack8(*(const GAS v4u*)src, a); unpack8(*(const GAS v4u*)(src + 8), c);
#pragma unroll
        for (int i = 0; i < 8; ++i) { x[i] = a[i]; x[8 + i] = c[i]; } }
      float s = 0.f;
#pragma unroll
      for (int i = 0; i < 16; ++i) s += x[i];
      s += __shfl_xor(s, 1); s += __shfl_xor(s, 2); const float mean = s * (1.f / 64.f); float qq = 0.f;
#pragma unroll
      for (int i = 0; i < 16; ++i) { x[i] -= mean; qq += x[i] * x[i]; }
      qq += __shfl_xor(qq, 1); qq += __shfl_xor(qq, 2); const float rstd = 1.f / sqrtf(qq * (1.f / 64.f) + EPS);
      const float* lg = AIN(I_SLG) + l * DG + 64 * g + 16 * q; const float* lb = AIN(I_SLB) + l * DG + 64 * g + 16 * q;
#pragma unroll
      for (int i = 0; i < 16; ++i) VL[t * 64 + 16 * q + i] = x[i] * rstd * lg[i] + lb[i]; }
    __syncthreads();
    { const int t = F.wave * 16 + (F.lane >> 2), cb = F.lane & 3; const float bs = AIN(I_SB)[(size_t)(l * NH + g) * 128 + t]; float acc[16];
#pragma unroll
      for (int i = 0; i < 16; ++i) acc[i] = bs;
      const int send = 16 * (F.wave + 1);
      for (int s = 0; s < send; ++s) { const float w = WL[t * 129 + s];
#pragma unroll
          for (int j = 0; j < 4; ++j) { const f32x4 v = *(const LAS f32x4*)(VL + s * 64 + 16 * cb + 4 * j); acc[4 * j] += w * v.x; acc[4 * j + 1] += w * v.y; acc[4 * j + 2] += w * v.z; acc[4 * j + 3] += w * v.w; } }
      const bf16* us = H + (size_t)(m0 + t) * NIN + HC_BU + 64 * g + 16 * cb; float u0[8], u1[8]; unpack8(*(const GAS v4u*)us, u0); unpack8(*(const GAS v4u*)(us + 8), u1);
      float y0[8], y1[8];
#pragma unroll
      for (int i = 0; i < 8; ++i) { y0[i] = u0[i] * acc[i]; y1[i] = u1[i] * acc[8 + i]; }
      bf16* yd = Y + (size_t)(m0 + t) * DM + 256 + 64 * g + 16 * cb; *(GAS v4u*)yd = pack8(y0); *(GAS v4u*)(yd + 8) = pack8(y1); }
}

__device__ __forceinline__ void fox_page_wave(const Args& A, const int z, Frame& F, int l, int unit) {
    using namespace P;
    const int b = unit >> 6, pg = unit & 63, hh = F.lane >> 4, ds = F.lane & 15;
    const bf16* H = (const bf16*)(AWS + WS_H); const int* pt = (const int*)AIN(I_PT);
    f32x4 q4[4];
#pragma unroll
    for (int t = 0; t < 4; ++t) { const unsigned long long w = *(const GAS unsigned long long*)(H + (size_t)(MPR + 4 * b + t) * NIN + HC_CQ + 64 * hh + 4 * ds);
        q4[t] = (f32x4){bflo((unsigned)w), bfhi((unsigned)w), bflo((unsigned)(w >> 32)), bfhi((unsigned)(w >> 32))}; }
    const int page = pt[b * NPAGES + pg];
    const float* Kp = AIN(I_CK) + ((size_t)(l * NPOOL + page) * PAGE) * 256 + 4 * F.lane;
    const float* Vp = AIN(I_CV) + ((size_t)(l * NPOOL + page) * PAGE) * 256 + 4 * F.lane;
    const float* Lp = AIN(I_CL) + ((size_t)(l * NPOOL + page) * PAGE) * 4 + hh;
    const float* PS = (const float*)(AWS + WS_PS) + ((size_t)(l * DECB + b) * NPAGES) * 4 + hh;
    float run = 0.f;
    for (int p2 = pg + 1; p2 < NPAGES; ++p2) run += PS[p2 * 4];
    float mx[4], ls[4]; f32x4 O[4];
#pragma unroll
    for (int t = 0; t < 4; ++t) { mx[t] = -1e30f; ls[t] = 0.f; O[t] = (f32x4){0.f, 0.f, 0.f, 0.f}; }
    for (int r0 = PAGE - 4; r0 >= 0; r0 -= 4) {
        f32x4 k4[4], v4[4]; float lf[4], bias[4];
#pragma unroll
        for (int i = 0; i < 4; ++i) { k4[i] = __builtin_nontemporal_load((const GAS f32x4*)(Kp + (size_t)(r0 + i) * 256)); v4[i] = __builtin_nontemporal_load((const GAS f32x4*)(Vp + (size_t)(r0 + i) * 256)); lf[i] = Lp[(r0 + i) * 4]; }
#pragma unroll
        for (int i = 3; i >= 0; --i) { bias[i] = run * LOG2E; run += lf[i]; }
        float s[4][4];
#pragma unroll
        for (int i = 0; i < 4; ++i)
#pragma unroll
            for (int t = 0; t < 4; ++t) { float d = (k4[i].x * q4[t].x + k4[i].y * q4[t].y) + (k4[i].z * q4[t].z + k4[i].w * q4[t].w);
                d += __shfl_xor(d, 1); d += __shfl_xor(d, 2); d += __shfl_xor(d, 4); d += __shfl_xor(d, 8); s[i][t] = d + bias[i]; }
#pragma unroll
        for (int t = 0; t < 4; ++t) { const float mb = fmaxf(fmaxf(s[0][t], s[1][t]), fmaxf(s[2][t], s[3][t])), mn = fmaxf(mx[t], mb), corr = exp2f(mx[t] - mn);
            const float p0 = exp2f(s[0][t] - mn), p1 = exp2f(s[1][t] - mn), p2 = exp2f(s[2][t] - mn), p3 = exp2f(s[3][t] - mn);
            ls[t] = ls[t] * corr + ((p0 + p1) + (p2 + p3)); O[t] = O[t] * corr + v4[0] * p0 + v4[1] * p1 + v4[2] * p2 + v4[3] * p3; mx[t] = mn; }
    }
    float* PART = (float*)(AWS + WS_PART); float* ML = (float*)(AWS + WS_ML);
#pragma unroll
    for (int t = 0; t < 4; ++t) { const size_t o = ((size_t)(unit * 4 + hh) * 4 + t); *(GAS f32x4*)(PART + o * 64 + 4 * ds) = O[t]; if (ds == 0) { ML[o * 2] = mx[t]; ML[o * 2 + 1] = ls[t]; } }
}

__device__ __forceinline__ void sample_item(const Args& A, const int z, Frame& F, int l, int b) {
    using namespace P;
    LAS float* L = (LAS float*)F.lds;
    LAS float* SC = L; LAS float* DN = L + 64; LAS float* LA = L + 128; LAS float* QK = L + 640;
    const bf16* H = (const bf16*)(AWS + WS_H); bf16* Y = (bf16*)(AWS + WS_Y); const float* LRF = (const float*)(AWS + WS_LRF);
    const int mrow = MPR + 4 * b;
    if (F.tid < 4) { const int hh = F.tid; const float bf = AIN(I_FBF)[l * 4 + hh]; float run = 0.f;
        for (int t = 0; t < 4; ++t) { const float lf = logsig(LRF[(size_t)(mrow + t) * 32 + 16 + hh] + bf); AOUT[O_SFL + ((size_t)l * MS + 4 * b + t) * 4 + hh] = lf; run += lf; DN[t * 4 + hh] = run; } }
    { const int t = F.tid >> 7, j = F.tid & 127; const float* lr = LRF + (size_t)(mrow + t) * 32; float s = AIN(I_GBA)[l * 128 + j];
#pragma unroll
      for (int r = 0; r < 16; ++r) s += lr[r] * AIN(I_GWA)[(size_t)l * RANK * 128 + r * 128 + j];
      LA[t * 128 + j] = logsig(s) * (1.f / 16.f); }
    for (int idx = F.tid; idx < 1024; idx += 512) { const int t = idx >> 8, j = idx & 255; QK[idx] = bf1(H[(size_t)(mrow + t) * NIN + HC_AQ + j]); }
    __syncthreads();
    if (F.tid < 64) { const int hh = F.tid >> 4, t = (F.tid >> 2) & 3, j = F.tid & 3; float s = 0.f;
        const bf16* qp = H + (size_t)(mrow + t) * NIN + HC_CQ + 64 * hh; const bf16* kp = H + (size_t)(mrow + j) * NIN + HC_CK + 64 * hh;
        for (int d = 0; d < 64; ++d) s += bf1(qp[d]) * bf1(kp[d]);
        SC[F.tid] = (j <= t) ? s - DN[j * 4 + hh] * LOG2E : -INFINITY; }
    __syncthreads();
    {
      const int hh = F.tid >> 7, t = (F.tid >> 5) & 3, dp = F.tid & 31;
      const float* ML = (const float*)(AWS + WS_ML); const float* PART = (const float*)(AWS + WS_PART);
      float M = -1e30f;
      for (int pg = 0; pg < NPAGES; ++pg) M = fmaxf(M, ML[((size_t)((b * NPAGES + pg) * 4 + hh) * 4 + t) * 2]);
#pragma unroll
      for (int j = 0; j < 4; ++j) M = fmaxf(M, SC[(hh * 4 + t) * 4 + j]);
      float Ls = 0.f, o0 = 0.f, o1 = 0.f;
      for (int pg = 0; pg < NPAGES; ++pg) { const size_t o = ((size_t)((b * NPAGES + pg) * 4 + hh) * 4 + t); const float w = exp2f(ML[o * 2] - M); Ls += ML[o * 2 + 1] * w;
          const float2 pv = *(const float2*)(PART + o * 64 + 2 * dp); o0 += pv.x * w; o1 += pv.y * w; }
#pragma unroll
      for (int j = 0; j < 4; ++j) { const float w = exp2f(SC[(hh * 4 + t) * 4 + j] - M); Ls += w; const bf16* vp = H + (size_t)(mrow + j) * NIN + HC_CV + 64 * hh + 2 * dp; o0 += w * bf1(vp[0]); o1 += w * bf1(vp[1]); }
      const float inv = 1.f / Ls;
      *(GAS unsigned*)(Y + (size_t)(mrow + t) * DM + 512 + 64 * hh + 2 * dp) = pk2(o0 * inv, o1 * inv); }
    if (F.tid < 256) {
        const int hh = F.tid >> 6, e = F.tid & 63; float S[32];
        const float* S0 = AIN(I_SGLA) + ((size_t)((l * DECB + b) * NH + hh)) * 2048 + e;
#pragma unroll
        for (int d = 0; d < 32; ++d) S[d] = S0[d * 64];
        for (int t = 0; t < 4; ++t) {
            const float v = bf1(H[(size_t)(mrow + t) * NIN + HC_AV + 64 * hh + e]); float o = 0.f;
#pragma unroll
            for (int d = 0; d < 32; ++d) { S[d] = expf(LA[t * 128 + 32 * hh + d]) * S[d] + QK[t * 256 + 128 + 32 * hh + d] * v; o += QK[t * 256 + 32 * hh + d] * 0.17677669529663687f * S[d]; }
            const float ms = wave_sum(o * o) * (1.f / 64.f); const float rn = 1.f / sqrtf(ms + EPS);
            const float ag = bf1(H[(size_t)(mrow + t) * NIN + HC_AG + 64 * hh + e]);
            Y[(size_t)(mrow + t) * DM + 64 * hh + e] = (bf16)f2bf(o * rn * AIN(I_GNG)[l * 256 + 64 * hh + e] * silu(ag));
        }
        float* So = AOUT + O_SGLA + ((size_t)((l * DECB + b) * NH + hh)) * 2048 + e;
#pragma unroll
        for (int d = 0; d < 32; ++d) So[d * 64] = S[d];
    } else {
        const int c = F.tid - 256, g = c >> 6; float vl[4];
#pragma unroll
        for (int t = 0; t < 4; ++t) { const float x = bf1(H[(size_t)(mrow + t) * NIN + HC_BV + c]); const float mean = wave_sum(x) * (1.f / 64.f); const float dx = x - mean;
            const float var = wave_sum(dx * dx) * (1.f / 64.f); vl[t] = dx * (1.f / sqrtf(var + EPS)) * AIN(I_SLG)[l * DG + c] + AIN(I_SLB)[l * DG + c];
            AOUT[O_SSGU + ((size_t)l * MS + 4 * b + t) * DG + c] = vl[t]; }
        const float* Wg = AIN(I_SW) + ((size_t)(l * NH + g)) * 128 * 128; const float* bs = AIN(I_SB) + (size_t)(l * NH + g) * 128;
#pragma unroll
        for (int t = 0; t < 4; ++t) { float mix = bs[t];
#pragma unroll
            for (int s = 0; s < 4; ++s) if (s <= t) mix += Wg[t * 128 + s] * vl[s];
            const float u = bf1(H[(size_t)(mrow + t) * NIN + HC_BU + c]);
            Y[(size_t)(mrow + t) * DM + 256 + c] = (bf16)f2bf(u * mix); }
    }
    if (F.tid < 256) {
        const int c = F.tid; float xx[34];
        const float* st = AIN(I_SCONV) + ((size_t)(l * DECB + b) * 30) * DG + c;
#pragma unroll
        for (int j = 0; j < 30; ++j) xx[j] = st[j * DG];
#pragma unroll
        for (int t = 0; t < 4; ++t) { const float d1 = bf1(H[(size_t)(mrow + t) * NIN + HC_D1 + c]), d2 = bf1(H[(size_t)(mrow + t) * NIN + HC_D2 + c]); xx[30 + t] = d1 * sigm(d2); }
        float* so = AOUT + O_SCONV + ((size_t)(l * DECB + b) * 30) * DG + c;
#pragma unroll
        for (int j = 0; j < 30; ++j) so[j * DG] = xx[4 + j];
        const float* cw = AIN(I_CVW) + (size_t)l * CW * DG + c; const float cb = AIN(I_CVB)[l * DG + c];
        float co[4] = {cb, cb, cb, cb};
#pragma unroll
        for (int j = 0; j < 31; ++j) { const float w = cw[j * DG];
#pragma unroll
            for (int t = 0; t < 4; ++t) co[t] += w * xx[t + j]; }
#pragma unroll
        for (int t = 0; t < 4; ++t) { const float mean = wave_sum(co[t]) * (1.f / 64.f); const float dx = co[t] - mean; const float var = wave_sum(dx * dx) * (1.f / 64.f);
            const float yv = dx * (1.f / sqrtf(var + EPS)) * AIN(I_CNG)[l * DG + c] + AIN(I_CNB)[l * DG + c];
            Y[(size_t)(mrow + t) * DM + 768 + c] = (bf16)f2bf(silu(yv)); }
    }
}

__device__ __forceinline__ void ln_row(Frame& F, const float* zrow, const float* g, const float* b, float* of32, bf16* obf) {
    const GAS f32x4* zr = (const GAS f32x4*)zrow + F.lane; f32x4 v[4]; float s = 0.f;
#pragma unroll
    for (int j = 0; j < 4; ++j) { v[j] = zr[64 * j]; s += (v[j].x + v[j].y) + (v[j].z + v[j].w); }
    const float mean = wave_sum(s) * (1.f / 1024.f); float s2 = 0.f;
#pragma unroll
    for (int j = 0; j < 4; ++j) { v[j] = v[j] - mean; s2 += (v[j].x * v[j].x + v[j].y * v[j].y) + (v[j].z * v[j].z + v[j].w * v[j].w); }
    const float rstd = 1.f / sqrtf(wave_sum(s2) * (1.f / 1024.f) + P::EPS);
#pragma unroll
    for (int j = 0; j < 4; ++j) { const f32x4 gg = ((const GAS f32x4*)g)[F.lane + 64 * j], bb = ((const GAS f32x4*)b)[F.lane + 64 * j]; const f32x4 y = v[j] * rstd * gg + bb;
        ((GAS f32x4*)of32)[F.lane + 64 * j] = y;
        if (obf) ((GAS unsigned long long*)obf)[F.lane + 64 * j] = (unsigned long long)pk2(y.x, y.y) | ((unsigned long long)pk2(y.z, y.w) << 32); }
}

__device__ __forceinline__ void act_item(const Args& A, const int z, Frame& F, int l, int item) {
    using namespace P;
    if (F.tid >= DFF / 8) return;
    const bf16* G = (const bf16*)(AWS + WS_G); bf16* ACT = (bf16*)(AWS + WS_ACT);
    const int f0 = 8 * F.tid, m0 = 32 * item;
    float w0[8], w1[8], w2[8], cb[8];
#pragma unroll
    for (int i = 0; i < 8; ++i) { w0[i] = AIN(I_FCW)[(size_t)l * 3 * DFF + f0 + i]; w1[i] = AIN(I_FCW)[(size_t)l * 3 * DFF + DFF + f0 + i]; w2[i] = AIN(I_FCW)[(size_t)l * 3 * DFF + 2 * DFF + f0 + i]; cb[i] = AIN(I_FCB)[l * DFF + f0 + i]; }
    float h1[8], h2[8];
    if (m0 < MPR) {
        if ((m0 & (SEQ - 1)) == 0) {
#pragma unroll
            for (int i = 0; i < 8; ++i) { h1[i] = 0.f; h2[i] = 0.f; } }
        else { unpack8(*(const GAS v4u*)(G + (size_t)(m0 - 1) * NUP + f0), h1); unpack8(*(const GAS v4u*)(G + (size_t)(m0 - 2) * NUP + f0), h2); }
    } else {
#pragma unroll
        for (int i = 0; i < 8; ++i) { h1[i] = 0.f; h2[i] = 0.f; } }
    for (int r = 0; r < 32; ++r) {
        const int m = m0 + r; if (m >= MREAL) break;
        if (m >= MPR && ((m - MPR) & 3) == 0) { const float* st = AIN(I_SFFN) + ((size_t)(l * DECB + ((m - MPR) >> 2)) * 2) * DFF + f0;
#pragma unroll
            for (int i = 0; i < 8; ++i) { h2[i] = st[i]; h1[i] = st[DFF + i]; } }
        float g[8], v[8], y[8]; unpack8(*(const GAS v4u*)(G + (size_t)m * NUP + f0), g); unpack8(*(const GAS v4u*)(G + (size_t)m * NUP + DFF + f0), v);
#pragma unroll
        for (int i = 0; i < 8; ++i) { const float gc = w0[i] * h2[i] + w1[i] * h1[i] + w2[i] * g[i] + cb[i]; y[i] = silu(gc) * v[i]; h2[i] = h1[i]; h1[i] = g[i]; }
        *(GAS v4u*)(ACT + (size_t)m * DFF + f0) = pack8(y);
        if (m < MPR) { const int t = m & (SEQ - 1); if (t >= SEQ - 2) { float* o = AOUT + O_PFFN + ((size_t)(l * BATCH + (m >> 11)) * 2 + (t - (SEQ - 2))) * DFF + f0; *(GAS f32x4*)o = (f32x4){g[0], g[1], g[2], g[3]}; *(GAS f32x4*)(o + 4) = (f32x4){g[4], g[5], g[6], g[7]}; } }
        else { const int s = (m - MPR) & 3; if (s >= 2) { float* o = AOUT + O_SFFN + ((size_t)(l * DECB + ((m - MPR) >> 2)) * 2 + (s - 2)) * DFF + f0; *(GAS f32x4*)o = (f32x4){g[0], g[1], g[2], g[3]}; *(GAS f32x4*)(o + 4) = (f32x4){g[4], g[5], g[6], g[7]}; } }
    }
}

struct AttnOrder {
    int start, step;
    __device__ __forceinline__ bool next(int i, attn_body::AttnUnit& u) const { const int idx = start + i * step; if (idx >= 256) return false; u.bh = idx >> 3; u.qb = idx & 7; return true; }
    __device__ __forceinline__ void a_ready(const attn_body::AttnUnit&) const {}
    __device__ __forceinline__ void done(const attn_body::AttnUnit&) const {}
};

__global__ void __launch_bounds__(NWAVES * 64, 2) hybrid_fwd(Args A) {
    using namespace P;
    extern __shared__ __attribute__((aligned(16))) unsigned char lds[];
#define MKFRAME() Frame F; { F.lds = (LAS unsigned char*)lds; F.MISC = (volatile LAS unsigned*)(F.lds + MISC_OFF); F.tid = ltid(); F.lane = F.tid & 63; F.wave = __builtin_amdgcn_readfirstlane(F.tid >> 6); \
        F.G = lgrid(); const int bx_ = lbid(); F.vcu = (F.G % 8 == 0) ? (bx_ % 8) * (F.G / 8) + bx_ / 8 : bx_; F.ctl = (gu32*)(AWS + WS_CTL); }
    XcdBarrier bar;
    { const int z = OPAQUE_ZERO(); MKFRAME();
      for (int u = F.tid; u < (LDS_BYTES - RING_BYTES) / 4; u += NWAVES * 64) ((LAS unsigned*)(F.lds + RING_BYTES))[u] = 0u;
      __syncthreads();
      bar.bar = (unsigned*)(F.ctl + CW_BAR); bar.x = 0; bar.st = nullptr;
      if (!MK_PER_PHASE) bar = xcd_barrier_post((unsigned*)(F.ctl + CW_BAR), F.MISC + 8); }
    const int lo = A.ph_lo, hi = A.ph_hi;
#define IN(k) (lo <= (k) && (k) < hi)
#define SEAM(k) do { if (!MK_PER_PHASE && (k) + 1 < N_PHASES) xcd_barrier(bar); } while (0)
#define GW() (F.vcu * NWAVES + F.wave)
#define NGW() (F.G * NWAVES)

    if (IN(0)) { const int z = OPAQUE_ZERO(); MKFRAME(); p0_prologue(A, z, F); SEAM(0); }

    for (int l = 0; l < DEPTH; ++l) {
        const int pb = 1 + PH_PER_LAYER * l;
        if (IN(pb + 0)) {
            const int z = OPAQUE_ZERO(); MKFRAME(); unsigned char* const ws = AWS; float* const out = AOUT;
            pg8::Gemm g{(const bf16*)(ws + WS_XB), (const bf16*)(ws + WS_WIN + l * SZ_WIN), MP, NIN, DM}; pg8::StaticOrder S; S.init(MP, NIN, F.G, (int)lbid());
            pg8::EpiIn E{(bf16*)(ws + WS_H), (float*)(ws + WS_LRF), out, l};
            pg8::gemm_phase<pg8::EpiIn, pg8::StaticOrder, true, true>(F.lds, g, S, E);
            SEAM(pb + 0);
        }
        if (IN(pb + 1)) {
            const int z = OPAQUE_ZERO(); MKFRAME();
            gu32* head = F.ctl + CW_Q + 64 * (2 * l);
            constexpr int N_PG = DECB * NPAGES / 8, N_GL = 1024, N_SG = 512, N_CV = 512, N_CS = 4;
            for (;;) {
                int it = q_next(F, head);
                if (it < N_PG) { fox_page_wave(A, z, F, l, it * 8 + F.wave); continue; } it -= N_PG;
                if (it < N_GL) { gla_local_item(A, z, F, l, it); continue; } it -= N_GL;
                if (it < N_SG) { sgu_item(A, z, F, l, it); continue; } it -= N_SG;
                if (it < N_CV) { conv_item(A, z, F, l, it); continue; } it -= N_CV;
                if (it < N_CS) { fox_cumsum_wave(A, z, F, l, it * 8 + F.wave); continue; }
                break;
            }
            SEAM(pb + 1);
        }
        if (IN(pb + 2)) {
            { const int z = OPAQUE_ZERO(); MKFRAME(); unsigned char* const ws = AWS; const bf16* Hb = (const bf16*)(ws + WS_H);
              const attn_body::AttnTensors AT{(const attn_body::bf16*)(Hb + HC_CQ), (const attn_body::bf16*)(Hb + HC_CK), (const attn_body::bf16*)(Hb + HC_CV), (attn_body::bf16*)(ws + WS_Y) + 512, (const float*)(ws + WS_KBIAS)};
              const AttnOrder S{F.vcu, F.G};
              attn_body::attn_phase<AttnOrder>((char*)lds, AT, S); }
            const int z = OPAQUE_ZERO(); MKFRAME();
            gu32* head = F.ctl + CW_Q + 64 * (2 * l + 1);
            for (;;) {
                int it = q_next(F, head);
                if (it < DECB) { sample_item(A, z, F, l, it); continue; } it -= DECB;
                if (it < 1024) { gla_out_item(A, z, F, l, it); continue; }
                break;
            }
            SEAM(pb + 2);
        }
        if (IN(pb + 3)) {
            const int z = OPAQUE_ZERO(); MKFRAME(); unsigned char* const ws = AWS;
            pg8::Gemm g{(const bf16*)(ws + WS_Y), (const bf16*)(ws + WS_WO + l * SZ_WO), MP, DM, DM}; pg8::StaticOrder S; S.init(MP, DM, F.G, (int)lbid());
            pg8::EpiRes E{(const float*)(ws + WS_XF), (float*)(ws + WS_Z), DM, ALPHA};
            pg8::gemm_phase<pg8::EpiRes, pg8::StaticOrder, true, true>(F.lds, g, S, E);
            SEAM(pb + 3);
        }
        if (IN(pb + 4)) {
            const int z = OPAQUE_ZERO(); MKFRAME(); unsigned char* const ws = AWS; const float* Z = (const float*)(ws + WS_Z); float* X1F = (float*)(ws + WS_X1F); bf16* X1B = (bf16*)(ws + WS_X1B);
            const float* lg = AIN(I_L1G) + l * DM; const float* lb = AIN(I_L1B) + l * DM;
            for (int m = GW(); m < MREAL; m += NGW()) ln_row(F, Z + (size_t)m * DM, lg, lb, X1F + (size_t)m * DM, X1B + (size_t)m * DM);
            SEAM(pb + 4);
        }
        if (IN(pb + 5)) {
            const int z = OPAQUE_ZERO(); MKFRAME(); unsigned char* const ws = AWS;
            pg8::Gemm g{(const bf16*)(ws + WS_X1B), (const bf16*)(ws + WS_WUP + l * SZ_WUP), MP, NUP, DM}; pg8::StaticOrder S; S.init(MP, NUP, F.G, (int)lbid());
            pg8::EpiBf16 E{(bf16*)(ws + WS_G), NUP};
            pg8::gemm_phase<pg8::EpiBf16, pg8::StaticOrder, true, true>(F.lds, g, S, E);
            SEAM(pb + 5);
        }
        if (IN(pb + 6)) {
            const int z = OPAQUE_ZERO(); MKFRAME();
            for (int it = F.vcu; it < (MREAL + 31) / 32; it += F.G) act_item(A, z, F, l, it);
            SEAM(pb + 6);
        }
        if (IN(pb + 7)) {
            const int z = OPAQUE_ZERO(); MKFRAME(); unsigned char* const ws = AWS;
            pg8::Gemm g{(const bf16*)(ws + WS_ACT), (const bf16*)(ws + WS_WDN + l * SZ_WDN), MP, DM, DFF}; pg8::StaticOrder S; S.init(MP, DM, F.G, (int)lbid());
            pg8::EpiRes E{(const float*)(ws + WS_X1F), (float*)(ws + WS_Z), DM, ALPHA};
            pg8::gemm_phase<pg8::EpiRes, pg8::StaticOrder, true, true>(F.lds, g, S, E);
            SEAM(pb + 7);
        }
        if (IN(pb + 8)) {
            const int z = OPAQUE_ZERO(); MKFRAME(); unsigned char* const ws = AWS; float* const out = AOUT; const float* Z = (const float*)(ws + WS_Z);
            const float* lg = AIN(I_L2G) + l * DM; const float* lb = AIN(I_L2B) + l * DM;
            for (int m = GW(); m < MREAL; m += NGW()) {
                float* of; bf16* ob;
                if (l + 1 < DEPTH) { of = (float*)(ws + WS_XF) + (size_t)m * DM; ob = (bf16*)(ws + WS_XB) + (size_t)m * DM; }
                else { of = m < MPR ? out + O_YP + (size_t)m * DM : out + O_YS + (size_t)(m - MPR) * DM; ob = nullptr; }
                ln_row(F, Z + (size_t)m * DM, lg, lb, of, ob);
            }
            SEAM(pb + 8);
        }
    }
#undef IN
#undef SEAM
#undef GW
#undef NGW
#undef MKFRAME
}

extern "C" void kernel_launch(void* const* d_in, const int* in_sizes, int n_in, void* d_out, int out_size, void* d_ws, size_t ws_size, hipStream_t stream) {
    using namespace P;
    static int grid = 0;
    if (grid == 0) {
        if (n_in != N_IN || (size_t)out_size != O_END || ws_size < WS_END) { fprintf(stderr, "kernel_launch: unexpected shapes: n_in %d out %d ws %zu (need %zu)\n", n_in, out_size, ws_size, (size_t)WS_END); grid = -1; return; }
        int dev = 0, cus = 0, per_cu = 0;
        if (hipGetDevice(&dev) != hipSuccess || hipDeviceGetAttribute(&cus, hipDeviceAttributeMultiprocessorCount, dev) != hipSuccess) { grid = -1; return; }
        if (hipFuncSetAttribute((const void*)hybrid_fwd, hipFuncAttributeMaxDynamicSharedMemorySize, LDS_BYTES) != hipSuccess) { fprintf(stderr, "kernel_launch: hipFuncSetAttribute failed\n"); grid = -1; return; }
        if (hipOccupancyMaxActiveBlocksPerMultiprocessor(&per_cu, (const void*)hybrid_fwd, NWAVES * 64, LDS_BYTES) != hipSuccess || per_cu < 1)
            fprintf(stderr, "kernel_launch: note: occupancy query reports %d workgroups per CU\n", per_cu);
        (void)hipGetLastError();
        grid = cus;
    }
    if (grid < 0) return;
    if (hipMemsetAsync((char*)d_ws + WS_CTL, 0, CTL_ZERO_BYTES, stream) != hipSuccess) { fprintf(stderr, "kernel_launch: memset failed\n"); return; }
    Args a{};
    for (int i = 0; i < N_IN; ++i) a.p[i] = (const float*)d_in[i];
    a.p[N_IN] = (const float*)d_out; a.p[N_IN + 1] = (const float*)d_ws;
#if MK_PER_PHASE
    for (int p = 0; p < N_PHASES; ++p) { a.ph_lo = p; a.ph_hi = p + 1; hipLaunchKernelGGL(hybrid_fwd, dim3(grid), dim3(NWAVES * 64), LDS_BYTES, stream, a); }
#else
    a.ph_lo = 0; a.ph_hi = N_PHASES;
    hipLaunchKernelGGL(hybrid_fwd, dim3(grid), dim3(NWAVES * 64), LDS_BYTES, stream, a);
#endif
    const hipError_t le = hipPeekAtLastError();
    if (le != hipSuccess) fprintf(stderr, "kernel_launch: launch failed: %s\n", hipGetErrorName(le));
}
```

```cpp
#include <hip/hip_runtime.h>
#include <cstdio>
#include <cstdint>
#define LTID_TABLE_OFF (131072 + 1024)
__device__ __forceinline__ unsigned hw_wave_slot() { return (unsigned)__builtin_amdgcn_s_getreg((5 << 11) | 4) & 63u; }
__device__ __forceinline__ int ltid() {
    extern __shared__ __attribute__((aligned(16))) unsigned char lds[];
    const int w = __builtin_amdgcn_readfirstlane(((const __attribute__((address_space(3))) int*)((__attribute__((address_space(3))) unsigned char*)lds + LTID_TABLE_OFF))[hw_wave_slot()]);
    int lane; asm volatile("v_mbcnt_lo_u32_b32 %0, -1, 0\n\tv_mbcnt_hi_u32_b32 %0, -1, %0" : "=v"(lane));
    return w * 64 + lane; }
__device__ __forceinline__ int lbid() { int t = blockIdx.x; asm volatile("" : "+s"(t)); return t; }
__device__ __forceinline__ int lgrid() { int t = gridDim.x; asm volatile("" : "+s"(t)); return t; }
namespace pg8 {
#define PG8_LAS __attribute__((address_space(3)))
typedef unsigned short bf16_t;
typedef short bf16x8 __attribute__((ext_vector_type(8)));
typedef float f32x4 __attribute__((ext_vector_type(4)));
typedef unsigned u32x4 __attribute__((ext_vector_type(4)));
constexpr int BM = 256, BK = 64, HALF = 128, HTB = HALF * BK * 2  , STAGE_BYTES = 8 * HTB, NXCD = 8, WGM = 4;

__host__ __device__ __forceinline__ int lds_byte(int r, int c) { const int st = (r >> 4) * 2 + (c >> 5), rr = r & 15, cc = c & 31, ob = rr * 64 + cc * 2; return st * 1024 + (ob ^ (((ob >> 9) & 1) << 5)); }
__host__ __device__ __forceinline__ void stage_rc(int b, int& R, int& C) { const int st = b / 1024, sb = b % 1024, swz = sb ^ (((sb >> 9) & 1) << 5); R = (st >> 1) * 16 + swz / 64; C = (st & 1) * 32 + (swz % 64) / 2; }
__host__ __device__ __forceinline__ int perm32(int rho) { const int n = rho >> 4, i = rho & 15; return 8 * (i >> 2) + 4 * n + (i & 3); }

struct Unit { int pm, pn, k0; };
struct Gemm { const bf16_t* A; const bf16_t* Bt; int M, N, K, ld; };

struct StaticOrder {
    int nM, nN, nwg, G, c, wgm;
    __host__ __device__ __forceinline__ void init(int M, int N, int G_, int c_, int wgm_ = WGM) { nM = M / BM; nN = N / BM; nwg = nM * nN; G = G_; c = c_; wgm = wgm_; }
    __host__ __device__ __forceinline__ bool next(int i, Unit& u) const {
        const long L = (long)i * G + c; if (L >= nwg) return false;
        int wgid = (int)L; { const int q = nwg / NXCD, r = nwg % NXCD, xcd = wgid % NXCD, off = wgid / NXCD; wgid = (xcd < r ? xcd * (q + 1) : r * (q + 1) + (xcd - r) * q) + off; }
        const int nig = wgm * nN, gid = wgid / nig, fm = gid * wgm, gsz = (nM - fm) < wgm ? (nM - fm) : wgm;
        u.pm = fm + ((wgid % nig) % gsz); u.pn = (wgid % nig) / gsz; u.k0 = 0; return true;
    }
    __device__ __forceinline__ void a_ready(const Unit&) const {}
    __device__ __forceinline__ void done(const Unit&) const {}
};

struct SliceOrder {
    int pm, nN, nS, kslice, G, c;
    __host__ __device__ __forceinline__ bool next(int i, Unit& u) const { const int L = i * G + c; if (L >= nN * nS) return false; u.pm = pm; u.pn = L % nN; u.k0 = (L / nN) * kslice; return true; }
    __device__ __forceinline__ void a_ready(const Unit&) const {}
    __device__ __forceinline__ void done(const Unit&) const {}
};

__device__ __forceinline__ unsigned cvt_pk_bf16(float lo, float hi) { unsigned r; asm volatile("v_cvt_pk_bf16_f32 %0, %1, %2" : "=v"(r) : "v"(lo), "v"(hi)); return r; }
typedef float f32x2 __attribute__((ext_vector_type(2)));

struct EpiBf16 {
    static constexpr bool PERM = true, AFTER_DRAIN = false;
    bf16_t* O; int ldc;
    __device__ __forceinline__ void operator()(const f32x4 (&acc)[2][2][4][2], const Unit& u, int wr, int wc, int fr, int fq) const {
        const int row0 = u.pm * BM + wr * 64 + fr; const int col0 = u.pn * BM + wc * 32 + 8 * fq;
#pragma unroll
        for (int ai = 0; ai < 2; ++ai)
#pragma unroll
            for (int m = 0; m < 4; ++m) { bf16_t* rowp = O + (size_t)(row0 + ai * HALF + m * 16) * ldc + col0;
#pragma unroll
                for (int bj = 0; bj < 2; ++bj) { const f32x4 v0 = acc[ai][bj][m][0], v1 = acc[ai][bj][m][1];
                    u32x4 w; w.x = cvt_pk_bf16(v0[0], v0[1]); w.y = cvt_pk_bf16(v0[2], v0[3]); w.z = cvt_pk_bf16(v1[0], v1[1]); w.w = cvt_pk_bf16(v1[2], v1[3]);
                    *(u32x4*)(rowp + bj * HALF) = w; } }
    }
};
struct EpiIn {
    static constexpr bool PERM = true, AFTER_DRAIN = false;
    bf16_t* H; float* lrf; float* out; int layer; float* logf; f32x4 fbf;
    static constexpr int ldc = 2816, pm_sample = 64; static constexpr float qscale = 0.125f * 1.4426950408889634f;
    static constexpr size_t O_PFK = 16908288, O_PFV = O_PFK + 8388608, O_PFL = O_PFV + 8388608, O_SFK = 34156544, O_SFV = O_SFK + 65536;
    __device__ __forceinline__ void operator()(const f32x4 (&acc)[2][2][4][2], const Unit& u, int wr, int wc, int fr, int fq) const {
        const int row0 = u.pm * BM + wr * 64 + fr; const int col0 = u.pn * BM + wc * 32 + 8 * fq;
        const float sc = (u.pn == 5) ? qscale : 1.f;
#pragma unroll
        for (int ai = 0; ai < 2; ++ai)
#pragma unroll
            for (int m = 0; m < 4; ++m) { bf16_t* rowp = H + (size_t)(row0 + ai * HALF + m * 16) * ldc + col0;
#pragma unroll
                for (int bj = 0; bj < 2; ++bj) { const f32x4 v0 = acc[ai][bj][m][0] * sc, v1 = acc[ai][bj][m][1] * sc;
                    u32x4 w; w.x = cvt_pk_bf16(v0[0], v0[1]); w.y = cvt_pk_bf16(v0[2], v0[3]); w.z = cvt_pk_bf16(v1[0], v1[1]); w.w = cvt_pk_bf16(v1[2], v1[3]);
                    *(u32x4*)(rowp + bj * HALF) = w; } }
        if (u.pn == 6 || u.pn == 7) {
            const int lcol0 = wc * 32 + 8 * fq;
#pragma unroll
            for (int ai = 0; ai < 2; ++ai) {
                float* dst; int rbase;
                if (u.pm < pm_sample) { dst = out + ((u.pn == 6) ? O_PFK : O_PFV) + (size_t)layer * (16384 * 256); rbase = u.pm * BM; }
                else { if (ai == 1) continue; dst = out + ((u.pn == 6) ? O_SFK : O_SFV) + (size_t)layer * (128 * 256); rbase = 0; }
#pragma unroll
                for (int m = 0; m < 4; ++m) { float* rowp = dst + (size_t)(rbase + wr * 64 + fr + ai * HALF + m * 16) * 256 + lcol0;
#pragma unroll
                    for (int bj = 0; bj < 2; ++bj) { *(f32x4*)(rowp + bj * HALF) = acc[ai][bj][m][0]; *(f32x4*)(rowp + bj * HALF + 4) = acc[ai][bj][m][1]; } }
            }
        }
        if (u.pn == 10 && wc == 0) {
#pragma unroll
            for (int ai = 0; ai < 2; ++ai)
#pragma unroll
                for (int m = 0; m < 4; ++m) { const int row = row0 + ai * HALF + m * 16; float* rowp = lrf + (size_t)row * 32 + 8 * fq;
                    *(f32x4*)(rowp) = acc[ai][0][m][0]; *(f32x4*)(rowp + 4) = acc[ai][0][m][1];
                    if (fq == 2 && row < 16384) {
                        f32x4 lf;
#pragma unroll
                        for (int i = 0; i < 4; ++i) { const float x = acc[ai][0][m][0][i] + fbf[i]; lf[i] = fminf(x, 0.f) - log1pf(expf(-fabsf(x))); }
                        *(f32x4*)(logf + (size_t)row * 4) = lf; *(f32x4*)(out + O_PFL + ((size_t)layer * 16384 + row) * 4) = lf; } }
        }
    }
};
struct EpiRes {
    static constexpr bool PERM = true, AFTER_DRAIN = false;
    const bf16_t* R; bf16_t* Z; int ldc; float alpha;
    __device__ __forceinline__ void operator()(const f32x4 (&acc)[2][2][4][2], const Unit& u, int wr, int wc, int fr, int fq) const {
        const int row0 = u.pm * BM + wr * 64 + fr; const int col0 = u.pn * BM + wc * 32 + 8 * fq;
#pragma unroll
        for (int ai = 0; ai < 2; ++ai)
#pragma unroll
            for (int m = 0; m < 4; ++m) { const size_t off = (size_t)(row0 + ai * HALF + m * 16) * ldc + col0;
#pragma unroll
                for (int bj = 0; bj < 2; ++bj) { const u32x4 r = *(const u32x4*)(R + off + bj * HALF); const f32x4 a0 = acc[ai][bj][m][0], a1 = acc[ai][bj][m][1];
                    u32x4 w; w.x = cvt_pk_bf16(__uint_as_float(r.x << 16) * alpha + a0[0], __uint_as_float(r.x & 0xffff0000u) * alpha + a0[1]); w.y = cvt_pk_bf16(__uint_as_float(r.y << 16) * alpha + a0[2], __uint_as_float(r.y & 0xffff0000u) * alpha + a0[3]);
                    w.z = cvt_pk_bf16(__uint_as_float(r.z << 16) * alpha + a1[0], __uint_as_float(r.z & 0xffff0000u) * alpha + a1[1]); w.w = cvt_pk_bf16(__uint_as_float(r.w << 16) * alpha + a1[2], __uint_as_float(r.w & 0xffff0000u) * alpha + a1[3]);
                    *(u32x4*)(Z + off + bj * HALF) = w; } }
    }
};
struct EpiPart {
    static constexpr bool PERM = false, AFTER_DRAIN = false;
    float* PZ; int ldc, kslice;
    __device__ __forceinline__ void operator()(const f32x4 (&acc)[2][2][4][2], const Unit& u, int wr, int wc, int fr, int fq) const {
        const int col0 = u.pn * BM + wc * 32 + 4 * fq; float* base = PZ + (size_t)(u.k0 / kslice) * 128 * ldc;
#pragma unroll
        for (int m = 0; m < 4; ++m) { const size_t off = (size_t)(wr * 64 + m * 16 + fr) * ldc + col0;
#pragma unroll
            for (int bj = 0; bj < 2; ++bj)
#pragma unroll
                for (int n = 0; n < 2; ++n) *(f32x4*)(base + off + bj * HALF + n * 16) = acc[0][bj][m][n]; }
    }
};

template <class Epi, class Sched, bool ALIGN_EPI = false, bool SP2 = false>
__device__ __forceinline__ void gemm_phase(PG8_LAS unsigned char* lds, const Gemm g, const Sched& S, const Epi& E) {
    const int tid = ltid(), wid = __builtin_amdgcn_readfirstlane(tid >> 6), lane = tid & 63, wr = wid >> 2, wc = wid & 3, fr = lane & 15, fq = lane >> 4;
    const int K = g.K, nt = K / BK, LD = g.ld;
    unsigned voffA[2], voffB[2];
#pragma unroll
    for (int i = 0; i < 2; ++i) { int R, C; stage_rc(tid * 16 + i * 8192, R, C); const int Rb = Epi::PERM ? ((R & ~31) + perm32(R & 31)) : R;
        voffA[i] = (unsigned)(R * LD + C) * 2u; voffB[i] = (unsigned)(Rb * LD + C) * 2u; }
    const size_t kstep = (size_t)(BK * 2);
    const size_t hstep = (size_t)HALF * LD * 2;
    const size_t tstep = 2 * hstep;
    const unsigned ldsw = (unsigned)wid * 1024u;
    const int aoff = lds_byte(wr * 64 + fr, fq * 8), boff = lds_byte(wc * 32 + fr, fq * 8);
#define PG8_SA(b, h) (((b) * 2 + (h)) * HTB)
#define PG8_SB(b, h) ((4 + (b) * 2 + (h)) * HTB)
#define PG8_STAGE(bufoff, gbase, voff) do { _Pragma("unroll") for (int _i = 0; _i < 2; ++_i) \
        __builtin_amdgcn_global_load_lds((const unsigned*)((const char*)(gbase) + (voff)[_i]), (PG8_LAS unsigned*)(lds + (bufoff) + ldsw + _i * 8192), 16, 0, 0); } while (0)
#define PG8_LDA(dst, b, h) do { _Pragma("unroll") for (int m = 0; m < 4; ++m) _Pragma("unroll") for (int k = 0; k < 2; ++k) dst[m][k] = *(const PG8_LAS bf16x8*)(lds + PG8_SA(b, h) + aoff + m * 2048 + k * 1024); } while (0)
#define PG8_LDB(dst, b, h) do { _Pragma("unroll") for (int n = 0; n < 2; ++n) _Pragma("unroll") for (int k = 0; k < 2; ++k) dst[n][k] = *(const PG8_LAS bf16x8*)(lds + PG8_SB(b, h) + boff + n * 2048 + k * 1024); } while (0)
#define PG8_MMA(ai, bj, At, Bt) do { __builtin_amdgcn_s_setprio(1); _Pragma("unroll") for (int m = 0; m < 4; ++m) _Pragma("unroll") for (int n = 0; n < 2; ++n) _Pragma("unroll") for (int k = 0; k < 2; ++k) \
        acc[ai][bj][m][n] = __builtin_amdgcn_mfma_f32_16x16x32_bf16(Bt[n][k], At[m][k], acc[ai][bj][m][n], 0, 0, 0); __builtin_amdgcn_s_setprio(0); } while (0)
#define PG8_WAIT_V(n) asm volatile("s_waitcnt vmcnt(" #n ")" ::: "memory")
#define PG8_WAIT_L(n) asm volatile("s_waitcnt lgkmcnt(" #n ")" ::: "memory")
#define PG8_BAR __builtin_amdgcn_s_barrier()
#define PG8_SCHED __builtin_amdgcn_sched_barrier(0)
    Unit cur, nxt; int ui = 0;
    if (!S.next(0, cur)) return;
    f32x4 acc[2][2][4][2];
#pragma unroll
    for (int a = 0; a < 2; ++a)
#pragma unroll
        for (int b = 0; b < 2; ++b)
#pragma unroll
            for (int m = 0; m < 4; ++m)
#pragma unroll
                for (int n = 0; n < 2; ++n) acc[a][b][m][n] = (f32x4){0.f, 0.f, 0.f, 0.f};
    bf16x8 At[4][2], B0[2][2], B1[2][2];
    const char* cA = (const char*)g.A + (size_t)cur.pm * tstep + (size_t)cur.k0 * 2; const char* cB = (const char*)g.Bt + (size_t)cur.pn * tstep + (size_t)cur.k0 * 2;
    S.a_ready(cur);
    if constexpr (SP2) {
        PG8_STAGE(PG8_SB(0, 0), cB, voffB); PG8_STAGE(PG8_SB(0, 1), cB + hstep, voffB); PG8_STAGE(PG8_SA(0, 0), cA, voffA); PG8_STAGE(PG8_SA(0, 1), cA + hstep, voffA);
        if (wr == 1) PG8_BAR;
        PG8_WAIT_V(2); PG8_BAR;
        PG8_STAGE(PG8_SB(1, 0), cB + kstep, voffB); PG8_STAGE(PG8_SA(1, 0), cA + kstep, voffA); PG8_STAGE(PG8_SB(1, 1), cB + hstep + kstep, voffB);
        PG8_WAIT_V(6); PG8_BAR;
    } else {
        PG8_STAGE(PG8_SB(0, 0), cB, voffB); PG8_STAGE(PG8_SA(0, 0), cA, voffA); PG8_STAGE(PG8_SB(0, 1), cB + hstep, voffB); PG8_STAGE(PG8_SA(0, 1), cA + hstep, voffA);
        if (wr == 1) PG8_BAR;
        PG8_WAIT_V(4); PG8_BAR;
        PG8_STAGE(PG8_SB(1, 0), cB + kstep, voffB); PG8_STAGE(PG8_SA(1, 0), cA + kstep, voffA); PG8_STAGE(PG8_SB(1, 1), cB + hstep + kstep, voffB);
        PG8_WAIT_V(6); PG8_BAR;
    }
    for (;;) {
        const bool has_next = S.next(ui + 1, nxt);
        const char* nA = has_next ? (const char*)g.A + (size_t)nxt.pm * tstep + (size_t)nxt.k0 * 2 : cA; const char* nB = has_next ? (const char*)g.Bt + (size_t)nxt.pn * tstep + (size_t)nxt.k0 * 2 : cB;
        for (int t = 0; t < nt; t += 2) {
            const bool last = (t == nt - 2);
            const char* a1 = cA + (size_t)(t + 1) * kstep;
            const char* a2 = last ? nA : cA + (size_t)(t + 2) * kstep; const char* b2 = last ? nB : cB + (size_t)(t + 2) * kstep;
            const char* a3 = a2 + kstep; const char* b3 = b2 + kstep;
            if (last && has_next) S.a_ready(nxt);
            if constexpr (SP2) {
            PG8_LDB(B0, 0, 0); PG8_LDB(B1, 0, 1); PG8_SCHED; PG8_LDA(At, 0, 0); PG8_STAGE(PG8_SA(1, 1), a1 + hstep, voffA);
            PG8_WAIT_V(8); PG8_WAIT_L(0); PG8_BAR; PG8_MMA(0, 0, At, B0); PG8_MMA(0, 1, At, B1); PG8_BAR; PG8_SCHED;
            PG8_LDA(At, 0, 1); PG8_STAGE(PG8_SB(0, 0), b2, voffB); PG8_STAGE(PG8_SB(0, 1), b2 + hstep, voffB); PG8_STAGE(PG8_SA(0, 0), a2, voffA);
            PG8_WAIT_V(8); PG8_WAIT_L(0); PG8_BAR; PG8_MMA(1, 0, At, B0); PG8_MMA(1, 1, At, B1); PG8_BAR; PG8_SCHED;
            PG8_LDB(B0, 1, 0); PG8_LDB(B1, 1, 1); PG8_SCHED; PG8_LDA(At, 1, 0); PG8_STAGE(PG8_SA(0, 1), a2 + hstep, voffA);
            PG8_WAIT_V(8); PG8_WAIT_L(0); PG8_BAR; PG8_MMA(0, 0, At, B0); PG8_MMA(0, 1, At, B1); PG8_BAR; PG8_SCHED;
            PG8_LDA(At, 1, 1); PG8_STAGE(PG8_SB(1, 0), b3, voffB); PG8_STAGE(PG8_SB(1, 1), b3 + hstep, voffB); PG8_STAGE(PG8_SA(1, 0), a3, voffA);
            PG8_WAIT_V(8); PG8_WAIT_L(0); PG8_BAR; PG8_MMA(1, 0, At, B0); PG8_MMA(1, 1, At, B1); PG8_BAR; PG8_SCHED;
            } else {
            PG8_LDB(B0, 0, 0); PG8_SCHED; PG8_LDA(At, 0, 0); PG8_STAGE(PG8_SA(1, 1), a1 + hstep, voffA);
            PG8_WAIT_L(8); PG8_BAR; PG8_WAIT_L(0); PG8_MMA(0, 0, At, B0); PG8_BAR; PG8_SCHED;
            PG8_LDB(B1, 0, 1); PG8_STAGE(PG8_SB(0, 0), b2, voffB);
            PG8_BAR; PG8_WAIT_L(0); PG8_MMA(0, 1, At, B1); PG8_BAR;
            PG8_LDA(At, 0, 1); PG8_STAGE(PG8_SA(0, 0), a2, voffA);
            PG8_BAR; PG8_WAIT_L(0); PG8_MMA(1, 0, At, B0); PG8_BAR; PG8_SCHED;
            PG8_STAGE(PG8_SB(0, 1), b2 + hstep, voffB);
            PG8_WAIT_V(6); PG8_BAR; PG8_MMA(1, 1, At, B1); PG8_BAR;
            PG8_LDB(B0, 1, 0); PG8_SCHED; PG8_LDA(At, 1, 0); PG8_STAGE(PG8_SA(0, 1), a2 + hstep, voffA);
            PG8_WAIT_L(8); PG8_BAR; PG8_WAIT_L(0); PG8_MMA(0, 0, At, B0); PG8_BAR; PG8_SCHED;
            PG8_LDB(B1, 1, 1); PG8_STAGE(PG8_SB(1, 0), b3, voffB);
            PG8_BAR; PG8_WAIT_L(0); PG8_MMA(0, 1, At, B1); PG8_BAR;
            PG8_LDA(At, 1, 1); PG8_STAGE(PG8_SA(1, 0), a3, voffA);
            PG8_BAR; PG8_WAIT_L(0); PG8_MMA(1, 0, At, B0); PG8_BAR; PG8_SCHED;
            PG8_STAGE(PG8_SB(1, 1), b3 + hstep, voffB);
            PG8_WAIT_V(6); PG8_BAR; PG8_MMA(1, 1, At, B1); PG8_BAR;
            }
        }
        if constexpr (ALIGN_EPI) { if (wr == 0) PG8_BAR; }
        if constexpr (!Epi::AFTER_DRAIN) { E(acc, cur, wr, wc, fr, fq); S.done(cur); }
        if (!has_next) break;
#pragma unroll
        for (int a = 0; a < 2; ++a)
#pragma unroll
            for (int b = 0; b < 2; ++b)
#pragma unroll
                for (int m = 0; m < 4; ++m)
#pragma unroll
                    for (int n = 0; n < 2; ++n) acc[a][b][m][n] = (f32x4){0.f, 0.f, 0.f, 0.f};
        cur = nxt; cA = nA; cB = nB; ++ui;
        if constexpr (ALIGN_EPI) { if (wr == 1) PG8_BAR; }
    }
    PG8_WAIT_V(0);
    if constexpr (!ALIGN_EPI) { if (wr == 0) PG8_BAR; }
    PG8_BAR;
    if constexpr (Epi::AFTER_DRAIN) { E.fused(acc, cur, wr, wc, fr, fq, lds, wid, lane); S.done(cur); }
#undef PG8_SA
#undef PG8_SB
#undef PG8_STAGE
#undef PG8_LDA
#undef PG8_LDB
#undef PG8_MMA
#undef PG8_WAIT_V
#undef PG8_WAIT_L
#undef PG8_BAR
#undef PG8_SCHED
}
}

#ifndef PG8_SP2
#define PG8_SP2 true
#endif

#include <hip/hip_bf16.h>
#include <cmath>
namespace attn_body {
using bf16=__hip_bfloat16;
using bf16x8=__attribute__((ext_vector_type(8)))short;
using s16x4=__attribute__((ext_vector_type(4)))short;
using f32x16=__attribute__((ext_vector_type(16)))float;
using u32x4=__attribute__((ext_vector_type(4)))unsigned;
constexpr int BATCH=8,NHEAD=4,SEQ=2048,D=64,DM=2816,DMO=1024;
constexpr int NW=8,QBLK=32,QB=QBLK*NW,KVBLK=64,NQB=SEQ/QB;
constexpr int ATTN_PITCH=DM, ATTN_UNIT_ROWS=QB;
__device__ __forceinline__ int crow(int r,int hi){return (r&3)+8*(r>>2)+4*hi;}
#define SBAR() __builtin_amdgcn_sched_barrier(0)
__device__ __forceinline__ void cmask(f32x16&p0,f32x16&p1,int jb,int qrel,int hi){
  const float NEG=-INFINITY; int kb=64*jb+4*hi;
  #pragma unroll
  for(int r=0;r<16;++r){int kv=kb+(r&3)+8*(r>>2); if(kv>qrel)p0[r]=NEG; if(kv+32>qrel)p1[r]=NEG;}
}

constexpr int NSLOT=3, SLOTB=8192;
constexpr int LDS_K=0, LDS_V=NSLOT*SLOTB, LDS_WS=2*NSLOT*SLOTB, LDS_OST=LDS_WS+NW*64*4, LDS_KB=LDS_OST+NW*4096, LDS_BYTES=LDS_KB+SEQ*4;
constexpr float C2=0.125f*1.4426950408889634f;
__device__ __forceinline__ void glds16(const void*gsrc,unsigned lds_dst){unsigned keep;
  asm volatile("s_mov_b32 %0, m0\n\ts_mov_b32 m0, %2\n\ts_nop 0\n\tglobal_load_lds_dwordx4 %1, off\n\ts_mov_b32 m0, %0":"=&s"(keep):"v"(gsrc),"s"(lds_dst):"memory");}
__device__ __forceinline__ float max3f(float a,float b,float c){float r;asm("v_max3_f32 %0, %1, %2, %3":"=v"(r):"v"(a),"v"(b),"v"(c));return r;}
__device__ __forceinline__ float max2f(float a,float b){float r;asm("v_max_f32_e32 %0, %1, %2":"=v"(r):"v"(a),"v"(b));return r;}
__device__ __forceinline__ float fadd_s(float a,float b){float r;asm("v_add_f32_e32 %0, %1, %2":"=v"(r):"v"(a),"v"(b));return r;}
__device__ __forceinline__ float fsub_s(float a,float b){float r;asm("v_sub_f32_e32 %0, %1, %2":"=v"(r):"v"(a),"v"(b));return r;}
typedef float f32x2_t __attribute__((ext_vector_type(2))); typedef __bf16 bf16x2_t __attribute__((ext_vector_type(2)));
__device__ __forceinline__ unsigned cvtpk_s(float lo,float hi){f32x2_t v={lo,hi};bf16x2_t b=__builtin_convertvector(v,bf16x2_t);return __builtin_bit_cast(unsigned,b);}
#define WAIT_BAR(N) asm volatile("s_waitcnt vmcnt(" #N ") lgkmcnt(0)\n\ts_barrier":::"memory")

__device__ __forceinline__ void qkt(f32x16&p0,f32x16&p1,const char*Kslot,const bf16x8*qr,const f32x16&c0,const f32x16&c1,int r32,int hi){
  const char*kb=Kslot+hi*1024+r32*16;
  #pragma unroll
  for(int d0=0;d0<4;++d0){
    const bf16x8 b0=*reinterpret_cast<const bf16x8*>(kb+d0*2048);
    const bf16x8 b1=*reinterpret_cast<const bf16x8*>(kb+d0*2048+512);
    if(d0==0){p0=__builtin_amdgcn_mfma_f32_32x32x16_bf16(b0,qr[0],c0,0,0,0);p1=__builtin_amdgcn_mfma_f32_32x32x16_bf16(b1,qr[0],c1,0,0,0);}
    else{p0=__builtin_amdgcn_mfma_f32_32x32x16_bf16(b0,qr[d0],p0,0,0,0);p1=__builtin_amdgcn_mfma_f32_32x32x16_bf16(b1,qr[d0],p1,0,0,0);}}
}
typedef __attribute__((address_space(3))) const char* lds_cptr;
typedef short v4i16_t __attribute__((ext_vector_type(4)));
__device__ __forceinline__ void kload8(bf16x8*kf,lds_cptr kp){
  kf[0]=*(const __attribute__((address_space(3))) bf16x8*)(kp);      kf[1]=*(const __attribute__((address_space(3))) bf16x8*)(kp+512);
  kf[2]=*(const __attribute__((address_space(3))) bf16x8*)(kp+2048); kf[3]=*(const __attribute__((address_space(3))) bf16x8*)(kp+2560);
  kf[4]=*(const __attribute__((address_space(3))) bf16x8*)(kp+4096); kf[5]=*(const __attribute__((address_space(3))) bf16x8*)(kp+4608);
  kf[6]=*(const __attribute__((address_space(3))) bf16x8*)(kp+6144); kf[7]=*(const __attribute__((address_space(3))) bf16x8*)(kp+6656);
}
__device__ __forceinline__ void kload2(bf16x8*kf,lds_cptr kp,int j){ kf[2*j]=*(const __attribute__((address_space(3))) bf16x8*)(kp+j*2048); kf[2*j+1]=*(const __attribute__((address_space(3))) bf16x8*)(kp+j*2048+512); }
__device__ __forceinline__ s16x4 vtr(lds_cptr p){ return __builtin_bit_cast(s16x4,__builtin_amdgcn_ds_read_tr16_b64_v4i16((__attribute__((address_space(3))) v4i16_t*)p)); }
__device__ __forceinline__ float rowmax(const f32x16&p0,const f32x16&p1){
  float a=max3f(p0[0],p0[1],p1[0]),b=max3f(p0[2],p0[3],p1[1]);a=max3f(a,p1[2],p1[3]);
  #pragma unroll
  for(int r=4;r<16;r+=4){a=max3f(a,p0[r],p0[r+1]);b=max3f(b,p0[r+2],p0[r+3]);a=max3f(a,p1[r],p1[r+1]);b=max3f(b,p1[r+2],p1[r+3]);}
  const float m=max2f(a,b);
  auto rr=__builtin_amdgcn_permlane32_swap(__float_as_uint(m),__float_as_uint(m),false,false);
  return max2f(__uint_as_float(rr[0]),__uint_as_float(rr[1]));
}
__device__ __forceinline__ void pv(f32x16*o,int vb,bf16x8 pa0,bf16x8 pa1,bf16x8 pa2,bf16x8 pa3){
  #pragma unroll
  for(int d0=0;d0<2;++d0){s16x4 lo[4],hi[4];
    #pragma unroll
    for(int ks=0;ks<4;++ks){
      asm volatile("ds_read_b64_tr_b16 %0,%1 offset:%c2":"=&v"(lo[ks]):"v"(vb),"i"(d0*4096+ks*1024):"memory");
      asm volatile("ds_read_b64_tr_b16 %0,%1 offset:%c2":"=&v"(hi[ks]):"v"(vb),"i"(d0*4096+ks*1024+512):"memory");}
    asm volatile("s_waitcnt lgkmcnt(0)":::"memory");SBAR();
    #define PK(k) (bf16x8){lo[k][0],lo[k][1],lo[k][2],lo[k][3],hi[k][0],hi[k][1],hi[k][2],hi[k][3]}
    o[d0]=__builtin_amdgcn_mfma_f32_32x32x16_bf16(pa0,PK(0),o[d0],0,0,0);
    o[d0]=__builtin_amdgcn_mfma_f32_32x32x16_bf16(pa1,PK(1),o[d0],0,0,0);
    o[d0]=__builtin_amdgcn_mfma_f32_32x32x16_bf16(pa2,PK(2),o[d0],0,0,0);
    o[d0]=__builtin_amdgcn_mfma_f32_32x32x16_bf16(pa3,PK(3),o[d0],0,0,0);
    #undef PK
  }
}

#ifndef ATTN_STORE16
#define ATTN_STORE16(p,v) (*(u32x4*)(p)=(v))
#endif
template<int THRL> __device__ __forceinline__ void attn_unit(int b,int h,int qb,const bf16*Q,const bf16*__restrict__ K,const bf16*__restrict__ V,bf16*O,const float*__restrict__ KBg,char*shm){
  const int tid=ltid(),lane=tid&63,r32=lane&31,hi=lane>>5; const int wid=__builtin_amdgcn_readfirstlane(tid>>6);
  const long rowbase=(long)b*SEQ; const int q0=qb*QB;
  const bf16*Qw=Q+(rowbase+q0+wid*QBLK)*DM+h*D;
  const bf16*Kh=K+rowbase*DM+h*D,*Vh=V+rowbase*DM+h*D;
  const lds_cptr shm3=(lds_cptr)shm;
  const unsigned lds0=(unsigned)(uintptr_t)shm;
  float*wsf=(float*)(shm+LDS_WS)+wid*64;
  const bf16*ksrc=Kh+(long)lane*DM+wid*8;
  const bf16*vsrc=Vh+(long)(16*(wid&3)+(lane>>2))*DM+(wid>>2)*32+(lane&3)*8;
  const unsigned kdst=lds0+LDS_K+wid*1024, vdst=lds0+LDS_V+wid*1024;
  #define DMA_K(t,slot) glds16(ksrc+(long)(t)*KVBLK*DM,(unsigned)__builtin_amdgcn_readfirstlane(kdst+(slot)))
  #define DMA_V(t,slot) glds16(vsrc+(long)(t)*KVBLK*DM,(unsigned)__builtin_amdgcn_readfirstlane(vdst+(slot)))
  const int vb0=(int)(lds0+LDS_V)+((lane>>4)&1)*32+(lane&3)*8+(4*hi+((lane&15)>>2))*64;
  const char*Kbase=shm+LDS_K; bf16x8 kf[8];
  const lds_cptr kp0=shm3+LDS_K+hi*1024+r32*16; const lds_cptr vp0=shm3+LDS_V+((lane>>4)&1)*32+(lane&3)*8+(4*hi+((lane&15)>>2))*64;
  const int NT=(q0+QB)/KVBLK;
  { typedef float f32x4_t __attribute__((ext_vector_type(4))); const int i4=tid*4; if(i4<q0+QB){ const f32x4_t kv=*(const f32x4_t*)(KBg+((long)(b*NHEAD+h))*SEQ+i4); *(__attribute__((address_space(3))) f32x4_t*)((lds_cptr)shm+LDS_KB+i4*4)=kv; } }
  typedef float kb4_t __attribute__((ext_vector_type(4))); const __attribute__((address_space(3))) kb4_t* kbp=(const __attribute__((address_space(3))) kb4_t*)(shm3+LDS_KB)+hi;
  DMA_K(0,0);DMA_V(0,0);DMA_K(1,SLOTB);
  bf16x8 qr[4];
  #pragma unroll
  for(int d0=0;d0<4;++d0)qr[d0]=*reinterpret_cast<const bf16x8*>(&Qw[(long)r32*DM+d0*16+hi*8]);
  float mhat=0.f,l_reg=0.f;f32x16 o[2];o[0]=f32x16{};o[1]=f32x16{};float nm=0.f;asm volatile("":"+v"(nm));
  #define NBIAS(N0,N1,t) do{ _Pragma("unroll") for(int g_=0;g_<4;++g_){ const kb4_t a_=kbp[16*(t)+2*g_], b_=kbp[16*(t)+2*g_+8]; \
      _Pragma("unroll") for(int i_=0;i_<4;++i_){ N0[4*g_+i_]=a_[i_]+nm; N1[4*g_+i_]=b_[i_]+nm; } } }while(0)
  const int qrel=wid*QBLK+r32;
  #define CMASK(P0,P1,t) do{int jb_=(t)-(NT-4); if(jb_>=0)cmask(P0,P1,jb_,qrel,hi);}while(0)
  bool resc=false;
  #define START(P0,P1) do{ const float rm=rowmax(P0,P1); resc=false; \
    { const float dl=rm; mhat=fadd_s(mhat,dl); \
      _Pragma("unroll") for(int r=0;r<16;++r){P0[r]=fsub_s(P0[r],dl);P1[r]=fsub_s(P1[r],dl);} \
      nm=-mhat; asm volatile("":"+v"(nm)); } \
    _Pragma("unroll") for(int r=0;r<16;++r)P0[r]=__builtin_amdgcn_exp2f(P0[r]); }while(0)
  #define RESC() do{ if(resc){ asm volatile("s_waitcnt lgkmcnt(0)":::"memory"); \
      _Pragma("unroll") for(int d_=0;d_<2;++d_) _Pragma("unroll") for(int r=0;r<16;++r)o[d_][r]*=wsf[crow(r,hi)]; } }while(0)
  f32x16 pA0,pA1,pB0,pB1;
  int sl_prev=0,sl_cur=0,sl_next=SLOTB;
  #define ROT() do{sl_prev=sl_cur;sl_cur=sl_next;sl_next=(sl_next==(NSLOT-1)*SLOTB)?0:sl_next+SLOTB;}while(0)
  DMA_K(2,2*SLOTB);
  WAIT_BAR(3);
  { f32x16 c0_,c1_; NBIAS(c0_,c1_,0); qkt(pA0,pA1,Kbase,qr,c0_,c1_,r32,hi); } asm volatile("s_nop 15\n\ts_nop 7":"+v"(pA0),"+v"(pA1));CMASK(pA0,pA1,0);
  START(pA0,pA1);
  _Pragma("unroll") for(int r=0;r<16;++r)pA1[r]=__builtin_amdgcn_exp2f(pA1[r]);
  WAIT_BAR(0);
  DMA_K(3,0);DMA_V(1,SLOTB);
  ROT();
  kload8(kf,kp0+sl_cur);
  WAIT_BAR(2);
  s16x4 vlo[8],vhi[8]; u32x4 pw0,pw1,pw2,pw3;
  #define PKW(P,B) cvtpk_s(P[B],P[B+1])
  #define PAF(k) __builtin_bit_cast(bf16x8,pw##k)
  #define VFR(i) (bf16x8){vlo[i][0],vlo[i][1],vlo[i][2],vlo[i][3],vhi[i][0],vhi[i][1],vhi[i][2],vhi[i][3]}
  #define PIN(x) asm volatile("":"+v"(x))
  #define MX3(a,b,c) __builtin_fmaxf(__builtin_fmaxf((a),(b)),(c))
  #define GAPA(MF,A0,A1,A2,A3,W0,W1,PW) do{ MF; sacc+=A0; sacc+=A1; sacc+=A2; sacc+=A3; PIN(sacc); W0; W1; PIN(PW); SBAR(); }while(0)
  #define EX(v) __builtin_amdgcn_exp2f(v)
  #define GAPB(MF,X,B) do{ MF; X[B]=EX(X[B]); X[B+1]=EX(X[B+1]); X[B+2]=EX(X[B+2]); X[B+3]=EX(X[B+3]); PIN(X); SBAR(); }while(0)
  #define VRD(i) do{ vlo[i]=vtr(vp_+(((i)>>2)*4096+((i)&3)*1024)); vhi[i]=vtr(vp_+(((i)>>2)*4096+((i)&3)*1024+512)); }while(0)
  #define KRD(G,j) do{ if(G){ kload2(kf,kp0+sl_next,j); SBAR(); } }while(0)
  #define STEP(C0,C1,P0,P1,t,GK,GV,GL) do{ SBAR(); \
    const lds_cptr vp_=vp0+sl_prev; \
    NBIAS(C0,C1,t); SBAR(); \
    VRD(0); SBAR(); float sacc=(P0[0]+P0[1]); \
    GAPA(C0=__builtin_amdgcn_mfma_f32_32x32x16_bf16(kf[0],qr[0],C0,0,0,0), P0[2],P0[3],P0[4],P0[5],     pw0[0]=PKW(P0,0), pw0[1]=PKW(P0,2), pw0); \
    VRD(4); SBAR(); GAPA(C1=__builtin_amdgcn_mfma_f32_32x32x16_bf16(kf[1],qr[0],C1,0,0,0), P0[6],P0[7],P0[8],P0[9],     pw0[2]=PKW(P0,4), pw0[3]=PKW(P0,6), pw0); \
    VRD(1); SBAR(); GAPA(C0=__builtin_amdgcn_mfma_f32_32x32x16_bf16(kf[2],qr[1],C0,0,0,0),   P0[10],P0[11],P0[12],P0[13], pw1[0]=PKW(P0,8), pw1[1]=PKW(P0,10), pw1); \
    VRD(5); SBAR(); GAPA(C1=__builtin_amdgcn_mfma_f32_32x32x16_bf16(kf[3],qr[1],C1,0,0,0),   P0[14],P0[15],P1[0],P1[1],   pw1[2]=PKW(P0,12),pw1[3]=PKW(P0,14), pw1); \
    VRD(2); SBAR(); GAPA(C0=__builtin_amdgcn_mfma_f32_32x32x16_bf16(kf[4],qr[2],C0,0,0,0),   P1[2],P1[3],P1[4],P1[5],     pw2[0]=PKW(P1,0), pw2[1]=PKW(P1,2), pw2); \
    VRD(6); SBAR(); GAPA(C1=__builtin_amdgcn_mfma_f32_32x32x16_bf16(kf[5],qr[2],C1,0,0,0),   P1[6],P1[7],P1[8],P1[9],     pw2[2]=PKW(P1,4), pw2[3]=PKW(P1,6), pw2); \
    VRD(3); SBAR(); GAPA(C0=__builtin_amdgcn_mfma_f32_32x32x16_bf16(kf[6],qr[3],C0,0,0,0),   P1[10],P1[11],P1[12],P1[13], pw3[0]=PKW(P1,8), pw3[1]=PKW(P1,10), pw3); \
    VRD(7); SBAR(); GAPA(C1=__builtin_amdgcn_mfma_f32_32x32x16_bf16(kf[7],qr[3],C1,0,0,0),   P1[14],P1[15],0.f,0.f,       pw3[2]=PKW(P1,12),pw3[3]=PKW(P1,14), pw3); \
    l_reg+=sacc; \
    if(GK){DMA_K((t)+3,sl_cur);} if(GV){DMA_V((t)+1,sl_next);} \
    CMASK(C0,C1,t); \
    { float a=MX3(C0[0],C0[1],C1[0]),b=MX3(C0[2],C0[3],C1[1]); a=MX3(a,C1[2],C1[3]); \
      _Pragma("unroll") for(int r=4;r<16;r+=4){a=MX3(a,C0[r],C0[r+1]);b=MX3(b,C0[r+2],C0[r+3]);a=MX3(a,C1[r],C1[r+1]);b=MX3(b,C1[r+2],C1[r+3]);} \
      float rm=__builtin_fmaxf(a,b); { auto rr=__builtin_amdgcn_permlane32_swap(__float_as_uint(rm),__float_as_uint(rm),false,false); rm=__builtin_fmaxf(__uint_as_float(rr[0]),__uint_as_float(rr[1])); } \
      resc=false; \
      if(__builtin_expect(__any(rm>(float)THRL),0)){ const float dl=__builtin_fmaxf(rm,0.f); mhat+=dl; \
        _Pragma("unroll") for(int r=0;r<16;++r){C0[r]-=dl;C1[r]-=dl;} \
        nm=-mhat; asm volatile("":"+v"(nm)); \
        const float f=__builtin_amdgcn_exp2f(-dl); l_reg*=f; if(hi==0)wsf[r32]=f; resc=true; } } \
    SBAR(); \
    GAPB(o[0]=__builtin_amdgcn_mfma_f32_32x32x16_bf16(PAF(0),VFR(0),o[0],0,0,0), C0,0); \
    GAPB(o[1]=__builtin_amdgcn_mfma_f32_32x32x16_bf16(PAF(0),VFR(4),o[1],0,0,0), C0,4); \
    KRD(GL,0); GAPB(o[0]=__builtin_amdgcn_mfma_f32_32x32x16_bf16(PAF(1),VFR(1),o[0],0,0,0), C0,8); \
    KRD(GL,1); GAPB(o[1]=__builtin_amdgcn_mfma_f32_32x32x16_bf16(PAF(1),VFR(5),o[1],0,0,0), C0,12); \
    KRD(GL,2); GAPB(o[0]=__builtin_amdgcn_mfma_f32_32x32x16_bf16(PAF(2),VFR(2),o[0],0,0,0), C1,0); \
    KRD(GL,3); GAPB(o[1]=__builtin_amdgcn_mfma_f32_32x32x16_bf16(PAF(2),VFR(6),o[1],0,0,0), C1,4); \
    GAPB(o[0]=__builtin_amdgcn_mfma_f32_32x32x16_bf16(PAF(3),VFR(3),o[0],0,0,0), C1,8); \
    GAPB(o[1]=__builtin_amdgcn_mfma_f32_32x32x16_bf16(PAF(3),VFR(7),o[1],0,0,0), C1,12); \
    }while(0)
  int t=1;
  #undef CMASK
  #define CMASK(P0,P1,t) do{}while(0)
  for(;t+5<NT;t+=2){
    STEP(pB0,pB1,pA0,pA1,t,true,true,true);     WAIT_BAR(2); RESC(); ROT();
    STEP(pA0,pA1,pB0,pB1,t+1,true,true,true);   WAIT_BAR(2); RESC(); ROT();
  }
  #undef CMASK
  #define CMASK(P0,P1,t) do{int jb_=(t)-(NT-4); if(jb_>=0)cmask(P0,P1,jb_,qrel,hi);}while(0)
  #define ENDW(tt) do{ if((tt)+3<NT){WAIT_BAR(2);} else if((tt)+2<NT){WAIT_BAR(1);} else {WAIT_BAR(0);} }while(0)
  for(;t+1<NT;t+=2){
    STEP(pB0,pB1,pA0,pA1,t,(t+3<NT),(t+1<NT),(t+1<NT));       ENDW(t);   RESC(); ROT();
    STEP(pA0,pA1,pB0,pB1,t+1,(t+4<NT),(t+2<NT),(t+2<NT));     ENDW(t+1); RESC(); ROT();
  }
  STEP(pB0,pB1,pA0,pA1,NT-1,false,false,false); RESC();
  { float sacc=pB0[0]+pB0[1]; _Pragma("unroll") for(int r=2;r<16;++r)sacc+=pB0[r]; _Pragma("unroll") for(int r=0;r<16;++r)sacc+=pB1[r]; l_reg+=sacc;
    pw0=(u32x4){PKW(pB0,0),PKW(pB0,2),PKW(pB0,4),PKW(pB0,6)};pw1=(u32x4){PKW(pB0,8),PKW(pB0,10),PKW(pB0,12),PKW(pB0,14)};pw2=(u32x4){PKW(pB1,0),PKW(pB1,2),PKW(pB1,4),PKW(pB1,6)};pw3=(u32x4){PKW(pB1,8),PKW(pB1,10),PKW(pB1,12),PKW(pB1,14)};
    SBAR(); pv(o,vb0+sl_cur,PAF(0),PAF(1),PAF(2),PAF(3)); }
  #undef PKW
  #undef PAF
  #undef VFR
  #undef PIN
  #undef MX3
  #undef GAPA
  #undef GAPB
  #undef EX
  #undef VRD
  #undef KRD
  #undef STEP
  #undef ENDW
  {auto rr=__builtin_amdgcn_permlane32_swap(__float_as_uint(l_reg),__float_as_uint(l_reg),false,false);l_reg=__uint_as_float(rr[0])+__uint_as_float(rr[1]);}
  if(hi==0)wsf[32+r32]=l_reg;asm volatile("s_waitcnt lgkmcnt(0)":::"memory");
  float rli[16];
  #pragma unroll
  for(int r=0;r<16;++r)rli[r]=__builtin_amdgcn_rcpf(wsf[32+crow(r,hi)]);
  bf16*Ow=O+(rowbase+q0+wid*QBLK)*DMO+h*D;
  { bf16*stg=(bf16*)(shm+LDS_OST)+wid*2048;
    #pragma unroll
    for(int r=0;r<16;++r){const int orow=crow(r,hi);
      #pragma unroll
      for(int d0=0;d0<2;++d0)stg[orow*64+d0*32+r32]=__float2bfloat16(o[d0][r]*rli[r]);}
    asm volatile("s_waitcnt lgkmcnt(0)":::"memory");
    #pragma unroll
    for(int i=0;i<4;++i){const int row=i*8+(lane>>3),ch=lane&7; const u32x4 v=*(const u32x4*)(stg+row*64+ch*8); ATTN_STORE16(Ow+(long)row*DMO+ch*8,v);} }
  asm volatile("s_waitcnt lgkmcnt(0)\n\ts_barrier":::"memory");
  #undef NBIAS
  #undef DMA_K
  #undef DMA_V
  #undef CMASK
  #undef START
  #undef RESC
  #undef ROT
}
constexpr int ATTN_LDS_BYTES=LDS_BYTES;
struct AttnTensors { const bf16* Q; const bf16* K; const bf16* V; bf16* O; const float* KB; };
struct AttnUnit { int bh; int qb; };
struct StaticOrder {
  int vcu;
  __device__ __forceinline__ explicit StaticOrder(int grid,int block):vcu((block%8)*(grid/8)+block/8){}
  __device__ __forceinline__ bool next(int i,AttnUnit&u)const{ if(i>=4)return false; const int s=vcu&7; u.bh=vcu>>3; u.qb=(i==0)?s:(i==1)?15-s:(i==2)?16+s:31-s; return true; }
  __device__ __forceinline__ void a_ready(const AttnUnit&)const{}
  __device__ __forceinline__ void done(const AttnUnit&)const{}
};
template<class Sched,int THRL=8> __device__ __forceinline__ void attn_phase(char*lds,const AttnTensors&T,const Sched&S){
  AttnUnit u;
  for(int i=0;S.next(i,u);++i){ S.a_ready(u); attn_unit<THRL>(u.bh/NHEAD,u.bh%NHEAD,u.qb,T.Q,T.K,T.V,T.O,T.KB,lds); S.done(u); }
}
#undef SBAR
#undef WAIT_BAR
}

#define GAS __attribute__((address_space(1)))
#define LAS __attribute__((address_space(3)))
typedef unsigned short bf16;
typedef unsigned v4u __attribute__((ext_vector_type(4)));
typedef float f32x4 __attribute__((ext_vector_type(4)));
typedef short bf16x8 __attribute__((ext_vector_type(8)));
typedef GAS unsigned gu32;
typedef GAS unsigned long long gu64;
#define RLX_AGENT __ATOMIC_RELAXED, __HIP_MEMORY_SCOPE_AGENT
#define LDS_WAIT() asm volatile("s_waitcnt lgkmcnt(0)" ::: "memory")
#define VM_WAIT() asm volatile("s_waitcnt vmcnt(0)" ::: "memory")
__device__ __forceinline__ unsigned long long rt() { return __builtin_amdgcn_s_memrealtime(); }
__device__ __forceinline__ unsigned f2bf(float f) { unsigned u = __builtin_bit_cast(unsigned, f); return (u + 0x7fffu + ((u >> 16) & 1u)) >> 16; }
__device__ __forceinline__ unsigned pk2(float lo, float hi) { return f2bf(lo) | (f2bf(hi) << 16); }

#define XB_TMO      128
#define XB_XCNT(j)  (256  + 64 * (j))
#define XB_XSUB(j)  (1280 + 64 * (j))
#define XB_XGEN(j)  (2304 + 64 * (j))
#define XB_TOP      3328
#define XB_TOPGEN   3392
#define XCD_BAR_WORDS 3456
#define XB_SPIN_CAP (1u << 18)

__device__ __forceinline__ unsigned xb_ld(unsigned* p)              { return __hip_atomic_load(p, __ATOMIC_RELAXED, __HIP_MEMORY_SCOPE_AGENT); }
__device__ __forceinline__ unsigned xb_add(unsigned* p, unsigned v) { return __hip_atomic_fetch_add(p, v, __ATOMIC_RELAXED, __HIP_MEMORY_SCOPE_AGENT); }
__device__ __forceinline__ unsigned xb_xcc_id() { return (unsigned)__builtin_amdgcn_s_getreg((3 << 11) | 20) & 0xFu; }
#define XB_SPIN(cond, bar) do { unsigned _sp = 0; while (cond) { __builtin_amdgcn_s_sleep(1); \
    if ((++_sp & 255u) == 0u) { if (xb_ld(&(bar)[XB_TMO])) break; if (_sp > XB_SPIN_CAP) { atomicAdd(&(bar)[XB_TMO], 1u); break; } } } } while (0)

struct XcdBarrier {
    unsigned* bar; unsigned x;
    volatile LAS unsigned* st;
};

__device__ __forceinline__ XcdBarrier xcd_barrier_post(unsigned* bar, volatile LAS unsigned* st) {
    XcdBarrier b; b.bar = bar; b.x = xb_xcc_id(); b.st = st;
    if (ltid() == 0) (void)xb_add(&bar[XB_XCNT(b.x)], 1u);
    return b;
}
__device__ __forceinline__ void xcd_barrier_complete(unsigned* bar, unsigned x, unsigned& nloc, unsigned& nx) {
    const unsigned G = lgrid();
    unsigned sum, cnt, mine, sp = 0u;
    for (;;) {
        sum = 0u; cnt = 0u; mine = 0u;
#pragma unroll
        for (unsigned j = 0; j < 16; ++j) { const unsigned c = xb_ld(&bar[XB_XCNT(j)]); sum += c; cnt += (c > 0u) ? 1u : 0u; mine = (j == x) ? c : mine; }
        if (sum == G) break;
        __builtin_amdgcn_s_sleep(1);
        if ((++sp & 255u) == 0u) { if (xb_ld(&bar[XB_TMO])) break; if (sp > XB_SPIN_CAP) { atomicAdd(&bar[XB_TMO], 1u); break; } }
    }
    nloc = mine > 0u ? mine : 1u; nx = cnt > 0u ? cnt : 1u;
}

__device__ __forceinline__ void xcd_barrier(const XcdBarrier& b) {
    asm volatile("s_waitcnt vmcnt(0)" ::: "memory");
    __syncthreads();
    if (ltid() == 0) {
        unsigned* bar = b.bar;
        __builtin_amdgcn_s_waitcnt(0);
        unsigned nloc = b.st[0], nx = b.st[1];
        if (nloc == 0u) { xcd_barrier_complete(bar, b.x, nloc, nx); b.st[0] = nloc; b.st[1] = nx; }
        const unsigned old = xb_add(&bar[XB_XSUB(b.x)], 1u);
        const unsigned gen = old / nloc;
        if (old + 1u == (gen + 1u) * nloc) {
            __builtin_amdgcn_fence(__ATOMIC_RELEASE, "agent");
            asm volatile("s_waitcnt vmcnt(0)" ::: "memory");
            const unsigned og = xb_add(&bar[XB_TOP], 1u);
            const unsigned tg = og / nx;
            if (og + 1u == (tg + 1u) * nx) xb_add(&bar[XB_TOPGEN], 1u);
            else XB_SPIN(xb_ld(&bar[XB_TOPGEN]) == tg, bar);
            __builtin_amdgcn_fence(__ATOMIC_ACQUIRE, "agent");
            xb_add(&bar[XB_XGEN(b.x)], 1u);
            asm volatile("s_waitcnt vmcnt(0)" ::: "memory");
        } else {
            XB_SPIN(xb_ld(&bar[XB_XGEN(b.x)]) == gen, bar);
            __builtin_amdgcn_fence(__ATOMIC_ACQUIRE, "agent");
            asm volatile("s_waitcnt vmcnt(0)" ::: "memory");
        }
    }
    __syncthreads();
}

constexpr int NWAVES = 8;
#ifndef MK_REP_MASK
#define MK_REP_MASK 0
#endif
#ifndef MK_REP_CLASS
#define MK_REP_CLASS 0
#endif
#ifndef MK_SN
#define MK_SN 9
#endif
#ifndef MK_WGM_IN
#define MK_WGM_IN 2
#endif
#ifndef MK_WGM_UP
#define MK_WGM_UP 4
#endif
#ifndef MK_PER_PHASE
#define MK_PER_PHASE 0
#endif
namespace P {
constexpr int BATCH = 8, SEQ = 2048, DM = 1024, DEPTH = 2, DECB = 32, DECS = 4, PAST = 8192, PAGE = 128, NPAGES = 64, NPOOL = 2560;
constexpr int NH = 4, HD = 64, DG = 256, GDK = 32, GDV = 64, RANK = 16, DFF = 2688, CW = 31, DIN = 2580;
constexpr int MPR = BATCH * SEQ, MS = DECB * DECS, MREAL = MPR + MS, MP = 16640;
constexpr int NIN = 2816, NUP = 2 * DFF;
constexpr int HC_AQ = 0, HC_AK = 128, HC_AV = 256, HC_AG = 512, HC_BU = 768, HC_BV = 1024, HC_CQ = 1280, HC_CK = 1536, HC_CV = 1792, HC_D1 = 2048, HC_D2 = 2304, HC_LR = 2560, HC_CF = 2576;
constexpr float ALPHA = 1.4142135623730951f;
constexpr float EPS = 1e-5f, LOG2E = 1.4426950408889634f;
constexpr float QSCALE = 0.125f * 1.4426950408889634f;
constexpr size_t O_YP = 0, O_YS = O_YP + (size_t)MPR * DM, O_PFK = O_YS + (size_t)MS * DM, O_PFV = O_PFK + (size_t)DEPTH * MPR * 256, O_PFL = O_PFV + (size_t)DEPTH * MPR * 256,
    O_PGLA = O_PFL + (size_t)DEPTH * MPR * 4, O_PCONV = O_PGLA + (size_t)DEPTH * BATCH * NH * GDK * GDV, O_PFFN = O_PCONV + (size_t)DEPTH * BATCH * 30 * DG,
    O_SFK = O_PFFN + (size_t)DEPTH * BATCH * 2 * DFF, O_SFV = O_SFK + (size_t)DEPTH * MS * 256, O_SFL = O_SFV + (size_t)DEPTH * MS * 256, O_SGLA = O_SFL + (size_t)DEPTH * MS * 4,
    O_SCONV = O_SGLA + (size_t)DEPTH * DECB * NH * GDK * GDV, O_SFFN = O_SCONV + (size_t)DEPTH * DECB * 30 * DG, O_SSGU = O_SFFN + (size_t)DEPTH * DECB * 2 * DFF,
    O_END = O_SSGU + (size_t)DEPTH * MS * DG;
static_assert(O_END == 35714048, "output size");
enum { I_XP = 0, I_XS, I_CK, I_CV, I_CL, I_SGLA, I_SCONV, I_SFFN, I_PT, I_WIN, I_GWA, I_GBA, I_GNG, I_SLG, I_SLB, I_SW, I_SB, I_FBF, I_CVW, I_CVB, I_CNG, I_CNB, I_WO, I_L1G, I_L1B,
       I_WUP, I_FCW, I_FCB, I_WDN, I_L2G, I_L2B, N_IN };
constexpr size_t MiB = 1u << 20;
constexpr size_t WS_CTL = 0, CTL_ZERO_BYTES = 1 * MiB;
constexpr size_t WS_WIN = 2 * MiB, SZ_WIN = (size_t)NIN * DM * 2;
constexpr size_t WS_WO = WS_WIN + 2 * SZ_WIN, SZ_WO = (size_t)DM * DM * 2;
constexpr size_t WS_WUP = WS_WO + 2 * SZ_WO, SZ_WUP = (size_t)NUP * DM * 2;
constexpr size_t WS_WDN = WS_WUP + 2 * SZ_WUP, SZ_WDN = (size_t)DM * DFF * 2;
constexpr size_t WS_PS = WS_WDN + 2 * SZ_WDN;
constexpr size_t WS_LRF = WS_PS + 1 * MiB;
constexpr size_t WS_LOGF = WS_LRF + 3 * MiB;
constexpr size_t WS_KBIAS = WS_LOGF + 1 * MiB;
constexpr size_t WS_DELTA = WS_KBIAS + 1 * MiB;
constexpr size_t WS_GAMMA = WS_DELTA + 8 * MiB;
constexpr size_t WS_GBUF = WS_GAMMA + 1 * MiB;
constexpr size_t WS_PART = WS_GBUF + 8 * MiB;
constexpr size_t WS_ML = WS_PART + 8 * MiB;
constexpr size_t WS_PZ = WS_ML + 1 * MiB;
constexpr size_t WS_XF = WS_PZ + 4 * MiB, SZ_F32 = (size_t)MP * DM * 4, SZ_B16 = (size_t)MP * DM * 2;
constexpr size_t WS_XB = WS_XF + SZ_F32;
constexpr size_t WS_H = WS_XB + SZ_B16;
constexpr size_t WS_Y = WS_H + (size_t)MP * NIN * 2;
constexpr size_t WS_Z = WS_Y + SZ_B16;
constexpr size_t WS_X1F = WS_Z + SZ_F32;
constexpr size_t WS_X1B = WS_X1F + SZ_F32;
constexpr size_t WS_G = WS_X1B + SZ_B16;
constexpr size_t WS_HALO = WS_G;
constexpr size_t WS_FG = WS_HALO + 2 * MiB, WS_FV = WS_FG + 2 * MiB;
constexpr size_t WS_ACT = WS_FV + 2 * MiB;
constexpr size_t WS_END = WS_ACT + (size_t)MP * DFF * 2;
static_assert(WS_PS % 256 == 0 && WS_XF % 256 == 0 && WS_H % 256 == 0 && WS_G % 256 == 0 && WS_ACT % 256 == 0, "alignment");
constexpr int CW_BAR = 4096;
constexpr int CW_Q = 16384;
constexpr int PH_PER_LAYER = 8, N_PHASES = 1 + DEPTH * PH_PER_LAYER;
constexpr int RING_BYTES = 131072, MISC_OFF = RING_BYTES + 320, HALO_OFF = RING_BYTES + 2048  , LDS_BYTES = 147456;
}

struct Args { const float* p[P::N_IN + 2]; int ph_lo, ph_hi, qoff, pad; };
#define AIN(k) (A.p[(k) + z])
#define AOUT ((float*)A.p[P::N_IN + z])
#define AWS ((unsigned char*)A.p[P::N_IN + 1 + z])
#define OPAQUE_ZERO() ({ int z_ = 0; asm volatile("" : "+s"(z_)); z_; })
static_assert(sizeof(Args) == (P::N_IN + 2) * 8 + 16, "Args has no padding");

struct Frame {
    LAS unsigned char* lds; volatile LAS unsigned* MISC; gu32* ctl; int tid, lane, wave, vcu, G;
};

__device__ __forceinline__ float bflo(unsigned u) { return __uint_as_float(u << 16); }
__device__ __forceinline__ float bfhi(unsigned u) { return __uint_as_float(u & 0xffff0000u); }
__device__ __forceinline__ float bf1(bf16 v) { return __uint_as_float((unsigned)v << 16); }
__device__ __forceinline__ void unpack8(const v4u w, float (&f)[8]) { f[0] = bflo(w.x); f[1] = bfhi(w.x); f[2] = bflo(w.y); f[3] = bfhi(w.y); f[4] = bflo(w.z); f[5] = bfhi(w.z); f[6] = bflo(w.w); f[7] = bfhi(w.w); }
__device__ __forceinline__ v4u pack8(const float (&f)[8]) { v4u w; w.x = pk2(f[0], f[1]); w.y = pk2(f[2], f[3]); w.z = pk2(f[4], f[5]); w.w = pk2(f[6], f[7]); return w; }
__device__ __forceinline__ float logsig(float x) { return fminf(x, 0.f) - log1pf(expf(-fabsf(x))); }
__device__ __forceinline__ float sigm(float x) { return 1.f / (1.f + expf(-x)); }
__device__ __forceinline__ float silu(float x) { return x / (1.f + expf(-x)); }
#define DPP_F(v, ctrl) __builtin_bit_cast(float, __builtin_amdgcn_mov_dpp(__builtin_bit_cast(int, (v)), (ctrl), 0xF, 0xF, true))
__device__ __forceinline__ float sum4(float v) { v += DPP_F(v, 0xB1); v += DPP_F(v, 0x4E); return v; }
__device__ __forceinline__ float sum8(float v) { v = sum4(v); v += DPP_F(v, 0x141); return v; }
__device__ __forceinline__ float sum16(float v) { v = sum8(v); v += DPP_F(v, 0x140); return v; }
__device__ __forceinline__ float wave_sum(float v) { v = sum16(v);
    return (__builtin_bit_cast(float, __builtin_amdgcn_readlane(__builtin_bit_cast(int, v), 0)) + __builtin_bit_cast(float, __builtin_amdgcn_readlane(__builtin_bit_cast(int, v), 16)))
         + (__builtin_bit_cast(float, __builtin_amdgcn_readlane(__builtin_bit_cast(int, v), 32)) + __builtin_bit_cast(float, __builtin_amdgcn_readlane(__builtin_bit_cast(int, v), 48))); }
#define LBAR() do { asm volatile("s_waitcnt lgkmcnt(0)" ::: "memory"); __builtin_amdgcn_s_barrier(); asm volatile("" ::: "memory"); } while (0)
struct TeamBar { volatile LAS unsigned* ctr; unsigned ep; unsigned nw; };
__device__ __forceinline__ void tbar(TeamBar& tb, int lane) {
    asm volatile("s_waitcnt lgkmcnt(0)" ::: "memory");
    tb.ep += tb.nw;
    if (lane == 0) (void)__hip_atomic_fetch_add((LAS unsigned*)tb.ctr, 1u, __ATOMIC_RELAXED, __HIP_MEMORY_SCOPE_WORKGROUP);
    while ((int)(*tb.ctr - tb.ep) < 0) __builtin_amdgcn_s_sleep(0);
    asm volatile("" ::: "memory");
}
#define IBAR() do { if constexpr (TEAM) tbar(tb, F.lane); else LBAR(); } while (0)
__device__ __forceinline__ int q_next(Frame& F, gu32* head) {
    __syncthreads();
    if (F.tid == 0) F.MISC[0] = __hip_atomic_fetch_add(head, 1u, RLX_AGENT);
    __syncthreads();
    return (int)F.MISC[0];
}

__device__ __forceinline__ int win_src(int n) {
    if (n < 768) return n;
    if (n < 2048) return n + 16;
    if (n < 2560) return n + 20;
    if (n < 2576) return n - 1792;
    if (n < 2580) return n - 512;
    return -1;
}
template <int MODE>
__device__ __forceinline__ void p0_transpose_item(const float* W, int K, int N, int NT, bf16* WT, LAS float* scr, int item, int lane) {
    const int nblk = NT / 32, kb = item / nblk, nb = item % nblk, k0 = 64 * kb, n0 = 32 * nb;
    const int ncol = n0 + (lane & 31); const int src = MODE == 1 ? win_src(ncol) : (MODE == 2 ? ((ncol & 255) < 128 ? (ncol >> 8) * 128 + (ncol & 127) : P::DFF + (ncol >> 8) * 128 + (ncol & 127)) : ncol);
    float wv[32];
#pragma unroll
    for (int i = 0; i < 32; ++i) { const int kk = 2 * i + (lane >> 5); wv[i] = src >= 0 ? W[(size_t)(k0 + kk) * N + src] : 0.f; }
#pragma unroll
    for (int i = 0; i < 32; ++i) { const int kk = 2 * i + (lane >> 5); scr[kk * 33 + (lane & 31)] = wv[i]; }
    LDS_WAIT(); asm volatile("" ::: "memory");
    const int c = lane & 7;
#pragma unroll
    for (int j = 0; j < 4; ++j) { const int n = (lane >> 3) + 8 * j; const LAS float* s = scr + (8 * c) * 33 + n;
        v4u o; o.x = pk2(s[0 * 33], s[1 * 33]); o.y = pk2(s[2 * 33], s[3 * 33]); o.z = pk2(s[4 * 33], s[5 * 33]); o.w = pk2(s[6 * 33], s[7 * 33]);
        *(GAS v4u*)(WT + (size_t)(n0 + n) * K + k0 + 8 * c) = o; }
    LDS_WAIT(); asm volatile("" ::: "memory");
}
namespace WC { using namespace P; constexpr int I_IN = (DM / 64) * (NIN / 32), I_O = (DM / 64) * (DM / 32), I_UP = (DM / 64) * (NUP / 32), I_DN = (DFF / 64) * (DM / 32), I_LAYER = I_IN + I_O + I_UP + I_DN, I_ALL = DEPTH * I_LAYER; }
__device__ __forceinline__ void wconv_wave_item(const Args& A, const int z, Frame& F, int it) {
    using namespace P; using namespace WC;
    LAS float* scr = (LAS float*)(F.lds + F.wave * 16384);
    int lane_ = F.lane; asm volatile("" : "+v"(lane_));
    const int l = it / I_LAYER; int r = it % I_LAYER;
    if (r < I_IN) { p0_transpose_item<1>(AIN(I_WIN) + (size_t)l * DM * DIN, DM, DIN, NIN, (bf16*)(AWS + WS_WIN + l * SZ_WIN), scr, r, lane_); return; } r -= I_IN;
    if (r < I_O) { p0_transpose_item<0>(AIN(I_WO) + (size_t)l * DM * DM, DM, DM, DM, (bf16*)(AWS + WS_WO + l * SZ_WO), scr, r, lane_); return; } r -= I_O;
    if (r < I_UP) { p0_transpose_item<2>(AIN(I_WUP) + (size_t)l * DM * NUP, DM, NUP, NUP, (bf16*)(AWS + WS_WUP + l * SZ_WUP), scr, r, lane_); return; } r -= I_UP;
    p0_transpose_item<0>(AIN(I_WDN) + (size_t)l * DFF * DM, DFF, DM, DM, (bf16*)(AWS + WS_WDN + l * SZ_WDN), scr, r, lane_);
}
__device__ __forceinline__ void p0_prologue(const Args& A, const int z, Frame& F) {
    using namespace P;
    const int gw = F.vcu * NWAVES + F.wave, NGW = F.G * NWAVES;
    for (int it = gw; it < WC::I_IN; it += NGW) wconv_wave_item(A, z, F, it);
    bf16* XB = (bf16*)(AWS + WS_XB);
    for (int m = gw; m < MP; m += NGW) {
        const float* src = m < MPR ? AIN(I_XP) + (size_t)m * DM : (m < MREAL ? AIN(I_XS) + (size_t)(m - MPR) * DM : nullptr);
#pragma unroll
        for (int j = 0; j < 4; ++j) { const int c = 4 * F.lane + 256 * j; f32x4 v = src ? *(const GAS f32x4*)(src + c) : (f32x4){0.f, 0.f, 0.f, 0.f};
            *(GAS unsigned long long*)(XB + (size_t)m * DM + c) = (unsigned long long)pk2(v.x, v.y) | ((unsigned long long)pk2(v.z, v.w) << 32); }
    }
    float* PS = (float*)(AWS + WS_PS); const int* pt = (const int*)AIN(I_PT);
    for (int it = gw; it < DEPTH * DECB * NPAGES; it += NGW) {
        const int l = it / (DECB * NPAGES), bp = it % (DECB * NPAGES); const int page = pt[bp];
        const float* Lp = AIN(I_CL) + ((size_t)(l * NPOOL + page) * PAGE) * 4;
        f32x4 a = *(const GAS f32x4*)(Lp + 4 * F.lane), b = *(const GAS f32x4*)(Lp + 4 * (F.lane + 64)); a = a + b;
        a.x = wave_sum(a.x); a.y = wave_sum(a.y); a.z = wave_sum(a.z); a.w = wave_sum(a.w);
        if (F.lane == 0) *(GAS f32x4*)(PS + (size_t)it * 4) = a;
    }
}

namespace GL {
constexpr int G = 0, T = G + 64 * 33, WA = T + 256, BA = WA + 512, LR = BA + 32, QT = LR + 64 * 16  , KT = QT + 64 * 33, VV = KT + 32 * 68, SS = VV + 64 * 64, AT = SS + 32 * 64, END = AT + 64 * 68;
static_assert(END * 4 <= P::RING_BYTES && LR % 4 == 0 && QT % 4 == 0 && KT % 4 == 0 && VV % 4 == 0 && SS % 4 == 0, "GLA LDS");
}
template <int NI>
__device__ __forceinline__ void gla_local_items(const Args& A, const int z, Frame& F, int l, int item0) {
    using namespace P;
    LAS float* L = (LAS float*)F.lds; const bf16* H = (const bf16*)(AWS + WS_H);
    const int bh = item0 >> 5, b = bh >> 2, h = bh & 3;
    const int s = F.tid >> 3, d4 = (F.tid & 7) * 4, e8 = (F.tid & 7) * 8;
    const float wa = AIN(I_GWA)[(size_t)l * RANK * 128 + (F.tid >> 5) * 128 + 32 * h + (F.tid & 31)];
    const float ba = AIN(I_GBA)[l * 128 + 32 * h + (F.tid & 31)];
    unsigned long long kw[NI]; v4u vw[NI]; f32x4 lr4[NI];
#pragma unroll
    for (int q = 0; q < NI; ++q) { const int m0 = b * SEQ + 64 * ((item0 + q) & 31);
        kw[q] = *(const GAS unsigned long long*)(H + (size_t)(m0 + s) * NIN + HC_AK + 32 * h + d4); vw[q] = *(const GAS v4u*)(H + (size_t)(m0 + s) * NIN + HC_AV + 64 * h + e8);
        lr4[q] = (f32x4){0.f, 0.f, 0.f, 0.f}; if (F.tid < 256) lr4[q] = *(const GAS f32x4*)((const float*)(AWS + WS_LRF) + (size_t)(m0 + (F.tid >> 2)) * 32 + 4 * (F.tid & 3)); }
    L[GL::WA + F.tid] = wa; if (F.tid < 32) L[GL::BA + F.tid] = ba;
#pragma unroll
    for (int q = 0; q < NI; ++q) { const int item = item0 + q;
    if (q) LBAR();
    if (F.tid < 256) *(LAS f32x4*)(L + GL::LR + (F.tid >> 2) * 16 + 4 * (F.tid & 3)) = lr4[q];
    { LAS unsigned char* VT = (LAS unsigned char*)(L + GL::VV); const unsigned vv[4] = {vw[q].x, vw[q].y, vw[q].z, vw[q].w};
#pragma unroll
      for (int i = 0; i < 4; ++i) { *(LAS bf16*)(VT + (e8 + 2 * i) * 144 + 2 * s) = (bf16)(vv[i] & 0xffffu); *(LAS bf16*)(VT + (e8 + 2 * i + 1) * 144 + 2 * s) = (bf16)(vv[i] >> 16); } }
    LBAR();
    float loc[8]; const int d = F.tid & 31, seg = (F.tid >> 5) & 7;
    if (F.tid < 256) {
        float run = 0.f;
#pragma unroll
        for (int i = 0; i < 8; ++i) { const LAS float* lr = L + GL::LR + (8 * seg + i) * 16; float sacc = L[GL::BA + d];
#pragma unroll
            for (int r = 0; r < 16; ++r) sacc += lr[r] * L[GL::WA + r * 32 + d];
            run += logsig(sacc) * (1.f / 16.f); loc[i] = run; }
        L[GL::T + seg * 32 + d] = run;
    }
    LBAR();
    if (F.tid < 256) {
        float off = 0.f;
        for (int p = 0; p < seg; ++p) off += L[GL::T + p * 32 + d];
#pragma unroll
        for (int i = 0; i < 8; ++i) L[GL::G + (8 * seg + i) * 33 + d] = off + loc[i];
    }
    LBAR();
    { const unsigned lo = (unsigned)kw[q], hi = (unsigned)(kw[q] >> 32); const float kv[4] = {bflo(lo), bfhi(lo), bflo(hi), bfhi(hi)}; f32x4 g4;
#pragma unroll
      for (int i = 0; i < 4; ++i) { const float g = L[GL::G + s * 33 + d4 + i]; g4[i] = g; *(LAS bf16*)((LAS unsigned char*)(L + GL::QT) + (d4 + i) * 144 + 2 * s) = (bf16)f2bf(kv[i] * expf(L[GL::G + 63 * 33 + d4 + i] - g)); }
      *(GAS f32x4*)((float*)(AWS + WS_GBUF) + (size_t)item * 2048 + s * 32 + d4) = g4; }
    LBAR();
    { typedef short s8v __attribute__((ext_vector_type(8)));
      const LAS unsigned char* KT = (const LAS unsigned char*)(L + GL::QT); const LAS unsigned char* VT = (const LAS unsigned char*)(L + GL::VV);
      const int fi = F.lane & 15, kq = F.lane >> 4, d0 = 16 * (F.wave & 1), e0 = 16 * (F.wave >> 1); f32x4 acc = {0.f, 0.f, 0.f, 0.f};
#pragma unroll
      for (int ks = 0; ks < 2; ++ks) { const s8v af = *(const LAS s8v*)(KT + (d0 + fi) * 144 + 64 * ks + 16 * kq), bfr = *(const LAS s8v*)(VT + (e0 + fi) * 144 + 64 * ks + 16 * kq);
          acc = __builtin_amdgcn_mfma_f32_16x16x32_bf16(af, bfr, acc, 0, 0, 0); }
      float* DLo = (float*)(AWS + WS_DELTA) + (size_t)item * 2048;
#pragma unroll
      for (int r = 0; r < 4; ++r) DLo[(d0 + 4 * kq + r) * 64 + e0 + fi] = acc[r]; }
    if (F.tid < 32) ((float*)(AWS + WS_GAMMA))[(size_t)item * 32 + F.tid] = expf(L[GL::G + 63 * 33 + F.tid]);
    }
}
namespace GO {
constexpr int QB = 0, QP = 80, KB = QB + 64 * QP, PB = KB + 64 * QP, PP = 144, VT = PB + 64 * PP, ST = VT + 64 * PP, AG = ST + 64 * QP, AP = 144, SSQ = AG + 64 * AP, END = SSQ + 64 * 8;
static_assert(END <= P::RING_BYTES, "GLA out LDS");
}
__device__ __forceinline__ void gla_out_item(const Args& A, const int z, Frame& F, int l, int item) {
    using namespace P;
    typedef short s8v __attribute__((ext_vector_type(8)));
    LAS unsigned char* L = F.lds; const bf16* H = (const bf16*)(AWS + WS_H); bf16* Y = (bf16*)(AWS + WS_Y);
    const int bh = item >> 5, c = item & 31, b = bh >> 2, h = bh & 3, m0 = b * SEQ + 64 * c;
    const int s = F.tid >> 3, d4 = (F.tid & 7) * 4, e8 = (F.tid & 7) * 8, d = F.tid >> 4, e4 = (F.tid & 15) * 4;
    const f32x4 g4 = *(const GAS f32x4*)((const float*)(AWS + WS_GBUF) + (size_t)item * 2048 + s * 32 + d4);
    const unsigned long long wq = *(const GAS unsigned long long*)(H + (size_t)(m0 + s) * NIN + HC_AQ + 32 * h + d4);
    const unsigned long long wk = *(const GAS unsigned long long*)(H + (size_t)(m0 + s) * NIN + HC_AK + 32 * h + d4);
    const v4u vw = *(const GAS v4u*)(H + (size_t)(m0 + s) * NIN + HC_AV + 64 * h + e8);
    const v4u gw = *(const GAS v4u*)(H + (size_t)(m0 + s) * NIN + HC_AG + 64 * h + e8);
    const float* DL = (const float*)(AWS + WS_DELTA) + (size_t)(bh * 32) * 2048 + d * 64 + e4; const float* GM = (const float*)(AWS + WS_GAMMA) + (size_t)(bh * 32) * 32 + d;
    f32x4 S = {0.f, 0.f, 0.f, 0.f};
    for (int j0 = 0; j0 < c; j0 += 16) { float gm[16]; f32x4 dl[16];
#pragma unroll
        for (int j = 0; j < 16; ++j) { gm[j] = GM[(j0 + j) * 32]; dl[j] = *(const GAS f32x4*)(DL + (size_t)(j0 + j) * 2048); }
#pragma unroll
        for (int j = 0; j < 16; ++j) if (j0 + j < c) S = S * gm[j] + dl[j]; }
    if (c == 31) { const float gm = GM[31 * 32]; const f32x4 dl = *(const GAS f32x4*)(DL + (size_t)31 * 2048); const f32x4 Sf = S * gm + dl;
        *(GAS f32x4*)(AOUT + O_PGLA + ((size_t)(l * BATCH + b) * NH + h) * 2048 + d * 64 + e4) = Sf; }
#pragma unroll
    for (int i = 0; i < 4; ++i) *(LAS bf16*)(L + GO::ST + (e4 + i) * GO::QP + 2 * d) = (bf16)f2bf(S[i]);
    { const float qv[4] = {bflo((unsigned)wq), bfhi((unsigned)wq), bflo((unsigned)(wq >> 32)), bfhi((unsigned)(wq >> 32))};
      const float kv[4] = {bflo((unsigned)wk), bfhi((unsigned)wk), bflo((unsigned)(wk >> 32)), bfhi((unsigned)(wk >> 32))};
      float qt[4], kt[4];
#pragma unroll
      for (int i = 0; i < 4; ++i) { qt[i] = qv[i] * 0.17677669529663687f * expf(g4[i]); kt[i] = kv[i] * expf(-g4[i]); }
      *(LAS unsigned long long*)(L + GO::QB + s * GO::QP + 2 * d4) = (unsigned long long)pk2(qt[0], qt[1]) | ((unsigned long long)pk2(qt[2], qt[3]) << 32);
      *(LAS unsigned long long*)(L + GO::KB + s * GO::QP + 2 * d4) = (unsigned long long)pk2(kt[0], kt[1]) | ((unsigned long long)pk2(kt[2], kt[3]) << 32);
      const unsigned vv[4] = {vw.x, vw.y, vw.z, vw.w};
#pragma unroll
      for (int i = 0; i < 4; ++i) { *(LAS bf16*)(L + GO::VT + (e8 + 2 * i) * GO::PP + 2 * s) = (bf16)(vv[i] & 0xffffu); *(LAS bf16*)(L + GO::VT + (e8 + 2 * i + 1) * GO::PP + 2 * s) = (bf16)(vv[i] >> 16); }
      *(LAS v4u*)(L + GO::AG + s * GO::AP + 2 * e8) = gw; }
    LBAR();
    const int fi = F.lane & 15, kq = F.lane >> 4;
    { const int t0 = 16 * (F.wave >> 1); const s8v af = *(const LAS s8v*)(L + GO::QB + (t0 + fi) * GO::QP + 16 * kq);
#pragma unroll
      for (int k = 0; k < 2; ++k) { const int s0 = 16 * (2 * (F.wave & 1) + k); const s8v bfr = *(const LAS s8v*)(L + GO::KB + (s0 + fi) * GO::QP + 16 * kq);
          f32x4 acc = {0.f, 0.f, 0.f, 0.f}; acc = __builtin_amdgcn_mfma_f32_16x16x32_bf16(af, bfr, acc, 0, 0, 0);
#pragma unroll
          for (int r = 0; r < 4; ++r) { const int t = t0 + 4 * kq + r, sc = s0 + fi; *(LAS bf16*)(L + GO::PB + t * GO::PP + 2 * sc) = (bf16)f2bf(sc <= t ? acc[r] : 0.f); } } }
    LBAR();
    { const int t0 = 16 * (F.wave & 3), eb = 32 * (F.wave >> 2);
      const s8v a0 = *(const LAS s8v*)(L + GO::PB + (t0 + fi) * GO::PP + 16 * kq), a1 = *(const LAS s8v*)(L + GO::PB + (t0 + fi) * GO::PP + 64 + 16 * kq), a2 = *(const LAS s8v*)(L + GO::QB + (t0 + fi) * GO::QP + 16 * kq);
      f32x4 o[2]; float ssq[4] = {0.f, 0.f, 0.f, 0.f};
#pragma unroll
      for (int k = 0; k < 2; ++k) { const int e0 = eb + 16 * k;
          const s8v b0 = *(const LAS s8v*)(L + GO::VT + (e0 + fi) * GO::PP + 16 * kq), b1 = *(const LAS s8v*)(L + GO::VT + (e0 + fi) * GO::PP + 64 + 16 * kq), b2 = *(const LAS s8v*)(L + GO::ST + (e0 + fi) * GO::QP + 16 * kq);
          f32x4 acc = {0.f, 0.f, 0.f, 0.f};
          acc = __builtin_amdgcn_mfma_f32_16x16x32_bf16(a0, b0, acc, 0, 0, 0); acc = __builtin_amdgcn_mfma_f32_16x16x32_bf16(a1, b1, acc, 0, 0, 0); acc = __builtin_amdgcn_mfma_f32_16x16x32_bf16(a2, b2, acc, 0, 0, 0);
          o[k] = acc;
#pragma unroll
          for (int r = 0; r < 4; ++r) ssq[r] += acc[r] * acc[r]; }
#pragma unroll
      for (int r = 0; r < 4; ++r) { ssq[r] = sum16(ssq[r]); if (fi == 0) *(LAS float*)(L + GO::SSQ + ((t0 + 4 * kq + r) * 2 + (F.wave >> 2)) * 4) = ssq[r]; }
      LBAR();
#pragma unroll
      for (int r = 0; r < 4; ++r) { const int t = t0 + 4 * kq + r; const float tot = *(const LAS float*)(L + GO::SSQ + (t * 2) * 4) + *(const LAS float*)(L + GO::SSQ + (t * 2 + 1) * 4);
          const float rn = 1.f / sqrtf(tot * (1.f / 64.f) + EPS);
#pragma unroll
          for (int k = 0; k < 2; ++k) { const int e = eb + 16 * k + fi; const float ag = bf1(*(const LAS bf16*)(L + GO::AG + t * GO::AP + 2 * e));
              Y[(size_t)(m0 + t) * DM + 64 * h + e] = (bf16)f2bf(o[k][r] * rn * AIN(I_GNG)[l * 256 + 64 * h + e] * silu(ag)); } } }
}

__device__ __forceinline__ void fox_cumsum_wave(const Args& A, const int z, Frame& F, int l, int b) {
    using namespace P;
    const float* LG = (const float*)(AWS + WS_LOGF) + ((size_t)b * SEQ + 32 * F.lane) * 4; float* KB = (float*)(AWS + WS_KBIAS);
    f32x4 lf[32]; f32x4 run = {0.f, 0.f, 0.f, 0.f};
#pragma unroll
    for (int i = 0; i < 32; ++i) lf[i] = *(const GAS f32x4*)(LG + 4 * i);
#pragma unroll
    for (int i = 0; i < 32; ++i) { run = run + lf[i]; lf[i] = run; }
    f32x4 off;
#pragma unroll
    for (int c = 0; c < 4; ++c) { float incl = run[c];
        incl += DPP_F(incl, 0x111); incl += DPP_F(incl, 0x112); incl += DPP_F(incl, 0x114); incl += DPP_F(incl, 0x118);
        const float t0 = __builtin_bit_cast(float, __builtin_amdgcn_readlane(__builtin_bit_cast(int, incl), 15)), t1 = __builtin_bit_cast(float, __builtin_amdgcn_readlane(__builtin_bit_cast(int, incl), 31)), t2 = __builtin_bit_cast(float, __builtin_amdgcn_readlane(__builtin_bit_cast(int, incl), 47));
        incl += (F.lane >= 16 ? t0 : 0.f) + (F.lane >= 32 ? t1 : 0.f) + (F.lane >= 48 ? t2 : 0.f);
        off[c] = incl - run[c]; }
#pragma unroll
    for (int c = 0; c < 4; ++c) { float* kb = KB + ((size_t)(b * NH + c)) * SEQ + 32 * F.lane;
#pragma unroll
        for (int i = 0; i < 32; i += 4) *(GAS f32x4*)(kb + i) = (f32x4){-(off[c] + lf[i][c]) * LOG2E, -(off[c] + lf[i + 1][c]) * LOG2E, -(off[c] + lf[i + 2][c]) * LOG2E, -(off[c] + lf[i + 3][c]) * LOG2E}; }
}

template <bool TEAM>
__device__ __forceinline__ void conv_item(const Args& A, const int z, Frame& F, int l, int item, TeamBar& tb) {
    using namespace P;
    constexpr int NT = TEAM ? 256 : 512, R = 512 / NT;
    LAS float* GLU = (LAS float*)F.lds;
    const bf16* H = (const bf16*)(AWS + WS_H); bf16* Y = (bf16*)(AWS + WS_Y);
    const int b = item >> 6, t0 = (item & 63) * 32;
    v4u d1w[4 * R], d2w[4 * R];
#pragma unroll
    for (int j = 0; j < 4 * R; ++j) { int idx = F.tid + NT * j; idx = idx < 62 * 32 ? idx : 62 * 32 - 1; const int rr = idx >> 5, c8 = (idx & 31) * 8; int t = t0 - 30 + rr; t = t < 0 ? 0 : t;
        const size_t m = (size_t)b * SEQ + t; d1w[j] = *(const GAS v4u*)(H + m * NIN + HC_D1 + c8); d2w[j] = *(const GAS v4u*)(H + m * NIN + HC_D2 + c8); }
    const int c = F.tid & 255, half = F.tid >> 8; float w[31]; const float* cw = AIN(I_CVW) + (size_t)l * CW * DG + c;
#pragma unroll
    for (int j = 0; j < 31; ++j) w[j] = cw[j * DG];
    const float cb = AIN(I_CVB)[l * DG + c], ng = AIN(I_CNG)[l * DG + c], nb = AIN(I_CNB)[l * DG + c];
#pragma unroll
    for (int j = 0; j < 4 * R; ++j) { const int idx = F.tid + NT * j;
        if (idx < 62 * 32) { const int rr = idx >> 5, c8 = (idx & 31) * 8, t = t0 - 30 + rr; float g[8];
            if (t >= 0) { float d1[8], d2[8]; unpack8(d1w[j], d1); unpack8(d2w[j], d2);
#pragma unroll
                for (int i = 0; i < 8; ++i) g[i] = d1[i] * sigm(d2[i]);
                if (t >= SEQ - 30) { float* o = AOUT + O_PCONV + ((size_t)(l * BATCH + b) * 30 + (t - (SEQ - 30))) * DG + c8; *(GAS f32x4*)o = (f32x4){g[0], g[1], g[2], g[3]}; *(GAS f32x4*)(o + 4) = (f32x4){g[4], g[5], g[6], g[7]}; }
            } else {
#pragma unroll
                for (int i = 0; i < 8; ++i) g[i] = 0.f; }
            *(LAS f32x4*)(GLU + rr * 256 + c8) = (f32x4){g[0], g[1], g[2], g[3]}; *(LAS f32x4*)(GLU + rr * 256 + c8 + 4) = (f32x4){g[4], g[5], g[6], g[7]}; } }
    IBAR();
#pragma unroll
    for (int hb = 0; hb < R; ++hb) { const int tb0 = (TEAM ? hb : half) * 16; float win[46];
#pragma unroll
        for (int j = 0; j < 46; ++j) win[j] = GLU[(tb0 + j) * 256 + c];
#pragma unroll
        for (int i = 0; i < 16; ++i) { float s = cb;
#pragma unroll
            for (int j = 0; j < 31; ++j) s += w[j] * win[i + j];
            const float mean = wave_sum(s) * (1.f / 64.f); const float dx = s - mean; const float var = wave_sum(dx * dx) * (1.f / 64.f);
            const float yv = dx * (1.f / sqrtf(var + EPS)) * ng + nb;
            Y[(size_t)(b * SEQ + t0 + tb0 + i) * DM + 768 + c] = (bf16)f2bf(silu(yv)); } }
}

template <int NI>
__device__ __forceinline__ void conv_items(const Args& A, const int z, Frame& F, int l, int item0, int istride) {
    using namespace P;
    LAS float* GLU = (LAS float*)F.lds; LAS float* CO = GLU + 62 * 256;
    const bf16* H = (const bf16*)(AWS + WS_H); bf16* Y = (bf16*)(AWS + WS_Y);
    v4u d1w[NI][4], d2w[NI][4];
#pragma unroll
    for (int q = 0; q < NI; ++q) { const int item = item0 + q * istride, b = item >> 6, t0 = (item & 63) * 32;
#pragma unroll
        for (int j = 0; j < 4; ++j) { int idx = F.tid + 512 * j; idx = idx < 62 * 32 ? idx : 62 * 32 - 1; const int rr = idx >> 5, c8 = (idx & 31) * 8; int t = t0 - 30 + rr; t = t < 0 ? 0 : t;
            const size_t m = (size_t)b * SEQ + t; d1w[q][j] = *(const GAS v4u*)(H + m * NIN + HC_D1 + c8); d2w[q][j] = *(const GAS v4u*)(H + m * NIN + HC_D2 + c8); } }
    const int c = F.tid & 255, half = F.tid >> 8; float w[31]; const float* cw = AIN(I_CVW) + (size_t)l * CW * DG + c;
#pragma unroll
    for (int j = 0; j < 31; ++j) w[j] = cw[j * DG];
    const float cb = AIN(I_CVB)[l * DG + c];
    const f32x4 g4 = *(const GAS f32x4*)(AIN(I_CNG) + l * DG + 4 * F.lane), b4 = *(const GAS f32x4*)(AIN(I_CNB) + l * DG + 4 * F.lane);
#pragma unroll
    for (int q = 0; q < NI; ++q) { const int item = item0 + q * istride, b = item >> 6, t0 = (item & 63) * 32;
    if (q) LBAR();
#pragma unroll
    for (int j = 0; j < 4; ++j) { const int idx = F.tid + 512 * j;
        if (idx < 62 * 32) { const int rr = idx >> 5, c8 = (idx & 31) * 8, t = t0 - 30 + rr; float g[8];
            if (t >= 0) { float d1[8], d2[8]; unpack8(d1w[q][j], d1); unpack8(d2w[q][j], d2);
#pragma unroll
                for (int i = 0; i < 8; ++i) g[i] = d1[i] * sigm(d2[i]);
                if (t >= SEQ - 30) { float* o = AOUT + O_PCONV + ((size_t)(l * BATCH + b) * 30 + (t - (SEQ - 30))) * DG + c8; *(GAS f32x4*)o = (f32x4){g[0], g[1], g[2], g[3]}; *(GAS f32x4*)(o + 4) = (f32x4){g[4], g[5], g[6], g[7]}; }
            } else {
#pragma unroll
                for (int i = 0; i < 8; ++i) g[i] = 0.f; }
            *(LAS f32x4*)(GLU + rr * 256 + c8) = (f32x4){g[0], g[1], g[2], g[3]}; *(LAS f32x4*)(GLU + rr * 256 + c8 + 4) = (f32x4){g[4], g[5], g[6], g[7]}; } }
    LBAR();
    { float win[46];
#pragma unroll
      for (int j = 0; j < 46; ++j) win[j] = GLU[(half * 16 + j) * 256 + c];
#pragma unroll
      for (int i = 0; i < 16; ++i) { float s = cb;
#pragma unroll
          for (int j = 0; j < 31; ++j) s += w[j] * win[i + j];
          CO[(half * 16 + i) * 256 + c] = s; } }
    LBAR();
#pragma unroll
    for (int k = 0; k < 4; ++k) { const int tok = 4 * F.wave + k; const f32x4 x = *(const LAS f32x4*)(CO + tok * 256 + 4 * F.lane);
        const float s = sum16((x.x + x.y) + (x.z + x.w));
        const float mean = s * (1.f / 64.f); const f32x4 dx = x - mean; const float qq = sum16((dx.x * dx.x + dx.y * dx.y) + (dx.z * dx.z + dx.w * dx.w));
        const float rstd = 1.f / sqrtf(qq * (1.f / 64.f) + EPS); const f32x4 yv = dx * rstd * g4 + b4;
        *(GAS unsigned long long*)(Y + (size_t)(b * SEQ + t0 + tok) * DM + 768 + 4 * F.lane) = (unsigned long long)pk2(silu(yv.x), silu(yv.y)) | ((unsigned long long)pk2(silu(yv.z), silu(yv.w)) << 32); }
    }
}

namespace SG { constexpr int WB = 0, WP = 272  , VT = WB + 128 * WP, VP = 272, END = VT + 64 * VP; static_assert(END <= P::RING_BYTES, "SGU LDS"); }
template <int NI>
__device__ __forceinline__ void sgu_items(const Args& A, const int z, Frame& F, int l, int item0, int istride) {
    using namespace P;
    typedef short s8v __attribute__((ext_vector_type(8)));
    LAS unsigned char* L = F.lds;
    const bf16* H = (const bf16*)(AWS + WS_H); bf16* Y = (bf16*)(AWS + WS_Y);
    const int g = item0 & 3;
    const int tv = F.tid >> 2, qv = F.tid & 3, fi = F.lane & 15, kq = F.lane >> 4, t0 = 16 * F.wave;
    v4u va[NI], vb[NI]; bf16 uu[NI][4][4]; float bsv[4];
#pragma unroll
    for (int q = 0; q < NI; ++q) { const int bn = (item0 + q * istride) >> 2, m0 = (bn >> 4) * SEQ + 128 * (bn & 15);
        const bf16* vsrc = H + (size_t)(m0 + tv) * NIN + HC_BV + 64 * g + 16 * qv; va[q] = *(const GAS v4u*)vsrc; vb[q] = *(const GAS v4u*)(vsrc + 8);
#pragma unroll
        for (int r = 0; r < 4; ++r)
#pragma unroll
            for (int k = 0; k < 4; ++k) uu[q][r][k] = H[(size_t)(m0 + t0 + 4 * kq + r) * NIN + HC_BU + 64 * g + 16 * k + fi]; }
#pragma unroll
    for (int r = 0; r < 4; ++r) bsv[r] = AIN(I_SB)[(size_t)(l * NH + g) * 128 + t0 + 4 * kq + r];
    f32x4 lg[4], lb[4];
#pragma unroll
    for (int j = 0; j < 4; ++j) { lg[j] = *(const GAS f32x4*)(AIN(I_SLG) + l * DG + 64 * g + 16 * qv + 4 * j); lb[j] = *(const GAS f32x4*)(AIN(I_SLB) + l * DG + 64 * g + 16 * qv + 4 * j); }
    { const float* Wg = AIN(I_SW) + ((size_t)(l * NH + g)) * 128 * 128; f32x4 w[8];
#pragma unroll
      for (int j = 0; j < 8; ++j) { const int idx = F.tid + 512 * j; w[j] = *(const GAS f32x4*)(Wg + (idx >> 5) * 128 + (idx & 31) * 4); }
#pragma unroll
      for (int j = 0; j < 8; ++j) { const int idx = F.tid + 512 * j, tt = idx >> 5, s4 = (idx & 31) * 4;
          *(LAS unsigned long long*)(L + SG::WB + tt * SG::WP + 2 * s4) = (unsigned long long)pk2(s4 + 0 <= tt ? w[j].x : 0.f, s4 + 1 <= tt ? w[j].y : 0.f) | ((unsigned long long)pk2(s4 + 2 <= tt ? w[j].z : 0.f, s4 + 3 <= tt ? w[j].w : 0.f) << 32); } }
#pragma unroll
    for (int q = 0; q < NI; ++q) { const int bn = (item0 + q * istride) >> 2, m0 = (bn >> 4) * SEQ + 128 * (bn & 15);
    if (q) LBAR();
    { float x[16]; { float a[8], c[8]; unpack8(va[q], a); unpack8(vb[q], c);
#pragma unroll
        for (int i = 0; i < 8; ++i) { x[i] = a[i]; x[8 + i] = c[i]; } }
      float s = 0.f;
#pragma unroll
      for (int i = 0; i < 16; ++i) s += x[i];
      s = sum4(s); const float mean = s * (1.f / 64.f); float qq = 0.f;
#pragma unroll
      for (int i = 0; i < 16; ++i) { x[i] -= mean; qq += x[i] * x[i]; }
      qq = sum4(qq); const float rstd = 1.f / sqrtf(qq * (1.f / 64.f) + EPS);
#pragma unroll
      for (int i = 0; i < 16; ++i) *(LAS bf16*)(L + SG::VT + (16 * qv + i) * SG::VP + 2 * tv) = (bf16)f2bf(x[i] * rstd * lg[i >> 2][i & 3] + lb[i >> 2][i & 3]); }
    LBAR();
    { f32x4 acc[4];
#pragma unroll
      for (int k = 0; k < 4; ++k) acc[k] = (f32x4){0.f, 0.f, 0.f, 0.f};
      const int nks = (t0 + 16 + 31) >> 5;
      for (int ks = 0; ks < nks; ++ks) { const s8v af = *(const LAS s8v*)(L + SG::WB + (t0 + fi) * SG::WP + 64 * ks + 16 * kq);
#pragma unroll
          for (int k = 0; k < 4; ++k) { const s8v bfr = *(const LAS s8v*)(L + SG::VT + (16 * k + fi) * SG::VP + 64 * ks + 16 * kq); acc[k] = __builtin_amdgcn_mfma_f32_16x16x32_bf16(af, bfr, acc[k], 0, 0, 0); } }
#pragma unroll
      for (int r = 0; r < 4; ++r) { const int t = t0 + 4 * kq + r;
#pragma unroll
          for (int k = 0; k < 4; ++k) Y[(size_t)(m0 + t) * DM + 256 + 64 * g + 16 * k + fi] = (bf16)f2bf(bf1(uu[q][r][k]) * (acc[k][r] + bsv[r])); } }
    }
}

__device__ __forceinline__ float row16_sum(float v) {
    v += __builtin_bit_cast(float, __builtin_amdgcn_mov_dpp(__builtin_bit_cast(int, v), 0xB1, 0xF, 0xF, true));
    v += __builtin_bit_cast(float, __builtin_amdgcn_mov_dpp(__builtin_bit_cast(int, v), 0x4E, 0xF, 0xF, true));
    v += __builtin_bit_cast(float, __builtin_amdgcn_mov_dpp(__builtin_bit_cast(int, v), 0x141, 0xF, 0xF, true));
    v += __builtin_bit_cast(float, __builtin_amdgcn_mov_dpp(__builtin_bit_cast(int, v), 0x140, 0xF, 0xF, true));
    return v;
}
__device__ __forceinline__ void fox_page_wave(const Args& A, const int z, Frame& F, int l, int unit) {
    using namespace P;
    int lane_ = F.lane; asm volatile("" : "+v"(lane_));
    const int b = unit >> 6, pg = unit & 63, hh = lane_ >> 4, ds = lane_ & 15;
    const bf16* H = (const bf16*)(AWS + WS_H); const int* pt = (const int*)AIN(I_PT);
    const int page = __builtin_amdgcn_readfirstlane(pt[b * NPAGES + pg]);
    const __amdgpu_buffer_rsrc_t rK = __builtin_amdgcn_make_buffer_rsrc((void*)(AIN(I_CK) + ((size_t)(l * NPOOL + page) * PAGE) * 256), 0, PAGE * 1024, 0x00020000);
    const __amdgpu_buffer_rsrc_t rV = __builtin_amdgcn_make_buffer_rsrc((void*)(AIN(I_CV) + ((size_t)(l * NPOOL + page) * PAGE) * 256), 0, PAGE * 1024, 0x00020000);
    const __amdgpu_buffer_rsrc_t rL = __builtin_amdgcn_make_buffer_rsrc((void*)(AIN(I_CL) + ((size_t)(l * NPOOL + page) * PAGE) * 4), 0, PAGE * 16, 0x00020000);
    const int vo16 = 16 * lane_, vo4 = 4 * hh;
    f32x4 kA[4], vA[4], kB[4], vB[4]; float lfA[4], lfB[4];
#define PG_LOAD(K4, V4, LF, r0) do { _Pragma("unroll") for (int i = 0; i < 4; ++i) { K4[i] = __builtin_bit_cast(f32x4, __builtin_amdgcn_raw_buffer_load_b128(rK, vo16, ((r0) + i) * 1024, 2)); \
        V4[i] = __builtin_bit_cast(f32x4, __builtin_amdgcn_raw_buffer_load_b128(rV, vo16, ((r0) + i) * 1024, 2)); LF[i] = __builtin_bit_cast(float, __builtin_amdgcn_raw_buffer_load_b32(rL, vo4, ((r0) + i) * 16, 0)); } } while (0)
    PG_LOAD(kA, vA, lfA, PAGE - 4); PG_LOAD(kB, vB, lfB, PAGE - 8);
    f32x4 q4[4];
#pragma unroll
    for (int t = 0; t < 4; ++t) { const unsigned long long w = *(const GAS unsigned long long*)(H + (size_t)(MPR + 4 * b + t) * NIN + HC_CQ + 64 * hh + 4 * ds);
        q4[t] = (f32x4){bflo((unsigned)w), bfhi((unsigned)w), bflo((unsigned)(w >> 32)), bfhi((unsigned)(w >> 32))}; }
    float run;
    { const f32x4 ps = *(const GAS f32x4*)((const float*)(AWS + WS_PS) + ((size_t)(l * DECB + b) * NPAGES + lane_) * 4); const bool later = lane_ > pg;
      const float r0 = wave_sum(later ? ps.x : 0.f), r1 = wave_sum(later ? ps.y : 0.f), r2 = wave_sum(later ? ps.z : 0.f), r3 = wave_sum(later ? ps.w : 0.f);
      run = hh == 0 ? r0 : (hh == 1 ? r1 : (hh == 2 ? r2 : r3)); }
    float mx[4], ls[4]; f32x4 O[4];
#pragma unroll
    for (int t = 0; t < 4; ++t) { mx[t] = -1e30f; ls[t] = 0.f; O[t] = (f32x4){0.f, 0.f, 0.f, 0.f}; }
#define PG_STEP(K4, V4, LF, o) do { float bias[4]; \
        _Pragma("unroll") for (int i = 3; i >= 0; --i) { bias[i] = run * LOG2E; run += LF[(o) + i]; } \
        _Pragma("unroll") for (int t = 0; t < 4; ++t) { float s[4]; \
            _Pragma("unroll") for (int i = 0; i < 4; ++i) { \
                typedef float f2_ __attribute__((ext_vector_type(2))); f2_ a_ = __builtin_shufflevector(K4[(o) + i], K4[(o) + i], 0, 1) * __builtin_shufflevector(q4[t], q4[t], 0, 1); \
                a_ = __builtin_shufflevector(K4[(o) + i], K4[(o) + i], 2, 3) * __builtin_shufflevector(q4[t], q4[t], 2, 3) + a_; s[i] = sum16(a_.x + a_.y) + bias[i]; } \
            const float mb = fmaxf(fmaxf(s[0], s[1]), fmaxf(s[2], s[3])), mn = fmaxf(mx[t], mb), corr = exp2f(mx[t] - mn); \
            const float p0 = exp2f(s[0] - mn), p1 = exp2f(s[1] - mn), p2 = exp2f(s[2] - mn), p3 = exp2f(s[3] - mn); \
            ls[t] = ls[t] * corr + ((p0 + p1) + (p2 + p3)); O[t] = O[t] * corr + V4[(o)] * p0 + V4[(o) + 1] * p1 + V4[(o) + 2] * p2 + V4[(o) + 3] * p3; mx[t] = mn; __builtin_amdgcn_sched_barrier(0); } } while (0)
#pragma unroll 1
    for (int r0 = PAGE - 4; r0 >= 0; r0 -= 8) {
        PG_STEP(kA, vA, lfA, 0); asm volatile("" ::: "memory"); __builtin_amdgcn_sched_barrier(0); if (r0 >= 8) PG_LOAD(kA, vA, lfA, r0 - 8); asm volatile("" ::: "memory"); __builtin_amdgcn_sched_barrier(0);
        PG_STEP(kB, vB, lfB, 0); asm volatile("" ::: "memory"); __builtin_amdgcn_sched_barrier(0); if (r0 >= 12) PG_LOAD(kB, vB, lfB, r0 - 12); asm volatile("" ::: "memory"); __builtin_amdgcn_sched_barrier(0);
    }
#undef PG_LOAD
#undef PG_STEP
    float* PART = (float*)(AWS + WS_PART); float* ML = (float*)(AWS + WS_ML);
#pragma unroll
    for (int t = 0; t < 4; ++t) { const size_t o = ((size_t)(unit * 4 + hh) * 4 + t); *(GAS f32x4*)(PART + o * 64 + 4 * ds) = O[t]; if (ds == 0) { ML[o * 2] = mx[t]; ML[o * 2 + 1] = ls[t]; } }
}

__device__ __forceinline__ void fox_page_dma(const Args& A, const int z, Frame& F, int l, int unit, int ring_off) {
    using namespace P;
    int lane_ = F.lane; asm volatile("" : "+v"(lane_));
    const int b = unit >> 6, pg = unit & 63, hh = lane_ >> 4, ds = lane_ & 15;
    const bf16* H = (const bf16*)(AWS + WS_H); const int* pt = (const int*)AIN(I_PT);
    const int page = __builtin_amdgcn_readfirstlane(pt[b * NPAGES + pg]);
    const char* Kg = (const char*)(AIN(I_CK) + ((size_t)(l * NPOOL + page) * PAGE) * 256) + 16 * lane_;
    const char* Vg = (const char*)(AIN(I_CV) + ((size_t)(l * NPOOL + page) * PAGE) * 256) + 16 * lane_;
    const float* Lg = AIN(I_CL) + ((size_t)(l * NPOOL + page) * PAGE) * 4 + 8 * lane_;
    const f32x4 lfa = *(const GAS f32x4*)Lg, lfb = *(const GAS f32x4*)(Lg + 4);
    const f32x4 ps = *(const GAS f32x4*)((const float*)(AWS + WS_PS) + ((size_t)(l * DECB + b) * NPAGES + lane_) * 4);
    f32x4 q4[4];
#pragma unroll
    for (int t = 0; t < 4; ++t) { const unsigned long long w = *(const GAS unsigned long long*)(H + (size_t)(MPR + 4 * b + t) * NIN + HC_CQ + 64 * hh + 4 * ds);
        q4[t] = (f32x4){bflo((unsigned)w), bfhi((unsigned)w), bflo((unsigned)(w >> 32)), bfhi((unsigned)(w >> 32))}; }
    f32x4 bhi, blo;
#pragma unroll
    for (int c = 0; c < 4; ++c) { const float lat = wave_sum(lane_ > pg ? ps[c] : 0.f); const float s = lfa[c] + lfb[c]; float incl = s;
        incl += DPP_F(incl, 0x111); incl += DPP_F(incl, 0x112); incl += DPP_F(incl, 0x114); incl += DPP_F(incl, 0x118);
        const float t0 = __builtin_bit_cast(float, __builtin_amdgcn_readlane(__builtin_bit_cast(int, incl), 15)), t1 = __builtin_bit_cast(float, __builtin_amdgcn_readlane(__builtin_bit_cast(int, incl), 31)), t2 = __builtin_bit_cast(float, __builtin_amdgcn_readlane(__builtin_bit_cast(int, incl), 47)), t3 = __builtin_bit_cast(float, __builtin_amdgcn_readlane(__builtin_bit_cast(int, incl), 63));
        incl += (lane_ >= 16 ? t0 : 0.f) + (lane_ >= 32 ? t1 : 0.f) + (lane_ >= 48 ? t2 : 0.f);
        const float tot = (t0 + t1) + (t2 + t3), after = tot - incl;
        bhi[c] = (lat + after) * LOG2E; blo[c] = (lat + after + lfb[c]) * LOG2E; }
    float mx[4], ls[4]; f32x4 O[4];
#pragma unroll
    for (int t = 0; t < 4; ++t) { mx[t] = -1e30f; ls[t] = 0.f; O[t] = (f32x4){0.f, 0.f, 0.f, 0.f}; }
    const unsigned rb = (unsigned)(uintptr_t)(F.lds + ring_off);
    const LAS unsigned char* rl = F.lds + ring_off + 16 * lane_;
    asm volatile("s_waitcnt vmcnt(0) lgkmcnt(0)" ::: "memory");
#define PD_DMA(j) do { const int r_ = 127 - (j); const unsigned d_ = (unsigned)__builtin_amdgcn_readfirstlane(rb + (((j) & 7) << 11)); attn_body::glds16(Kg + (size_t)r_ * 1024, d_); attn_body::glds16(Vg + (size_t)r_ * 1024, d_ + 1024u); } while (0)
#define PD_ROW(j, NV, bias_) do { asm volatile("s_waitcnt vmcnt(" #NV ")" ::: "memory"); \
        const f32x4 k4 = *(const LAS f32x4*)(rl + (((j) & 7) << 11)), v4 = *(const LAS f32x4*)(rl + (((j) & 7) << 11) + 1024); \
        asm volatile("s_waitcnt lgkmcnt(0)" ::: "memory"); \
        if ((j) + 7 < 128) PD_DMA((j) + 7); \
        _Pragma("unroll") for (int t = 0; t < 4; ++t) { typedef float f2_ __attribute__((ext_vector_type(2))); \
            f2_ a_ = __builtin_shufflevector(k4, k4, 0, 1) * __builtin_shufflevector(q4[t], q4[t], 0, 1); a_ = __builtin_shufflevector(k4, k4, 2, 3) * __builtin_shufflevector(q4[t], q4[t], 2, 3) + a_; \
            const float s = sum16(a_.x + a_.y) + (bias_); const float mn = fmaxf(mx[t], s), corr = exp2f(mx[t] - mn), p = exp2f(s - mn); \
            ls[t] = ls[t] * corr + p; O[t] = O[t] * corr + v4 * p; mx[t] = mn; } } while (0)
#define PD_BIAS(vec, L) (hh == 0 ? __builtin_bit_cast(float, __builtin_amdgcn_readlane(__builtin_bit_cast(int, vec[0]), (L))) : hh == 1 ? __builtin_bit_cast(float, __builtin_amdgcn_readlane(__builtin_bit_cast(int, vec[1]), (L))) : \
                         hh == 2 ? __builtin_bit_cast(float, __builtin_amdgcn_readlane(__builtin_bit_cast(int, vec[2]), (L))) : __builtin_bit_cast(float, __builtin_amdgcn_readlane(__builtin_bit_cast(int, vec[3]), (L))))
    PD_DMA(0); PD_DMA(1); PD_DMA(2); PD_DMA(3); PD_DMA(4); PD_DMA(5); PD_DMA(6);
#pragma unroll 1
    for (int i = 0; i < 60; ++i) { const int j = 2 * i, L = 63 - i;
        const float b1 = PD_BIAS(bhi, L), b0 = PD_BIAS(blo, L);
        PD_ROW(j, 12, b1); PD_ROW(j + 1, 12, b0); }
    { const float b1 = PD_BIAS(bhi, 3), b0 = PD_BIAS(blo, 3); PD_ROW(120, 12, b1); PD_ROW(121, 12, b0); }
    { const float b1 = PD_BIAS(bhi, 2), b0 = PD_BIAS(blo, 2); PD_ROW(122, 10, b1); PD_ROW(123, 8, b0); }
    { const float b1 = PD_BIAS(bhi, 1), b0 = PD_BIAS(blo, 1); PD_ROW(124, 6, b1); PD_ROW(125, 4, b0); }
    { const float b1 = PD_BIAS(bhi, 0), b0 = PD_BIAS(blo, 0); PD_ROW(126, 2, b1); PD_ROW(127, 0, b0); }
#undef PD_DMA
#undef PD_ROW
#undef PD_BIAS
    float* PART = (float*)(AWS + WS_PART); float* ML = (float*)(AWS + WS_ML);
#pragma unroll
    for (int t = 0; t < 4; ++t) { const size_t o = ((size_t)(unit * 4 + hh) * 4 + t); *(GAS f32x4*)(PART + o * 64 + 4 * ds) = O[t]; if (ds == 0) { ML[o * 2] = mx[t]; ML[o * 2 + 1] = ls[t]; } }
    asm volatile("s_waitcnt vmcnt(0)" ::: "memory");
}

__device__ __forceinline__ void sample_fox_item(const Args& A, const int z, Frame& F, int l, int b) {
    using namespace P;
    LAS float* L = (LAS float*)F.lds; LAS float* SC = L; LAS float* DN = L + 64;
    const bf16* H = (const bf16*)(AWS + WS_H); bf16* Y = (bf16*)(AWS + WS_Y); const float* LRF = (const float*)(AWS + WS_LRF);
    const int mrow = MPR + 4 * b;
    const int hh = F.tid >> 7, t = (F.tid >> 5) & 3, dp = F.tid & 31;
    const float* ML = (const float*)(AWS + WS_ML) + ((size_t)(b * NPAGES * 4 + hh) * 4 + t) * 2; const float* PART = (const float*)(AWS + WS_PART) + ((size_t)(b * NPAGES * 4 + hh) * 4 + t) * 64 + 2 * dp;
    float2 ml[16]; float M = -1e30f; asm volatile("" : "+v"(M));
    if (F.tid < 4) { const int h2 = F.tid; const float bf = AIN(I_FBF)[l * 4 + h2]; float run = 0.f;
        for (int tt = 0; tt < 4; ++tt) { const float lf = logsig(LRF[(size_t)(mrow + tt) * 32 + 16 + h2] + bf); AOUT[O_SFL + ((size_t)l * MS + 4 * b + tt) * 4 + h2] = lf; run += lf; DN[tt * 4 + h2] = run; } }
    LBAR();
    if (F.tid < 64) { const int h2 = F.tid >> 4, tt = (F.tid >> 2) & 3, j = F.tid & 3; float s = 0.f;
        const bf16* qp = H + (size_t)(mrow + tt) * NIN + HC_CQ + 64 * h2; const bf16* kp = H + (size_t)(mrow + j) * NIN + HC_CK + 64 * h2;
#pragma unroll
        for (int d8 = 0; d8 < 8; ++d8) { float qf[8], kf[8]; unpack8(*(const GAS v4u*)(qp + 8 * d8), qf); unpack8(*(const GAS v4u*)(kp + 8 * d8), kf);
#pragma unroll
            for (int i = 0; i < 8; ++i) s += qf[i] * kf[i]; }
        float l2e = LOG2E; asm volatile("" : "+v"(l2e));
        SC[F.tid] = (j <= tt) ? s - DN[j * 4 + h2] * l2e : -INFINITY; }
    LBAR();
    float Ls = 0.f, o0 = 0.f, o1 = 0.f;
    for (int p0 = 0; p0 < NPAGES; p0 += 16) {
#pragma unroll
        for (int p = 0; p < 16; ++p) ml[p] = *(const float2*)(ML + (size_t)(p0 + p) * 32);
#pragma unroll
        for (int p = 0; p < 16; ++p) M = fmaxf(M, ml[p].x); }
#pragma unroll
    for (int j = 0; j < 4; ++j) M = fmaxf(M, SC[(hh * 4 + t) * 4 + j]);
    for (int p0 = 0; p0 < NPAGES; p0 += 16) { float2 pv[16];
#pragma unroll
        for (int p = 0; p < 16; ++p) { ml[p] = *(const float2*)(ML + (size_t)(p0 + p) * 32); pv[p] = *(const float2*)(PART + (size_t)(p0 + p) * 1024); }
#pragma unroll
        for (int p = 0; p < 16; ++p) { const float w = exp2f(ml[p].x - M); Ls += ml[p].y * w; o0 += pv[p].x * w; o1 += pv[p].y * w; } }
#pragma unroll
    for (int j = 0; j < 4; ++j) { const float w = exp2f(SC[(hh * 4 + t) * 4 + j] - M); Ls += w; const bf16* vp = H + (size_t)(mrow + j) * NIN + HC_CV + 64 * hh + 2 * dp; o0 += w * bf1(vp[0]); o1 += w * bf1(vp[1]); }
    const float inv = 1.f / Ls;
    *(GAS unsigned*)(Y + (size_t)(mrow + t) * DM + 512 + 64 * hh + 2 * dp) = pk2(o0 * inv, o1 * inv);
}
__device__ __forceinline__ void sample_gs_item(const Args& A, const int z, Frame& F, int l, int b) {
    using namespace P;
    LAS float* L = (LAS float*)F.lds; LAS float* LA = L; LAS float* QK = L + 512;
    const bf16* H = (const bf16*)(AWS + WS_H); bf16* Y = (bf16*)(AWS + WS_Y); const float* LRF = (const float*)(AWS + WS_LRF);
    const int mrow = MPR + 4 * b;
    { const int t = F.tid >> 7, j = F.tid & 127; const float* lr = LRF + (size_t)(mrow + t) * 32; float s = AIN(I_GBA)[l * 128 + j]; float wv[16]; f32x4 l4[4];
#pragma unroll
      for (int r = 0; r < 16; ++r) wv[r] = AIN(I_GWA)[(size_t)l * RANK * 128 + r * 128 + j];
#pragma unroll
      for (int r = 0; r < 4; ++r) l4[r] = *(const GAS f32x4*)(lr + 4 * r);
#pragma unroll
      for (int r = 0; r < 16; ++r) s += l4[r >> 2][r & 3] * wv[r];
      LA[t * 128 + j] = logsig(s) * (1.f / 16.f); }
    if (F.tid < 128) { const int t = F.tid >> 5, j8 = (F.tid & 31) * 8; float qf[8]; unpack8(*(const GAS v4u*)(H + (size_t)(mrow + t) * NIN + HC_AQ + j8), qf);
#pragma unroll
        for (int i = 0; i < 8; ++i) QK[t * 256 + j8 + i] = qf[i]; }
    if (F.tid < 256) {
        int e = F.tid & 63; asm volatile("" : "+v"(e)); const int hh = F.tid >> 6; float S[32];
        const float* S0 = AIN(I_SGLA) + ((size_t)((l * DECB + b) * NH + hh)) * 2048 + e;
#pragma unroll
        for (int d = 0; d < 32; ++d) S[d] = S0[d * 64];
        float vv[4], ag[4];
#pragma unroll
        for (int t = 0; t < 4; ++t) { vv[t] = bf1(H[(size_t)(mrow + t) * NIN + HC_AV + 64 * hh + e]); ag[t] = bf1(H[(size_t)(mrow + t) * NIN + HC_AG + 64 * hh + e]); }
        const float ng = AIN(I_GNG)[l * 256 + 64 * hh + e];
        LBAR();
#pragma unroll
        for (int t = 0; t < 4; ++t) { float o = 0.f;
#pragma unroll
            for (int d = 0; d < 32; ++d) { S[d] = expf(LA[t * 128 + 32 * hh + d]) * S[d] + QK[t * 256 + 128 + 32 * hh + d] * vv[t]; o += QK[t * 256 + 32 * hh + d] * 0.17677669529663687f * S[d]; }
            const float ms = wave_sum(o * o) * (1.f / 64.f); const float rn = 1.f / sqrtf(ms + EPS);
            Y[(size_t)(mrow + t) * DM + 64 * hh + e] = (bf16)f2bf(o * rn * ng * silu(ag[t])); }
        float* So = AOUT + O_SGLA + ((size_t)((l * DECB + b) * NH + hh)) * 2048 + e;
#pragma unroll
        for (int d = 0; d < 32; ++d) So[d * 64] = S[d];
    } else {
        int c = F.tid - 256; asm volatile("" : "+v"(c)); const int g = c >> 6; float xv[4], uv[4], wv[10], bsv[4];
#pragma unroll
        for (int t = 0; t < 4; ++t) { xv[t] = bf1(H[(size_t)(mrow + t) * NIN + HC_BV + c]); uv[t] = bf1(H[(size_t)(mrow + t) * NIN + HC_BU + c]); }
        const float* Wg = AIN(I_SW) + ((size_t)(l * NH + g)) * 128 * 128; const float* bs = AIN(I_SB) + (size_t)(l * NH + g) * 128;
        { int k = 0;
#pragma unroll
          for (int t = 0; t < 4; ++t) { bsv[t] = bs[t];
#pragma unroll
              for (int s = 0; s <= t; ++s) wv[k++] = Wg[t * 128 + s]; } }
        const float lgv = AIN(I_SLG)[l * DG + c], lbv = AIN(I_SLB)[l * DG + c];
        LBAR();
        float vl[4];
#pragma unroll
        for (int t = 0; t < 4; ++t) { const float mean = wave_sum(xv[t]) * (1.f / 64.f); const float dx = xv[t] - mean;
            const float var = wave_sum(dx * dx) * (1.f / 64.f); vl[t] = dx * (1.f / sqrtf(var + EPS)) * lgv + lbv;
            AOUT[O_SSGU + ((size_t)l * MS + 4 * b + t) * DG + c] = vl[t]; }
        { int k = 0;
#pragma unroll
          for (int t = 0; t < 4; ++t) { float mix = bsv[t];
#pragma unroll
              for (int s = 0; s <= t; ++s) mix += wv[k++] * vl[s];
              Y[(size_t)(mrow + t) * DM + 256 + c] = (bf16)f2bf(uv[t] * mix); } }
    }
}
__device__ __forceinline__ void sample_conv_item(const Args& A, const int z, Frame& F, int l, int b) {
    using namespace P;
    const bf16* H = (const bf16*)(AWS + WS_H); bf16* Y = (bf16*)(AWS + WS_Y);
    const int mrow = MPR + 4 * b;
    if (F.tid < 256) {
        int c = F.tid; asm volatile("" : "+v"(c)); float xx[34], w[31], d1[4], d2[4];
        const float* st = AIN(I_SCONV) + ((size_t)(l * DECB + b) * 30) * DG + c;
#pragma unroll
        for (int j = 0; j < 30; ++j) xx[j] = st[j * DG];
#pragma unroll
        for (int t = 0; t < 4; ++t) { d1[t] = bf1(H[(size_t)(mrow + t) * NIN + HC_D1 + c]); d2[t] = bf1(H[(size_t)(mrow + t) * NIN + HC_D2 + c]); }
        const float* cw = AIN(I_CVW) + (size_t)l * CW * DG + c; const float cb = AIN(I_CVB)[l * DG + c];
#pragma unroll
        for (int j = 0; j < 31; ++j) w[j] = cw[j * DG];
        const float ngv = AIN(I_CNG)[l * DG + c], nbv = AIN(I_CNB)[l * DG + c];
#pragma unroll
        for (int t = 0; t < 4; ++t) xx[30 + t] = d1[t] * sigm(d2[t]);
        float* so = AOUT + O_SCONV + ((size_t)(l * DECB + b) * 30) * DG + c;
#pragma unroll
        for (int j = 0; j < 30; ++j) so[j * DG] = xx[4 + j];
        float co[4] = {cb, cb, cb, cb};
#pragma unroll
        for (int j = 0; j < 31; ++j)
#pragma unroll
            for (int t = 0; t < 4; ++t) co[t] += w[j] * xx[t + j];
#pragma unroll
        for (int t = 0; t < 4; ++t) { const float mean = wave_sum(co[t]) * (1.f / 64.f); const float dx = co[t] - mean; const float var = wave_sum(dx * dx) * (1.f / 64.f);
            const float yv = dx * (1.f / sqrtf(var + EPS)) * ngv + nbv;
            Y[(size_t)(mrow + t) * DM + 768 + c] = (bf16)f2bf(silu(yv)); }
    }
}

struct LnIo { const bf16* Z; const bf16* res; const float* pz; int nsl; const float* g; const float* b; float* of32_p; float* of32_s; bf16* obf; };
__device__ __forceinline__ void ln_finish(Frame& F, float (&v)[16], const LnIo& io, int m) {
    using namespace P;
    float s = 0.f;
#pragma unroll
    for (int i = 0; i < 16; ++i) s += v[i];
    const float mean = wave_sum(s) * (1.f / 1024.f); float s2 = 0.f;
#pragma unroll
    for (int i = 0; i < 16; ++i) { v[i] -= mean; s2 += v[i] * v[i]; }
    const float rstd = 1.f / sqrtf(wave_sum(s2) * (1.f / 1024.f) + EPS);
    float y0[8], y1[8];
#pragma unroll
    for (int h = 0; h < 2; ++h) { const f32x4 ga = *(const GAS f32x4*)(io.g + 8 * F.lane + 4 * h), ba = *(const GAS f32x4*)(io.b + 8 * F.lane + 4 * h), gc = *(const GAS f32x4*)(io.g + 512 + 8 * F.lane + 4 * h), bc = *(const GAS f32x4*)(io.b + 512 + 8 * F.lane + 4 * h);
#pragma unroll
        for (int i = 0; i < 4; ++i) { y0[4 * h + i] = v[4 * h + i] * rstd * ga[i] + ba[i]; y1[4 * h + i] = v[8 + 4 * h + i] * rstd * gc[i] + bc[i]; } }
    if (io.obf) { bf16* o = io.obf + (size_t)m * DM; *(GAS v4u*)(o + 8 * F.lane) = pack8(y0); *(GAS v4u*)(o + 512 + 8 * F.lane) = pack8(y1); }
    float* of = m < MPR ? (io.of32_p ? io.of32_p + (size_t)m * DM : nullptr) : (io.of32_s ? io.of32_s + (size_t)(m - MPR) * DM : nullptr);
    if (of) { *(GAS f32x4*)(of + 8 * F.lane) = (f32x4){y0[0], y0[1], y0[2], y0[3]}; *(GAS f32x4*)(of + 8 * F.lane + 4) = (f32x4){y0[4], y0[5], y0[6], y0[7]};
        *(GAS f32x4*)(of + 512 + 8 * F.lane) = (f32x4){y1[0], y1[1], y1[2], y1[3]}; *(GAS f32x4*)(of + 512 + 8 * F.lane + 4) = (f32x4){y1[4], y1[5], y1[6], y1[7]}; }
}
__device__ __forceinline__ void ln_phase(Frame& F, const LnIo& io) {
    using namespace P;
    constexpr int NR = 4;
    const int gw = F.vcu * NWAVES + F.wave, ngw = F.G * NWAVES;
    const bool xmap = F.G == 256; const int xg = F.vcu >> 5, wl = (F.vcu & 31) * NWAVES + F.wave;
    for (int it_ = 0; it_ < (xmap ? 2 : (MPR / NR + ngw - 1) / ngw); ++it_) { const int m0 = xmap ? 2048 * xg + NR * wl + 1024 * it_ : (gw + ngw * it_) * NR; if (m0 >= MPR) break;
        v4u za[NR], zb[NR];
#pragma unroll
        for (int r = 0; r < NR; ++r) { za[r] = *(const GAS v4u*)(io.Z + (size_t)(m0 + r) * DM + 8 * F.lane); zb[r] = *(const GAS v4u*)(io.Z + (size_t)(m0 + r) * DM + 512 + 8 * F.lane); }
#pragma unroll
        for (int r = 0; r < NR; ++r) { float v[16]; float r0[8], r1[8]; unpack8(za[r], r0); unpack8(zb[r], r1);
#pragma unroll
            for (int i = 0; i < 8; ++i) { v[i] = r0[i]; v[8 + i] = r1[i]; }
            ln_finish(F, v, io, m0 + r); }
    }
    for (int m = MPR + gw; m < MREAL; m += ngw) {
        const bf16* res = io.res + (size_t)m * DM; const float* pz = io.pz + (size_t)(m - MPR) * DM; float v[16];
        float r0[8], r1[8]; unpack8(*(const GAS v4u*)(res + 8 * F.lane), r0); unpack8(*(const GAS v4u*)(res + 512 + 8 * F.lane), r1);
#pragma unroll
        for (int i = 0; i < 8; ++i) { v[i] = r0[i] * ALPHA; v[8 + i] = r1[i] * ALPHA; }
        for (int k = 0; k < io.nsl; ++k) { const float* p = pz + (size_t)k * 128 * 1024 + 8 * F.lane;
            const f32x4 a0 = *(const GAS f32x4*)p, a1 = *(const GAS f32x4*)(p + 4), c0 = *(const GAS f32x4*)(p + 512), c1 = *(const GAS f32x4*)(p + 516);
#pragma unroll
            for (int i = 0; i < 4; ++i) { v[i] += a0[i]; v[4 + i] += a1[i]; v[8 + i] += c0[i]; v[12 + i] += c1[i]; } }
        ln_finish(F, v, io, m);
    }
}

__device__ __forceinline__ void act_fixup(const Args& A, const int z, Frame& F, int l, int pm) {
    using namespace P;
    if (pm >= MPR / 256 || (pm & 7) == 0) return;
    if (F.tid < DFF / 8) {
        const int f0 = 8 * F.tid; bf16* ACT = (bf16*)(AWS + WS_ACT);
        const float* hg = (const float*)(AWS + WS_HALO) + (size_t)((pm - 1) * 2) * DFF + f0; const float* fg = (const float*)(AWS + WS_FG) + (size_t)(pm * 2) * DFF + f0; const float* fv = (const float*)(AWS + WS_FV) + (size_t)(pm * 2) * DFF + f0;
        const float* fw = AIN(I_FCW) + (size_t)l * 3 * DFF + f0; const float* fb = AIN(I_FCB) + l * DFF + f0;
        float y0[8], y1[8];
#pragma unroll
        for (int h = 0; h < 2; ++h) { const int o = 4 * h;
            const f32x4 m2 = *(const GAS f32x4*)(hg + o), m1 = *(const GAS f32x4*)(hg + DFF + o), g0 = *(const GAS f32x4*)(fg + o), g1 = *(const GAS f32x4*)(fg + DFF + o), v0 = *(const GAS f32x4*)(fv + o), v1 = *(const GAS f32x4*)(fv + DFF + o);
            const f32x4 a = *(const GAS f32x4*)(fw + o), b = *(const GAS f32x4*)(fw + DFF + o), c = *(const GAS f32x4*)(fw + 2 * DFF + o), d = *(const GAS f32x4*)(fb + o);
#pragma unroll
            for (int i = 0; i < 4; ++i) { y0[o + i] = silu(a[i] * m2[i] + b[i] * m1[i] + c[i] * g0[i] + d[i]) * v0[i]; y1[o + i] = silu(a[i] * m1[i] + b[i] * g0[i] + c[i] * g1[i] + d[i]) * v1[i]; } }
        *(GAS v4u*)(ACT + (size_t)(pm * 256) * DFF + f0) = pack8(y0); *(GAS v4u*)(ACT + (size_t)(pm * 256 + 1) * DFF + f0) = pack8(y1);
    }
    asm volatile("s_waitcnt vmcnt(0)" ::: "memory"); __syncthreads();
}

namespace pg8 {
__device__ __forceinline__ float dpp_ror1(float v) { return __builtin_bit_cast(float, __builtin_amdgcn_mov_dpp(__builtin_bit_cast(int, v), 0x121, 0xF, 0xF, true)); }
__device__ __forceinline__ float dpp_ror2(float v) { return __builtin_bit_cast(float, __builtin_amdgcn_mov_dpp(__builtin_bit_cast(int, v), 0x122, 0xF, 0xF, true)); }
__device__ __forceinline__ float fast_silu(float x) { return x * __builtin_amdgcn_rcpf(1.0f + __builtin_amdgcn_exp2f(-1.4426950408889634f * x)); }
struct EpiUpAct {
    static constexpr bool PERM = true, AFTER_DRAIN = false;
    const Args& A; int z; int layer;
    static constexpr int DFF = 2688, PM_S = 64; static constexpr size_t O_PFFN = P::O_PFFN, O_SFFN = P::O_SFFN;
    __device__ __forceinline__ void operator()(const f32x4 (&acc)[2][2][4][2], const Unit& u, int wr, int wc, int fr, int fq) const {
        asm volatile("" : "+v"(fr), "+v"(fq));
        const int lc = wc * 32 + 8 * fq, col = u.pn * 128 + lc;
        unsigned char* const ws = AWS; float* const out = AOUT; bf16_t* const ACT = (bf16_t*)(ws + P::WS_ACT); float* const halo_g = (float*)(ws + P::WS_HALO); float* const first_g = (float*)(ws + P::WS_FG); float* const first_v = (float*)(ws + P::WS_FV);
        const float* const cw = AIN(P::I_FCW) + (size_t)layer * 3 * DFF; const float* const cb = AIN(P::I_FCB) + layer * DFF; const float* const st = AIN(P::I_SFFN) + (size_t)layer * P::DECB * 2 * DFF;
        extern __shared__ __attribute__((aligned(16))) unsigned char lds_dyn_[]; PG8_LAS float* const lh = (PG8_LAS float*)((PG8_LAS unsigned char*)lds_dyn_ + P::HALO_OFF);
        f32x4 w0[2], w1[2], w2[2], cbv[2];
#pragma unroll
        for (int n = 0; n < 2; ++n) { w0[n] = *(const f32x4*)(cw + col + 4 * n); w1[n] = *(const f32x4*)(cw + DFF + col + 4 * n); w2[n] = *(const f32x4*)(cw + 2 * DFF + col + 4 * n); cbv[n] = *(const f32x4*)(cb + col + 4 * n); }
        if (fr >= 14) {
#pragma unroll
            for (int ai = 0; ai < 2; ++ai)
#pragma unroll
                for (int n = 0; n < 2; ++n) *(PG8_LAS f32x4*)(lh + (((ai * 2 + wr) * 2 + (fr - 14)) * 128 + lc + 4 * n)) = acc[ai][0][3][n];
            if (wr == 1) {
#pragma unroll
                for (int n = 0; n < 2; ++n) *(f32x4*)(halo_g + (size_t)(u.pm * 2 + (fr - 14)) * DFF + col + 4 * n) = acc[1][0][3][n];
                if (u.pm < PM_S && (u.pm & 7) == 7) {
#pragma unroll
                    for (int n = 0; n < 2; ++n) *(f32x4*)(out + O_PFFN + (size_t)((layer * 8 + (u.pm >> 3)) * 2 + (fr - 14)) * DFF + col + 4 * n) = acc[1][0][3][n]; }
            }
        }
        asm volatile("s_waitcnt lgkmcnt(0)" ::: "memory"); __builtin_amdgcn_s_barrier(); asm volatile("" ::: "memory");
        const bool sample = u.pm >= PM_S;
#pragma unroll
        for (int ai = 0; ai < 2; ++ai) {
            f32x4 pv[2];
            if (wr == 1 || ai == 1) { const int pai = (wr == 1) ? ai : 0, pwr = (wr == 1) ? 0 : 1; const PG8_LAS float* hp = lh + (((pai * 2 + pwr) * 2 + ((fr == 15) ? 1 : 0)) * 128 + lc);
                pv[0] = *(const PG8_LAS f32x4*)hp; pv[1] = *(const PG8_LAS f32x4*)(hp + 4); }
            else { pv[0] = (f32x4){0.f, 0.f, 0.f, 0.f}; pv[1] = pv[0]; }
#pragma unroll
            for (int m = 0; m < 4; ++m) {
                const int lrow = ai * HALF + wr * 64 + m * 16 + fr;
                f32x4 s0[2], s1[2];
                const int sidx = fr & 3;
                if (sample && ai == 0 && sidx <= 1) { const float* sp = st + (size_t)(lrow >> 2) * 2 * DFF + col;
#pragma unroll
                    for (int n = 0; n < 2; ++n) { s0[n] = *(const f32x4*)(sp + 4 * n); s1[n] = *(const f32x4*)(sp + DFF + 4 * n); } }
                else {
#pragma unroll
                    for (int n = 0; n < 2; ++n) { s0[n] = (f32x4){0.f, 0.f, 0.f, 0.f}; s1[n] = s0[n]; } }
                float y[8]; float gk[8], vk[8];
#pragma unroll
                for (int n = 0; n < 2; ++n)
#pragma unroll
                    for (int i = 0; i < 4; ++i) {
                        const float g = acc[ai][0][m][n][i], gp = (m == 0) ? pv[n][i] : acc[ai][0][m == 0 ? 0 : m - 1][n][i];
                        const float a1 = dpp_ror1(g), a2 = dpp_ror2(g), b1 = dpp_ror1(gp), b2 = dpp_ror2(gp);
                        float h1 = fr >= 1 ? a1 : b1, h2 = fr >= 2 ? a2 : b2;
                        if (sample && ai == 0) { if (sidx == 0) { h1 = s1[n][i]; h2 = s0[n][i]; } else if (sidx == 1) { h2 = s1[n][i]; } }
                        const float gc = w0[n][i] * h2 + w1[n][i] * h1 + w2[n][i] * g + cbv[n][i];
                        y[4 * n + i] = fast_silu(gc) * acc[ai][1][m][n][i]; gk[4 * n + i] = g; vk[4 * n + i] = acc[ai][1][m][n][i];
                    }
                const bool defer = !sample && lrow < 2 && (u.pm & 7) != 0;
                if (defer) {
                    float* fg = first_g + (size_t)(u.pm * 2 + lrow) * DFF + col; float* fv = first_v + (size_t)(u.pm * 2 + lrow) * DFF + col;
                    *(f32x4*)fg = (f32x4){gk[0], gk[1], gk[2], gk[3]}; *(f32x4*)(fg + 4) = (f32x4){gk[4], gk[5], gk[6], gk[7]};
                    *(f32x4*)fv = (f32x4){vk[0], vk[1], vk[2], vk[3]}; *(f32x4*)(fv + 4) = (f32x4){vk[4], vk[5], vk[6], vk[7]};
                } else {
                    u32x4 w; w.x = cvt_pk_bf16(y[0], y[1]); w.y = cvt_pk_bf16(y[2], y[3]); w.z = cvt_pk_bf16(y[4], y[5]); w.w = cvt_pk_bf16(y[6], y[7]);
                    *(u32x4*)(ACT + (size_t)(u.pm * BM + lrow) * DFF + col) = w;
                }
                if (sample && ai == 0 && sidx >= 2) { float* o = out + O_SFFN + (size_t)((layer * 32 + (lrow >> 2)) * 2 + (sidx - 2)) * DFF + col;
                    *(f32x4*)o = (f32x4){gk[0], gk[1], gk[2], gk[3]}; *(f32x4*)(o + 4) = (f32x4){gk[4], gk[5], gk[6], gk[7]}; }
            }
        }
    }
};
}

struct AttnOrder {
    int start, step;
    __device__ __forceinline__ bool next(int i, attn_body::AttnUnit& u) const { const int idx = start + i * step; if (idx >= 256) return false; u.bh = idx >> 3; u.qb = idx & 7; return true; }
    __device__ __forceinline__ void a_ready(const attn_body::AttnUnit&) const {}
    __device__ __forceinline__ void done(const attn_body::AttnUnit&) const {}
};

__global__ void __launch_bounds__(NWAVES * 64, 2) hybrid_fwd(Args A) {
    using namespace P;
    extern __shared__ __attribute__((aligned(16))) unsigned char lds[];
#define MKFRAME() Frame F; { F.lds = (LAS unsigned char*)lds; F.MISC = (volatile LAS unsigned*)(F.lds + MISC_OFF); F.tid = ltid(); F.lane = F.tid & 63; F.wave = __builtin_amdgcn_readfirstlane(F.tid >> 6); \
        F.G = lgrid(); const int bx_ = lbid(); F.vcu = (F.G % 8 == 0) ? (bx_ % 8) * (F.G / 8) + bx_ / 8 : bx_; F.ctl = (gu32*)(AWS + WS_CTL); }
    XcdBarrier bar;
    { for (int u = threadIdx.x; u < (LDS_BYTES - RING_BYTES) / 4; u += NWAVES * 64) ((LAS unsigned*)((LAS unsigned char*)lds + RING_BYTES))[u] = 0u;
      __syncthreads();
      if ((threadIdx.x & 63) == 0) ((LAS int*)((LAS unsigned char*)lds + LTID_TABLE_OFF))[hw_wave_slot()] = (int)(threadIdx.x >> 6);
      __syncthreads(); }
    { const int z = OPAQUE_ZERO(); MKFRAME();
      bar.bar = (unsigned*)(F.ctl + CW_BAR); bar.x = 0; bar.st = nullptr;
      if (!MK_PER_PHASE) bar = xcd_barrier_post((unsigned*)(F.ctl + CW_BAR), F.MISC + 8); }
    const int lo = A.ph_lo, hi = A.ph_hi;
#define IN(k) (lo <= (k) && (k) < hi)
#define SEAM(k) do { if (!MK_PER_PHASE && (k) + 1 < N_PHASES) xcd_barrier(bar); } while (0)
#define CLS(c) (!MK_PER_PHASE || A.pad == 0 || A.pad == 1 + (c))
#define GW() (F.vcu * NWAVES + F.wave)
#define NGW() (F.G * NWAVES)

    if (IN(0)) { const int z = OPAQUE_ZERO(); MKFRAME(); p0_prologue(A, z, F); SEAM(0); }

    for (int l = 0; l < DEPTH; ++l) {
        const int pb = 1 + PH_PER_LAYER * l;
        if (IN(pb + 0)) {
            const int z = OPAQUE_ZERO(); MKFRAME(); unsigned char* const ws = AWS; float* const out = AOUT;
            pg8::Gemm g{(const bf16*)(ws + WS_XB), (const bf16*)(ws + WS_WIN + l * SZ_WIN), MP, NIN, DM, DM}; pg8::StaticOrder S; S.init(MP, NIN, F.G, (int)lbid(), MK_WGM_IN);
            const float* fb_ = AIN(I_FBF) + 4 * l; pg8::EpiIn E{(bf16*)(ws + WS_H), (float*)(ws + WS_LRF), out, l, (float*)(ws + WS_LOGF), (pg8::f32x4){fb_[0], fb_[1], fb_[2], fb_[3]}};
            pg8::gemm_phase<pg8::EpiIn, pg8::StaticOrder, true, true>(F.lds, g, S, E);
            SEAM(pb + 0);
        }
        if (IN(pb + 1)) {
            constexpr int N_GL = 1024, N_SG = 512, N_CV = 512, N_CS = BATCH;
            { const int z = OPAQUE_ZERO(); MKFRAME();
              if (CLS(0)) for (int unit = F.vcu * NWAVES + F.wave; unit < DECB * NPAGES; unit += F.G * NWAVES) fox_page_wave(A, z, F, l, unit); }
            { const int z = OPAQUE_ZERO(); MKFRAME();
              if (CLS(4) && F.wave == 0) for (int unit = F.vcu; unit < N_CS; unit += F.G) fox_cumsum_wave(A, z, F, l, unit); }
            { const int z = OPAQUE_ZERO(); MKFRAME(); TeamBar tb{F.MISC + 16, 0u, 8u};
              if (CLS(1)) for (int it = 4 * F.vcu; it < N_GL; it += 4 * F.G) { LBAR(); gla_local_items<4>(A, z, F, l, it); }
              if (F.G == 256) {
                  if (CLS(2)) { LBAR(); sgu_items<2>(A, z, F, l, F.vcu, 256); }
                  if (CLS(3)) { LBAR(); conv_items<2>(A, z, F, l, F.vcu, 256); }
              } else {
                  if (CLS(2)) for (int it = F.vcu; it < N_SG; it += F.G) { LBAR(); sgu_items<1>(A, z, F, l, it, 0); }
                  if (CLS(3)) for (int it = F.vcu; it < N_CV; it += F.G) { LBAR(); conv_items<1>(A, z, F, l, it, 0); }
              } }
            SEAM(pb + 1);
        }
        if (IN(pb + 2)) {
            { const int z = OPAQUE_ZERO(); MKFRAME(); unsigned char* const ws = AWS; const bf16* Hb = (const bf16*)(ws + WS_H);
              const attn_body::AttnTensors AT{(const attn_body::bf16*)(Hb + HC_CQ), (const attn_body::bf16*)(Hb + HC_CK), (const attn_body::bf16*)(Hb + HC_CV), (attn_body::bf16*)(ws + WS_Y) + 512, (const float*)(ws + WS_KBIAS)};
              const AttnOrder S{F.vcu, F.G};
              if (CLS(0)) attn_body::attn_phase<AttnOrder>((char*)lds, AT, S); }
            const int z = OPAQUE_ZERO(); MKFRAME();
            const int shard = (int)lbid() & 7; gu32* head = F.ctl + CW_Q + 64 * (8 * (2 * l + A.qoff) + shard);
            const int nwc = l == 0 ? (WC::I_ALL - WC::I_IN + 63) / 64 * 8 : 0;
            const int nq = (3 * DECB + 1024 + nwc) / 8;
            int j = q_next(F, head);
            while (j < nq) {
                unsigned pend = 0u; if (F.tid == 0) pend = __hip_atomic_fetch_add(head, 1u, RLX_AGENT);
                int it = 8 * j + shard;
                if (it < 1024) { if (CLS(2)) gla_out_item(A, z, F, l, it); }
                else if ((it -= 1024) < DECB) { if (CLS(1)) sample_fox_item(A, z, F, l, it); }
                else if ((it -= DECB) < DECB) { if (CLS(1)) sample_gs_item(A, z, F, l, it); }
                else if ((it -= DECB) < DECB) { if (CLS(1)) sample_conv_item(A, z, F, l, it); }
                else { it -= DECB; const int wi = WC::I_IN + it * 8 + F.wave; if (wi < WC::I_ALL) wconv_wave_item(A, z, F, wi); }
                __syncthreads();
                if (F.tid == 0) F.MISC[0] = pend;
                __syncthreads();
                j = (int)F.MISC[0];
            }
            SEAM(pb + 2);
        }
        if (IN(pb + 3)) {
            const int z = OPAQUE_ZERO(); MKFRAME(); unsigned char* const ws = AWS;
            { pg8::Gemm g{(const bf16*)(ws + WS_Y), (const bf16*)(ws + WS_WO + l * SZ_WO), MPR, DM, DM, DM}; pg8::StaticOrder S; S.init(MPR, DM, F.G, (int)lbid());
              pg8::EpiRes E{(const bf16*)(ws + WS_XB), (bf16*)(ws + WS_Z), DM, ALPHA};
              pg8::gemm_phase<pg8::EpiRes, pg8::StaticOrder, true, true>(F.lds, g, S, E); }
            { pg8::Gemm g{(const bf16*)(ws + WS_Y), (const bf16*)(ws + WS_WO + l * SZ_WO), MP, DM, 128, DM}; const pg8::SliceOrder S{MPR / 256, DM / 256, 8, 128, F.G, (int)lbid()};
              pg8::EpiPart E{(float*)(ws + WS_PZ), DM, 128};
              pg8::gemm_phase<pg8::EpiPart, pg8::SliceOrder, true, true>(F.lds, g, S, E); }
            SEAM(pb + 3);
        }
        if (IN(pb + 4)) {
            const int z = OPAQUE_ZERO(); MKFRAME(); unsigned char* const ws = AWS;
            const LnIo io{(const bf16*)(ws + WS_Z), (const bf16*)(ws + WS_XB), (const float*)(ws + WS_PZ), 8, AIN(I_L1G) + l * DM, AIN(I_L1B) + l * DM, nullptr, nullptr, (bf16*)(ws + WS_X1B)};
            ln_phase(F, io);
            SEAM(pb + 4);
        }
        if (IN(pb + 5)) {
            const int z = OPAQUE_ZERO(); MKFRAME(); unsigned char* const ws = AWS;
            pg8::Gemm g{(const bf16*)(ws + WS_X1B), (const bf16*)(ws + WS_WUP + l * SZ_WUP), MP, NUP, DM, DM}; pg8::StaticOrder S; S.init(MP, NUP, F.G, (int)lbid(), MK_WGM_UP);
            pg8::EpiUpAct E{A, z, l};
            pg8::gemm_phase<pg8::EpiUpAct, pg8::StaticOrder, true, true>(F.lds, g, S, E);
            SEAM(pb + 5);
        }
        if (IN(pb + 6)) {
            const int z = OPAQUE_ZERO(); MKFRAME(); unsigned char* const ws = AWS;
            { pg8::Gemm g{(const bf16*)(ws + WS_ACT), (const bf16*)(ws + WS_WDN + l * SZ_WDN), MPR, DM, DFF, DFF}; pg8::StaticOrder S; S.init(MPR, DM, F.G, (int)lbid());
              { pg8::Unit u_; for (int i = 0; S.next(i, u_); ++i) act_fixup(A, z, F, l, u_.pm); }
              pg8::EpiRes E{(const bf16*)(ws + WS_X1B), (bf16*)(ws + WS_Z), DM, ALPHA};
              pg8::gemm_phase<pg8::EpiRes, pg8::StaticOrder, true, true>(F.lds, g, S, E); }
            { pg8::Gemm g{(const bf16*)(ws + WS_ACT), (const bf16*)(ws + WS_WDN + l * SZ_WDN), MP, DM, 384, DFF}; const pg8::SliceOrder S{MPR / 256, DM / 256, 7, 384, F.G, (int)lbid()};
              pg8::EpiPart E{(float*)(ws + WS_PZ), DM, 384};
              pg8::gemm_phase<pg8::EpiPart, pg8::SliceOrder, true, true>(F.lds, g, S, E); }
            SEAM(pb + 6);
        }
        if (IN(pb + 7)) {
            const int z = OPAQUE_ZERO(); MKFRAME(); unsigned char* const ws = AWS; float* const out = AOUT; const bool last = l + 1 == DEPTH;
            const LnIo io{(const bf16*)(ws + WS_Z), (const bf16*)(ws + WS_X1B), (const float*)(ws + WS_PZ), 7, AIN(I_L2G) + l * DM, AIN(I_L2B) + l * DM, last ? out + O_YP : nullptr, last ? out + O_YS : nullptr, last ? nullptr : (bf16*)(ws + WS_XB)};
            ln_phase(F, io);
            SEAM(pb + 7);
        }
    }
#undef IN
#undef SEAM
#undef GW
#undef NGW
#undef CLS
#undef MKFRAME
}

extern "C" void kernel_launch(void* const* d_in, const int* in_sizes, int n_in, void* d_out, int out_size, void* d_ws, size_t ws_size, hipStream_t stream) {
    using namespace P;
    static int grid = 0;
    if (grid == 0) {
        if (n_in != N_IN || (size_t)out_size != O_END || ws_size < WS_END) { fprintf(stderr, "kernel_launch: unexpected shapes: n_in %d out %d ws %zu (need %zu)\n", n_in, out_size, ws_size, (size_t)WS_END); grid = -1; return; }
        int dev = 0, cus = 0, per_cu = 0;
        if (hipGetDevice(&dev) != hipSuccess || hipDeviceGetAttribute(&cus, hipDeviceAttributeMultiprocessorCount, dev) != hipSuccess) { grid = -1; return; }
        if (hipFuncSetAttribute((const void*)hybrid_fwd, hipFuncAttributeMaxDynamicSharedMemorySize, LDS_BYTES) != hipSuccess) { fprintf(stderr, "kernel_launch: hipFuncSetAttribute failed\n"); grid = -1; return; }
        if (hipOccupancyMaxActiveBlocksPerMultiprocessor(&per_cu, (const void*)hybrid_fwd, NWAVES * 64, LDS_BYTES) != hipSuccess || per_cu < 1)
            fprintf(stderr, "kernel_launch: note: occupancy query reports %d workgroups per CU\n", per_cu);
        (void)hipGetLastError();
        grid = cus;
    }
    if (grid < 0) return;
    if (hipMemsetAsync((char*)d_ws + WS_CTL, 0, CTL_ZERO_BYTES, stream) != hipSuccess) { fprintf(stderr, "kernel_launch: memset failed\n"); return; }
    Args a{};
    for (int i = 0; i < N_IN; ++i) a.p[i] = (const float*)d_in[i];
    a.p[N_IN] = (const float*)d_out; a.p[N_IN + 1] = (const float*)d_ws;
#if MK_PER_PHASE
    for (int p = 0; p < N_PHASES; ++p) { const int type = p == 0 ? 0 : 1 + (p - 1) % PH_PER_LAYER; const int reps = 1 + ((MK_REP_MASK >> type) & 1);
        for (int r = 0; r < reps; ++r) { a.ph_lo = p; a.ph_hi = p + 1; a.qoff = r; a.pad = r ? MK_REP_CLASS : 0; hipLaunchKernelGGL(hybrid_fwd, dim3(grid), dim3(NWAVES * 64), LDS_BYTES, stream, a); } }
#else
    a.ph_lo = 0; a.ph_hi = N_PHASES;
    hipLaunchKernelGGL(hybrid_fwd, dim3(grid), dim3(NWAVES * 64), LDS_BYTES, stream, a);
#endif
    const hipError_t le = hipPeekAtLastError();
    if (le != hipSuccess) fprintf(stderr, "kernel_launch: launch failed: %s\n", hipGetErrorName(le));
}
```

```cpp
#include <hip/hip_runtime.h>
#include <cstdio>
#include <cstdint>
#define LTID_TABLE_OFF (131072 + 1024)
__device__ __forceinline__ unsigned hw_wave_slot() { return (unsigned)__builtin_amdgcn_s_getreg((5 << 11) | 4) & 63u; }
__device__ __forceinline__ int ltid() {
    extern __shared__ __attribute__((aligned(16))) unsigned char lds[];
    const int w = __builtin_amdgcn_readfirstlane(((const __attribute__((address_space(3))) int*)((__attribute__((address_space(3))) unsigned char*)lds + LTID_TABLE_OFF))[hw_wave_slot()]);
    int lane; asm volatile("v_mbcnt_lo_u32_b32 %0, -1, 0\n\tv_mbcnt_hi_u32_b32 %0, -1, %0" : "=v"(lane));
    return w * 64 + lane; }
__device__ __forceinline__ int lbid() { int t = blockIdx.x; asm volatile("" : "+s"(t)); return t; }
__device__ __forceinline__ int lgrid() { int t = gridDim.x; asm volatile("" : "+s"(t)); return t; }
namespace pg8 {
#define PG8_LAS __attribute__((address_space(3)))
typedef unsigned short bf16_t;
typedef short bf16x8 __attribute__((ext_vector_type(8)));
typedef float f32x4 __attribute__((ext_vector_type(4)));
typedef unsigned u32x4 __attribute__((ext_vector_type(4)));
constexpr int BM = 256, BK = 64, HALF = 128, HTB = HALF * BK * 2  , STAGE_BYTES = 8 * HTB, NXCD = 8, WGM = 4;

__host__ __device__ __forceinline__ int lds_byte(int r, int c) { const int st = (r >> 4) * 2 + (c >> 5), rr = r & 15, cc = c & 31, ob = rr * 64 + cc * 2; return st * 1024 + (ob ^ (((ob >> 9) & 1) << 5)); }
__host__ __device__ __forceinline__ void stage_rc(int b, int& R, int& C) { const int st = b / 1024, sb = b % 1024, swz = sb ^ (((sb >> 9) & 1) << 5); R = (st >> 1) * 16 + swz / 64; C = (st & 1) * 32 + (swz % 64) / 2; }
__host__ __device__ __forceinline__ int perm32(int rho) { const int n = rho >> 4, i = rho & 15; return 8 * (i >> 2) + 4 * n + (i & 3); }

struct Unit { int pm, pn, k0; };
struct Gemm { const bf16_t* A; const bf16_t* Bt; int M, N, K, ld; };

struct StaticOrder {
    int nM, nN, nwg, G, c, wgm;
    __host__ __device__ __forceinline__ void init(int M, int N, int G_, int c_, int wgm_ = WGM) { nM = M / BM; nN = N / BM; nwg = nM * nN; G = G_; c = c_; wgm = wgm_; }
    __host__ __device__ __forceinline__ bool next(int i, Unit& u) const {
        const long L = (long)i * G + c; if (L >= nwg) return false;
        int wgid = (int)L; { const int q = nwg / NXCD, r = nwg % NXCD, xcd = wgid % NXCD, off = wgid / NXCD; wgid = (xcd < r ? xcd * (q + 1) : r * (q + 1) + (xcd - r) * q) + off; }
        const int nig = wgm * nN, gid = wgid / nig, fm = gid * wgm, gsz = (nM - fm) < wgm ? (nM - fm) : wgm;
        u.pm = fm + ((wgid % nig) % gsz); u.pn = (wgid % nig) / gsz; u.k0 = 0; return true;
    }
    __device__ __forceinline__ void a_ready(const Unit&) const {}
    __device__ __forceinline__ void done(const Unit&) const {}
};

struct SliceOrder {
    int pm, nN, nS, kslice, G, c;
    __host__ __device__ __forceinline__ bool next(int i, Unit& u) const { const int L = i * G + c; if (L >= nN * nS) return false; u.pm = pm; u.pn = L % nN; u.k0 = (L / nN) * kslice; return true; }
    __device__ __forceinline__ void a_ready(const Unit&) const {}
    __device__ __forceinline__ void done(const Unit&) const {}
};

__device__ __forceinline__ unsigned cvt_pk_bf16(float lo, float hi) { unsigned r; asm volatile("v_cvt_pk_bf16_f32 %0, %1, %2" : "=v"(r) : "v"(lo), "v"(hi)); return r; }
typedef float f32x2 __attribute__((ext_vector_type(2)));

struct EpiBf16 {
    static constexpr bool PERM = true, AFTER_DRAIN = false;
    bf16_t* O; int ldc;
    __device__ __forceinline__ void operator()(const f32x4 (&acc)[2][2][4][2], const Unit& u, int wr, int wc, int fr, int fq) const {
        const int row0 = u.pm * BM + wr * 64 + fr; const int col0 = u.pn * BM + wc * 32 + 8 * fq;
#pragma unroll
        for (int ai = 0; ai < 2; ++ai)
#pragma unroll
            for (int m = 0; m < 4; ++m) { bf16_t* rowp = O + (size_t)(row0 + ai * HALF + m * 16) * ldc + col0;
#pragma unroll
                for (int bj = 0; bj < 2; ++bj) { const f32x4 v0 = acc[ai][bj][m][0], v1 = acc[ai][bj][m][1];
                    u32x4 w; w.x = cvt_pk_bf16(v0[0], v0[1]); w.y = cvt_pk_bf16(v0[2], v0[3]); w.z = cvt_pk_bf16(v1[0], v1[1]); w.w = cvt_pk_bf16(v1[2], v1[3]);
                    *(u32x4*)(rowp + bj * HALF) = w; } }
    }
};
struct EpiIn {
    static constexpr bool PERM = true, AFTER_DRAIN = false;
    bf16_t* H; float* lrf; float* out; int layer; float* logf; f32x4 fbf;
    static constexpr int ldc = 2816, pm_sample = 64; static constexpr float qscale = 0.125f * 1.4426950408889634f;
    static constexpr size_t O_PFK = 16908288, O_PFV = O_PFK + 8388608, O_PFL = O_PFV + 8388608, O_SFK = 34156544, O_SFV = O_SFK + 65536;
    __device__ __forceinline__ void operator()(const f32x4 (&acc)[2][2][4][2], const Unit& u, int wr, int wc, int fr, int fq) const {
        const int row0 = u.pm * BM + wr * 64 + fr; const int col0 = u.pn * BM + wc * 32 + 8 * fq;
        const float sc = (u.pn == 5) ? qscale : 1.f;
#pragma unroll
        for (int ai = 0; ai < 2; ++ai)
#pragma unroll
            for (int m = 0; m < 4; ++m) { bf16_t* rowp = H + (size_t)(row0 + ai * HALF + m * 16) * ldc + col0;
#pragma unroll
                for (int bj = 0; bj < 2; ++bj) { const f32x4 v0 = acc[ai][bj][m][0] * sc, v1 = acc[ai][bj][m][1] * sc;
                    u32x4 w; w.x = cvt_pk_bf16(v0[0], v0[1]); w.y = cvt_pk_bf16(v0[2], v0[3]); w.z = cvt_pk_bf16(v1[0], v1[1]); w.w = cvt_pk_bf16(v1[2], v1[3]);
                    *(u32x4*)(rowp + bj * HALF) = w; } }
        if (u.pn == 6 || u.pn == 7) {
            const int lcol0 = wc * 32 + 8 * fq;
#pragma unroll
            for (int ai = 0; ai < 2; ++ai) {
                float* dst; int rbase;
                if (u.pm < pm_sample) { dst = out + ((u.pn == 6) ? O_PFK : O_PFV) + (size_t)layer * (16384 * 256); rbase = u.pm * BM; }
                else { if (ai == 1) continue; dst = out + ((u.pn == 6) ? O_SFK : O_SFV) + (size_t)layer * (128 * 256); rbase = 0; }
#pragma unroll
                for (int m = 0; m < 4; ++m) { float* rowp = dst + (size_t)(rbase + wr * 64 + fr + ai * HALF + m * 16) * 256 + lcol0;
#pragma unroll
                    for (int bj = 0; bj < 2; ++bj) { *(f32x4*)(rowp + bj * HALF) = acc[ai][bj][m][0]; *(f32x4*)(rowp + bj * HALF + 4) = acc[ai][bj][m][1]; } }
            }
        }
        if (u.pn == 10 && wc == 0) {
#pragma unroll
            for (int ai = 0; ai < 2; ++ai)
#pragma unroll
                for (int m = 0; m < 4; ++m) { const int row = row0 + ai * HALF + m * 16; float* rowp = lrf + (size_t)row * 32 + 8 * fq;
                    *(f32x4*)(rowp) = acc[ai][0][m][0]; *(f32x4*)(rowp + 4) = acc[ai][0][m][1];
                    if (fq == 2 && row < 16384) {
                        f32x4 lf;
#pragma unroll
                        for (int i = 0; i < 4; ++i) { const float x = acc[ai][0][m][0][i] + fbf[i]; lf[i] = fminf(x, 0.f) - log1pf(expf(-fabsf(x))); }
                        *(f32x4*)(logf + (size_t)row * 4) = lf; *(f32x4*)(out + O_PFL + ((size_t)layer * 16384 + row) * 4) = lf; } }
        }
    }
};
struct EpiRes {
    static constexpr bool PERM = true, AFTER_DRAIN = false;
    const bf16_t* R; bf16_t* Z; int ldc; float alpha;
    __device__ __forceinline__ void operator()(const f32x4 (&acc)[2][2][4][2], const Unit& u, int wr, int wc, int fr, int fq) const {
        const int row0 = u.pm * BM + wr * 64 + fr; const int col0 = u.pn * BM + wc * 32 + 8 * fq;
#pragma unroll
        for (int ai = 0; ai < 2; ++ai)
#pragma unroll
            for (int m = 0; m < 4; ++m) { const size_t off = (size_t)(row0 + ai * HALF + m * 16) * ldc + col0;
#pragma unroll
                for (int bj = 0; bj < 2; ++bj) { const u32x4 r = *(const u32x4*)(R + off + bj * HALF); const f32x4 a0 = acc[ai][bj][m][0], a1 = acc[ai][bj][m][1];
                    u32x4 w; w.x = cvt_pk_bf16(__uint_as_float(r.x << 16) * alpha + a0[0], __uint_as_float(r.x & 0xffff0000u) * alpha + a0[1]); w.y = cvt_pk_bf16(__uint_as_float(r.y << 16) * alpha + a0[2], __uint_as_float(r.y & 0xffff0000u) * alpha + a0[3]);
                    w.z = cvt_pk_bf16(__uint_as_float(r.z << 16) * alpha + a1[0], __uint_as_float(r.z & 0xffff0000u) * alpha + a1[1]); w.w = cvt_pk_bf16(__uint_as_float(r.w << 16) * alpha + a1[2], __uint_as_float(r.w & 0xffff0000u) * alpha + a1[3]);
                    *(u32x4*)(Z + off + bj * HALF) = w; } }
    }
};
struct EpiPart {
    static constexpr bool PERM = false, AFTER_DRAIN = false;
    float* PZ; int ldc, kslice;
    __device__ __forceinline__ void operator()(const f32x4 (&acc)[2][2][4][2], const Unit& u, int wr, int wc, int fr, int fq) const {
        const int col0 = u.pn * BM + wc * 32 + 4 * fq; float* base = PZ + (size_t)(u.k0 / kslice) * 128 * ldc;
#pragma unroll
        for (int m = 0; m < 4; ++m) { const size_t off = (size_t)(wr * 64 + m * 16 + fr) * ldc + col0;
#pragma unroll
            for (int bj = 0; bj < 2; ++bj)
#pragma unroll
                for (int n = 0; n < 2; ++n) *(f32x4*)(base + off + bj * HALF + n * 16) = acc[0][bj][m][n]; }
    }
};

template <class Epi, class Sched, bool ALIGN_EPI = false, bool SP2 = false>
__device__ __forceinline__ void gemm_phase(PG8_LAS unsigned char* lds, const Gemm g, const Sched& S, const Epi& E) {
    const int tid = ltid(), wid = __builtin_amdgcn_readfirstlane(tid >> 6), lane = tid & 63, wr = wid >> 2, wc = wid & 3, fr = lane & 15, fq = lane >> 4;
    const int K = g.K, nt = K / BK, LD = g.ld;
    unsigned voffA[2], voffB[2];
#pragma unroll
    for (int i = 0; i < 2; ++i) { int R, C; stage_rc(tid * 16 + i * 8192, R, C); const int Rb = Epi::PERM ? ((R & ~31) + perm32(R & 31)) : R;
        voffA[i] = (unsigned)(R * LD + C) * 2u; voffB[i] = (unsigned)(Rb * LD + C) * 2u; }
    const size_t kstep = (size_t)(BK * 2);
    const size_t hstep = (size_t)HALF * LD * 2;
    const size_t tstep = 2 * hstep;
    const unsigned ldsw = (unsigned)wid * 1024u;
    const int aoff = lds_byte(wr * 64 + fr, fq * 8), boff = lds_byte(wc * 32 + fr, fq * 8);
#define PG8_SA(b, h) (((b) * 2 + (h)) * HTB)
#define PG8_SB(b, h) ((4 + (b) * 2 + (h)) * HTB)
#define PG8_STAGE(bufoff, gbase, voff) do { _Pragma("unroll") for (int _i = 0; _i < 2; ++_i) \
        __builtin_amdgcn_global_load_lds((const unsigned*)((const char*)(gbase) + (voff)[_i]), (PG8_LAS unsigned*)(lds + (bufoff) + ldsw + _i * 8192), 16, 0, 0); } while (0)
#define PG8_LDA(dst, b, h) do { _Pragma("unroll") for (int m = 0; m < 4; ++m) _Pragma("unroll") for (int k = 0; k < 2; ++k) dst[m][k] = *(const PG8_LAS bf16x8*)(lds + PG8_SA(b, h) + aoff + m * 2048 + k * 1024); } while (0)
#define PG8_LDB(dst, b, h) do { _Pragma("unroll") for (int n = 0; n < 2; ++n) _Pragma("unroll") for (int k = 0; k < 2; ++k) dst[n][k] = *(const PG8_LAS bf16x8*)(lds + PG8_SB(b, h) + boff + n * 2048 + k * 1024); } while (0)
#define PG8_MMA(ai, bj, At, Bt) do { __builtin_amdgcn_s_setprio(1); _Pragma("unroll") for (int m = 0; m < 4; ++m) _Pragma("unroll") for (int n = 0; n < 2; ++n) _Pragma("unroll") for (int k = 0; k < 2; ++k) \
        acc[ai][bj][m][n] = __builtin_amdgcn_mfma_f32_16x16x32_bf16(Bt[n][k], At[m][k], acc[ai][bj][m][n], 0, 0, 0); __builtin_amdgcn_s_setprio(0); } while (0)
#define PG8_WAIT_V(n) asm volatile("s_waitcnt vmcnt(" #n ")" ::: "memory")
#define PG8_WAIT_L(n) asm volatile("s_waitcnt lgkmcnt(" #n ")" ::: "memory")
#define PG8_BAR __builtin_amdgcn_s_barrier()
#define PG8_SCHED __builtin_amdgcn_sched_barrier(0)
    Unit cur, nxt; int ui = 0;
    if (!S.next(0, cur)) return;
    f32x4 acc[2][2][4][2];
#pragma unroll
    for (int a = 0; a < 2; ++a)
#pragma unroll
        for (int b = 0; b < 2; ++b)
#pragma unroll
            for (int m = 0; m < 4; ++m)
#pragma unroll
                for (int n = 0; n < 2; ++n) acc[a][b][m][n] = (f32x4){0.f, 0.f, 0.f, 0.f};
    bf16x8 At[4][2], B0[2][2], B1[2][2];
    const char* cA = (const char*)g.A + (size_t)cur.pm * tstep + (size_t)cur.k0 * 2; const char* cB = (const char*)g.Bt + (size_t)cur.pn * tstep + (size_t)cur.k0 * 2;
    S.a_ready(cur);
    if constexpr (SP2) {
        PG8_STAGE(PG8_SB(0, 0), cB, voffB); PG8_STAGE(PG8_SB(0, 1), cB + hstep, voffB); PG8_STAGE(PG8_SA(0, 0), cA, voffA); PG8_STAGE(PG8_SA(0, 1), cA + hstep, voffA);
        if (wr == 1) PG8_BAR;
        PG8_WAIT_V(2); PG8_BAR;
        PG8_STAGE(PG8_SB(1, 0), cB + kstep, voffB); PG8_STAGE(PG8_SA(1, 0), cA + kstep, voffA); PG8_STAGE(PG8_SB(1, 1), cB + hstep + kstep, voffB);
        PG8_WAIT_V(6); PG8_BAR;
    } else {
        PG8_STAGE(PG8_SB(0, 0), cB, voffB); PG8_STAGE(PG8_SA(0, 0), cA, voffA); PG8_STAGE(PG8_SB(0, 1), cB + hstep, voffB); PG8_STAGE(PG8_SA(0, 1), cA + hstep, voffA);
        if (wr == 1) PG8_BAR;
        PG8_WAIT_V(4); PG8_BAR;
        PG8_STAGE(PG8_SB(1, 0), cB + kstep, voffB); PG8_STAGE(PG8_SA(1, 0), cA + kstep, voffA); PG8_STAGE(PG8_SB(1, 1), cB + hstep + kstep, voffB);
        PG8_WAIT_V(6); PG8_BAR;
    }
    for (;;) {
        const bool has_next = S.next(ui + 1, nxt);
        const char* nA = has_next ? (const char*)g.A + (size_t)nxt.pm * tstep + (size_t)nxt.k0 * 2 : cA; const char* nB = has_next ? (const char*)g.Bt + (size_t)nxt.pn * tstep + (size_t)nxt.k0 * 2 : cB;
        for (int t = 0; t < nt; t += 2) {
            const bool last = (t == nt - 2);
            const char* a1 = cA + (size_t)(t + 1) * kstep;
            const char* a2 = last ? nA : cA + (size_t)(t + 2) * kstep; const char* b2 = last ? nB : cB + (size_t)(t + 2) * kstep;
            const char* a3 = a2 + kstep; const char* b3 = b2 + kstep;
            if (last && has_next) S.a_ready(nxt);
            if constexpr (SP2) {
            PG8_LDB(B0, 0, 0); PG8_LDB(B1, 0, 1); PG8_SCHED; PG8_LDA(At, 0, 0); PG8_STAGE(PG8_SA(1, 1), a1 + hstep, voffA);
            PG8_WAIT_V(8); PG8_WAIT_L(0); PG8_BAR; PG8_MMA(0, 0, At, B0); PG8_MMA(0, 1, At, B1); PG8_BAR; PG8_SCHED;
            PG8_LDA(At, 0, 1); PG8_STAGE(PG8_SB(0, 0), b2, voffB); PG8_STAGE(PG8_SB(0, 1), b2 + hstep, voffB); PG8_STAGE(PG8_SA(0, 0), a2, voffA);
            PG8_WAIT_V(8); PG8_WAIT_L(0); PG8_BAR; PG8_MMA(1, 0, At, B0); PG8_MMA(1, 1, At, B1); PG8_BAR; PG8_SCHED;
            PG8_LDB(B0, 1, 0); PG8_LDB(B1, 1, 1); PG8_SCHED; PG8_LDA(At, 1, 0); PG8_STAGE(PG8_SA(0, 1), a2 + hstep, voffA);
            PG8_WAIT_V(8); PG8_WAIT_L(0); PG8_BAR; PG8_MMA(0, 0, At, B0); PG8_MMA(0, 1, At, B1); PG8_BAR; PG8_SCHED;
            PG8_LDA(At, 1, 1); PG8_STAGE(PG8_SB(1, 0), b3, voffB); PG8_STAGE(PG8_SB(1, 1), b3 + hstep, voffB); PG8_STAGE(PG8_SA(1, 0), a3, voffA);
            PG8_WAIT_V(8); PG8_WAIT_L(0); PG8_BAR; PG8_MMA(1, 0, At, B0); PG8_MMA(1, 1, At, B1); PG8_BAR; PG8_SCHED;
            } else {
            PG8_LDB(B0, 0, 0); PG8_SCHED; PG8_LDA(At, 0, 0); PG8_STAGE(PG8_SA(1, 1), a1 + hstep, voffA);
            PG8_WAIT_L(8); PG8_BAR; PG8_WAIT_L(0); PG8_MMA(0, 0, At, B0); PG8_BAR; PG8_SCHED;
            PG8_LDB(B1, 0, 1); PG8_STAGE(PG8_SB(0, 0), b2, voffB);
            PG8_BAR; PG8_WAIT_L(0); PG8_MMA(0, 1, At, B1); PG8_BAR;
            PG8_LDA(At, 0, 1); PG8_STAGE(PG8_SA(0, 0), a2, voffA);
            PG8_BAR; PG8_WAIT_L(0); PG8_MMA(1, 0, At, B0); PG8_BAR; PG8_SCHED;
            PG8_STAGE(PG8_SB(0, 1), b2 + hstep, voffB);
            PG8_WAIT_V(6); PG8_BAR; PG8_MMA(1, 1, At, B1); PG8_BAR;
            PG8_LDB(B0, 1, 0); PG8_SCHED; PG8_LDA(At, 1, 0); PG8_STAGE(PG8_SA(0, 1), a2 + hstep, voffA);
            PG8_WAIT_L(8); PG8_BAR; PG8_WAIT_L(0); PG8_MMA(0, 0, At, B0); PG8_BAR; PG8_SCHED;
            PG8_LDB(B1, 1, 1); PG8_STAGE(PG8_SB(1, 0), b3, voffB);
            PG8_BAR; PG8_WAIT_L(0); PG8_MMA(0, 1, At, B1); PG8_BAR;
            PG8_LDA(At, 1, 1); PG8_STAGE(PG8_SA(1, 0), a3, voffA);
            PG8_BAR; PG8_WAIT_L(0); PG8_MMA(1, 0, At, B0); PG8_BAR; PG8_SCHED;
            PG8_STAGE(PG8_SB(1, 1), b3 + hstep, voffB);
            PG8_WAIT_V(6); PG8_BAR; PG8_MMA(1, 1, At, B1); PG8_BAR;
            }
        }
        if constexpr (ALIGN_EPI) { if (wr == 0) PG8_BAR; }
        if constexpr (!Epi::AFTER_DRAIN) { E(acc, cur, wr, wc, fr, fq); S.done(cur); }
        if (!has_next) break;
#pragma unroll
        for (int a = 0; a < 2; ++a)
#pragma unroll
            for (int b = 0; b < 2; ++b)
#pragma unroll
                for (int m = 0; m < 4; ++m)
#pragma unroll
                    for (int n = 0; n < 2; ++n) acc[a][b][m][n] = (f32x4){0.f, 0.f, 0.f, 0.f};
        cur = nxt; cA = nA; cB = nB; ++ui;
        if constexpr (ALIGN_EPI) { if (wr == 1) PG8_BAR; }
    }
    PG8_WAIT_V(0);
    if constexpr (!ALIGN_EPI) { if (wr == 0) PG8_BAR; }
    PG8_BAR;
    if constexpr (Epi::AFTER_DRAIN) { E.fused(acc, cur, wr, wc, fr, fq, lds, wid, lane); S.done(cur); }
#undef PG8_SA
#undef PG8_SB
#undef PG8_STAGE
#undef PG8_LDA
#undef PG8_LDB
#undef PG8_MMA
#undef PG8_WAIT_V
#undef PG8_WAIT_L
#undef PG8_BAR
#undef PG8_SCHED
}
}

#ifndef PG8_SP2
#define PG8_SP2 true
#endif

#include <hip/hip_bf16.h>
#include <cmath>
namespace attn_body {
using bf16=__hip_bfloat16;
using bf16x8=__attribute__((ext_vector_type(8)))short;
using s16x4=__attribute__((ext_vector_type(4)))short;
using f32x16=__attribute__((ext_vector_type(16)))float;
using u32x4=__attribute__((ext_vector_type(4)))unsigned;
constexpr int BATCH=8,NHEAD=4,SEQ=2048,D=64,DM=2816,DMO=1024;
constexpr int NW=8,QBLK=32,QB=QBLK*NW,KVBLK=64,NQB=SEQ/QB;
constexpr int ATTN_PITCH=DM, ATTN_UNIT_ROWS=QB;
__device__ __forceinline__ int crow(int r,int hi){return (r&3)+8*(r>>2)+4*hi;}
#define SBAR() __builtin_amdgcn_sched_barrier(0)
__device__ __forceinline__ void cmask(f32x16&p0,f32x16&p1,int jb,int qrel,int hi){
  const float NEG=-INFINITY; int kb=64*jb+4*hi;
  #pragma unroll
  for(int r=0;r<16;++r){int kv=kb+(r&3)+8*(r>>2); if(kv>qrel)p0[r]=NEG; if(kv+32>qrel)p1[r]=NEG;}
}

constexpr int NSLOT=3, SLOTB=8192;
constexpr int LDS_K=0, LDS_V=NSLOT*SLOTB, LDS_WS=2*NSLOT*SLOTB, LDS_OST=LDS_WS+NW*64*4, LDS_KB=LDS_OST+NW*4096, LDS_BYTES=LDS_KB+SEQ*4;
constexpr float C2=0.125f*1.4426950408889634f;
__device__ __forceinline__ void glds16(const void*gsrc,unsigned lds_dst){unsigned keep;
  asm volatile("s_mov_b32 %0, m0\n\ts_mov_b32 m0, %2\n\ts_nop 0\n\tglobal_load_lds_dwordx4 %1, off\n\ts_mov_b32 m0, %0":"=&s"(keep):"v"(gsrc),"s"(lds_dst):"memory");}
__device__ __forceinline__ float max3f(float a,float b,float c){float r;asm("v_max3_f32 %0, %1, %2, %3":"=v"(r):"v"(a),"v"(b),"v"(c));return r;}
__device__ __forceinline__ float max2f(float a,float b){float r;asm("v_max_f32_e32 %0, %1, %2":"=v"(r):"v"(a),"v"(b));return r;}
__device__ __forceinline__ float fadd_s(float a,float b){float r;asm("v_add_f32_e32 %0, %1, %2":"=v"(r):"v"(a),"v"(b));return r;}
__device__ __forceinline__ float fsub_s(float a,float b){float r;asm("v_sub_f32_e32 %0, %1, %2":"=v"(r):"v"(a),"v"(b));return r;}
typedef float f32x2_t __attribute__((ext_vector_type(2))); typedef __bf16 bf16x2_t __attribute__((ext_vector_type(2)));
__device__ __forceinline__ unsigned cvtpk_s(float lo,float hi){f32x2_t v={lo,hi};bf16x2_t b=__builtin_convertvector(v,bf16x2_t);return __builtin_bit_cast(unsigned,b);}
#define WAIT_BAR(N) asm volatile("s_waitcnt vmcnt(" #N ") lgkmcnt(0)\n\ts_barrier":::"memory")

__device__ __forceinline__ void qkt(f32x16&p0,f32x16&p1,const char*Kslot,const bf16x8*qr,const f32x16&c0,const f32x16&c1,int r32,int hi){
  const char*kb=Kslot+hi*1024+r32*16;
  #pragma unroll
  for(int d0=0;d0<4;++d0){
    const bf16x8 b0=*reinterpret_cast<const bf16x8*>(kb+d0*2048);
    const bf16x8 b1=*reinterpret_cast<const bf16x8*>(kb+d0*2048+512);
    if(d0==0){p0=__builtin_amdgcn_mfma_f32_32x32x16_bf16(b0,qr[0],c0,0,0,0);p1=__builtin_amdgcn_mfma_f32_32x32x16_bf16(b1,qr[0],c1,0,0,0);}
    else{p0=__builtin_amdgcn_mfma_f32_32x32x16_bf16(b0,qr[d0],p0,0,0,0);p1=__builtin_amdgcn_mfma_f32_32x32x16_bf16(b1,qr[d0],p1,0,0,0);}}
}
typedef __attribute__((address_space(3))) const char* lds_cptr;
typedef short v4i16_t __attribute__((ext_vector_type(4)));
__device__ __forceinline__ void kload8(bf16x8*kf,lds_cptr kp){
  kf[0]=*(const __attribute__((address_space(3))) bf16x8*)(kp);      kf[1]=*(const __attribute__((address_space(3))) bf16x8*)(kp+512);
  kf[2]=*(const __attribute__((address_space(3))) bf16x8*)(kp+2048); kf[3]=*(const __attribute__((address_space(3))) bf16x8*)(kp+2560);
  kf[4]=*(const __attribute__((address_space(3))) bf16x8*)(kp+4096); kf[5]=*(const __attribute__((address_space(3))) bf16x8*)(kp+4608);
  kf[6]=*(const __attribute__((address_space(3))) bf16x8*)(kp+6144); kf[7]=*(const __attribute__((address_space(3))) bf16x8*)(kp+6656);
}
__device__ __forceinline__ void kload2(bf16x8*kf,lds_cptr kp,int j){ kf[2*j]=*(const __attribute__((address_space(3))) bf16x8*)(kp+j*2048); kf[2*j+1]=*(const __attribute__((address_space(3))) bf16x8*)(kp+j*2048+512); }
__device__ __forceinline__ s16x4 vtr(lds_cptr p){ return __builtin_bit_cast(s16x4,__builtin_amdgcn_ds_read_tr16_b64_v4i16((__attribute__((address_space(3))) v4i16_t*)p)); }
__device__ __forceinline__ float rowmax(const f32x16&p0,const f32x16&p1){
  float a=max3f(p0[0],p0[1],p1[0]),b=max3f(p0[2],p0[3],p1[1]);a=max3f(a,p1[2],p1[3]);
  #pragma unroll
  for(int r=4;r<16;r+=4){a=max3f(a,p0[r],p0[r+1]);b=max3f(b,p0[r+2],p0[r+3]);a=max3f(a,p1[r],p1[r+1]);b=max3f(b,p1[r+2],p1[r+3]);}
  const float m=max2f(a,b);
  auto rr=__builtin_amdgcn_permlane32_swap(__float_as_uint(m),__float_as_uint(m),false,false);
  return max2f(__uint_as_float(rr[0]),__uint_as_float(rr[1]));
}
__device__ __forceinline__ void pv(f32x16*o,int vb,bf16x8 pa0,bf16x8 pa1,bf16x8 pa2,bf16x8 pa3){
  #pragma unroll
  for(int d0=0;d0<2;++d0){s16x4 lo[4],hi[4];
    #pragma unroll
    for(int ks=0;ks<4;++ks){
      asm volatile("ds_read_b64_tr_b16 %0,%1 offset:%c2":"=&v"(lo[ks]):"v"(vb),"i"(d0*4096+ks*1024):"memory");
      asm volatile("ds_read_b64_tr_b16 %0,%1 offset:%c2":"=&v"(hi[ks]):"v"(vb),"i"(d0*4096+ks*1024+512):"memory");}
    asm volatile("s_waitcnt lgkmcnt(0)":::"memory");SBAR();
    #define PK(k) (bf16x8){lo[k][0],lo[k][1],lo[k][2],lo[k][3],hi[k][0],hi[k][1],hi[k][2],hi[k][3]}
    o[d0]=__builtin_amdgcn_mfma_f32_32x32x16_bf16(pa0,PK(0),o[d0],0,0,0);
    o[d0]=__builtin_amdgcn_mfma_f32_32x32x16_bf16(pa1,PK(1),o[d0],0,0,0);
    o[d0]=__builtin_amdgcn_mfma_f32_32x32x16_bf16(pa2,PK(2),o[d0],0,0,0);
    o[d0]=__builtin_amdgcn_mfma_f32_32x32x16_bf16(pa3,PK(3),o[d0],0,0,0);
    #undef PK
  }
}

#ifndef ATTN_STORE16
#define ATTN_STORE16(p,v) (*(u32x4*)(p)=(v))
#endif
template<int THRL> __device__ __forceinline__ void attn_unit(int b,int h,int qb,const bf16*Q,const bf16*__restrict__ K,const bf16*__restrict__ V,bf16*O,const float*__restrict__ KBg,char*shm){
  const int tid=ltid(),lane=tid&63,r32=lane&31,hi=lane>>5; const int wid=__builtin_amdgcn_readfirstlane(tid>>6);
  const long rowbase=(long)b*SEQ; const int q0=qb*QB;
  const bf16*Qw=Q+(rowbase+q0+wid*QBLK)*DM+h*D;
  const bf16*Kh=K+rowbase*DM+h*D,*Vh=V+rowbase*DM+h*D;
  const lds_cptr shm3=(lds_cptr)shm;
  const unsigned lds0=(unsigned)(uintptr_t)shm;
  float*wsf=(float*)(shm+LDS_WS)+wid*64;
  const bf16*ksrc=Kh+(long)lane*DM+wid*8;
  const bf16*vsrc=Vh+(long)(16*(wid&3)+(lane>>2))*DM+(wid>>2)*32+(lane&3)*8;
  const unsigned kdst=lds0+LDS_K+wid*1024, vdst=lds0+LDS_V+wid*1024;
  #define DMA_K(t,slot) glds16(ksrc+(long)(t)*KVBLK*DM,(unsigned)__builtin_amdgcn_readfirstlane(kdst+(slot)))
  #define DMA_V(t,slot) glds16(vsrc+(long)(t)*KVBLK*DM,(unsigned)__builtin_amdgcn_readfirstlane(vdst+(slot)))
  const int vb0=(int)(lds0+LDS_V)+((lane>>4)&1)*32+(lane&3)*8+(4*hi+((lane&15)>>2))*64;
  const char*Kbase=shm+LDS_K; bf16x8 kf[8];
  const lds_cptr kp0=shm3+LDS_K+hi*1024+r32*16; const lds_cptr vp0=shm3+LDS_V+((lane>>4)&1)*32+(lane&3)*8+(4*hi+((lane&15)>>2))*64;
  const int NT=(q0+QB)/KVBLK;
  { typedef float f32x4_t __attribute__((ext_vector_type(4))); const int i4=tid*4; if(i4<q0+QB){ const f32x4_t kv=*(const f32x4_t*)(KBg+((long)(b*NHEAD+h))*SEQ+i4); *(__attribute__((address_space(3))) f32x4_t*)((lds_cptr)shm+LDS_KB+i4*4)=kv; } }
  typedef float kb4_t __attribute__((ext_vector_type(4))); const __attribute__((address_space(3))) kb4_t* kbp=(const __attribute__((address_space(3))) kb4_t*)(shm3+LDS_KB)+hi;
  DMA_K(0,0);DMA_V(0,0);DMA_K(1,SLOTB);
  bf16x8 qr[4];
  #pragma unroll
  for(int d0=0;d0<4;++d0)qr[d0]=*reinterpret_cast<const bf16x8*>(&Qw[(long)r32*DM+d0*16+hi*8]);
  float mhat=0.f,l_reg=0.f;f32x16 o[2];o[0]=f32x16{};o[1]=f32x16{};float nm=0.f;asm volatile("":"+v"(nm));
  #define NBIAS(N0,N1,t) do{ _Pragma("unroll") for(int g_=0;g_<4;++g_){ const kb4_t a_=kbp[16*(t)+2*g_], b_=kbp[16*(t)+2*g_+8]; \
      _Pragma("unroll") for(int i_=0;i_<4;++i_){ N0[4*g_+i_]=a_[i_]+nm; N1[4*g_+i_]=b_[i_]+nm; } } }while(0)
  const int qrel=wid*QBLK+r32;
  #define CMASK(P0,P1,t) do{int jb_=(t)-(NT-4); if(jb_>=0)cmask(P0,P1,jb_,qrel,hi);}while(0)
  bool resc=false;
  #define START(P0,P1) do{ const float rm=rowmax(P0,P1); resc=false; \
    { const float dl=rm; mhat=fadd_s(mhat,dl); \
      _Pragma("unroll") for(int r=0;r<16;++r){P0[r]=fsub_s(P0[r],dl);P1[r]=fsub_s(P1[r],dl);} \
      nm=-mhat; asm volatile("":"+v"(nm)); } \
    _Pragma("unroll") for(int r=0;r<16;++r)P0[r]=__builtin_amdgcn_exp2f(P0[r]); }while(0)
  #define RESC() do{ if(resc){ asm volatile("s_waitcnt lgkmcnt(0)":::"memory"); \
      _Pragma("unroll") for(int d_=0;d_<2;++d_) _Pragma("unroll") for(int r=0;r<16;++r)o[d_][r]*=wsf[crow(r,hi)]; } }while(0)
  f32x16 pA0,pA1,pB0,pB1;
  int sl_prev=0,sl_cur=0,sl_next=SLOTB;
  #define ROT() do{sl_prev=sl_cur;sl_cur=sl_next;sl_next=(sl_next==(NSLOT-1)*SLOTB)?0:sl_next+SLOTB;}while(0)
  DMA_K(2,2*SLOTB);
  WAIT_BAR(3);
  { f32x16 c0_,c1_; NBIAS(c0_,c1_,0); qkt(pA0,pA1,Kbase,qr,c0_,c1_,r32,hi); } asm volatile("s_nop 15\n\ts_nop 7":"+v"(pA0),"+v"(pA1));CMASK(pA0,pA1,0);
  START(pA0,pA1);
  _Pragma("unroll") for(int r=0;r<16;++r)pA1[r]=__builtin_amdgcn_exp2f(pA1[r]);
  WAIT_BAR(0);
  DMA_K(3,0);DMA_V(1,SLOTB);
  ROT();
  kload8(kf,kp0+sl_cur);
  WAIT_BAR(2);
  s16x4 vlo[8],vhi[8]; u32x4 pw0,pw1,pw2,pw3;
  #define PKW(P,B) cvtpk_s(P[B],P[B+1])
  #define PAF(k) __builtin_bit_cast(bf16x8,pw##k)
  #define VFR(i) (bf16x8){vlo[i][0],vlo[i][1],vlo[i][2],vlo[i][3],vhi[i][0],vhi[i][1],vhi[i][2],vhi[i][3]}
  #define PIN(x) asm volatile("":"+v"(x))
  #define MX3(a,b,c) __builtin_fmaxf(__builtin_fmaxf((a),(b)),(c))
  #define GAPA(MF,A0,A1,A2,A3,W0,W1,PW) do{ MF; sacc+=A0; sacc+=A1; sacc+=A2; sacc+=A3; PIN(sacc); W0; W1; PIN(PW); SBAR(); }while(0)
  #define EX(v) __builtin_amdgcn_exp2f(v)
  #define GAPB(MF,X,B) do{ MF; X[B]=EX(X[B]); X[B+1]=EX(X[B+1]); X[B+2]=EX(X[B+2]); X[B+3]=EX(X[B+3]); PIN(X); SBAR(); }while(0)
  #define VRD(i) do{ vlo[i]=vtr(vp_+(((i)>>2)*4096+((i)&3)*1024)); vhi[i]=vtr(vp_+(((i)>>2)*4096+((i)&3)*1024+512)); }while(0)
  #define KRD(G,j) do{ if(G){ kload2(kf,kp0+sl_next,j); SBAR(); } }while(0)
  #define STEP(C0,C1,P0,P1,t,GK,GV,GL) do{ SBAR(); \
    const lds_cptr vp_=vp0+sl_prev; \
    NBIAS(C0,C1,t); SBAR(); \
    VRD(0); SBAR(); float sacc=(P0[0]+P0[1]); \
    GAPA(C0=__builtin_amdgcn_mfma_f32_32x32x16_bf16(kf[0],qr[0],C0,0,0,0), P0[2],P0[3],P0[4],P0[5],     pw0[0]=PKW(P0,0), pw0[1]=PKW(P0,2), pw0); \
    VRD(4); SBAR(); GAPA(C1=__builtin_amdgcn_mfma_f32_32x32x16_bf16(kf[1],qr[0],C1,0,0,0), P0[6],P0[7],P0[8],P0[9],     pw0[2]=PKW(P0,4), pw0[3]=PKW(P0,6), pw0); \
    VRD(1); SBAR(); GAPA(C0=__builtin_amdgcn_mfma_f32_32x32x16_bf16(kf[2],qr[1],C0,0,0,0),   P0[10],P0[11],P0[12],P0[13], pw1[0]=PKW(P0,8), pw1[1]=PKW(P0,10), pw1); \
    VRD(5); SBAR(); GAPA(C1=__builtin_amdgcn_mfma_f32_32x32x16_bf16(kf[3],qr[1],C1,0,0,0),   P0[14],P0[15],P1[0],P1[1],   pw1[2]=PKW(P0,12),pw1[3]=PKW(P0,14), pw1); \
    VRD(2); SBAR(); GAPA(C0=__builtin_amdgcn_mfma_f32_32x32x16_bf16(kf[4],qr[2],C0,0,0,0),   P1[2],P1[3],P1[4],P1[5],     pw2[0]=PKW(P1,0), pw2[1]=PKW(P1,2), pw2); \
    VRD(6); SBAR(); GAPA(C1=__builtin_amdgcn_mfma_f32_32x32x16_bf16(kf[5],qr[2],C1,0,0,0),   P1[6],P1[7],P1[8],P1[9],     pw2[2]=PKW(P1,4), pw2[3]=PKW(P1,6), pw2); \
    VRD(3); SBAR(); GAPA(C0=__builtin_amdgcn_mfma_f32_32x32x16_bf16(kf[6],qr[3],C0,0,0,0),   P1[10],P1[11],P1[12],P1[13], pw3[0]=PKW(P1,8), pw3[1]=PKW(P1,10), pw3); \
    VRD(7); SBAR(); GAPA(C1=__builtin_amdgcn_mfma_f32_32x32x16_bf16(kf[7],qr[3],C1,0,0,0),   P1[14],P1[15],0.f,0.f,       pw3[2]=PKW(P1,12),pw3[3]=PKW(P1,14), pw3); \
    l_reg+=sacc; \
    if(GK){DMA_K((t)+3,sl_cur);} if(GV){DMA_V((t)+1,sl_next);} \
    CMASK(C0,C1,t); \
    { float a=MX3(C0[0],C0[1],C1[0]),b=MX3(C0[2],C0[3],C1[1]); a=MX3(a,C1[2],C1[3]); \
      _Pragma("unroll") for(int r=4;r<16;r+=4){a=MX3(a,C0[r],C0[r+1]);b=MX3(b,C0[r+2],C0[r+3]);a=MX3(a,C1[r],C1[r+1]);b=MX3(b,C1[r+2],C1[r+3]);} \
      float rm=__builtin_fmaxf(a,b); { auto rr=__builtin_amdgcn_permlane32_swap(__float_as_uint(rm),__float_as_uint(rm),false,false); rm=__builtin_fmaxf(__uint_as_float(rr[0]),__uint_as_float(rr[1])); } \
      resc=false; \
      if(__builtin_expect(__any(rm>(float)THRL),0)){ const float dl=__builtin_fmaxf(rm,0.f); mhat+=dl; \
        _Pragma("unroll") for(int r=0;r<16;++r){C0[r]-=dl;C1[r]-=dl;} \
        nm=-mhat; asm volatile("":"+v"(nm)); \
        const float f=__builtin_amdgcn_exp2f(-dl); l_reg*=f; if(hi==0)wsf[r32]=f; resc=true; } } \
    SBAR(); \
    GAPB(o[0]=__builtin_amdgcn_mfma_f32_32x32x16_bf16(PAF(0),VFR(0),o[0],0,0,0), C0,0); \
    GAPB(o[1]=__builtin_amdgcn_mfma_f32_32x32x16_bf16(PAF(0),VFR(4),o[1],0,0,0), C0,4); \
    KRD(GL,0); GAPB(o[0]=__builtin_amdgcn_mfma_f32_32x32x16_bf16(PAF(1),VFR(1),o[0],0,0,0), C0,8); \
    KRD(GL,1); GAPB(o[1]=__builtin_amdgcn_mfma_f32_32x32x16_bf16(PAF(1),VFR(5),o[1],0,0,0), C0,12); \
    KRD(GL,2); GAPB(o[0]=__builtin_amdgcn_mfma_f32_32x32x16_bf16(PAF(2),VFR(2),o[0],0,0,0), C1,0); \
    KRD(GL,3); GAPB(o[1]=__builtin_amdgcn_mfma_f32_32x32x16_bf16(PAF(2),VFR(6),o[1],0,0,0), C1,4); \
    GAPB(o[0]=__builtin_amdgcn_mfma_f32_32x32x16_bf16(PAF(3),VFR(3),o[0],0,0,0), C1,8); \
    GAPB(o[1]=__builtin_amdgcn_mfma_f32_32x32x16_bf16(PAF(3),VFR(7),o[1],0,0,0), C1,12); \
    }while(0)
  int t=1;
  #undef CMASK
  #define CMASK(P0,P1,t) do{}while(0)
  for(;t+5<NT;t+=2){
    STEP(pB0,pB1,pA0,pA1,t,true,true,true);     WAIT_BAR(2); RESC(); ROT();
    STEP(pA0,pA1,pB0,pB1,t+1,true,true,true);   WAIT_BAR(2); RESC(); ROT();
  }
  #undef CMASK
  #define CMASK(P0,P1,t) do{int jb_=(t)-(NT-4); if(jb_>=0)cmask(P0,P1,jb_,qrel,hi);}while(0)
  #define ENDW(tt) do{ if((tt)+3<NT){WAIT_BAR(2);} else if((tt)+2<NT){WAIT_BAR(1);} else {WAIT_BAR(0);} }while(0)
  for(;t+1<NT;t+=2){
    STEP(pB0,pB1,pA0,pA1,t,(t+3<NT),(t+1<NT),(t+1<NT));       ENDW(t);   RESC(); ROT();
    STEP(pA0,pA1,pB0,pB1,t+1,(t+4<NT),(t+2<NT),(t+2<NT));     ENDW(t+1); RESC(); ROT();
  }
  STEP(pB0,pB1,pA0,pA1,NT-1,false,false,false); RESC();
  { float sacc=pB0[0]+pB0[1]; _Pragma("unroll") for(int r=2;r<16;++r)sacc+=pB0[r]; _Pragma("unroll") for(int r=0;r<16;++r)sacc+=pB1[r]; l_reg+=sacc;
    pw0=(u32x4){PKW(pB0,0),PKW(pB0,2),PKW(pB0,4),PKW(pB0,6)};pw1=(u32x4){PKW(pB0,8),PKW(pB0,10),PKW(pB0,12),PKW(pB0,14)};pw2=(u32x4){PKW(pB1,0),PKW(pB1,2),PKW(pB1,4),PKW(pB1,6)};pw3=(u32x4){PKW(pB1,8),PKW(pB1,10),PKW(pB1,12),PKW(pB1,14)};
    SBAR(); pv(o,vb0+sl_cur,PAF(0),PAF(1),PAF(2),PAF(3)); }
  #undef PKW
  #undef PAF
  #undef VFR
  #undef PIN
  #undef MX3
  #undef GAPA
  #undef GAPB
  #undef EX
  #undef VRD
  #undef KRD
  #undef STEP
  #undef ENDW
  {auto rr=__builtin_amdgcn_permlane32_swap(__float_as_uint(l_reg),__float_as_uint(l_reg),false,false);l_reg=__uint_as_float(rr[0])+__uint_as_float(rr[1]);}
  if(hi==0)wsf[32+r32]=l_reg;asm volatile("s_waitcnt lgkmcnt(0)":::"memory");
  float rli[16];
  #pragma unroll
  for(int r=0;r<16;++r)rli[r]=__builtin_amdgcn_rcpf(wsf[32+crow(r,hi)]);
  bf16*Ow=O+(rowbase+q0+wid*QBLK)*DMO+h*D;
  { bf16*stg=(bf16*)(shm+LDS_OST)+wid*2048;
    #pragma unroll
    for(int r=0;r<16;++r){const int orow=crow(r,hi);
      #pragma unroll
      for(int d0=0;d0<2;++d0)stg[orow*64+d0*32+r32]=__float2bfloat16(o[d0][r]*rli[r]);}
    asm volatile("s_waitcnt lgkmcnt(0)":::"memory");
    #pragma unroll
    for(int i=0;i<4;++i){const int row=i*8+(lane>>3),ch=lane&7; const u32x4 v=*(const u32x4*)(stg+row*64+ch*8); ATTN_STORE16(Ow+(long)row*DMO+ch*8,v);} }
  asm volatile("s_waitcnt lgkmcnt(0)\n\ts_barrier":::"memory");
  #undef NBIAS
  #undef DMA_K
  #undef DMA_V
  #undef CMASK
  #undef START
  #undef RESC
  #undef ROT
}
constexpr int ATTN_LDS_BYTES=LDS_BYTES;
struct AttnTensors { const bf16* Q; const bf16* K; const bf16* V; bf16* O; const float* KB; };
struct AttnUnit { int bh; int qb; };
struct StaticOrder {
  int vcu;
  __device__ __forceinline__ explicit StaticOrder(int grid,int block):vcu((block%8)*(grid/8)+block/8){}
  __device__ __forceinline__ bool next(int i,AttnUnit&u)const{ if(i>=4)return false; const int s=vcu&7; u.bh=vcu>>3; u.qb=(i==0)?s:(i==1)?15-s:(i==2)?16+s:31-s; return true; }
  __device__ __forceinline__ void a_ready(const AttnUnit&)const{}
  __device__ __forceinline__ void done(const AttnUnit&)const{}
};
template<class Sched,int THRL=8> __device__ __forceinline__ void attn_phase(char*lds,const AttnTensors&T,const Sched&S){
  AttnUnit u;
  for(int i=0;S.next(i,u);++i){ S.a_ready(u); attn_unit<THRL>(u.bh/NHEAD,u.bh%NHEAD,u.qb,T.Q,T.K,T.V,T.O,T.KB,lds); S.done(u); }
}
#undef SBAR
#undef WAIT_BAR
}

#define GAS __attribute__((address_space(1)))
#define LAS __attribute__((address_space(3)))
typedef unsigned short bf16;
typedef unsigned v4u __attribute__((ext_vector_type(4)));
typedef float f32x4 __attribute__((ext_vector_type(4)));
typedef short bf16x8 __attribute__((ext_vector_type(8)));
typedef GAS unsigned gu32;
typedef GAS unsigned long long gu64;
#define RLX_AGENT __ATOMIC_RELAXED, __HIP_MEMORY_SCOPE_AGENT
#define LDS_WAIT() asm volatile("s_waitcnt lgkmcnt(0)" ::: "memory")
#define VM_WAIT() asm volatile("s_waitcnt vmcnt(0)" ::: "memory")
__device__ __forceinline__ unsigned long long rt() { return __builtin_amdgcn_s_memrealtime(); }
__device__ __forceinline__ unsigned f2bf(float f) { unsigned u = __builtin_bit_cast(unsigned, f); return (u + 0x7fffu + ((u >> 16) & 1u)) >> 16; }
__device__ __forceinline__ unsigned pk2(float lo, float hi) { return f2bf(lo) | (f2bf(hi) << 16); }

#define XB_TMO      128
#define XB_XCNT(j)  (256  + 64 * (j))
#define XB_XSUB(j)  (1280 + 64 * (j))
#define XB_XGEN(j)  (2304 + 64 * (j))
#define XB_TOP      3328
#define XB_TOPGEN   3392
#define XCD_BAR_WORDS 3456
#define XB_SPIN_CAP (1u << 18)

__device__ __forceinline__ unsigned xb_ld(unsigned* p)              { return __hip_atomic_load(p, __ATOMIC_RELAXED, __HIP_MEMORY_SCOPE_AGENT); }
__device__ __forceinline__ unsigned xb_add(unsigned* p, unsigned v) { return __hip_atomic_fetch_add(p, v, __ATOMIC_RELAXED, __HIP_MEMORY_SCOPE_AGENT); }
__device__ __forceinline__ unsigned xb_xcc_id() { return (unsigned)__builtin_amdgcn_s_getreg((3 << 11) | 20) & 0xFu; }
#define XB_SPIN(cond, bar) do { unsigned _sp = 0; while (cond) { __builtin_amdgcn_s_sleep(1); \
    if ((++_sp & 255u) == 0u) { if (xb_ld(&(bar)[XB_TMO])) break; if (_sp > XB_SPIN_CAP) { atomicAdd(&(bar)[XB_TMO], 1u); break; } } } } while (0)

struct XcdBarrier {
    unsigned* bar; unsigned x;
    volatile LAS unsigned* st;
};

__device__ __forceinline__ XcdBarrier xcd_barrier_post(unsigned* bar, volatile LAS unsigned* st) {
    XcdBarrier b; b.bar = bar; b.x = xb_xcc_id(); b.st = st;
    if (ltid() == 0) (void)xb_add(&bar[XB_XCNT(b.x)], 1u);
    return b;
}
__device__ __forceinline__ void xcd_barrier_complete(unsigned* bar, unsigned x, unsigned& nloc, unsigned& nx) {
    const unsigned G = lgrid();
    unsigned sum, cnt, mine, sp = 0u;
    for (;;) {
        sum = 0u; cnt = 0u; mine = 0u;
#pragma unroll
        for (unsigned j = 0; j < 16; ++j) { const unsigned c = xb_ld(&bar[XB_XCNT(j)]); sum += c; cnt += (c > 0u) ? 1u : 0u; mine = (j == x) ? c : mine; }
        if (sum == G) break;
        __builtin_amdgcn_s_sleep(1);
        if ((++sp & 255u) == 0u) { if (xb_ld(&bar[XB_TMO])) break; if (sp > XB_SPIN_CAP) { atomicAdd(&bar[XB_TMO], 1u); break; } }
    }
    nloc = mine > 0u ? mine : 1u; nx = cnt > 0u ? cnt : 1u;
}

__device__ __forceinline__ void xcd_barrier(const XcdBarrier& b) {
    asm volatile("s_waitcnt vmcnt(0)" ::: "memory");
    __syncthreads();
    if (ltid() == 0) {
        unsigned* bar = b.bar;
        __builtin_amdgcn_s_waitcnt(0);
        unsigned nloc = b.st[0], nx = b.st[1];
        if (nloc == 0u) { xcd_barrier_complete(bar, b.x, nloc, nx); b.st[0] = nloc; b.st[1] = nx; }
        const unsigned old = xb_add(&bar[XB_XSUB(b.x)], 1u);
        const unsigned gen = old / nloc;
        if (old + 1u == (gen + 1u) * nloc) {
            __builtin_amdgcn_fence(__ATOMIC_RELEASE, "agent");
            asm volatile("s_waitcnt vmcnt(0)" ::: "memory");
            const unsigned og = xb_add(&bar[XB_TOP], 1u);
            const unsigned tg = og / nx;
            if (og + 1u == (tg + 1u) * nx) xb_add(&bar[XB_TOPGEN], 1u);
            else XB_SPIN(xb_ld(&bar[XB_TOPGEN]) == tg, bar);
            __builtin_amdgcn_fence(__ATOMIC_ACQUIRE, "agent");
            xb_add(&bar[XB_XGEN(b.x)], 1u);
            asm volatile("s_waitcnt vmcnt(0)" ::: "memory");
        } else {
            XB_SPIN(xb_ld(&bar[XB_XGEN(b.x)]) == gen, bar);
            __builtin_amdgcn_fence(__ATOMIC_ACQUIRE, "agent");
            asm volatile("s_waitcnt vmcnt(0)" ::: "memory");
        }
    }
    __syncthreads();
}

constexpr int NWAVES = 8;
#ifndef MK_REP_MASK
#define MK_REP_MASK 0
#endif
#ifndef MK_REP_CLASS
#define MK_REP_CLASS 0
#endif
#ifndef MK_SN
#define MK_SN 9
#endif
#ifndef MK_WGM_IN
#define MK_WGM_IN 2
#endif
#ifndef MK_WGM_UP
#define MK_WGM_UP 4
#endif
#ifndef MK_PER_PHASE
#define MK_PER_PHASE 0
#endif
namespace P {
constexpr int BATCH = 8, SEQ = 2048, DM = 1024, DEPTH = 2, DECB = 32, DECS = 4, PAST = 8192, PAGE = 128, NPAGES = 64, NPOOL = 2560;
constexpr int NH = 4, HD = 64, DG = 256, GDK = 32, GDV = 64, RANK = 16, DFF = 2688, CW = 31, DIN = 2580;
constexpr int MPR = BATCH * SEQ, MS = DECB * DECS, MREAL = MPR + MS, MP = 16640;
constexpr int NIN = 2816, NUP = 2 * DFF;
constexpr int HC_AQ = 0, HC_AK = 128, HC_AV = 256, HC_AG = 512, HC_BU = 768, HC_BV = 1024, HC_CQ = 1280, HC_CK = 1536, HC_CV = 1792, HC_D1 = 2048, HC_D2 = 2304, HC_LR = 2560, HC_CF = 2576;
constexpr float ALPHA = 1.4142135623730951f;
constexpr float EPS = 1e-5f, LOG2E = 1.4426950408889634f;
constexpr float QSCALE = 0.125f * 1.4426950408889634f;
constexpr size_t O_YP = 0, O_YS = O_YP + (size_t)MPR * DM, O_PFK = O_YS + (size_t)MS * DM, O_PFV = O_PFK + (size_t)DEPTH * MPR * 256, O_PFL = O_PFV + (size_t)DEPTH * MPR * 256,
    O_PGLA = O_PFL + (size_t)DEPTH * MPR * 4, O_PCONV = O_PGLA + (size_t)DEPTH * BATCH * NH * GDK * GDV, O_PFFN = O_PCONV + (size_t)DEPTH * BATCH * 30 * DG,
    O_SFK = O_PFFN + (size_t)DEPTH * BATCH * 2 * DFF, O_SFV = O_SFK + (size_t)DEPTH * MS * 256, O_SFL = O_SFV + (size_t)DEPTH * MS * 256, O_SGLA = O_SFL + (size_t)DEPTH * MS * 4,
    O_SCONV = O_SGLA + (size_t)DEPTH * DECB * NH * GDK * GDV, O_SFFN = O_SCONV + (size_t)DEPTH * DECB * 30 * DG, O_SSGU = O_SFFN + (size_t)DEPTH * DECB * 2 * DFF,
    O_END = O_SSGU + (size_t)DEPTH * MS * DG;
static_assert(O_END == 35714048, "output size");
enum { I_XP = 0, I_XS, I_CK, I_CV, I_CL, I_SGLA, I_SCONV, I_SFFN, I_PT, I_WIN, I_GWA, I_GBA, I_GNG, I_SLG, I_SLB, I_SW, I_SB, I_FBF, I_CVW, I_CVB, I_CNG, I_CNB, I_WO, I_L1G, I_L1B,
       I_WUP, I_FCW, I_FCB, I_WDN, I_L2G, I_L2B, N_IN };
constexpr size_t MiB = 1u << 20;
constexpr size_t WS_CTL = 0, CTL_ZERO_BYTES = 1 * MiB;
constexpr size_t WS_WIN = 2 * MiB, SZ_WIN = (size_t)NIN * DM * 2;
constexpr size_t WS_WO = WS_WIN + 2 * SZ_WIN, SZ_WO = (size_t)DM * DM * 2;
constexpr size_t WS_WUP = WS_WO + 2 * SZ_WO, SZ_WUP = (size_t)NUP * DM * 2;
constexpr size_t WS_WDN = WS_WUP + 2 * SZ_WUP, SZ_WDN = (size_t)DM * DFF * 2;
constexpr size_t WS_PS = WS_WDN + 2 * SZ_WDN;
constexpr size_t WS_LRF = WS_PS + 1 * MiB;
constexpr size_t WS_LOGF = WS_LRF + 3 * MiB;
constexpr size_t WS_KBIAS = WS_LOGF + 1 * MiB;
constexpr size_t WS_DELTA = WS_KBIAS + 1 * MiB;
constexpr size_t WS_GAMMA = WS_DELTA + 8 * MiB;
constexpr size_t WS_GBUF = WS_GAMMA + 1 * MiB;
constexpr size_t WS_PART = WS_GBUF + 8 * MiB;
constexpr size_t WS_ML = WS_PART + 8 * MiB;
constexpr size_t WS_PZ = WS_ML + 1 * MiB;
constexpr size_t WS_XF = WS_PZ + 4 * MiB, SZ_F32 = (size_t)MP * DM * 4, SZ_B16 = (size_t)MP * DM * 2;
constexpr size_t WS_XB = WS_XF + SZ_F32;
constexpr size_t WS_H = WS_XB + SZ_B16;
constexpr size_t WS_Y = WS_H + (size_t)MP * NIN * 2;
constexpr size_t WS_Z = WS_Y + SZ_B16;
constexpr size_t WS_X1F = WS_Z + SZ_F32;
constexpr size_t WS_X1B = WS_X1F + SZ_F32;
constexpr size_t WS_G = WS_X1B + SZ_B16;
constexpr size_t WS_HALO = WS_G;
constexpr size_t WS_FG = WS_HALO + 2 * MiB, WS_FV = WS_FG + 2 * MiB;
constexpr size_t WS_ACT = WS_FV + 2 * MiB;
constexpr size_t WS_END = WS_ACT + (size_t)MP * DFF * 2;
static_assert(WS_PS % 256 == 0 && WS_XF % 256 == 0 && WS_H % 256 == 0 && WS_G % 256 == 0 && WS_ACT % 256 == 0, "alignment");
constexpr int CW_BAR = 4096;
constexpr int CW_Q = 16384;
constexpr int PH_PER_LAYER = 8, N_PHASES = 1 + DEPTH * PH_PER_LAYER;
constexpr int RING_BYTES = 131072, MISC_OFF = RING_BYTES + 320, HALO_OFF = RING_BYTES + 2048  , LDS_BYTES = 147456;
}

struct Args { const float* p[P::N_IN + 2]; int ph_lo, ph_hi, qoff, pad; };
#define AIN(k) (A.p[(k) + z])
#define AOUT ((float*)A.p[P::N_IN + z])
#define AWS ((unsigned char*)A.p[P::N_IN + 1 + z])
#define OPAQUE_ZERO() ({ int z_ = 0; asm volatile("" : "+s"(z_)); z_; })
static_assert(sizeof(Args) == (P::N_IN + 2) * 8 + 16, "Args has no padding");

struct Frame {
    LAS unsigned char* lds; volatile LAS unsigned* MISC; gu32* ctl; int tid, lane, wave, vcu, G;
};

__device__ __forceinline__ float bflo(unsigned u) { return __uint_as_float(u << 16); }
__device__ __forceinline__ float bfhi(unsigned u) { return __uint_as_float(u & 0xffff0000u); }
__device__ __forceinline__ float bf1(bf16 v) { return __uint_as_float((unsigned)v << 16); }
__device__ __forceinline__ void unpack8(const v4u w, float (&f)[8]) { f[0] = bflo(w.x); f[1] = bfhi(w.x); f[2] = bflo(w.y); f[3] = bfhi(w.y); f[4] = bflo(w.z); f[5] = bfhi(w.z); f[6] = bflo(w.w); f[7] = bfhi(w.w); }
__device__ __forceinline__ v4u pack8(const float (&f)[8]) { v4u w; w.x = pk2(f[0], f[1]); w.y = pk2(f[2], f[3]); w.z = pk2(f[4], f[5]); w.w = pk2(f[6], f[7]); return w; }
__device__ __forceinline__ float logsig(float x) { return fminf(x, 0.f) - log1pf(expf(-fabsf(x))); }
__device__ __forceinline__ float sigm(float x) { return 1.f / (1.f + expf(-x)); }
__device__ __forceinline__ float silu(float x) { return x / (1.f + expf(-x)); }
#define DPP_F(v, ctrl) __builtin_bit_cast(float, __builtin_amdgcn_mov_dpp(__builtin_bit_cast(int, (v)), (ctrl), 0xF, 0xF, true))
__device__ __forceinline__ float sum4(float v) { v += DPP_F(v, 0xB1); v += DPP_F(v, 0x4E); return v; }
__device__ __forceinline__ float sum8(float v) { v = sum4(v); v += DPP_F(v, 0x141); return v; }
__device__ __forceinline__ float sum16(float v) { v = sum8(v); v += DPP_F(v, 0x140); return v; }
__device__ __forceinline__ float wave_sum(float v) { v = sum16(v);
    return (__builtin_bit_cast(float, __builtin_amdgcn_readlane(__builtin_bit_cast(int, v), 0)) + __builtin_bit_cast(float, __builtin_amdgcn_readlane(__builtin_bit_cast(int, v), 16)))
         + (__builtin_bit_cast(float, __builtin_amdgcn_readlane(__builtin_bit_cast(int, v), 32)) + __builtin_bit_cast(float, __builtin_amdgcn_readlane(__builtin_bit_cast(int, v), 48))); }
#define LBAR() do { asm volatile("s_waitcnt lgkmcnt(0)" ::: "memory"); __builtin_amdgcn_s_barrier(); asm volatile("" ::: "memory"); } while (0)
struct TeamBar { volatile LAS unsigned* ctr; unsigned ep; unsigned nw; };
__device__ __forceinline__ void tbar(TeamBar& tb, int lane) {
    asm volatile("s_waitcnt lgkmcnt(0)" ::: "memory");
    tb.ep += tb.nw;
    if (lane == 0) (void)__hip_atomic_fetch_add((LAS unsigned*)tb.ctr, 1u, __ATOMIC_RELAXED, __HIP_MEMORY_SCOPE_WORKGROUP);
    while ((int)(*tb.ctr - tb.ep) < 0) __builtin_amdgcn_s_sleep(0);
    asm volatile("" ::: "memory");
}
#define IBAR() do { if constexpr (TEAM) tbar(tb, F.lane); else LBAR(); } while (0)
__device__ __forceinline__ int q_next(Frame& F, gu32* head) {
    __syncthreads();
    if (F.tid == 0) F.MISC[0] = __hip_atomic_fetch_add(head, 1u, RLX_AGENT);
    __syncthreads();
    return (int)F.MISC[0];
}

__device__ __forceinline__ int win_src(int n) {
    if (n < 768) return n;
    if (n < 2048) return n + 16;
    if (n < 2560) return n + 20;
    if (n < 2576) return n - 1792;
    if (n < 2580) return n - 512;
    return -1;
}
template <int MODE>
__device__ __forceinline__ void p0_transpose_item(const float* W, int K, int N, int NT, bf16* WT, LAS float* scr, int item, int lane) {
    const int nblk = NT / 32, kb = item / nblk, nb = item % nblk, k0 = 64 * kb, n0 = 32 * nb;
    const int ncol = n0 + (lane & 31); const int src = MODE == 1 ? win_src(ncol) : (MODE == 2 ? ((ncol & 255) < 128 ? (ncol >> 8) * 128 + (ncol & 127) : P::DFF + (ncol >> 8) * 128 + (ncol & 127)) : ncol);
    float wv[32];
#pragma unroll
    for (int i = 0; i < 32; ++i) { const int kk = 2 * i + (lane >> 5); wv[i] = src >= 0 ? __builtin_nontemporal_load(W + (size_t)(k0 + kk) * N + src) : 0.f; }
#pragma unroll
    for (int i = 0; i < 32; ++i) { const int kk = 2 * i + (lane >> 5); scr[kk * 33 + (lane & 31)] = wv[i]; }
    LDS_WAIT(); asm volatile("" ::: "memory");
    const int c = lane & 7;
#pragma unroll
    for (int j = 0; j < 4; ++j) { const int n = (lane >> 3) + 8 * j; const LAS float* s = scr + (8 * c) * 33 + n;
        v4u o; o.x = pk2(s[0 * 33], s[1 * 33]); o.y = pk2(s[2 * 33], s[3 * 33]); o.z = pk2(s[4 * 33], s[5 * 33]); o.w = pk2(s[6 * 33], s[7 * 33]);
        *(GAS v4u*)(WT + (size_t)(n0 + n) * K + k0 + 8 * c) = o; }
    LDS_WAIT(); asm volatile("" ::: "memory");
}
namespace WC { using namespace P; constexpr int I_IN = (DM / 64) * (NIN / 32), I_O = (DM / 64) * (DM / 32), I_UP = (DM / 64) * (NUP / 32), I_DN = (DFF / 64) * (DM / 32), I_LAYER = I_IN + I_O + I_UP + I_DN, I_ALL = DEPTH * I_LAYER; }
__device__ __forceinline__ void wconv_wave_item(const Args& A, const int z, Frame& F, int it) {
    using namespace P; using namespace WC;
    LAS float* scr = (LAS float*)(F.lds + F.wave * 16384);
    int lane_ = F.lane; asm volatile("" : "+v"(lane_));
    const int l = it / I_LAYER; int r = it % I_LAYER;
    if (r < I_IN) { p0_transpose_item<1>(AIN(I_WIN) + (size_t)l * DM * DIN, DM, DIN, NIN, (bf16*)(AWS + WS_WIN + l * SZ_WIN), scr, r, lane_); return; } r -= I_IN;
    if (r < I_O) { p0_transpose_item<0>(AIN(I_WO) + (size_t)l * DM * DM, DM, DM, DM, (bf16*)(AWS + WS_WO + l * SZ_WO), scr, r, lane_); return; } r -= I_O;
    if (r < I_UP) { p0_transpose_item<2>(AIN(I_WUP) + (size_t)l * DM * NUP, DM, NUP, NUP, (bf16*)(AWS + WS_WUP + l * SZ_WUP), scr, r, lane_); return; } r -= I_UP;
    p0_transpose_item<0>(AIN(I_WDN) + (size_t)l * DFF * DM, DFF, DM, DM, (bf16*)(AWS + WS_WDN + l * SZ_WDN), scr, r, lane_);
}
__device__ __forceinline__ void p0_prologue(const Args& A, const int z, Frame& F) {
    using namespace P;
    const int gw = F.vcu * NWAVES + F.wave, NGW = F.G * NWAVES;
    for (int it = gw; it < WC::I_IN; it += NGW) wconv_wave_item(A, z, F, it);
    bf16* XB = (bf16*)(AWS + WS_XB);
    for (int m = gw; m < MP; m += NGW) {
        const float* src = m < MPR ? AIN(I_XP) + (size_t)m * DM : (m < MREAL ? AIN(I_XS) + (size_t)(m - MPR) * DM : nullptr);
#pragma unroll
        for (int j = 0; j < 4; ++j) { const int c = 4 * F.lane + 256 * j; f32x4 v = src ? __builtin_nontemporal_load((const GAS f32x4*)(src + c)) : (f32x4){0.f, 0.f, 0.f, 0.f};
            *(GAS unsigned long long*)(XB + (size_t)m * DM + c) = (unsigned long long)pk2(v.x, v.y) | ((unsigned long long)pk2(v.z, v.w) << 32); }
    }
    float* PS = (float*)(AWS + WS_PS); const int* pt = (const int*)AIN(I_PT);
    for (int it = gw; it < DEPTH * DECB * NPAGES; it += NGW) {
        const int l = it / (DECB * NPAGES), bp = it % (DECB * NPAGES); const int page = pt[bp];
        const float* Lp = AIN(I_CL) + ((size_t)(l * NPOOL + page) * PAGE) * 4;
        f32x4 a = *(const GAS f32x4*)(Lp + 4 * F.lane), b = *(const GAS f32x4*)(Lp + 4 * (F.lane + 64)); a = a + b;
        a.x = wave_sum(a.x); a.y = wave_sum(a.y); a.z = wave_sum(a.z); a.w = wave_sum(a.w);
        if (F.lane == 0) *(GAS f32x4*)(PS + (size_t)it * 4) = a;
    }
}

namespace GL {
constexpr int G = 0, T = G + 64 * 33, WA = T + 256, BA = WA + 512, LR = BA + 32, QT = LR + 64 * 16  , KT = QT + 64 * 33, VV = KT + 32 * 68, SS = VV + 64 * 64, AT = SS + 32 * 64, END = AT + 64 * 68;
static_assert(END * 4 <= P::RING_BYTES && LR % 4 == 0 && QT % 4 == 0 && KT % 4 == 0 && VV % 4 == 0 && SS % 4 == 0, "GLA LDS");
}
template <int NI>
__device__ __forceinline__ void gla_local_items(const Args& A, const int z, Frame& F, int l, int item0) {
    using namespace P;
    LAS float* L = (LAS float*)F.lds; const bf16* H = (const bf16*)(AWS + WS_H);
    const int bh = item0 >> 5, b = bh >> 2, h = bh & 3;
    const int s = F.tid >> 3, d4 = (F.tid & 7) * 4, e8 = (F.tid & 7) * 8;
    const float wa = AIN(I_GWA)[(size_t)l * RANK * 128 + (F.tid >> 5) * 128 + 32 * h + (F.tid & 31)];
    const float ba = AIN(I_GBA)[l * 128 + 32 * h + (F.tid & 31)];
    unsigned long long kw[NI]; v4u vw[NI]; f32x4 lr4[NI];
#pragma unroll
    for (int q = 0; q < NI; ++q) { const int m0 = b * SEQ + 64 * ((item0 + q) & 31);
        kw[q] = *(const GAS unsigned long long*)(H + (size_t)(m0 + s) * NIN + HC_AK + 32 * h + d4); vw[q] = *(const GAS v4u*)(H + (size_t)(m0 + s) * NIN + HC_AV + 64 * h + e8);
        lr4[q] = (f32x4){0.f, 0.f, 0.f, 0.f}; if (F.tid < 256) lr4[q] = *(const GAS f32x4*)((const float*)(AWS + WS_LRF) + (size_t)(m0 + (F.tid >> 2)) * 32 + 4 * (F.tid & 3)); }
    L[GL::WA + F.tid] = wa; if (F.tid < 32) L[GL::BA + F.tid] = ba;
#pragma unroll
    for (int q = 0; q < NI; ++q) { const int item = item0 + q;
    if (q) LBAR();
    if (F.tid < 256) *(LAS f32x4*)(L + GL::LR + (F.tid >> 2) * 16 + 4 * (F.tid & 3)) = lr4[q];
    { LAS unsigned char* VT = (LAS unsigned char*)(L + GL::VV); const unsigned vv[4] = {vw[q].x, vw[q].y, vw[q].z, vw[q].w};
#pragma unroll
      for (int i = 0; i < 4; ++i) { *(LAS bf16*)(VT + (e8 + 2 * i) * 144 + 2 * s) = (bf16)(vv[i] & 0xffffu); *(LAS bf16*)(VT + (e8 + 2 * i + 1) * 144 + 2 * s) = (bf16)(vv[i] >> 16); } }
    LBAR();
    float loc[8]; const int d = F.tid & 31, seg = (F.tid >> 5) & 7;
    if (F.tid < 256) {
        float run = 0.f;
#pragma unroll
        for (int i = 0; i < 8; ++i) { const LAS float* lr = L + GL::LR + (8 * seg + i) * 16; float sacc = L[GL::BA + d];
#pragma unroll
            for (int r = 0; r < 16; ++r) sacc += lr[r] * L[GL::WA + r * 32 + d];
            run += logsig(sacc) * (1.f / 16.f); loc[i] = run; }
        L[GL::T + seg * 32 + d] = run;
    }
    LBAR();
    if (F.tid < 256) {
        float off = 0.f;
        for (int p = 0; p < seg; ++p) off += L[GL::T + p * 32 + d];
#pragma unroll
        for (int i = 0; i < 8; ++i) L[GL::G + (8 * seg + i) * 33 + d] = off + loc[i];
    }
    LBAR();
    { const unsigned lo = (unsigned)kw[q], hi = (unsigned)(kw[q] >> 32); const float kv[4] = {bflo(lo), bfhi(lo), bflo(hi), bfhi(hi)}; f32x4 g4;
#pragma unroll
      for (int i = 0; i < 4; ++i) { const float g = L[GL::G + s * 33 + d4 + i]; g4[i] = g; *(LAS bf16*)((LAS unsigned char*)(L + GL::QT) + (d4 + i) * 144 + 2 * s) = (bf16)f2bf(kv[i] * expf(L[GL::G + 63 * 33 + d4 + i] - g)); }
      *(GAS f32x4*)((float*)(AWS + WS_GBUF) + (size_t)item * 2048 + s * 32 + d4) = g4; }
    LBAR();
    { typedef short s8v __attribute__((ext_vector_type(8)));
      const LAS unsigned char* KT = (const LAS unsigned char*)(L + GL::QT); const LAS unsigned char* VT = (const LAS unsigned char*)(L + GL::VV);
      const int fi = F.lane & 15, kq = F.lane >> 4, d0 = 16 * (F.wave & 1), e0 = 16 * (F.wave >> 1); f32x4 acc = {0.f, 0.f, 0.f, 0.f};
#pragma unroll
      for (int ks = 0; ks < 2; ++ks) { const s8v af = *(const LAS s8v*)(KT + (d0 + fi) * 144 + 64 * ks + 16 * kq), bfr = *(const LAS s8v*)(VT + (e0 + fi) * 144 + 64 * ks + 16 * kq);
          acc = __builtin_amdgcn_mfma_f32_16x16x32_bf16(af, bfr, acc, 0, 0, 0); }
      float* DLo = (float*)(AWS + WS_DELTA) + (size_t)item * 2048;
#pragma unroll
      for (int r = 0; r < 4; ++r) DLo[(d0 + 4 * kq + r) * 64 + e0 + fi] = acc[r]; }
    if (F.tid < 32) ((float*)(AWS + WS_GAMMA))[(size_t)item * 32 + F.tid] = expf(L[GL::G + 63 * 33 + F.tid]);
    }
}
namespace GO {
constexpr int QB = 0, QP = 80, KB = QB + 64 * QP, PB = KB + 64 * QP, PP = 144, VT = PB + 64 * PP, ST = VT + 64 * PP, AG = ST + 64 * QP, AP = 144, SSQ = AG + 64 * AP, END = SSQ + 64 * 8;
static_assert(END <= P::RING_BYTES, "GLA out LDS");
}
__device__ __forceinline__ void gla_out_item(const Args& A, const int z, Frame& F, int l, int item) {
    using namespace P;
    typedef short s8v __attribute__((ext_vector_type(8)));
    LAS unsigned char* L = F.lds; const bf16* H = (const bf16*)(AWS + WS_H); bf16* Y = (bf16*)(AWS + WS_Y);
    const int bh = item >> 5, c = item & 31, b = bh >> 2, h = bh & 3, m0 = b * SEQ + 64 * c;
    const int s = F.tid >> 3, d4 = (F.tid & 7) * 4, e8 = (F.tid & 7) * 8, d = F.tid >> 4, e4 = (F.tid & 15) * 4;
    const f32x4 g4 = *(const GAS f32x4*)((const float*)(AWS + WS_GBUF) + (size_t)item * 2048 + s * 32 + d4);
    const unsigned long long wq = *(const GAS unsigned long long*)(H + (size_t)(m0 + s) * NIN + HC_AQ + 32 * h + d4);
    const unsigned long long wk = *(const GAS unsigned long long*)(H + (size_t)(m0 + s) * NIN + HC_AK + 32 * h + d4);
    const v4u vw = *(const GAS v4u*)(H + (size_t)(m0 + s) * NIN + HC_AV + 64 * h + e8);
    const v4u gw = *(const GAS v4u*)(H + (size_t)(m0 + s) * NIN + HC_AG + 64 * h + e8);
    const float* DL = (const float*)(AWS + WS_DELTA) + (size_t)(bh * 32) * 2048 + d * 64 + e4; const float* GM = (const float*)(AWS + WS_GAMMA) + (size_t)(bh * 32) * 32 + d;
    f32x4 S = {0.f, 0.f, 0.f, 0.f};
    for (int j0 = 0; j0 < c; j0 += 16) { float gm[16]; f32x4 dl[16];
#pragma unroll
        for (int j = 0; j < 16; ++j) { gm[j] = GM[(j0 + j) * 32]; dl[j] = *(const GAS f32x4*)(DL + (size_t)(j0 + j) * 2048); }
#pragma unroll
        for (int j = 0; j < 16; ++j) if (j0 + j < c) S = S * gm[j] + dl[j]; }
    if (c == 31) { const float gm = GM[31 * 32]; const f32x4 dl = *(const GAS f32x4*)(DL + (size_t)31 * 2048); const f32x4 Sf = S * gm + dl;
        *(GAS f32x4*)(AOUT + O_PGLA + ((size_t)(l * BATCH + b) * NH + h) * 2048 + d * 64 + e4) = Sf; }
#pragma unroll
    for (int i = 0; i < 4; ++i) *(LAS bf16*)(L + GO::ST + (e4 + i) * GO::QP + 2 * d) = (bf16)f2bf(S[i]);
    { const float qv[4] = {bflo((unsigned)wq), bfhi((unsigned)wq), bflo((unsigned)(wq >> 32)), bfhi((unsigned)(wq >> 32))};
      const float kv[4] = {bflo((unsigned)wk), bfhi((unsigned)wk), bflo((unsigned)(wk >> 32)), bfhi((unsigned)(wk >> 32))};
      float qt[4], kt[4];
#pragma unroll
      for (int i = 0; i < 4; ++i) { qt[i] = qv[i] * 0.17677669529663687f * expf(g4[i]); kt[i] = kv[i] * expf(-g4[i]); }
      *(LAS unsigned long long*)(L + GO::QB + s * GO::QP + 2 * d4) = (unsigned long long)pk2(qt[0], qt[1]) | ((unsigned long long)pk2(qt[2], qt[3]) << 32);
      *(LAS unsigned long long*)(L + GO::KB + s * GO::QP + 2 * d4) = (unsigned long long)pk2(kt[0], kt[1]) | ((unsigned long long)pk2(kt[2], kt[3]) << 32);
      const unsigned vv[4] = {vw.x, vw.y, vw.z, vw.w};
#pragma unroll
      for (int i = 0; i < 4; ++i) { *(LAS bf16*)(L + GO::VT + (e8 + 2 * i) * GO::PP + 2 * s) = (bf16)(vv[i] & 0xffffu); *(LAS bf16*)(L + GO::VT + (e8 + 2 * i + 1) * GO::PP + 2 * s) = (bf16)(vv[i] >> 16); }
      *(LAS v4u*)(L + GO::AG + s * GO::AP + 2 * e8) = gw; }
    LBAR();
    const int fi = F.lane & 15, kq = F.lane >> 4;
    { const int t0 = 16 * (F.wave >> 1); const s8v af = *(const LAS s8v*)(L + GO::QB + (t0 + fi) * GO::QP + 16 * kq);
#pragma unroll
      for (int k = 0; k < 2; ++k) { const int s0 = 16 * (2 * (F.wave & 1) + k); const s8v bfr = *(const LAS s8v*)(L + GO::KB + (s0 + fi) * GO::QP + 16 * kq);
          f32x4 acc = {0.f, 0.f, 0.f, 0.f}; acc = __builtin_amdgcn_mfma_f32_16x16x32_bf16(af, bfr, acc, 0, 0, 0);
#pragma unroll
          for (int r = 0; r < 4; ++r) { const int t = t0 + 4 * kq + r, sc = s0 + fi; *(LAS bf16*)(L + GO::PB + t * GO::PP + 2 * sc) = (bf16)f2bf(sc <= t ? acc[r] : 0.f); } } }
    LBAR();
    { const int t0 = 16 * (F.wave & 3), eb = 32 * (F.wave >> 2);
      const s8v a0 = *(const LAS s8v*)(L + GO::PB + (t0 + fi) * GO::PP + 16 * kq), a1 = *(const LAS s8v*)(L + GO::PB + (t0 + fi) * GO::PP + 64 + 16 * kq), a2 = *(const LAS s8v*)(L + GO::QB + (t0 + fi) * GO::QP + 16 * kq);
      f32x4 o[2]; float ssq[4] = {0.f, 0.f, 0.f, 0.f};
#pragma unroll
      for (int k = 0; k < 2; ++k) { const int e0 = eb + 16 * k;
          const s8v b0 = *(const LAS s8v*)(L + GO::VT + (e0 + fi) * GO::PP + 16 * kq), b1 = *(const LAS s8v*)(L + GO::VT + (e0 + fi) * GO::PP + 64 + 16 * kq), b2 = *(const LAS s8v*)(L + GO::ST + (e0 + fi) * GO::QP + 16 * kq);
          f32x4 acc = {0.f, 0.f, 0.f, 0.f};
          acc = __builtin_amdgcn_mfma_f32_16x16x32_bf16(a0, b0, acc, 0, 0, 0); acc = __builtin_amdgcn_mfma_f32_16x16x32_bf16(a1, b1, acc, 0, 0, 0); acc = __builtin_amdgcn_mfma_f32_16x16x32_bf16(a2, b2, acc, 0, 0, 0);
          o[k] = acc;
#pragma unroll
          for (int r = 0; r < 4; ++r) ssq[r] += acc[r] * acc[r]; }
#pragma unroll
      for (int r = 0; r < 4; ++r) { ssq[r] = sum16(ssq[r]); if (fi == 0) *(LAS float*)(L + GO::SSQ + ((t0 + 4 * kq + r) * 2 + (F.wave >> 2)) * 4) = ssq[r]; }
      LBAR();
#pragma unroll
      for (int r = 0; r < 4; ++r) { const int t = t0 + 4 * kq + r; const float tot = *(const LAS float*)(L + GO::SSQ + (t * 2) * 4) + *(const LAS float*)(L + GO::SSQ + (t * 2 + 1) * 4);
          const float rn = 1.f / sqrtf(tot * (1.f / 64.f) + EPS);
#pragma unroll
          for (int k = 0; k < 2; ++k) { const int e = eb + 16 * k + fi; const float ag = bf1(*(const LAS bf16*)(L + GO::AG + t * GO::AP + 2 * e));
              Y[(size_t)(m0 + t) * DM + 64 * h + e] = (bf16)f2bf(o[k][r] * rn * AIN(I_GNG)[l * 256 + 64 * h + e] * silu(ag)); } } }
}

__device__ __forceinline__ void fox_cumsum_wave(const Args& A, const int z, Frame& F, int l, int b) {
    using namespace P;
    const float* LG = (const float*)(AWS + WS_LOGF) + ((size_t)b * SEQ + 32 * F.lane) * 4; float* KB = (float*)(AWS + WS_KBIAS);
    f32x4 lf[32]; f32x4 run = {0.f, 0.f, 0.f, 0.f};
#pragma unroll
    for (int i = 0; i < 32; ++i) lf[i] = *(const GAS f32x4*)(LG + 4 * i);
#pragma unroll
    for (int i = 0; i < 32; ++i) { run = run + lf[i]; lf[i] = run; }
    f32x4 off;
#pragma unroll
    for (int c = 0; c < 4; ++c) { float incl = run[c];
        incl += DPP_F(incl, 0x111); incl += DPP_F(incl, 0x112); incl += DPP_F(incl, 0x114); incl += DPP_F(incl, 0x118);
        const float t0 = __builtin_bit_cast(float, __builtin_amdgcn_readlane(__builtin_bit_cast(int, incl), 15)), t1 = __builtin_bit_cast(float, __builtin_amdgcn_readlane(__builtin_bit_cast(int, incl), 31)), t2 = __builtin_bit_cast(float, __builtin_amdgcn_readlane(__builtin_bit_cast(int, incl), 47));
        incl += (F.lane >= 16 ? t0 : 0.f) + (F.lane >= 32 ? t1 : 0.f) + (F.lane >= 48 ? t2 : 0.f);
        off[c] = incl - run[c]; }
#pragma unroll
    for (int c = 0; c < 4; ++c) { float* kb = KB + ((size_t)(b * NH + c)) * SEQ + 32 * F.lane;
#pragma unroll
        for (int i = 0; i < 32; i += 4) *(GAS f32x4*)(kb + i) = (f32x4){-(off[c] + lf[i][c]) * LOG2E, -(off[c] + lf[i + 1][c]) * LOG2E, -(off[c] + lf[i + 2][c]) * LOG2E, -(off[c] + lf[i + 3][c]) * LOG2E}; }
}

template <bool TEAM>
__device__ __forceinline__ void conv_item(const Args& A, const int z, Frame& F, int l, int item, TeamBar& tb) {
    using namespace P;
    constexpr int NT = TEAM ? 256 : 512, R = 512 / NT;
    LAS float* GLU = (LAS float*)F.lds;
    const bf16* H = (const bf16*)(AWS + WS_H); bf16* Y = (bf16*)(AWS + WS_Y);
    const int b = item >> 6, t0 = (item & 63) * 32;
    v4u d1w[4 * R], d2w[4 * R];
#pragma unroll
    for (int j = 0; j < 4 * R; ++j) { int idx = F.tid + NT * j; idx = idx < 62 * 32 ? idx : 62 * 32 - 1; const int rr = idx >> 5, c8 = (idx & 31) * 8; int t = t0 - 30 + rr; t = t < 0 ? 0 : t;
        const size_t m = (size_t)b * SEQ + t; d1w[j] = *(const GAS v4u*)(H + m * NIN + HC_D1 + c8); d2w[j] = *(const GAS v4u*)(H + m * NIN + HC_D2 + c8); }
    const int c = F.tid & 255, half = F.tid >> 8; float w[31]; const float* cw = AIN(I_CVW) + (size_t)l * CW * DG + c;
#pragma unroll
    for (int j = 0; j < 31; ++j) w[j] = cw[j * DG];
    const float cb = AIN(I_CVB)[l * DG + c], ng = AIN(I_CNG)[l * DG + c], nb = AIN(I_CNB)[l * DG + c];
#pragma unroll
    for (int j = 0; j < 4 * R; ++j) { const int idx = F.tid + NT * j;
        if (idx < 62 * 32) { const int rr = idx >> 5, c8 = (idx & 31) * 8, t = t0 - 30 + rr; float g[8];
            if (t >= 0) { float d1[8], d2[8]; unpack8(d1w[j], d1); unpack8(d2w[j], d2);
#pragma unroll
                for (int i = 0; i < 8; ++i) g[i] = d1[i] * sigm(d2[i]);
                if (t >= SEQ - 30) { float* o = AOUT + O_PCONV + ((size_t)(l * BATCH + b) * 30 + (t - (SEQ - 30))) * DG + c8; *(GAS f32x4*)o = (f32x4){g[0], g[1], g[2], g[3]}; *(GAS f32x4*)(o + 4) = (f32x4){g[4], g[5], g[6], g[7]}; }
            } else {
#pragma unroll
                for (int i = 0; i < 8; ++i) g[i] = 0.f; }
            *(LAS f32x4*)(GLU + rr * 256 + c8) = (f32x4){g[0], g[1], g[2], g[3]}; *(LAS f32x4*)(GLU + rr * 256 + c8 + 4) = (f32x4){g[4], g[5], g[6], g[7]}; } }
    IBAR();
#pragma unroll
    for (int hb = 0; hb < R; ++hb) { const int tb0 = (TEAM ? hb : half) * 16; float win[46];
#pragma unroll
        for (int j = 0; j < 46; ++j) win[j] = GLU[(tb0 + j) * 256 + c];
#pragma unroll
        for (int i = 0; i < 16; ++i) { float s = cb;
#pragma unroll
            for (int j = 0; j < 31; ++j) s += w[j] * win[i + j];
            const float mean = wave_sum(s) * (1.f / 64.f); const float dx = s - mean; const float var = wave_sum(dx * dx) * (1.f / 64.f);
            const float yv = dx * (1.f / sqrtf(var + EPS)) * ng + nb;
            Y[(size_t)(b * SEQ + t0 + tb0 + i) * DM + 768 + c] = (bf16)f2bf(silu(yv)); } }
}

template <int NI>
__device__ __forceinline__ void conv_items(const Args& A, const int z, Frame& F, int l, int item0, int istride) {
    using namespace P;
    LAS float* GLU = (LAS float*)F.lds; LAS float* CO = GLU + 62 * 256;
    const bf16* H = (const bf16*)(AWS + WS_H); bf16* Y = (bf16*)(AWS + WS_Y);
    v4u d1w[NI][4], d2w[NI][4];
#pragma unroll
    for (int q = 0; q < NI; ++q) { const int item = item0 + q * istride, b = item >> 6, t0 = (item & 63) * 32;
#pragma unroll
        for (int j = 0; j < 4; ++j) { int idx = F.tid + 512 * j; idx = idx < 62 * 32 ? idx : 62 * 32 - 1; const int rr = idx >> 5, c8 = (idx & 31) * 8; int t = t0 - 30 + rr; t = t < 0 ? 0 : t;
            const size_t m = (size_t)b * SEQ + t; d1w[q][j] = *(const GAS v4u*)(H + m * NIN + HC_D1 + c8); d2w[q][j] = *(const GAS v4u*)(H + m * NIN + HC_D2 + c8); } }
    const int c = F.tid & 255, half = F.tid >> 8; float w[31]; const float* cw = AIN(I_CVW) + (size_t)l * CW * DG + c;
#pragma unroll
    for (int j = 0; j < 31; ++j) w[j] = cw[j * DG];
    const float cb = AIN(I_CVB)[l * DG + c];
    const f32x4 g4 = *(const GAS f32x4*)(AIN(I_CNG) + l * DG + 4 * F.lane), b4 = *(const GAS f32x4*)(AIN(I_CNB) + l * DG + 4 * F.lane);
#pragma unroll
    for (int q = 0; q < NI; ++q) { const int item = item0 + q * istride, b = item >> 6, t0 = (item & 63) * 32;
    if (q) LBAR();
#pragma unroll
    for (int j = 0; j < 4; ++j) { const int idx = F.tid + 512 * j;
        if (idx < 62 * 32) { const int rr = idx >> 5, c8 = (idx & 31) * 8, t = t0 - 30 + rr; float g[8];
            if (t >= 0) { float d1[8], d2[8]; unpack8(d1w[q][j], d1); unpack8(d2w[q][j], d2);
#pragma unroll
                for (int i = 0; i < 8; ++i) g[i] = d1[i] * sigm(d2[i]);
                if (t >= SEQ - 30) { float* o = AOUT + O_PCONV + ((size_t)(l * BATCH + b) * 30 + (t - (SEQ - 30))) * DG + c8; *(GAS f32x4*)o = (f32x4){g[0], g[1], g[2], g[3]}; *(GAS f32x4*)(o + 4) = (f32x4){g[4], g[5], g[6], g[7]}; }
            } else {
#pragma unroll
                for (int i = 0; i < 8; ++i) g[i] = 0.f; }
            *(LAS f32x4*)(GLU + rr * 256 + c8) = (f32x4){g[0], g[1], g[2], g[3]}; *(LAS f32x4*)(GLU + rr * 256 + c8 + 4) = (f32x4){g[4], g[5], g[6], g[7]}; } }
    LBAR();
    { float win[46];
#pragma unroll
      for (int j = 0; j < 46; ++j) win[j] = GLU[(half * 16 + j) * 256 + c];
#pragma unroll
      for (int i = 0; i < 16; ++i) { float s = cb;
#pragma unroll
          for (int j = 0; j < 31; ++j) s += w[j] * win[i + j];
          CO[(half * 16 + i) * 256 + c] = s; } }
    LBAR();
#pragma unroll
    for (int k = 0; k < 4; ++k) { const int tok = 4 * F.wave + k; const f32x4 x = *(const LAS f32x4*)(CO + tok * 256 + 4 * F.lane);
        const float s = sum16((x.x + x.y) + (x.z + x.w));
        const float mean = s * (1.f / 64.f); const f32x4 dx = x - mean; const float qq = sum16((dx.x * dx.x + dx.y * dx.y) + (dx.z * dx.z + dx.w * dx.w));
        const float rstd = 1.f / sqrtf(qq * (1.f / 64.f) + EPS); const f32x4 yv = dx * rstd * g4 + b4;
        *(GAS unsigned long long*)(Y + (size_t)(b * SEQ + t0 + tok) * DM + 768 + 4 * F.lane) = (unsigned long long)pk2(silu(yv.x), silu(yv.y)) | ((unsigned long long)pk2(silu(yv.z), silu(yv.w)) << 32); }
    }
}

namespace SG { constexpr int WB = 0, WP = 272  , VT = WB + 128 * WP, VP = 272, END = VT + 64 * VP; static_assert(END <= P::RING_BYTES, "SGU LDS"); }
template <int NI>
__device__ __forceinline__ void sgu_items(const Args& A, const int z, Frame& F, int l, int item0, int istride) {
    using namespace P;
    typedef short s8v __attribute__((ext_vector_type(8)));
    LAS unsigned char* L = F.lds;
    const bf16* H = (const bf16*)(AWS + WS_H); bf16* Y = (bf16*)(AWS + WS_Y);
    const int g = item0 & 3;
    const int tv = F.tid >> 2, qv = F.tid & 3, fi = F.lane & 15, kq = F.lane >> 4, t0 = 16 * F.wave;
    v4u va[NI], vb[NI]; bf16 uu[NI][4][4]; float bsv[4];
#pragma unroll
    for (int q = 0; q < NI; ++q) { const int bn = (item0 + q * istride) >> 2, m0 = (bn >> 4) * SEQ + 128 * (bn & 15);
        const bf16* vsrc = H + (size_t)(m0 + tv) * NIN + HC_BV + 64 * g + 16 * qv; va[q] = *(const GAS v4u*)vsrc; vb[q] = *(const GAS v4u*)(vsrc + 8);
#pragma unroll
        for (int r = 0; r < 4; ++r)
#pragma unroll
            for (int k = 0; k < 4; ++k) uu[q][r][k] = H[(size_t)(m0 + t0 + 4 * kq + r) * NIN + HC_BU + 64 * g + 16 * k + fi]; }
#pragma unroll
    for (int r = 0; r < 4; ++r) bsv[r] = AIN(I_SB)[(size_t)(l * NH + g) * 128 + t0 + 4 * kq + r];
    f32x4 lg[4], lb[4];
#pragma unroll
    for (int j = 0; j < 4; ++j) { lg[j] = *(const GAS f32x4*)(AIN(I_SLG) + l * DG + 64 * g + 16 * qv + 4 * j); lb[j] = *(const GAS f32x4*)(AIN(I_SLB) + l * DG + 64 * g + 16 * qv + 4 * j); }
    { const float* Wg = AIN(I_SW) + ((size_t)(l * NH + g)) * 128 * 128; f32x4 w[8];
#pragma unroll
      for (int j = 0; j < 8; ++j) { const int idx = F.tid + 512 * j; w[j] = *(const GAS f32x4*)(Wg + (idx >> 5) * 128 + (idx & 31) * 4); }
#pragma unroll
      for (int j = 0; j < 8; ++j) { const int idx = F.tid + 512 * j, tt = idx >> 5, s4 = (idx & 31) * 4;
          *(LAS unsigned long long*)(L + SG::WB + tt * SG::WP + 2 * s4) = (unsigned long long)pk2(s4 + 0 <= tt ? w[j].x : 0.f, s4 + 1 <= tt ? w[j].y : 0.f) | ((unsigned long long)pk2(s4 + 2 <= tt ? w[j].z : 0.f, s4 + 3 <= tt ? w[j].w : 0.f) << 32); } }
#pragma unroll
    for (int q = 0; q < NI; ++q) { const int bn = (item0 + q * istride) >> 2, m0 = (bn >> 4) * SEQ + 128 * (bn & 15);
    if (q) LBAR();
    { float x[16]; { float a[8], c[8]; unpack8(va[q], a); unpack8(vb[q], c);
#pragma unroll
        for (int i = 0; i < 8; ++i) { x[i] = a[i]; x[8 + i] = c[i]; } }
      float s = 0.f;
#pragma unroll
      for (int i = 0; i < 16; ++i) s += x[i];
      s = sum4(s); const float mean = s * (1.f / 64.f); float qq = 0.f;
#pragma unroll
      for (int i = 0; i < 16; ++i) { x[i] -= mean; qq += x[i] * x[i]; }
      qq = sum4(qq); const float rstd = 1.f / sqrtf(qq * (1.f / 64.f) + EPS);
#pragma unroll
      for (int i = 0; i < 16; ++i) *(LAS bf16*)(L + SG::VT + (16 * qv + i) * SG::VP + 2 * tv) = (bf16)f2bf(x[i] * rstd * lg[i >> 2][i & 3] + lb[i >> 2][i & 3]); }
    LBAR();
    { f32x4 acc[4];
#pragma unroll
      for (int k = 0; k < 4; ++k) acc[k] = (f32x4){0.f, 0.f, 0.f, 0.f};
      const int nks = (t0 + 16 + 31) >> 5;
      for (int ks = 0; ks < nks; ++ks) { const s8v af = *(const LAS s8v*)(L + SG::WB + (t0 + fi) * SG::WP + 64 * ks + 16 * kq);
#pragma unroll
          for (int k = 0; k < 4; ++k) { const s8v bfr = *(const LAS s8v*)(L + SG::VT + (16 * k + fi) * SG::VP + 64 * ks + 16 * kq); acc[k] = __builtin_amdgcn_mfma_f32_16x16x32_bf16(af, bfr, acc[k], 0, 0, 0); } }
#pragma unroll
      for (int r = 0; r < 4; ++r) { const int t = t0 + 4 * kq + r;
#pragma unroll
          for (int k = 0; k < 4; ++k) Y[(size_t)(m0 + t) * DM + 256 + 64 * g + 16 * k + fi] = (bf16)f2bf(bf1(uu[q][r][k]) * (acc[k][r] + bsv[r])); } }
    }
}

__device__ __forceinline__ float row16_sum(float v) {
    v += __builtin_bit_cast(float, __builtin_amdgcn_mov_dpp(__builtin_bit_cast(int, v), 0xB1, 0xF, 0xF, true));
    v += __builtin_bit_cast(float, __builtin_amdgcn_mov_dpp(__builtin_bit_cast(int, v), 0x4E, 0xF, 0xF, true));
    v += __builtin_bit_cast(float, __builtin_amdgcn_mov_dpp(__builtin_bit_cast(int, v), 0x141, 0xF, 0xF, true));
    v += __builtin_bit_cast(float, __builtin_amdgcn_mov_dpp(__builtin_bit_cast(int, v), 0x140, 0xF, 0xF, true));
    return v;
}
__device__ __forceinline__ void fox_page_wave(const Args& A, const int z, Frame& F, int l, int unit) {
    using namespace P;
    int lane_ = F.lane; asm volatile("" : "+v"(lane_));
    const int b = unit >> 6, pg = unit & 63, hh = lane_ >> 4, ds = lane_ & 15;
    const bf16* H = (const bf16*)(AWS + WS_H); const int* pt = (const int*)AIN(I_PT);
    const int page = __builtin_amdgcn_readfirstlane(pt[b * NPAGES + pg]);
    const __amdgpu_buffer_rsrc_t rK = __builtin_amdgcn_make_buffer_rsrc((void*)(AIN(I_CK) + ((size_t)(l * NPOOL + page) * PAGE) * 256), 0, PAGE * 1024, 0x00020000);
    const __amdgpu_buffer_rsrc_t rV = __builtin_amdgcn_make_buffer_rsrc((void*)(AIN(I_CV) + ((size_t)(l * NPOOL + page) * PAGE) * 256), 0, PAGE * 1024, 0x00020000);
    const __amdgpu_buffer_rsrc_t rL = __builtin_amdgcn_make_buffer_rsrc((void*)(AIN(I_CL) + ((size_t)(l * NPOOL + page) * PAGE) * 4), 0, PAGE * 16, 0x00020000);
    const int vo16 = 16 * lane_, vo4 = 4 * hh;
    f32x4 kA[4], vA[4], kB[4], vB[4]; float lfA[4], lfB[4];
#define PG_LOAD(K4, V4, LF, r0) do { _Pragma("unroll") for (int i = 0; i < 4; ++i) { K4[i] = __builtin_bit_cast(f32x4, __builtin_amdgcn_raw_buffer_load_b128(rK, vo16, ((r0) + i) * 1024, 2)); \
        V4[i] = __builtin_bit_cast(f32x4, __builtin_amdgcn_raw_buffer_load_b128(rV, vo16, ((r0) + i) * 1024, 2)); LF[i] = __builtin_bit_cast(float, __builtin_amdgcn_raw_buffer_load_b32(rL, vo4, ((r0) + i) * 16, 0)); } } while (0)
    PG_LOAD(kA, vA, lfA, PAGE - 4); PG_LOAD(kB, vB, lfB, PAGE - 8);
    f32x4 q4[4];
#pragma unroll
    for (int t = 0; t < 4; ++t) { const unsigned long long w = *(const GAS unsigned long long*)(H + (size_t)(MPR + 4 * b + t) * NIN + HC_CQ + 64 * hh + 4 * ds);
        q4[t] = (f32x4){bflo((unsigned)w), bfhi((unsigned)w), bflo((unsigned)(w >> 32)), bfhi((unsigned)(w >> 32))}; }
    float run;
    { const f32x4 ps = *(const GAS f32x4*)((const float*)(AWS + WS_PS) + ((size_t)(l * DECB + b) * NPAGES + lane_) * 4); const bool later = lane_ > pg;
      const float r0 = wave_sum(later ? ps.x : 0.f), r1 = wave_sum(later ? ps.y : 0.f), r2 = wave_sum(later ? ps.z : 0.f), r3 = wave_sum(later ? ps.w : 0.f);
      run = hh == 0 ? r0 : (hh == 1 ? r1 : (hh == 2 ? r2 : r3)); }
    float mx[4], ls[4]; f32x4 O[4];
#pragma unroll
    for (int t = 0; t < 4; ++t) { mx[t] = -1e30f; ls[t] = 0.f; O[t] = (f32x4){0.f, 0.f, 0.f, 0.f}; }
#define PG_STEP(K4, V4, LF, o) do { float bias[4]; \
        _Pragma("unroll") for (int i = 3; i >= 0; --i) { bias[i] = run * LOG2E; run += LF[(o) + i]; } \
        _Pragma("unroll") for (int t = 0; t < 4; ++t) { float s[4]; \
            _Pragma("unroll") for (int i = 0; i < 4; ++i) { \
                typedef float f2_ __attribute__((ext_vector_type(2))); f2_ a_ = __builtin_shufflevector(K4[(o) + i], K4[(o) + i], 0, 1) * __builtin_shufflevector(q4[t], q4[t], 0, 1); \
                a_ = __builtin_shufflevector(K4[(o) + i], K4[(o) + i], 2, 3) * __builtin_shufflevector(q4[t], q4[t], 2, 3) + a_; s[i] = sum16(a_.x + a_.y) + bias[i]; } \
            const float mb = fmaxf(fmaxf(s[0], s[1]), fmaxf(s[2], s[3])), mn = fmaxf(mx[t], mb), corr = exp2f(mx[t] - mn); \
            const float p0 = exp2f(s[0] - mn), p1 = exp2f(s[1] - mn), p2 = exp2f(s[2] - mn), p3 = exp2f(s[3] - mn); \
            ls[t] = ls[t] * corr + ((p0 + p1) + (p2 + p3)); O[t] = O[t] * corr + V4[(o)] * p0 + V4[(o) + 1] * p1 + V4[(o) + 2] * p2 + V4[(o) + 3] * p3; mx[t] = mn; __builtin_amdgcn_sched_barrier(0); } } while (0)
#pragma unroll 1
    for (int r0 = PAGE - 4; r0 >= 0; r0 -= 8) {
        PG_STEP(kA, vA, lfA, 0); asm volatile("" ::: "memory"); __builtin_amdgcn_sched_barrier(0); if (r0 >= 8) PG_LOAD(kA, vA, lfA, r0 - 8); asm volatile("" ::: "memory"); __builtin_amdgcn_sched_barrier(0);
        PG_STEP(kB, vB, lfB, 0); asm volatile("" ::: "memory"); __builtin_amdgcn_sched_barrier(0); if (r0 >= 12) PG_LOAD(kB, vB, lfB, r0 - 12); asm volatile("" ::: "memory"); __builtin_amdgcn_sched_barrier(0);
    }
#undef PG_LOAD
#undef PG_STEP
    float* PART = (float*)(AWS + WS_PART); float* ML = (float*)(AWS + WS_ML);
#pragma unroll
    for (int t = 0; t < 4; ++t) { const size_t o = ((size_t)(unit * 4 + hh) * 4 + t); *(GAS f32x4*)(PART + o * 64 + 4 * ds) = O[t]; if (ds == 0) { ML[o * 2] = mx[t]; ML[o * 2 + 1] = ls[t]; } }
}

__device__ __forceinline__ void fox_page_dma(const Args& A, const int z, Frame& F, int l, int unit, int ring_off) {
    using namespace P;
    int lane_ = F.lane; asm volatile("" : "+v"(lane_));
    const int b = unit >> 6, pg = unit & 63, hh = lane_ >> 4, ds = lane_ & 15;
    const bf16* H = (const bf16*)(AWS + WS_H); const int* pt = (const int*)AIN(I_PT);
    const int page = __builtin_amdgcn_readfirstlane(pt[b * NPAGES + pg]);
    const char* Kg = (const char*)(AIN(I_CK) + ((size_t)(l * NPOOL + page) * PAGE) * 256) + 16 * lane_;
    const char* Vg = (const char*)(AIN(I_CV) + ((size_t)(l * NPOOL + page) * PAGE) * 256) + 16 * lane_;
    const float* Lg = AIN(I_CL) + ((size_t)(l * NPOOL + page) * PAGE) * 4 + 8 * lane_;
    const f32x4 lfa = *(const GAS f32x4*)Lg, lfb = *(const GAS f32x4*)(Lg + 4);
    const f32x4 ps = *(const GAS f32x4*)((const float*)(AWS + WS_PS) + ((size_t)(l * DECB + b) * NPAGES + lane_) * 4);
    f32x4 q4[4];
#pragma unroll
    for (int t = 0; t < 4; ++t) { const unsigned long long w = *(const GAS unsigned long long*)(H + (size_t)(MPR + 4 * b + t) * NIN + HC_CQ + 64 * hh + 4 * ds);
        q4[t] = (f32x4){bflo((unsigned)w), bfhi((unsigned)w), bflo((unsigned)(w >> 32)), bfhi((unsigned)(w >> 32))}; }
    f32x4 bhi, blo;
#pragma unroll
    for (int c = 0; c < 4; ++c) { const float lat = wave_sum(lane_ > pg ? ps[c] : 0.f); const float s = lfa[c] + lfb[c]; float incl = s;
        incl += DPP_F(incl, 0x111); incl += DPP_F(incl, 0x112); incl += DPP_F(incl, 0x114); incl += DPP_F(incl, 0x118);
        const float t0 = __builtin_bit_cast(float, __builtin_amdgcn_readlane(__builtin_bit_cast(int, incl), 15)), t1 = __builtin_bit_cast(float, __builtin_amdgcn_readlane(__builtin_bit_cast(int, incl), 31)), t2 = __builtin_bit_cast(float, __builtin_amdgcn_readlane(__builtin_bit_cast(int, incl), 47)), t3 = __builtin_bit_cast(float, __builtin_amdgcn_readlane(__builtin_bit_cast(int, incl), 63));
        incl += (lane_ >= 16 ? t0 : 0.f) + (lane_ >= 32 ? t1 : 0.f) + (lane_ >= 48 ? t2 : 0.f);
        const float tot = (t0 + t1) + (t2 + t3), after = tot - incl;
        bhi[c] = (lat + after) * LOG2E; blo[c] = (lat + after + lfb[c]) * LOG2E; }
    float mx[4], ls[4]; f32x4 O[4];
#pragma unroll
    for (int t = 0; t < 4; ++t) { mx[t] = -1e30f; ls[t] = 0.f; O[t] = (f32x4){0.f, 0.f, 0.f, 0.f}; }
    const unsigned rb = (unsigned)(uintptr_t)(F.lds + ring_off);
    const LAS unsigned char* rl = F.lds + ring_off + 16 * lane_;
    asm volatile("s_waitcnt vmcnt(0) lgkmcnt(0)" ::: "memory");
#define PD_DMA(j) do { const int r_ = 127 - (j); const unsigned d_ = (unsigned)__builtin_amdgcn_readfirstlane(rb + (((j) & 7) << 11)); attn_body::glds16(Kg + (size_t)r_ * 1024, d_); attn_body::glds16(Vg + (size_t)r_ * 1024, d_ + 1024u); } while (0)
#define PD_ROW(j, NV, bias_) do { asm volatile("s_waitcnt vmcnt(" #NV ")" ::: "memory"); \
        const f32x4 k4 = *(const LAS f32x4*)(rl + (((j) & 7) << 11)), v4 = *(const LAS f32x4*)(rl + (((j) & 7) << 11) + 1024); \
        asm volatile("s_waitcnt lgkmcnt(0)" ::: "memory"); \
        if ((j) + 7 < 128) PD_DMA((j) + 7); \
        _Pragma("unroll") for (int t = 0; t < 4; ++t) { typedef float f2_ __attribute__((ext_vector_type(2))); \
            f2_ a_ = __builtin_shufflevector(k4, k4, 0, 1) * __builtin_shufflevector(q4[t], q4[t], 0, 1); a_ = __builtin_shufflevector(k4, k4, 2, 3) * __builtin_shufflevector(q4[t], q4[t], 2, 3) + a_; \
            const float s = sum16(a_.x + a_.y) + (bias_); const float mn = fmaxf(mx[t], s), corr = exp2f(mx[t] - mn), p = exp2f(s - mn); \
            ls[t] = ls[t] * corr + p; O[t] = O[t] * corr + v4 * p; mx[t] = mn; } } while (0)
#define PD_BIAS(vec, L) (hh == 0 ? __builtin_bit_cast(float, __builtin_amdgcn_readlane(__builtin_bit_cast(int, vec[0]), (L))) : hh == 1 ? __builtin_bit_cast(float, __builtin_amdgcn_readlane(__builtin_bit_cast(int, vec[1]), (L))) : \
                         hh == 2 ? __builtin_bit_cast(float, __builtin_amdgcn_readlane(__builtin_bit_cast(int, vec[2]), (L))) : __builtin_bit_cast(float, __builtin_amdgcn_readlane(__builtin_bit_cast(int, vec[3]), (L))))
    PD_DMA(0); PD_DMA(1); PD_DMA(2); PD_DMA(3); PD_DMA(4); PD_DMA(5); PD_DMA(6);
#pragma unroll 1
    for (int i = 0; i < 60; ++i) { const int j = 2 * i, L = 63 - i;
        const float b1 = PD_BIAS(bhi, L), b0 = PD_BIAS(blo, L);
        PD_ROW(j, 12, b1); PD_ROW(j + 1, 12, b0); }
    { const float b1 = PD_BIAS(bhi, 3), b0 = PD_BIAS(blo, 3); PD_ROW(120, 12, b1); PD_ROW(121, 12, b0); }
    { const float b1 = PD_BIAS(bhi, 2), b0 = PD_BIAS(blo, 2); PD_ROW(122, 10, b1); PD_ROW(123, 8, b0); }
    { const float b1 = PD_BIAS(bhi, 1), b0 = PD_BIAS(blo, 1); PD_ROW(124, 6, b1); PD_ROW(125, 4, b0); }
    { const float b1 = PD_BIAS(bhi, 0), b0 = PD_BIAS(blo, 0); PD_ROW(126, 2, b1); PD_ROW(127, 0, b0); }
#undef PD_DMA
#undef PD_ROW
#undef PD_BIAS
    float* PART = (float*)(AWS + WS_PART); float* ML = (float*)(AWS + WS_ML);
#pragma unroll
    for (int t = 0; t < 4; ++t) { const size_t o = ((size_t)(unit * 4 + hh) * 4 + t); *(GAS f32x4*)(PART + o * 64 + 4 * ds) = O[t]; if (ds == 0) { ML[o * 2] = mx[t]; ML[o * 2 + 1] = ls[t]; } }
    asm volatile("s_waitcnt vmcnt(0)" ::: "memory");
}

__device__ __forceinline__ void sample_fox_item(const Args& A, const int z, Frame& F, int l, int b) {
    using namespace P;
    LAS float* L = (LAS float*)F.lds; LAS float* SC = L; LAS float* DN = L + 64;
    const bf16* H = (const bf16*)(AWS + WS_H); bf16* Y = (bf16*)(AWS + WS_Y); const float* LRF = (const float*)(AWS + WS_LRF);
    const int mrow = MPR + 4 * b;
    const int hh = F.tid >> 7, t = (F.tid >> 5) & 3, dp = F.tid & 31;
    const float* ML = (const float*)(AWS + WS_ML) + ((size_t)(b * NPAGES * 4 + hh) * 4 + t) * 2; const float* PART = (const float*)(AWS + WS_PART) + ((size_t)(b * NPAGES * 4 + hh) * 4 + t) * 64 + 2 * dp;
    float2 ml[16]; float M = -1e30f; asm volatile("" : "+v"(M));
    if (F.tid < 4) { const int h2 = F.tid; const float bf = AIN(I_FBF)[l * 4 + h2]; float run = 0.f;
        for (int tt = 0; tt < 4; ++tt) { const float lf = logsig(LRF[(size_t)(mrow + tt) * 32 + 16 + h2] + bf); AOUT[O_SFL + ((size_t)l * MS + 4 * b + tt) * 4 + h2] = lf; run += lf; DN[tt * 4 + h2] = run; } }
    LBAR();
    if (F.tid < 64) { const int h2 = F.tid >> 4, tt = (F.tid >> 2) & 3, j = F.tid & 3; float s = 0.f;
        const bf16* qp = H + (size_t)(mrow + tt) * NIN + HC_CQ + 64 * h2; const bf16* kp = H + (size_t)(mrow + j) * NIN + HC_CK + 64 * h2;
#pragma unroll
        for (int d8 = 0; d8 < 8; ++d8) { float qf[8], kf[8]; unpack8(*(const GAS v4u*)(qp + 8 * d8), qf); unpack8(*(const GAS v4u*)(kp + 8 * d8), kf);
#pragma unroll
            for (int i = 0; i < 8; ++i) s += qf[i] * kf[i]; }
        float l2e = LOG2E; asm volatile("" : "+v"(l2e));
        SC[F.tid] = (j <= tt) ? s - DN[j * 4 + h2] * l2e : -INFINITY; }
    LBAR();
    float Ls = 0.f, o0 = 0.f, o1 = 0.f;
    for (int p0 = 0; p0 < NPAGES; p0 += 16) {
#pragma unroll
        for (int p = 0; p < 16; ++p) ml[p] = *(const float2*)(ML + (size_t)(p0 + p) * 32);
#pragma unroll
        for (int p = 0; p < 16; ++p) M = fmaxf(M, ml[p].x); }
#pragma unroll
    for (int j = 0; j < 4; ++j) M = fmaxf(M, SC[(hh * 4 + t) * 4 + j]);
    for (int p0 = 0; p0 < NPAGES; p0 += 16) { float2 pv[16];
#pragma unroll
        for (int p = 0; p < 16; ++p) { ml[p] = *(const float2*)(ML + (size_t)(p0 + p) * 32); pv[p] = *(const float2*)(PART + (size_t)(p0 + p) * 1024); }
#pragma unroll
        for (int p = 0; p < 16; ++p) { const float w = exp2f(ml[p].x - M); Ls += ml[p].y * w; o0 += pv[p].x * w; o1 += pv[p].y * w; } }
#pragma unroll
    for (int j = 0; j < 4; ++j) { const float w = exp2f(SC[(hh * 4 + t) * 4 + j] - M); Ls += w; const bf16* vp = H + (size_t)(mrow + j) * NIN + HC_CV + 64 * hh + 2 * dp; o0 += w * bf1(vp[0]); o1 += w * bf1(vp[1]); }
    const float inv = 1.f / Ls;
    *(GAS unsigned*)(Y + (size_t)(mrow + t) * DM + 512 + 64 * hh + 2 * dp) = pk2(o0 * inv, o1 * inv);
}
__device__ __forceinline__ void sample_gs_item(const Args& A, const int z, Frame& F, int l, int b) {
    using namespace P;
    LAS float* L = (LAS float*)F.lds; LAS float* LA = L; LAS float* QK = L + 512;
    const bf16* H = (const bf16*)(AWS + WS_H); bf16* Y = (bf16*)(AWS + WS_Y); const float* LRF = (const float*)(AWS + WS_LRF);
    const int mrow = MPR + 4 * b;
    { const int t = F.tid >> 7, j = F.tid & 127; const float* lr = LRF + (size_t)(mrow + t) * 32; float s = AIN(I_GBA)[l * 128 + j]; float wv[16]; f32x4 l4[4];
#pragma unroll
      for (int r = 0; r < 16; ++r) wv[r] = AIN(I_GWA)[(size_t)l * RANK * 128 + r * 128 + j];
#pragma unroll
      for (int r = 0; r < 4; ++r) l4[r] = *(const GAS f32x4*)(lr + 4 * r);
#pragma unroll
      for (int r = 0; r < 16; ++r) s += l4[r >> 2][r & 3] * wv[r];
      LA[t * 128 + j] = logsig(s) * (1.f / 16.f); }
    if (F.tid < 128) { const int t = F.tid >> 5, j8 = (F.tid & 31) * 8; float qf[8]; unpack8(*(const GAS v4u*)(H + (size_t)(mrow + t) * NIN + HC_AQ + j8), qf);
#pragma unroll
        for (int i = 0; i < 8; ++i) QK[t * 256 + j8 + i] = qf[i]; }
    if (F.tid < 256) {
        int e = F.tid & 63; asm volatile("" : "+v"(e)); const int hh = F.tid >> 6; float S[32];
        const float* S0 = AIN(I_SGLA) + ((size_t)((l * DECB + b) * NH + hh)) * 2048 + e;
#pragma unroll
        for (int d = 0; d < 32; ++d) S[d] = S0[d * 64];
        float vv[4], ag[4];
#pragma unroll
        for (int t = 0; t < 4; ++t) { vv[t] = bf1(H[(size_t)(mrow + t) * NIN + HC_AV + 64 * hh + e]); ag[t] = bf1(H[(size_t)(mrow + t) * NIN + HC_AG + 64 * hh + e]); }
        const float ng = AIN(I_GNG)[l * 256 + 64 * hh + e];
        LBAR();
#pragma unroll
        for (int t = 0; t < 4; ++t) { float o = 0.f;
#pragma unroll
            for (int d = 0; d < 32; ++d) { S[d] = expf(LA[t * 128 + 32 * hh + d]) * S[d] + QK[t * 256 + 128 + 32 * hh + d] * vv[t]; o += QK[t * 256 + 32 * hh + d] * 0.17677669529663687f * S[d]; }
            const float ms = wave_sum(o * o) * (1.f / 64.f); const float rn = 1.f / sqrtf(ms + EPS);
            Y[(size_t)(mrow + t) * DM + 64 * hh + e] = (bf16)f2bf(o * rn * ng * silu(ag[t])); }
        float* So = AOUT + O_SGLA + ((size_t)((l * DECB + b) * NH + hh)) * 2048 + e;
#pragma unroll
        for (int d = 0; d < 32; ++d) So[d * 64] = S[d];
    } else {
        int c = F.tid - 256; asm volatile("" : "+v"(c)); const int g = c >> 6; float xv[4], uv[4], wv[10], bsv[4];
#pragma unroll
        for (int t = 0; t < 4; ++t) { xv[t] = bf1(H[(size_t)(mrow + t) * NIN + HC_BV + c]); uv[t] = bf1(H[(size_t)(mrow + t) * NIN + HC_BU + c]); }
        const float* Wg = AIN(I_SW) + ((size_t)(l * NH + g)) * 128 * 128; const float* bs = AIN(I_SB) + (size_t)(l * NH + g) * 128;
        { int k = 0;
#pragma unroll
          for (int t = 0; t < 4; ++t) { bsv[t] = bs[t];
#pragma unroll
              for (int s = 0; s <= t; ++s) wv[k++] = Wg[t * 128 + s]; } }
        const float lgv = AIN(I_SLG)[l * DG + c], lbv = AIN(I_SLB)[l * DG + c];
        LBAR();
        float vl[4];
#pragma unroll
        for (int t = 0; t < 4; ++t) { const float mean = wave_sum(xv[t]) * (1.f / 64.f); const float dx = xv[t] - mean;
            const float var = wave_sum(dx * dx) * (1.f / 64.f); vl[t] = dx * (1.f / sqrtf(var + EPS)) * lgv + lbv;
            AOUT[O_SSGU + ((size_t)l * MS + 4 * b + t) * DG + c] = vl[t]; }
        { int k = 0;
#pragma unroll
          for (int t = 0; t < 4; ++t) { float mix = bsv[t];
#pragma unroll
              for (int s = 0; s <= t; ++s) mix += wv[k++] * vl[s];
              Y[(size_t)(mrow + t) * DM + 256 + c] = (bf16)f2bf(uv[t] * mix); } }
    }
}
__device__ __forceinline__ void sample_conv_item(const Args& A, const int z, Frame& F, int l, int b) {
    using namespace P;
    const bf16* H = (const bf16*)(AWS + WS_H); bf16* Y = (bf16*)(AWS + WS_Y);
    const int mrow = MPR + 4 * b;
    if (F.tid < 256) {
        int c = F.tid; asm volatile("" : "+v"(c)); float xx[34], w[31], d1[4], d2[4];
        const float* st = AIN(I_SCONV) + ((size_t)(l * DECB + b) * 30) * DG + c;
#pragma unroll
        for (int j = 0; j < 30; ++j) xx[j] = st[j * DG];
#pragma unroll
        for (int t = 0; t < 4; ++t) { d1[t] = bf1(H[(size_t)(mrow + t) * NIN + HC_D1 + c]); d2[t] = bf1(H[(size_t)(mrow + t) * NIN + HC_D2 + c]); }
        const float* cw = AIN(I_CVW) + (size_t)l * CW * DG + c; const float cb = AIN(I_CVB)[l * DG + c];
#pragma unroll
        for (int j = 0; j < 31; ++j) w[j] = cw[j * DG];
        const float ngv = AIN(I_CNG)[l * DG + c], nbv = AIN(I_CNB)[l * DG + c];
#pragma unroll
        for (int t = 0; t < 4; ++t) xx[30 + t] = d1[t] * sigm(d2[t]);
        float* so = AOUT + O_SCONV + ((size_t)(l * DECB + b) * 30) * DG + c;
#pragma unroll
        for (int j = 0; j < 30; ++j) so[j * DG] = xx[4 + j];
        float co[4] = {cb, cb, cb, cb};
#pragma unroll
        for (int j = 0; j < 31; ++j)
#pragma unroll
            for (int t = 0; t < 4; ++t) co[t] += w[j] * xx[t + j];
#pragma unroll
        for (int t = 0; t < 4; ++t) { const float mean = wave_sum(co[t]) * (1.f / 64.f); const float dx = co[t] - mean; const float var = wave_sum(dx * dx) * (1.f / 64.f);
            const float yv = dx * (1.f / sqrtf(var + EPS)) * ngv + nbv;
            Y[(size_t)(mrow + t) * DM + 768 + c] = (bf16)f2bf(silu(yv)); }
    }
}

struct LnIo { const bf16* Z; const bf16* res; const float* pz; int nsl; const float* g; const float* b; float* of32_p; float* of32_s; bf16* obf; };
__device__ __forceinline__ void ln_finish(Frame& F, float (&v)[16], const LnIo& io, int m) {
    using namespace P;
    float s = 0.f;
#pragma unroll
    for (int i = 0; i < 16; ++i) s += v[i];
    const float mean = wave_sum(s) * (1.f / 1024.f); float s2 = 0.f;
#pragma unroll
    for (int i = 0; i < 16; ++i) { v[i] -= mean; s2 += v[i] * v[i]; }
    const float rstd = 1.f / sqrtf(wave_sum(s2) * (1.f / 1024.f) + EPS);
    float y0[8], y1[8];
#pragma unroll
    for (int h = 0; h < 2; ++h) { const f32x4 ga = *(const GAS f32x4*)(io.g + 8 * F.lane + 4 * h), ba = *(const GAS f32x4*)(io.b + 8 * F.lane + 4 * h), gc = *(const GAS f32x4*)(io.g + 512 + 8 * F.lane + 4 * h), bc = *(const GAS f32x4*)(io.b + 512 + 8 * F.lane + 4 * h);
#pragma unroll
        for (int i = 0; i < 4; ++i) { y0[4 * h + i] = v[4 * h + i] * rstd * ga[i] + ba[i]; y1[4 * h + i] = v[8 + 4 * h + i] * rstd * gc[i] + bc[i]; } }
    if (io.obf) { bf16* o = io.obf + (size_t)m * DM; *(GAS v4u*)(o + 8 * F.lane) = pack8(y0); *(GAS v4u*)(o + 512 + 8 * F.lane) = pack8(y1); }
    float* of = m < MPR ? (io.of32_p ? io.of32_p + (size_t)m * DM : nullptr) : (io.of32_s ? io.of32_s + (size_t)(m - MPR) * DM : nullptr);
    if (of) { *(GAS f32x4*)(of + 8 * F.lane) = (f32x4){y0[0], y0[1], y0[2], y0[3]}; *(GAS f32x4*)(of + 8 * F.lane + 4) = (f32x4){y0[4], y0[5], y0[6], y0[7]};
        *(GAS f32x4*)(of + 512 + 8 * F.lane) = (f32x4){y1[0], y1[1], y1[2], y1[3]}; *(GAS f32x4*)(of + 512 + 8 * F.lane + 4) = (f32x4){y1[4], y1[5], y1[6], y1[7]}; }
}
__device__ __forceinline__ void ln_phase(Frame& F, const LnIo& io) {
    using namespace P;
    constexpr int NR = 4;
    const int gw = F.vcu * NWAVES + F.wave, ngw = F.G * NWAVES;
    const bool xmap = F.G == 256; const int xg = F.vcu >> 5, wl = (F.vcu & 31) * NWAVES + F.wave;
    for (int it_ = 0; it_ < (xmap ? 2 : (MPR / NR + ngw - 1) / ngw); ++it_) { const int m0 = xmap ? 2048 * xg + NR * wl + 1024 * it_ : (gw + ngw * it_) * NR; if (m0 >= MPR) break;
        v4u za[NR], zb[NR];
#pragma unroll
        for (int r = 0; r < NR; ++r) { za[r] = *(const GAS v4u*)(io.Z + (size_t)(m0 + r) * DM + 8 * F.lane); zb[r] = *(const GAS v4u*)(io.Z + (size_t)(m0 + r) * DM + 512 + 8 * F.lane); }
#pragma unroll
        for (int r = 0; r < NR; ++r) { float v[16]; float r0[8], r1[8]; unpack8(za[r], r0); unpack8(zb[r], r1);
#pragma unroll
            for (int i = 0; i < 8; ++i) { v[i] = r0[i]; v[8 + i] = r1[i]; }
            ln_finish(F, v, io, m0 + r); }
    }
    for (int m = MPR + gw; m < MREAL; m += ngw) {
        const bf16* res = io.res + (size_t)m * DM; const float* pz = io.pz + (size_t)(m - MPR) * DM; float v[16];
        float r0[8], r1[8]; unpack8(*(const GAS v4u*)(res + 8 * F.lane), r0); unpack8(*(const GAS v4u*)(res + 512 + 8 * F.lane), r1);
#pragma unroll
        for (int i = 0; i < 8; ++i) { v[i] = r0[i] * ALPHA; v[8 + i] = r1[i] * ALPHA; }
        for (int k = 0; k < io.nsl; ++k) { const float* p = pz + (size_t)k * 128 * 1024 + 8 * F.lane;
            const f32x4 a0 = *(const GAS f32x4*)p, a1 = *(const GAS f32x4*)(p + 4), c0 = *(const GAS f32x4*)(p + 512), c1 = *(const GAS f32x4*)(p + 516);
#pragma unroll
            for (int i = 0; i < 4; ++i) { v[i] += a0[i]; v[4 + i] += a1[i]; v[8 + i] += c0[i]; v[12 + i] += c1[i]; } }
        ln_finish(F, v, io, m);
    }
}

__device__ __forceinline__ void act_fixup(const Args& A, const int z, Frame& F, int l, int pm) {
    using namespace P;
    if (pm >= MPR / 256 || (pm & 7) == 0) return;
    if (F.tid < DFF / 8) {
        const int f0 = 8 * F.tid; bf16* ACT = (bf16*)(AWS + WS_ACT);
        const float* hg = (const float*)(AWS + WS_HALO) + (size_t)((pm - 1) * 2) * DFF + f0; const float* fg = (const float*)(AWS + WS_FG) + (size_t)(pm * 2) * DFF + f0; const float* fv = (const float*)(AWS + WS_FV) + (size_t)(pm * 2) * DFF + f0;
        const float* fw = AIN(I_FCW) + (size_t)l * 3 * DFF + f0; const float* fb = AIN(I_FCB) + l * DFF + f0;
        float y0[8], y1[8];
#pragma unroll
        for (int h = 0; h < 2; ++h) { const int o = 4 * h;
            const f32x4 m2 = *(const GAS f32x4*)(hg + o), m1 = *(const GAS f32x4*)(hg + DFF + o), g0 = *(const GAS f32x4*)(fg + o), g1 = *(const GAS f32x4*)(fg + DFF + o), v0 = *(const GAS f32x4*)(fv + o), v1 = *(const GAS f32x4*)(fv + DFF + o);
            const f32x4 a = *(const GAS f32x4*)(fw + o), b = *(const GAS f32x4*)(fw + DFF + o), c = *(const GAS f32x4*)(fw + 2 * DFF + o), d = *(const GAS f32x4*)(fb + o);
#pragma unroll
            for (int i = 0; i < 4; ++i) { y0[o + i] = silu(a[i] * m2[i] + b[i] * m1[i] + c[i] * g0[i] + d[i]) * v0[i]; y1[o + i] = silu(a[i] * m1[i] + b[i] * g0[i] + c[i] * g1[i] + d[i]) * v1[i]; } }
        *(GAS v4u*)(ACT + (size_t)(pm * 256) * DFF + f0) = pack8(y0); *(GAS v4u*)(ACT + (size_t)(pm * 256 + 1) * DFF + f0) = pack8(y1);
    }
    asm volatile("s_waitcnt vmcnt(0)" ::: "memory"); __syncthreads();
}

namespace pg8 {
__device__ __forceinline__ float dpp_ror1(float v) { return __builtin_bit_cast(float, __builtin_amdgcn_mov_dpp(__builtin_bit_cast(int, v), 0x121, 0xF, 0xF, true)); }
__device__ __forceinline__ float dpp_ror2(float v) { return __builtin_bit_cast(float, __builtin_amdgcn_mov_dpp(__builtin_bit_cast(int, v), 0x122, 0xF, 0xF, true)); }
__device__ __forceinline__ float fast_silu(float x) { return x * __builtin_amdgcn_rcpf(1.0f + __builtin_amdgcn_exp2f(-1.4426950408889634f * x)); }
struct EpiUpAct {
    static constexpr bool PERM = true, AFTER_DRAIN = false;
    const Args& A; int z; int layer;
    static constexpr int DFF = 2688, PM_S = 64; static constexpr size_t O_PFFN = P::O_PFFN, O_SFFN = P::O_SFFN;
    __device__ __forceinline__ void operator()(const f32x4 (&acc)[2][2][4][2], const Unit& u, int wr, int wc, int fr, int fq) const {
        asm volatile("" : "+v"(fr), "+v"(fq));
        const int lc = wc * 32 + 8 * fq, col = u.pn * 128 + lc;
        unsigned char* const ws = AWS; float* const out = AOUT; bf16_t* const ACT = (bf16_t*)(ws + P::WS_ACT); float* const halo_g = (float*)(ws + P::WS_HALO); float* const first_g = (float*)(ws + P::WS_FG); float* const first_v = (float*)(ws + P::WS_FV);
        const float* const cw = AIN(P::I_FCW) + (size_t)layer * 3 * DFF; const float* const cb = AIN(P::I_FCB) + layer * DFF; const float* const st = AIN(P::I_SFFN) + (size_t)layer * P::DECB * 2 * DFF;
        extern __shared__ __attribute__((aligned(16))) unsigned char lds_dyn_[]; PG8_LAS float* const lh = (PG8_LAS float*)((PG8_LAS unsigned char*)lds_dyn_ + P::HALO_OFF);
        f32x4 w0[2], w1[2], w2[2], cbv[2];
#pragma unroll
        for (int n = 0; n < 2; ++n) { w0[n] = *(const f32x4*)(cw + col + 4 * n); w1[n] = *(const f32x4*)(cw + DFF + col + 4 * n); w2[n] = *(const f32x4*)(cw + 2 * DFF + col + 4 * n); cbv[n] = *(const f32x4*)(cb + col + 4 * n); }
        if (fr >= 14) {
#pragma unroll
            for (int ai = 0; ai < 2; ++ai)
#pragma unroll
                for (int n = 0; n < 2; ++n) *(PG8_LAS f32x4*)(lh + (((ai * 2 + wr) * 2 + (fr - 14)) * 128 + lc + 4 * n)) = acc[ai][0][3][n];
            if (wr == 1) {
#pragma unroll
                for (int n = 0; n < 2; ++n) *(f32x4*)(halo_g + (size_t)(u.pm * 2 + (fr - 14)) * DFF + col + 4 * n) = acc[1][0][3][n];
                if (u.pm < PM_S && (u.pm & 7) == 7) {
#pragma unroll
                    for (int n = 0; n < 2; ++n) *(f32x4*)(out + O_PFFN + (size_t)((layer * 8 + (u.pm >> 3)) * 2 + (fr - 14)) * DFF + col + 4 * n) = acc[1][0][3][n]; }
            }
        }
        asm volatile("s_waitcnt lgkmcnt(0)" ::: "memory"); __builtin_amdgcn_s_barrier(); asm volatile("" ::: "memory");
        const bool sample = u.pm >= PM_S;
#pragma unroll
        for (int ai = 0; ai < 2; ++ai) {
            f32x4 pv[2];
            if (wr == 1 || ai == 1) { const int pai = (wr == 1) ? ai : 0, pwr = (wr == 1) ? 0 : 1; const PG8_LAS float* hp = lh + (((pai * 2 + pwr) * 2 + ((fr == 15) ? 1 : 0)) * 128 + lc);
                pv[0] = *(const PG8_LAS f32x4*)hp; pv[1] = *(const PG8_LAS f32x4*)(hp + 4); }
            else { pv[0] = (f32x4){0.f, 0.f, 0.f, 0.f}; pv[1] = pv[0]; }
#pragma unroll
            for (int m = 0; m < 4; ++m) {
                const int lrow = ai * HALF + wr * 64 + m * 16 + fr;
                f32x4 s0[2], s1[2];
                const int sidx = fr & 3;
                if (sample && ai == 0 && sidx <= 1) { const float* sp = st + (size_t)(lrow >> 2) * 2 * DFF + col;
#pragma unroll
                    for (int n = 0; n < 2; ++n) { s0[n] = *(const f32x4*)(sp + 4 * n); s1[n] = *(const f32x4*)(sp + DFF + 4 * n); } }
                else {
#pragma unroll
                    for (int n = 0; n < 2; ++n) { s0[n] = (f32x4){0.f, 0.f, 0.f, 0.f}; s1[n] = s0[n]; } }
                float y[8]; float gk[8], vk[8];
#pragma unroll
                for (int n = 0; n < 2; ++n)
#pragma unroll
                    for (int i = 0; i < 4; ++i) {
                        const float g = acc[ai][0][m][n][i], gp = (m == 0) ? pv[n][i] : acc[ai][0][m == 0 ? 0 : m - 1][n][i];
                        const float a1 = dpp_ror1(g), a2 = dpp_ror2(g), b1 = dpp_ror1(gp), b2 = dpp_ror2(gp);
                        float h1 = fr >= 1 ? a1 : b1, h2 = fr >= 2 ? a2 : b2;
                        if (sample && ai == 0) { if (sidx == 0) { h1 = s1[n][i]; h2 = s0[n][i]; } else if (sidx == 1) { h2 = s1[n][i]; } }
                        const float gc = w0[n][i] * h2 + w1[n][i] * h1 + w2[n][i] * g + cbv[n][i];
                        y[4 * n + i] = fast_silu(gc) * acc[ai][1][m][n][i]; gk[4 * n + i] = g; vk[4 * n + i] = acc[ai][1][m][n][i];
                    }
                const bool defer = !sample && lrow < 2 && (u.pm & 7) != 0;
                if (defer) {
                    float* fg = first_g + (size_t)(u.pm * 2 + lrow) * DFF + col; float* fv = first_v + (size_t)(u.pm * 2 + lrow) * DFF + col;
                    *(f32x4*)fg = (f32x4){gk[0], gk[1], gk[2], gk[3]}; *(f32x4*)(fg + 4) = (f32x4){gk[4], gk[5], gk[6], gk[7]};
                    *(f32x4*)fv = (f32x4){vk[0], vk[1], vk[2], vk[3]}; *(f32x4*)(fv + 4) = (f32x4){vk[4], vk[5], vk[6], vk[7]};
                } else {
                    u32x4 w; w.x = cvt_pk_bf16(y[0], y[1]); w.y = cvt_pk_bf16(y[2], y[3]); w.z = cvt_pk_bf16(y[4], y[5]); w.w = cvt_pk_bf16(y[6], y[7]);
                    *(u32x4*)(ACT + (size_t)(u.pm * BM + lrow) * DFF + col) = w;
                }
                if (sample && ai == 0 && sidx >= 2) { float* o = out + O_SFFN + (size_t)((layer * 32 + (lrow >> 2)) * 2 + (sidx - 2)) * DFF + col;
                    *(f32x4*)o = (f32x4){gk[0], gk[1], gk[2], gk[3]}; *(f32x4*)(o + 4) = (f32x4){gk[4], gk[5], gk[6], gk[7]}; }
            }
        }
    }
};
}

struct AttnOrder {
    int start, step;
    __device__ __forceinline__ bool next(int i, attn_body::AttnUnit& u) const { const int idx = start + i * step; if (idx >= 256) return false; u.bh = idx >> 3; u.qb = idx & 7; return true; }
    __device__ __forceinline__ void a_ready(const attn_body::AttnUnit&) const {}
    __device__ __forceinline__ void done(const attn_body::AttnUnit&) const {}
};

__global__ void __launch_bounds__(NWAVES * 64, 2) hybrid_fwd(Args A) {
    using namespace P;
    extern __shared__ __attribute__((aligned(16))) unsigned char lds[];
#define MKFRAME() Frame F; { F.lds = (LAS unsigned char*)lds; F.MISC = (volatile LAS unsigned*)(F.lds + MISC_OFF); F.tid = ltid(); F.lane = F.tid & 63; F.wave = __builtin_amdgcn_readfirstlane(F.tid >> 6); \
        F.G = lgrid(); const int bx_ = lbid(); F.vcu = (F.G % 8 == 0) ? (bx_ % 8) * (F.G / 8) + bx_ / 8 : bx_; F.ctl = (gu32*)(AWS + WS_CTL); }
    XcdBarrier bar;
    { for (int u = threadIdx.x; u < (LDS_BYTES - RING_BYTES) / 4; u += NWAVES * 64) ((LAS unsigned*)((LAS unsigned char*)lds + RING_BYTES))[u] = 0u;
      __syncthreads();
      if ((threadIdx.x & 63) == 0) ((LAS int*)((LAS unsigned char*)lds + LTID_TABLE_OFF))[hw_wave_slot()] = (int)(threadIdx.x >> 6);
      __syncthreads(); }
    { const int z = OPAQUE_ZERO(); MKFRAME();
      bar.bar = (unsigned*)(F.ctl + CW_BAR); bar.x = 0; bar.st = nullptr;
      if (!MK_PER_PHASE) bar = xcd_barrier_post((unsigned*)(F.ctl + CW_BAR), F.MISC + 8); }
    const int lo = A.ph_lo, hi = A.ph_hi;
#define IN(k) (lo <= (k) && (k) < hi)
#define SEAM(k) do { if (!MK_PER_PHASE && (k) + 1 < N_PHASES) xcd_barrier(bar); } while (0)
#define CLS(c) (!MK_PER_PHASE || A.pad == 0 || A.pad == 1 + (c))
#define GW() (F.vcu * NWAVES + F.wave)
#define NGW() (F.G * NWAVES)

    if (IN(0)) { const int z = OPAQUE_ZERO(); MKFRAME(); p0_prologue(A, z, F); SEAM(0); }

    for (int l = 0; l < DEPTH; ++l) {
        const int pb = 1 + PH_PER_LAYER * l;
        if (IN(pb + 0)) {
            const int z = OPAQUE_ZERO(); MKFRAME(); unsigned char* const ws = AWS; float* const out = AOUT;
            pg8::Gemm g{(const bf16*)(ws + WS_XB), (const bf16*)(ws + WS_WIN + l * SZ_WIN), MP, NIN, DM, DM}; pg8::StaticOrder S; S.init(MP, NIN, F.G, (int)lbid(), MK_WGM_IN);
            const float* fb_ = AIN(I_FBF) + 4 * l; pg8::EpiIn E{(bf16*)(ws + WS_H), (float*)(ws + WS_LRF), out, l, (float*)(ws + WS_LOGF), (pg8::f32x4){fb_[0], fb_[1], fb_[2], fb_[3]}};
            pg8::gemm_phase<pg8::EpiIn, pg8::StaticOrder, true, true>(F.lds, g, S, E);
            SEAM(pb + 0);
        }
        if (IN(pb + 1)) {
            constexpr int N_GL = 1024, N_SG = 512, N_CV = 512, N_CS = BATCH;
            { const int z = OPAQUE_ZERO(); MKFRAME();
              if (CLS(0)) for (int unit = F.vcu * NWAVES + F.wave; unit < DECB * NPAGES; unit += F.G * NWAVES) fox_page_wave(A, z, F, l, unit); }
            { const int z = OPAQUE_ZERO(); MKFRAME();
              if (CLS(4) && F.wave == 0) for (int unit = F.vcu; unit < N_CS; unit += F.G) fox_cumsum_wave(A, z, F, l, unit); }
            { const int z = OPAQUE_ZERO(); MKFRAME(); TeamBar tb{F.MISC + 16, 0u, 8u};
              if (CLS(1)) for (int it = 4 * F.vcu; it < N_GL; it += 4 * F.G) { LBAR(); gla_local_items<4>(A, z, F, l, it); }
              if (F.G == 256) {
                  if (CLS(2)) { LBAR(); sgu_items<2>(A, z, F, l, F.vcu, 256); }
                  if (CLS(3)) { LBAR(); conv_items<2>(A, z, F, l, F.vcu, 256); }
              } else {
                  if (CLS(2)) for (int it = F.vcu; it < N_SG; it += F.G) { LBAR(); sgu_items<1>(A, z, F, l, it, 0); }
                  if (CLS(3)) for (int it = F.vcu; it < N_CV; it += F.G) { LBAR(); conv_items<1>(A, z, F, l, it, 0); }
              } }
            SEAM(pb + 1);
        }
        if (IN(pb + 2)) {
            { const int z = OPAQUE_ZERO(); MKFRAME(); unsigned char* const ws = AWS; const bf16* Hb = (const bf16*)(ws + WS_H);
              const attn_body::AttnTensors AT{(const attn_body::bf16*)(Hb + HC_CQ), (const attn_body::bf16*)(Hb + HC_CK), (const attn_body::bf16*)(Hb + HC_CV), (attn_body::bf16*)(ws + WS_Y) + 512, (const float*)(ws + WS_KBIAS)};
              const AttnOrder S{F.vcu, F.G};
              if (CLS(0)) attn_body::attn_phase<AttnOrder>((char*)lds, AT, S); }
            const int z = OPAQUE_ZERO(); MKFRAME();
            const int shard = (int)lbid() & 7; gu32* head = F.ctl + CW_Q + 64 * (8 * (2 * l + A.qoff) + shard);
            const int nwc = l == 0 ? (WC::I_ALL - WC::I_IN + 63) / 64 * 8 : 0;
            const int nq = (3 * DECB + 1024 + nwc) / 8;
            int j = q_next(F, head);
            while (j < nq) {
                unsigned pend = 0u; if (F.tid == 0) pend = __hip_atomic_fetch_add(head, 1u, RLX_AGENT);
                int it = 8 * j + shard;
                if (it < 1024) { if (CLS(2)) gla_out_item(A, z, F, l, it); }
                else if ((it -= 1024) < DECB) { if (CLS(1)) sample_fox_item(A, z, F, l, it); }
                else if ((it -= DECB) < DECB) { if (CLS(1)) sample_gs_item(A, z, F, l, it); }
                else if ((it -= DECB) < DECB) { if (CLS(1)) sample_conv_item(A, z, F, l, it); }
                else { it -= DECB; const int wi = WC::I_IN + it * 8 + F.wave; if (wi < WC::I_ALL) wconv_wave_item(A, z, F, wi); }
                __syncthreads();
                if (F.tid == 0) F.MISC[0] = pend;
                __syncthreads();
                j = (int)F.MISC[0];
            }
            SEAM(pb + 2);
        }
        if (IN(pb + 3)) {
            const int z = OPAQUE_ZERO(); MKFRAME(); unsigned char* const ws = AWS;
            { pg8::Gemm g{(const bf16*)(ws + WS_Y), (const bf16*)(ws + WS_WO + l * SZ_WO), MPR, DM, DM, DM}; pg8::StaticOrder S; S.init(MPR, DM, F.G, (int)lbid());
              pg8::EpiRes E{(const bf16*)(ws + WS_XB), (bf16*)(ws + WS_Z), DM, ALPHA};
              pg8::gemm_phase<pg8::EpiRes, pg8::StaticOrder, true, true>(F.lds, g, S, E); }
            { pg8::Gemm g{(const bf16*)(ws + WS_Y), (const bf16*)(ws + WS_WO + l * SZ_WO), MP, DM, 128, DM}; const pg8::SliceOrder S{MPR / 256, DM / 256, 8, 128, F.G, (int)lbid()};
              pg8::EpiPart E{(float*)(ws + WS_PZ), DM, 128};
              pg8::gemm_phase<pg8::EpiPart, pg8::SliceOrder, true, true>(F.lds, g, S, E); }
            SEAM(pb + 3);
        }
        if (IN(pb + 4)) {
            const int z = OPAQUE_ZERO(); MKFRAME(); unsigned char* const ws = AWS;
            const LnIo io{(const bf16*)(ws + WS_Z), (const bf16*)(ws + WS_XB), (const float*)(ws + WS_PZ), 8, AIN(I_L1G) + l * DM, AIN(I_L1B) + l * DM, nullptr, nullptr, (bf16*)(ws + WS_X1B)};
            ln_phase(F, io);
            SEAM(pb + 4);
        }
        if (IN(pb + 5)) {
            const int z = OPAQUE_ZERO(); MKFRAME(); unsigned char* const ws = AWS;
            pg8::Gemm g{(const bf16*)(ws + WS_X1B), (const bf16*)(ws + WS_WUP + l * SZ_WUP), MP, NUP, DM, DM}; pg8::StaticOrder S; S.init(MP, NUP, F.G, (int)lbid(), MK_WGM_UP);
            pg8::EpiUpAct E{A, z, l};
            pg8::gemm_phase<pg8::EpiUpAct, pg8::StaticOrder, true, true>(F.lds, g, S, E);
            SEAM(pb + 5);
        }
        if (IN(pb + 6)) {
            const int z = OPAQUE_ZERO(); MKFRAME(); unsigned char* const ws = AWS;
            { pg8::Gemm g{(const bf16*)(ws + WS_ACT), (const bf16*)(ws + WS_WDN + l * SZ_WDN), MPR, DM, DFF, DFF}; pg8::StaticOrder S; S.init(MPR, DM, F.G, (int)lbid());
              { pg8::Unit u_; for (int i = 0; S.next(i, u_); ++i) act_fixup(A, z, F, l, u_.pm); }
              pg8::EpiRes E{(const bf16*)(ws + WS_X1B), (bf16*)(ws + WS_Z), DM, ALPHA};
              pg8::gemm_phase<pg8::EpiRes, pg8::StaticOrder, true, true>(F.lds, g, S, E); }
            { pg8::Gemm g{(const bf16*)(ws + WS_ACT), (const bf16*)(ws + WS_WDN + l * SZ_WDN), MP, DM, 384, DFF}; const pg8::SliceOrder S{MPR / 256, DM / 256, 7, 384, F.G, (int)lbid()};
              pg8::EpiPart E{(float*)(ws + WS_PZ), DM, 384};
              pg8::gemm_phase<pg8::EpiPart, pg8::SliceOrder, true, true>(F.lds, g, S, E); }
            SEAM(pb + 6);
        }
        if (IN(pb + 7)) {
            const int z = OPAQUE_ZERO(); MKFRAME(); unsigned char* const ws = AWS; float* const out = AOUT; const bool last = l + 1 == DEPTH;
            const LnIo io{(const bf16*)(ws + WS_Z), (const bf16*)(ws + WS_X1B), (const float*)(ws + WS_PZ), 7, AIN(I_L2G) + l * DM, AIN(I_L2B) + l * DM, last ? out + O_YP : nullptr, last ? out + O_YS : nullptr, last ? nullptr : (bf16*)(ws + WS_XB)};
            ln_phase(F, io);
            SEAM(pb + 7);
        }
    }
#undef IN
#undef SEAM
#undef GW
#undef NGW
#undef CLS
#undef MKFRAME
}

extern "C" void kernel_launch(void* const* d_in, const int* in_sizes, int n_in, void* d_out, int out_size, void* d_ws, size_t ws_size, hipStream_t stream) {
    using namespace P;
    static int grid = 0;
    if (grid == 0) {
        if (n_in != N_IN || (size_t)out_size != O_END || ws_size < WS_END) { fprintf(stderr, "kernel_launch: unexpected shapes: n_in %d out %d ws %zu (need %zu)\n", n_in, out_size, ws_size, (size_t)WS_END); grid = -1; return; }
        int dev = 0, cus = 0, per_cu = 0;
        if (hipGetDevice(&dev) != hipSuccess || hipDeviceGetAttribute(&cus, hipDeviceAttributeMultiprocessorCount, dev) != hipSuccess) { grid = -1; return; }
        if (hipFuncSetAttribute((const void*)hybrid_fwd, hipFuncAttributeMaxDynamicSharedMemorySize, LDS_BYTES) != hipSuccess) { fprintf(stderr, "kernel_launch: hipFuncSetAttribute failed\n"); grid = -1; return; }
        if (hipOccupancyMaxActiveBlocksPerMultiprocessor(&per_cu, (const void*)hybrid_fwd, NWAVES * 64, LDS_BYTES) != hipSuccess || per_cu < 1)
            fprintf(stderr, "kernel_launch: note: occupancy query reports %d workgroups per CU\n", per_cu);
        (void)hipGetLastError();
        grid = cus;
    }
    if (grid < 0) return;
    if (hipMemsetAsync((char*)d_ws + WS_CTL, 0, CTL_ZERO_BYTES, stream) != hipSuccess) { fprintf(stderr, "kernel_launch: memset failed\n"); return; }
    Args a{};
    for (int i = 0; i < N_IN; ++i) a.p[i] = (const float*)d_in[i];
    a.p[N_IN] = (const float*)d_out; a.p[N_IN + 1] = (const float*)d_ws;
#if MK_PER_PHASE
    for (int p = 0; p < N_PHASES; ++p) { const int type = p == 0 ? 0 : 1 + (p - 1) % PH_PER_LAYER; const int reps = 1 + ((MK_REP_MASK >> type) & 1);
        for (int r = 0; r < reps; ++r) { a.ph_lo = p; a.ph_hi = p + 1; a.qoff = r; a.pad = r ? MK_REP_CLASS : 0; hipLaunchKernelGGL(hybrid_fwd, dim3(grid), dim3(NWAVES * 64), LDS_BYTES, stream, a); } }
#else
    a.ph_lo = 0; a.ph_hi = N_PHASES;
    hipLaunchKernelGGL(hybrid_fwd, dim3(grid), dim3(NWAVES * 64), LDS_BYTES, stream, a);
#endif
    const hipError_t le = hipPeekAtLastError();
    if (le != hipSuccess) fprintf(stderr, "kernel_launch: launch failed: %s\n", hipGetErrorName(le));
}
```

```cpp
#include <hip/hip_runtime.h>
#include <cstdio>
#include <cstdint>
#define LTID_TABLE_OFF (131072 + 1024)
__device__ __forceinline__ unsigned hw_wave_slot() { return (unsigned)__builtin_amdgcn_s_getreg((5 << 11) | 4) & 63u; }
__device__ __forceinline__ int ltid() {
    extern __shared__ __attribute__((aligned(16))) unsigned char lds[];
    const int w = __builtin_amdgcn_readfirstlane(((const __attribute__((address_space(3))) int*)((__attribute__((address_space(3))) unsigned char*)lds + LTID_TABLE_OFF))[hw_wave_slot()]);
    int lane; asm volatile("v_mbcnt_lo_u32_b32 %0, -1, 0\n\tv_mbcnt_hi_u32_b32 %0, -1, %0" : "=v"(lane));
    return w * 64 + lane; }
__device__ __forceinline__ int lbid() { int t = blockIdx.x; asm volatile("" : "+s"(t)); return t; }
__device__ __forceinline__ int lgrid() { int t = gridDim.x; asm volatile("" : "+s"(t)); return t; }
namespace pg8 {
#define PG8_LAS __attribute__((address_space(3)))
typedef unsigned short bf16_t;
typedef short bf16x8 __attribute__((ext_vector_type(8)));
typedef float f32x4 __attribute__((ext_vector_type(4)));
typedef unsigned u32x4 __attribute__((ext_vector_type(4)));
constexpr int BM = 256, BK = 64, HALF = 128, HTB = HALF * BK * 2  , STAGE_BYTES = 8 * HTB, NXCD = 8, WGM = 4;

__host__ __device__ __forceinline__ int lds_byte(int r, int c) { const int st = (r >> 4) * 2 + (c >> 5), rr = r & 15, cc = c & 31, ob = rr * 64 + cc * 2; return st * 1024 + (ob ^ (((ob >> 9) & 1) << 5)); }
__host__ __device__ __forceinline__ void stage_rc(int b, int& R, int& C) { const int st = b / 1024, sb = b % 1024, swz = sb ^ (((sb >> 9) & 1) << 5); R = (st >> 1) * 16 + swz / 64; C = (st & 1) * 32 + (swz % 64) / 2; }
__host__ __device__ __forceinline__ int perm32(int rho) { const int n = rho >> 4, i = rho & 15; return 8 * (i >> 2) + 4 * n + (i & 3); }

struct Unit { int pm, pn, k0; };
struct Gemm { const bf16_t* A; const bf16_t* Bt; int M, N, K, ld; };

struct StaticOrder {
    int nM, nN, nwg, G, c, wgm;
    __host__ __device__ __forceinline__ void init(int M, int N, int G_, int c_, int wgm_ = WGM) { nM = M / BM; nN = N / BM; nwg = nM * nN; G = G_; c = c_; wgm = wgm_; }
    __host__ __device__ __forceinline__ bool next(int i, Unit& u) const {
        const long L = (long)i * G + c; if (L >= nwg) return false;
        int wgid = (int)L; { const int q = nwg / NXCD, r = nwg % NXCD, xcd = wgid % NXCD, off = wgid / NXCD; wgid = (xcd < r ? xcd * (q + 1) : r * (q + 1) + (xcd - r) * q) + off; }
        const int nig = wgm * nN, gid = wgid / nig, fm = gid * wgm, gsz = (nM - fm) < wgm ? (nM - fm) : wgm;
        u.pm = fm + ((wgid % nig) % gsz); u.pn = (wgid % nig) / gsz; u.k0 = 0; return true;
    }
    __device__ __forceinline__ void a_ready(const Unit&) const {}
    __device__ __forceinline__ void done(const Unit&) const {}
};

struct SliceOrder {
    int pm, nN, nS, kslice, G, c;
    __host__ __device__ __forceinline__ bool next(int i, Unit& u) const { const int L = i * G + c; if (L >= nN * nS) return false; u.pm = pm; u.pn = L % nN; u.k0 = (L / nN) * kslice; return true; }
    __device__ __forceinline__ void a_ready(const Unit&) const {}
    __device__ __forceinline__ void done(const Unit&) const {}
};

__device__ __forceinline__ unsigned cvt_pk_bf16(float lo, float hi) { unsigned r; asm volatile("v_cvt_pk_bf16_f32 %0, %1, %2" : "=v"(r) : "v"(lo), "v"(hi)); return r; }
typedef float f32x2 __attribute__((ext_vector_type(2)));

struct EpiBf16 {
    static constexpr bool PERM = true, AFTER_DRAIN = false;
    bf16_t* O; int ldc;
    __device__ __forceinline__ void operator()(const f32x4 (&acc)[2][2][4][2], const Unit& u, int wr, int wc, int fr, int fq) const {
        const int row0 = u.pm * BM + wr * 64 + fr; const int col0 = u.pn * BM + wc * 32 + 8 * fq;
#pragma unroll
        for (int ai = 0; ai < 2; ++ai)
#pragma unroll
            for (int m = 0; m < 4; ++m) { bf16_t* rowp = O + (size_t)(row0 + ai * HALF + m * 16) * ldc + col0;
#pragma unroll
                for (int bj = 0; bj < 2; ++bj) { const f32x4 v0 = acc[ai][bj][m][0], v1 = acc[ai][bj][m][1];
                    u32x4 w; w.x = cvt_pk_bf16(v0[0], v0[1]); w.y = cvt_pk_bf16(v0[2], v0[3]); w.z = cvt_pk_bf16(v1[0], v1[1]); w.w = cvt_pk_bf16(v1[2], v1[3]);
                    *(u32x4*)(rowp + bj * HALF) = w; } }
    }
};
struct EpiIn {
    static constexpr bool PERM = true, AFTER_DRAIN = false;
    bf16_t* H; float* lrf; float* out; int layer; float* logf; f32x4 fbf;
    static constexpr int ldc = 2816, pm_sample = 64; static constexpr float qscale = 0.125f * 1.4426950408889634f;
    static constexpr size_t O_PFK = 16908288, O_PFV = O_PFK + 8388608, O_PFL = O_PFV + 8388608, O_SFK = 34156544, O_SFV = O_SFK + 65536;
    __device__ __forceinline__ void operator()(const f32x4 (&acc)[2][2][4][2], const Unit& u, int wr, int wc, int fr, int fq) const {
        const int row0 = u.pm * BM + wr * 64 + fr; const int col0 = u.pn * BM + wc * 32 + 8 * fq;
        const float sc = (u.pn == 5) ? qscale : 1.f;
#pragma unroll
        for (int ai = 0; ai < 2; ++ai)
#pragma unroll
            for (int m = 0; m < 4; ++m) { bf16_t* rowp = H + (size_t)(row0 + ai * HALF + m * 16) * ldc + col0;
#pragma unroll
                for (int bj = 0; bj < 2; ++bj) { const f32x4 v0 = acc[ai][bj][m][0] * sc, v1 = acc[ai][bj][m][1] * sc;
                    u32x4 w; w.x = cvt_pk_bf16(v0[0], v0[1]); w.y = cvt_pk_bf16(v0[2], v0[3]); w.z = cvt_pk_bf16(v1[0], v1[1]); w.w = cvt_pk_bf16(v1[2], v1[3]);
                    *(u32x4*)(rowp + bj * HALF) = w; } }
        if (u.pn == 6 || u.pn == 7) {
            const int lcol0 = wc * 32 + 8 * fq;
#pragma unroll
            for (int ai = 0; ai < 2; ++ai) {
                float* dst; int rbase;
                if (u.pm < pm_sample) { dst = out + ((u.pn == 6) ? O_PFK : O_PFV) + (size_t)layer * (16384 * 256); rbase = u.pm * BM; }
                else { if (ai == 1) continue; dst = out + ((u.pn == 6) ? O_SFK : O_SFV) + (size_t)layer * (128 * 256); rbase = 0; }
#pragma unroll
                for (int m = 0; m < 4; ++m) { float* rowp = dst + (size_t)(rbase + wr * 64 + fr + ai * HALF + m * 16) * 256 + lcol0;
#pragma unroll
                    for (int bj = 0; bj < 2; ++bj) { *(f32x4*)(rowp + bj * HALF) = acc[ai][bj][m][0]; *(f32x4*)(rowp + bj * HALF + 4) = acc[ai][bj][m][1]; } }
            }
        }
        if (u.pn == 10 && wc == 0) {
#pragma unroll
            for (int ai = 0; ai < 2; ++ai)
#pragma unroll
                for (int m = 0; m < 4; ++m) { const int row = row0 + ai * HALF + m * 16; float* rowp = lrf + (size_t)row * 32 + 8 * fq;
                    *(f32x4*)(rowp) = acc[ai][0][m][0]; *(f32x4*)(rowp + 4) = acc[ai][0][m][1];
                    if (fq == 2 && row < 16384) {
                        f32x4 lf;
#pragma unroll
                        for (int i = 0; i < 4; ++i) { const float x = acc[ai][0][m][0][i] + fbf[i]; lf[i] = fminf(x, 0.f) - log1pf(expf(-fabsf(x))); }
                        *(f32x4*)(logf + (size_t)row * 4) = lf; *(f32x4*)(out + O_PFL + ((size_t)layer * 16384 + row) * 4) = lf; } }
        }
    }
};
struct EpiRes {
    static constexpr bool PERM = true, AFTER_DRAIN = false;
    const bf16_t* R; bf16_t* Z; int ldc; float alpha;
    __device__ __forceinline__ void operator()(const f32x4 (&acc)[2][2][4][2], const Unit& u, int wr, int wc, int fr, int fq) const {
        const int row0 = u.pm * BM + wr * 64 + fr; const int col0 = u.pn * BM + wc * 32 + 8 * fq;
#pragma unroll
        for (int ai = 0; ai < 2; ++ai)
#pragma unroll
            for (int m = 0; m < 4; ++m) { const size_t off = (size_t)(row0 + ai * HALF + m * 16) * ldc + col0;
#pragma unroll
                for (int bj = 0; bj < 2; ++bj) { const u32x4 r = *(const u32x4*)(R + off + bj * HALF); const f32x4 a0 = acc[ai][bj][m][0], a1 = acc[ai][bj][m][1];
                    u32x4 w; w.x = cvt_pk_bf16(__uint_as_float(r.x << 16) * alpha + a0[0], __uint_as_float(r.x & 0xffff0000u) * alpha + a0[1]); w.y = cvt_pk_bf16(__uint_as_float(r.y << 16) * alpha + a0[2], __uint_as_float(r.y & 0xffff0000u) * alpha + a0[3]);
                    w.z = cvt_pk_bf16(__uint_as_float(r.z << 16) * alpha + a1[0], __uint_as_float(r.z & 0xffff0000u) * alpha + a1[1]); w.w = cvt_pk_bf16(__uint_as_float(r.w << 16) * alpha + a1[2], __uint_as_float(r.w & 0xffff0000u) * alpha + a1[3]);
                    *(u32x4*)(Z + off + bj * HALF) = w; } }
    }
};
struct EpiPart {
    static constexpr bool PERM = false, AFTER_DRAIN = false;
    float* PZ; int ldc, kslice;
    __device__ __forceinline__ void operator()(const f32x4 (&acc)[2][2][4][2], const Unit& u, int wr, int wc, int fr, int fq) const {
        const int col0 = u.pn * BM + wc * 32 + 4 * fq; float* base = PZ + (size_t)(u.k0 / kslice) * 128 * ldc;
#pragma unroll
        for (int m = 0; m < 4; ++m) { const size_t off = (size_t)(wr * 64 + m * 16 + fr) * ldc + col0;
#pragma unroll
            for (int bj = 0; bj < 2; ++bj)
#pragma unroll
                for (int n = 0; n < 2; ++n) *(f32x4*)(base + off + bj * HALF + n * 16) = acc[0][bj][m][n]; }
    }
};

template <class Epi, class Sched, bool ALIGN_EPI = false, bool SP2 = false>
__device__ __forceinline__ void gemm_phase(PG8_LAS unsigned char* lds, const Gemm g, const Sched& S, const Epi& E) {
    const int tid = ltid(), wid = __builtin_amdgcn_readfirstlane(tid >> 6), lane = tid & 63, wr = wid >> 2, wc = wid & 3, fr = lane & 15, fq = lane >> 4;
    const int K = g.K, nt = K / BK, LD = g.ld;
    unsigned voffA[2], voffB[2];
#pragma unroll
    for (int i = 0; i < 2; ++i) { int R, C; stage_rc(tid * 16 + i * 8192, R, C); const int Rb = Epi::PERM ? ((R & ~31) + perm32(R & 31)) : R;
        voffA[i] = (unsigned)(R * LD + C) * 2u; voffB[i] = (unsigned)(Rb * LD + C) * 2u; }
    const size_t kstep = (size_t)(BK * 2);
    const size_t hstep = (size_t)HALF * LD * 2;
    const size_t tstep = 2 * hstep;
    const unsigned ldsw = (unsigned)wid * 1024u;
    const int aoff = lds_byte(wr * 64 + fr, fq * 8), boff = lds_byte(wc * 32 + fr, fq * 8);
#define PG8_SA(b, h) (((b) * 2 + (h)) * HTB)
#define PG8_SB(b, h) ((4 + (b) * 2 + (h)) * HTB)
#define PG8_STAGE(bufoff, gbase, voff) do { _Pragma("unroll") for (int _i = 0; _i < 2; ++_i) \
        __builtin_amdgcn_global_load_lds((const unsigned*)((const char*)(gbase) + (voff)[_i]), (PG8_LAS unsigned*)(lds + (bufoff) + ldsw + _i * 8192), 16, 0, 0); } while (0)
#define PG8_LDA(dst, b, h) do { _Pragma("unroll") for (int m = 0; m < 4; ++m) _Pragma("unroll") for (int k = 0; k < 2; ++k) dst[m][k] = *(const PG8_LAS bf16x8*)(lds + PG8_SA(b, h) + aoff + m * 2048 + k * 1024); } while (0)
#define PG8_LDB(dst, b, h) do { _Pragma("unroll") for (int n = 0; n < 2; ++n) _Pragma("unroll") for (int k = 0; k < 2; ++k) dst[n][k] = *(const PG8_LAS bf16x8*)(lds + PG8_SB(b, h) + boff + n * 2048 + k * 1024); } while (0)
#define PG8_MMA(ai, bj, At, Bt) do { __builtin_amdgcn_s_setprio(1); _Pragma("unroll") for (int m = 0; m < 4; ++m) _Pragma("unroll") for (int n = 0; n < 2; ++n) _Pragma("unroll") for (int k = 0; k < 2; ++k) \
        acc[ai][bj][m][n] = __builtin_amdgcn_mfma_f32_16x16x32_bf16(Bt[n][k], At[m][k], acc[ai][bj][m][n], 0, 0, 0); __builtin_amdgcn_s_setprio(0); } while (0)
#define PG8_WAIT_V(n) asm volatile("s_waitcnt vmcnt(" #n ")" ::: "memory")
#define PG8_WAIT_L(n) asm volatile("s_waitcnt lgkmcnt(" #n ")" ::: "memory")
#define PG8_BAR __builtin_amdgcn_s_barrier()
#define PG8_SCHED __builtin_amdgcn_sched_barrier(0)
    Unit cur, nxt; int ui = 0;
    if (!S.next(0, cur)) return;
    f32x4 acc[2][2][4][2];
#pragma unroll
    for (int a = 0; a < 2; ++a)
#pragma unroll
        for (int b = 0; b < 2; ++b)
#pragma unroll
            for (int m = 0; m < 4; ++m)
#pragma unroll
                for (int n = 0; n < 2; ++n) acc[a][b][m][n] = (f32x4){0.f, 0.f, 0.f, 0.f};
    bf16x8 At[4][2], B0[2][2], B1[2][2];
    const char* cA = (const char*)g.A + (size_t)cur.pm * tstep + (size_t)cur.k0 * 2; const char* cB = (const char*)g.Bt + (size_t)cur.pn * tstep + (size_t)cur.k0 * 2;
    S.a_ready(cur);
    if constexpr (SP2) {
        PG8_STAGE(PG8_SB(0, 0), cB, voffB); PG8_STAGE(PG8_SB(0, 1), cB + hstep, voffB); PG8_STAGE(PG8_SA(0, 0), cA, voffA); PG8_STAGE(PG8_SA(0, 1), cA + hstep, voffA);
        if (wr == 1) PG8_BAR;
        PG8_WAIT_V(2); PG8_BAR;
        PG8_STAGE(PG8_SB(1, 0), cB + kstep, voffB); PG8_STAGE(PG8_SA(1, 0), cA + kstep, voffA); PG8_STAGE(PG8_SB(1, 1), cB + hstep + kstep, voffB);
        PG8_WAIT_V(6); PG8_BAR;
    } else {
        PG8_STAGE(PG8_SB(0, 0), cB, voffB); PG8_STAGE(PG8_SA(0, 0), cA, voffA); PG8_STAGE(PG8_SB(0, 1), cB + hstep, voffB); PG8_STAGE(PG8_SA(0, 1), cA + hstep, voffA);
        if (wr == 1) PG8_BAR;
        PG8_WAIT_V(4); PG8_BAR;
        PG8_STAGE(PG8_SB(1, 0), cB + kstep, voffB); PG8_STAGE(PG8_SA(1, 0), cA + kstep, voffA); PG8_STAGE(PG8_SB(1, 1), cB + hstep + kstep, voffB);
        PG8_WAIT_V(6); PG8_BAR;
    }
    for (;;) {
        const bool has_next = S.next(ui + 1, nxt);
        const char* nA = has_next ? (const char*)g.A + (size_t)nxt.pm * tstep + (size_t)nxt.k0 * 2 : cA; const char* nB = has_next ? (const char*)g.Bt + (size_t)nxt.pn * tstep + (size_t)nxt.k0 * 2 : cB;
        for (int t = 0; t < nt; t += 2) {
            const bool last = (t == nt - 2);
            const char* a1 = cA + (size_t)(t + 1) * kstep;
            const char* a2 = last ? nA : cA + (size_t)(t + 2) * kstep; const char* b2 = last ? nB : cB + (size_t)(t + 2) * kstep;
            const char* a3 = a2 + kstep; const char* b3 = b2 + kstep;
            if (last && has_next) S.a_ready(nxt);
            if constexpr (SP2) {
            PG8_LDB(B0, 0, 0); PG8_LDB(B1, 0, 1); PG8_SCHED; PG8_LDA(At, 0, 0); PG8_STAGE(PG8_SA(1, 1), a1 + hstep, voffA);
            PG8_WAIT_V(8); PG8_WAIT_L(0); PG8_BAR; PG8_MMA(0, 0, At, B0); PG8_MMA(0, 1, At, B1); PG8_BAR; PG8_SCHED;
            PG8_LDA(At, 0, 1); PG8_STAGE(PG8_SB(0, 0), b2, voffB); PG8_STAGE(PG8_SB(0, 1), b2 + hstep, voffB); PG8_STAGE(PG8_SA(0, 0), a2, voffA);
            PG8_WAIT_V(8); PG8_WAIT_L(0); PG8_BAR; PG8_MMA(1, 0, At, B0); PG8_MMA(1, 1, At, B1); PG8_BAR; PG8_SCHED;
            PG8_LDB(B0, 1, 0); PG8_LDB(B1, 1, 1); PG8_SCHED; PG8_LDA(At, 1, 0); PG8_STAGE(PG8_SA(0, 1), a2 + hstep, voffA);
            PG8_WAIT_V(8); PG8_WAIT_L(0); PG8_BAR; PG8_MMA(0, 0, At, B0); PG8_MMA(0, 1, At, B1); PG8_BAR; PG8_SCHED;
            PG8_LDA(At, 1, 1); PG8_STAGE(PG8_SB(1, 0), b3, voffB); PG8_STAGE(PG8_SB(1, 1), b3 + hstep, voffB); PG8_STAGE(PG8_SA(1, 0), a3, voffA);
            PG8_WAIT_V(8); PG8_WAIT_L(0); PG8_BAR; PG8_MMA(1, 0, At, B0); PG8_MMA(1, 1, At, B1); PG8_BAR; PG8_SCHED;
            } else {
            PG8_LDB(B0, 0, 0); PG8_SCHED; PG8_LDA(At, 0, 0); PG8_STAGE(PG8_SA(1, 1), a1 + hstep, voffA);
            PG8_WAIT_L(8); PG8_BAR; PG8_WAIT_L(0); PG8_MMA(0, 0, At, B0); PG8_BAR; PG8_SCHED;
            PG8_LDB(B1, 0, 1); PG8_STAGE(PG8_SB(0, 0), b2, voffB);
            PG8_BAR; PG8_WAIT_L(0); PG8_MMA(0, 1, At, B1); PG8_BAR;
            PG8_LDA(At, 0, 1); PG8_STAGE(PG8_SA(0, 0), a2, voffA);
            PG8_BAR; PG8_WAIT_L(0); PG8_MMA(1, 0, At, B0); PG8_BAR; PG8_SCHED;
            PG8_STAGE(PG8_SB(0, 1), b2 + hstep, voffB);
            PG8_WAIT_V(6); PG8_BAR; PG8_MMA(1, 1, At, B1); PG8_BAR;
            PG8_LDB(B0, 1, 0); PG8_SCHED; PG8_LDA(At, 1, 0); PG8_STAGE(PG8_SA(0, 1), a2 + hstep, voffA);
            PG8_WAIT_L(8); PG8_BAR; PG8_WAIT_L(0); PG8_MMA(0, 0, At, B0); PG8_BAR; PG8_SCHED;
            PG8_LDB(B1, 1, 1); PG8_STAGE(PG8_SB(1, 0), b3, voffB);
            PG8_BAR; PG8_WAIT_L(0); PG8_MMA(0, 1, At, B1); PG8_BAR;
            PG8_LDA(At, 1, 1); PG8_STAGE(PG8_SA(1, 0), a3, voffA);
            PG8_BAR; PG8_WAIT_L(0); PG8_MMA(1, 0, At, B0); PG8_BAR; PG8_SCHED;
            PG8_STAGE(PG8_SB(1, 1), b3 + hstep, voffB);
            PG8_WAIT_V(6); PG8_BAR; PG8_MMA(1, 1, At, B1); PG8_BAR;
            }
        }
        if constexpr (ALIGN_EPI) { if (wr == 0) PG8_BAR; }
        if constexpr (!Epi::AFTER_DRAIN) { E(acc, cur, wr, wc, fr, fq); S.done(cur); }
        if (!has_next) break;
#pragma unroll
        for (int a = 0; a < 2; ++a)
#pragma unroll
            for (int b = 0; b < 2; ++b)
#pragma unroll
                for (int m = 0; m < 4; ++m)
#pragma unroll
                    for (int n = 0; n < 2; ++n) acc[a][b][m][n] = (f32x4){0.f, 0.f, 0.f, 0.f};
        cur = nxt; cA = nA; cB = nB; ++ui;
        if constexpr (ALIGN_EPI) { if (wr == 1) PG8_BAR; }
    }
    PG8_WAIT_V(0);
    if constexpr (!ALIGN_EPI) { if (wr == 0) PG8_BAR; }
    PG8_BAR;
    if constexpr (Epi::AFTER_DRAIN) { E.fused(acc, cur, wr, wc, fr, fq, lds, wid, lane); S.done(cur); }
#undef PG8_SA
#undef PG8_SB
#undef PG8_STAGE
#undef PG8_LDA
#undef PG8_LDB
#undef PG8_MMA
#undef PG8_WAIT_V
#undef PG8_WAIT_L
#undef PG8_BAR
#undef PG8_SCHED
}
}

#ifndef PG8_SP2
#define PG8_SP2 true
#endif

#include <hip/hip_bf16.h>
#include <cmath>
namespace attn_body {
using bf16=__hip_bfloat16;
using bf16x8=__attribute__((ext_vector_type(8)))short;
using s16x4=__attribute__((ext_vector_type(4)))short;
using f32x16=__attribute__((ext_vector_type(16)))float;
using u32x4=__attribute__((ext_vector_type(4)))unsigned;
constexpr int BATCH=8,NHEAD=4,SEQ=2048,D=64,DM=2816,DMO=1024;
constexpr int NW=8,QBLK=32,QB=QBLK*NW,KVBLK=64,NQB=SEQ/QB;
constexpr int ATTN_PITCH=DM, ATTN_UNIT_ROWS=QB;
__device__ __forceinline__ int crow(int r,int hi){return (r&3)+8*(r>>2)+4*hi;}
#define SBAR() __builtin_amdgcn_sched_barrier(0)
__device__ __forceinline__ void cmask(f32x16&p0,f32x16&p1,int jb,int qrel,int hi){
  const float NEG=-INFINITY; int kb=64*jb+4*hi;
  #pragma unroll
  for(int r=0;r<16;++r){int kv=kb+(r&3)+8*(r>>2); if(kv>qrel)p0[r]=NEG; if(kv+32>qrel)p1[r]=NEG;}
}

constexpr int NSLOT=3, SLOTB=8192;
constexpr int LDS_K=0, LDS_V=NSLOT*SLOTB, LDS_WS=2*NSLOT*SLOTB, LDS_OST=LDS_WS+NW*64*4, LDS_KB=LDS_OST+NW*4096, LDS_BYTES=LDS_KB+SEQ*4;
constexpr float C2=0.125f*1.4426950408889634f;
__device__ __forceinline__ void glds16(const void*gsrc,unsigned lds_dst){unsigned keep;
  asm volatile("s_mov_b32 %0, m0\n\ts_mov_b32 m0, %2\n\ts_nop 0\n\tglobal_load_lds_dwordx4 %1, off\n\ts_mov_b32 m0, %0":"=&s"(keep):"v"(gsrc),"s"(lds_dst):"memory");}
__device__ __forceinline__ float max3f(float a,float b,float c){float r;asm("v_max3_f32 %0, %1, %2, %3":"=v"(r):"v"(a),"v"(b),"v"(c));return r;}
__device__ __forceinline__ float max2f(float a,float b){float r;asm("v_max_f32_e32 %0, %1, %2":"=v"(r):"v"(a),"v"(b));return r;}
__device__ __forceinline__ float fadd_s(float a,float b){float r;asm("v_add_f32_e32 %0, %1, %2":"=v"(r):"v"(a),"v"(b));return r;}
__device__ __forceinline__ float fsub_s(float a,float b){float r;asm("v_sub_f32_e32 %0, %1, %2":"=v"(r):"v"(a),"v"(b));return r;}
typedef float f32x2_t __attribute__((ext_vector_type(2))); typedef __bf16 bf16x2_t __attribute__((ext_vector_type(2)));
__device__ __forceinline__ unsigned cvtpk_s(float lo,float hi){f32x2_t v={lo,hi};bf16x2_t b=__builtin_convertvector(v,bf16x2_t);return __builtin_bit_cast(unsigned,b);}
#define WAIT_BAR(N) asm volatile("s_waitcnt vmcnt(" #N ") lgkmcnt(0)\n\ts_barrier":::"memory")

__device__ __forceinline__ void qkt(f32x16&p0,f32x16&p1,const char*Kslot,const bf16x8*qr,const f32x16&c0,const f32x16&c1,int r32,int hi){
  const char*kb=Kslot+hi*1024+r32*16;
  #pragma unroll
  for(int d0=0;d0<4;++d0){
    const bf16x8 b0=*reinterpret_cast<const bf16x8*>(kb+d0*2048);
    const bf16x8 b1=*reinterpret_cast<const bf16x8*>(kb+d0*2048+512);
    if(d0==0){p0=__builtin_amdgcn_mfma_f32_32x32x16_bf16(b0,qr[0],c0,0,0,0);p1=__builtin_amdgcn_mfma_f32_32x32x16_bf16(b1,qr[0],c1,0,0,0);}
    else{p0=__builtin_amdgcn_mfma_f32_32x32x16_bf16(b0,qr[d0],p0,0,0,0);p1=__builtin_amdgcn_mfma_f32_32x32x16_bf16(b1,qr[d0],p1,0,0,0);}}
}
typedef __attribute__((address_space(3))) const char* lds_cptr;
typedef short v4i16_t __attribute__((ext_vector_type(4)));
__device__ __forceinline__ void kload8(bf16x8*kf,lds_cptr kp){
  kf[0]=*(const __attribute__((address_space(3))) bf16x8*)(kp);      kf[1]=*(const __attribute__((address_space(3))) bf16x8*)(kp+512);
  kf[2]=*(const __attribute__((address_space(3))) bf16x8*)(kp+2048); kf[3]=*(const __attribute__((address_space(3))) bf16x8*)(kp+2560);
  kf[4]=*(const __attribute__((address_space(3))) bf16x8*)(kp+4096); kf[5]=*(const __attribute__((address_space(3))) bf16x8*)(kp+4608);
  kf[6]=*(const __attribute__((address_space(3))) bf16x8*)(kp+6144); kf[7]=*(const __attribute__((address_space(3))) bf16x8*)(kp+6656);
}
__device__ __forceinline__ void kload2(bf16x8*kf,lds_cptr kp,int j){ kf[2*j]=*(const __attribute__((address_space(3))) bf16x8*)(kp+j*2048); kf[2*j+1]=*(const __attribute__((address_space(3))) bf16x8*)(kp+j*2048+512); }
__device__ __forceinline__ s16x4 vtr(lds_cptr p){ return __builtin_bit_cast(s16x4,__builtin_amdgcn_ds_read_tr16_b64_v4i16((__attribute__((address_space(3))) v4i16_t*)p)); }
__device__ __forceinline__ float rowmax(const f32x16&p0,const f32x16&p1){
  float a=max3f(p0[0],p0[1],p1[0]),b=max3f(p0[2],p0[3],p1[1]);a=max3f(a,p1[2],p1[3]);
  #pragma unroll
  for(int r=4;r<16;r+=4){a=max3f(a,p0[r],p0[r+1]);b=max3f(b,p0[r+2],p0[r+3]);a=max3f(a,p1[r],p1[r+1]);b=max3f(b,p1[r+2],p1[r+3]);}
  const float m=max2f(a,b);
  auto rr=__builtin_amdgcn_permlane32_swap(__float_as_uint(m),__float_as_uint(m),false,false);
  return max2f(__uint_as_float(rr[0]),__uint_as_float(rr[1]));
}
__device__ __forceinline__ void pv(f32x16*o,int vb,bf16x8 pa0,bf16x8 pa1,bf16x8 pa2,bf16x8 pa3){
  #pragma unroll
  for(int d0=0;d0<2;++d0){s16x4 lo[4],hi[4];
    #pragma unroll
    for(int ks=0;ks<4;++ks){
      asm volatile("ds_read_b64_tr_b16 %0,%1 offset:%c2":"=&v"(lo[ks]):"v"(vb),"i"(d0*4096+ks*1024):"memory");
      asm volatile("ds_read_b64_tr_b16 %0,%1 offset:%c2":"=&v"(hi[ks]):"v"(vb),"i"(d0*4096+ks*1024+512):"memory");}
    asm volatile("s_waitcnt lgkmcnt(0)":::"memory");SBAR();
    #define PK(k) (bf16x8){lo[k][0],lo[k][1],lo[k][2],lo[k][3],hi[k][0],hi[k][1],hi[k][2],hi[k][3]}
    o[d0]=__builtin_amdgcn_mfma_f32_32x32x16_bf16(pa0,PK(0),o[d0],0,0,0);
    o[d0]=__builtin_amdgcn_mfma_f32_32x32x16_bf16(pa1,PK(1),o[d0],0,0,0);
    o[d0]=__builtin_amdgcn_mfma_f32_32x32x16_bf16(pa2,PK(2),o[d0],0,0,0);
    o[d0]=__builtin_amdgcn_mfma_f32_32x32x16_bf16(pa3,PK(3),o[d0],0,0,0);
    #undef PK
  }
}

#ifndef ATTN_STORE16
#define ATTN_STORE16(p,v) (*(u32x4*)(p)=(v))
#endif
template<int THRL> __device__ __forceinline__ void attn_unit(int b,int h,int qb,const bf16*Q,const bf16*__restrict__ K,const bf16*__restrict__ V,bf16*O,const float*__restrict__ KBg,char*shm){
  const int tid=ltid(),lane=tid&63,r32=lane&31,hi=lane>>5; const int wid=__builtin_amdgcn_readfirstlane(tid>>6);
  const long rowbase=(long)b*SEQ; const int q0=qb*QB;
  const bf16*Qw=Q+(rowbase+q0+wid*QBLK)*DM+h*D;
  const bf16*Kh=K+rowbase*DM+h*D,*Vh=V+rowbase*DM+h*D;
  const lds_cptr shm3=(lds_cptr)shm;
  const unsigned lds0=(unsigned)(uintptr_t)shm;
  float*wsf=(float*)(shm+LDS_WS)+wid*64;
  const bf16*ksrc=Kh+(long)lane*DM+wid*8;
  const bf16*vsrc=Vh+(long)(16*(wid&3)+(lane>>2))*DM+(wid>>2)*32+(lane&3)*8;
  const unsigned kdst=lds0+LDS_K+wid*1024, vdst=lds0+LDS_V+wid*1024;
  #define DMA_K(t,slot) glds16(ksrc+(long)(t)*KVBLK*DM,(unsigned)__builtin_amdgcn_readfirstlane(kdst+(slot)))
  #define DMA_V(t,slot) glds16(vsrc+(long)(t)*KVBLK*DM,(unsigned)__builtin_amdgcn_readfirstlane(vdst+(slot)))
  const int vb0=(int)(lds0+LDS_V)+((lane>>4)&1)*32+(lane&3)*8+(4*hi+((lane&15)>>2))*64;
  const char*Kbase=shm+LDS_K; bf16x8 kf[8];
  const lds_cptr kp0=shm3+LDS_K+hi*1024+r32*16; const lds_cptr vp0=shm3+LDS_V+((lane>>4)&1)*32+(lane&3)*8+(4*hi+((lane&15)>>2))*64;
  const int NT=(q0+QB)/KVBLK;
  { typedef float f32x4_t __attribute__((ext_vector_type(4))); const int i4=tid*4; if(i4<q0+QB){ const f32x4_t kv=*(const f32x4_t*)(KBg+((long)(b*NHEAD+h))*SEQ+i4); *(__attribute__((address_space(3))) f32x4_t*)((lds_cptr)shm+LDS_KB+i4*4)=kv; } }
  typedef float kb4_t __attribute__((ext_vector_type(4))); const __attribute__((address_space(3))) kb4_t* kbp=(const __attribute__((address_space(3))) kb4_t*)(shm3+LDS_KB)+hi;
  DMA_K(0,0);DMA_V(0,0);DMA_K(1,SLOTB);
  bf16x8 qr[4];
  #pragma unroll
  for(int d0=0;d0<4;++d0)qr[d0]=*reinterpret_cast<const bf16x8*>(&Qw[(long)r32*DM+d0*16+hi*8]);
  float mhat=0.f,l_reg=0.f;f32x16 o[2];o[0]=f32x16{};o[1]=f32x16{};float nm=0.f;asm volatile("":"+v"(nm));
  #define NBIAS(N0,N1,t) do{ _Pragma("unroll") for(int g_=0;g_<4;++g_){ const kb4_t a_=kbp[16*(t)+2*g_], b_=kbp[16*(t)+2*g_+8]; \
      _Pragma("unroll") for(int i_=0;i_<4;++i_){ N0[4*g_+i_]=a_[i_]+nm; N1[4*g_+i_]=b_[i_]+nm; } } }while(0)
  const int qrel=wid*QBLK+r32;
  #define CMASK(P0,P1,t) do{int jb_=(t)-(NT-4); if(jb_>=0)cmask(P0,P1,jb_,qrel,hi);}while(0)
  bool resc=false;
  #define START(P0,P1) do{ const float rm=rowmax(P0,P1); resc=false; \
    { const float dl=rm; mhat=fadd_s(mhat,dl); \
      _Pragma("unroll") for(int r=0;r<16;++r){P0[r]=fsub_s(P0[r],dl);P1[r]=fsub_s(P1[r],dl);} \
      nm=-mhat; asm volatile("":"+v"(nm)); } \
    _Pragma("unroll") for(int r=0;r<16;++r)P0[r]=__builtin_amdgcn_exp2f(P0[r]); }while(0)
  #define RESC() do{ if(resc){ asm volatile("s_waitcnt lgkmcnt(0)":::"memory"); \
      _Pragma("unroll") for(int d_=0;d_<2;++d_) _Pragma("unroll") for(int r=0;r<16;++r)o[d_][r]*=wsf[crow(r,hi)]; } }while(0)
  f32x16 pA0,pA1,pB0,pB1;
  int sl_prev=0,sl_cur=0,sl_next=SLOTB;
  #define ROT() do{sl_prev=sl_cur;sl_cur=sl_next;sl_next=(sl_next==(NSLOT-1)*SLOTB)?0:sl_next+SLOTB;}while(0)
  DMA_K(2,2*SLOTB);
  WAIT_BAR(3);
  { f32x16 c0_,c1_; NBIAS(c0_,c1_,0); qkt(pA0,pA1,Kbase,qr,c0_,c1_,r32,hi); } asm volatile("s_nop 15\n\ts_nop 7":"+v"(pA0),"+v"(pA1));CMASK(pA0,pA1,0);
  START(pA0,pA1);
  _Pragma("unroll") for(int r=0;r<16;++r)pA1[r]=__builtin_amdgcn_exp2f(pA1[r]);
  WAIT_BAR(0);
  DMA_K(3,0);DMA_V(1,SLOTB);
  ROT();
  kload8(kf,kp0+sl_cur);
  WAIT_BAR(2);
  s16x4 vlo[8],vhi[8]; u32x4 pw0,pw1,pw2,pw3;
  #define PKW(P,B) cvtpk_s(P[B],P[B+1])
  #define PAF(k) __builtin_bit_cast(bf16x8,pw##k)
  #define VFR(i) (bf16x8){vlo[i][0],vlo[i][1],vlo[i][2],vlo[i][3],vhi[i][0],vhi[i][1],vhi[i][2],vhi[i][3]}
  #define PIN(x) asm volatile("":"+v"(x))
  #define MX3(a,b,c) __builtin_fmaxf(__builtin_fmaxf((a),(b)),(c))
  #define GAPA(MF,A0,A1,A2,A3,W0,W1,PW) do{ MF; sacc+=A0; sacc+=A1; sacc+=A2; sacc+=A3; PIN(sacc); W0; W1; PIN(PW); SBAR(); }while(0)
  #define EX(v) __builtin_amdgcn_exp2f(v)
  #define GAPB(MF,X,B) do{ MF; X[B]=EX(X[B]); X[B+1]=EX(X[B+1]); X[B+2]=EX(X[B+2]); X[B+3]=EX(X[B+3]); PIN(X); SBAR(); }while(0)
  #define VRD(i) do{ vlo[i]=vtr(vp_+(((i)>>2)*4096+((i)&3)*1024)); vhi[i]=vtr(vp_+(((i)>>2)*4096+((i)&3)*1024+512)); }while(0)
  #define KRD(G,j) do{ if(G){ kload2(kf,kp0+sl_next,j); SBAR(); } }while(0)
  #define STEP(C0,C1,P0,P1,t,GK,GV,GL) do{ SBAR(); \
    const lds_cptr vp_=vp0+sl_prev; \
    NBIAS(C0,C1,t); SBAR(); \
    VRD(0); SBAR(); float sacc=(P0[0]+P0[1]); \
    GAPA(C0=__builtin_amdgcn_mfma_f32_32x32x16_bf16(kf[0],qr[0],C0,0,0,0), P0[2],P0[3],P0[4],P0[5],     pw0[0]=PKW(P0,0), pw0[1]=PKW(P0,2), pw0); \
    VRD(4); SBAR(); GAPA(C1=__builtin_amdgcn_mfma_f32_32x32x16_bf16(kf[1],qr[0],C1,0,0,0), P0[6],P0[7],P0[8],P0[9],     pw0[2]=PKW(P0,4), pw0[3]=PKW(P0,6), pw0); \
    VRD(1); SBAR(); GAPA(C0=__builtin_amdgcn_mfma_f32_32x32x16_bf16(kf[2],qr[1],C0,0,0,0),   P0[10],P0[11],P0[12],P0[13], pw1[0]=PKW(P0,8), pw1[1]=PKW(P0,10), pw1); \
    VRD(5); SBAR(); GAPA(C1=__builtin_amdgcn_mfma_f32_32x32x16_bf16(kf[3],qr[1],C1,0,0,0),   P0[14],P0[15],P1[0],P1[1],   pw1[2]=PKW(P0,12),pw1[3]=PKW(P0,14), pw1); \
    VRD(2); SBAR(); GAPA(C0=__builtin_amdgcn_mfma_f32_32x32x16_bf16(kf[4],qr[2],C0,0,0,0),   P1[2],P1[3],P1[4],P1[5],     pw2[0]=PKW(P1,0), pw2[1]=PKW(P1,2), pw2); \
    VRD(6); SBAR(); GAPA(C1=__builtin_amdgcn_mfma_f32_32x32x16_bf16(kf[5],qr[2],C1,0,0,0),   P1[6],P1[7],P1[8],P1[9],     pw2[2]=PKW(P1,4), pw2[3]=PKW(P1,6), pw2); \
    VRD(3); SBAR(); GAPA(C0=__builtin_amdgcn_mfma_f32_32x32x16_bf16(kf[6],qr[3],C0,0,0,0),   P1[10],P1[11],P1[12],P1[13], pw3[0]=PKW(P1,8), pw3[1]=PKW(P1,10), pw3); \
    VRD(7); SBAR(); GAPA(C1=__builtin_amdgcn_mfma_f32_32x32x16_bf16(kf[7],qr[3],C1,0,0,0),   P1[14],P1[15],0.f,0.f,       pw3[2]=PKW(P1,12),pw3[3]=PKW(P1,14), pw3); \
    l_reg+=sacc; \
    if(GK){DMA_K((t)+3,sl_cur);} if(GV){DMA_V((t)+1,sl_next);} \
    CMASK(C0,C1,t); \
    { float a=MX3(C0[0],C0[1],C1[0]),b=MX3(C0[2],C0[3],C1[1]); a=MX3(a,C1[2],C1[3]); \
      _Pragma("unroll") for(int r=4;r<16;r+=4){a=MX3(a,C0[r],C0[r+1]);b=MX3(b,C0[r+2],C0[r+3]);a=MX3(a,C1[r],C1[r+1]);b=MX3(b,C1[r+2],C1[r+3]);} \
      float rm=__builtin_fmaxf(a,b); { auto rr=__builtin_amdgcn_permlane32_swap(__float_as_uint(rm),__float_as_uint(rm),false,false); rm=__builtin_fmaxf(__uint_as_float(rr[0]),__uint_as_float(rr[1])); } \
      resc=false; \
      if(__builtin_expect(__any(rm>(float)THRL),0)){ const float dl=__builtin_fmaxf(rm,0.f); mhat+=dl; \
        _Pragma("unroll") for(int r=0;r<16;++r){C0[r]-=dl;C1[r]-=dl;} \
        nm=-mhat; asm volatile("":"+v"(nm)); \
        const float f=__builtin_amdgcn_exp2f(-dl); l_reg*=f; if(hi==0)wsf[r32]=f; resc=true; } } \
    SBAR(); \
    GAPB(o[0]=__builtin_amdgcn_mfma_f32_32x32x16_bf16(PAF(0),VFR(0),o[0],0,0,0), C0,0); \
    GAPB(o[1]=__builtin_amdgcn_mfma_f32_32x32x16_bf16(PAF(0),VFR(4),o[1],0,0,0), C0,4); \
    KRD(GL,0); GAPB(o[0]=__builtin_amdgcn_mfma_f32_32x32x16_bf16(PAF(1),VFR(1),o[0],0,0,0), C0,8); \
    KRD(GL,1); GAPB(o[1]=__builtin_amdgcn_mfma_f32_32x32x16_bf16(PAF(1),VFR(5),o[1],0,0,0), C0,12); \
    KRD(GL,2); GAPB(o[0]=__builtin_amdgcn_mfma_f32_32x32x16_bf16(PAF(2),VFR(2),o[0],0,0,0), C1,0); \
    KRD(GL,3); GAPB(o[1]=__builtin_amdgcn_mfma_f32_32x32x16_bf16(PAF(2),VFR(6),o[1],0,0,0), C1,4); \
    GAPB(o[0]=__builtin_amdgcn_mfma_f32_32x32x16_bf16(PAF(3),VFR(3),o[0],0,0,0), C1,8); \
    GAPB(o[1]=__builtin_amdgcn_mfma_f32_32x32x16_bf16(PAF(3),VFR(7),o[1],0,0,0), C1,12); \
    }while(0)
  int t=1;
  #undef CMASK
  #define CMASK(P0,P1,t) do{}while(0)
  for(;t+5<NT;t+=2){
    STEP(pB0,pB1,pA0,pA1,t,true,true,true);     WAIT_BAR(2); RESC(); ROT();
    STEP(pA0,pA1,pB0,pB1,t+1,true,true,true);   WAIT_BAR(2); RESC(); ROT();
  }
  #undef CMASK
  #define CMASK(P0,P1,t) do{int jb_=(t)-(NT-4); if(jb_>=0)cmask(P0,P1,jb_,qrel,hi);}while(0)
  #define ENDW(tt) do{ if((tt)+3<NT){WAIT_BAR(2);} else if((tt)+2<NT){WAIT_BAR(1);} else {WAIT_BAR(0);} }while(0)
  for(;t+1<NT;t+=2){
    STEP(pB0,pB1,pA0,pA1,t,(t+3<NT),(t+1<NT),(t+1<NT));       ENDW(t);   RESC(); ROT();
    STEP(pA0,pA1,pB0,pB1,t+1,(t+4<NT),(t+2<NT),(t+2<NT));     ENDW(t+1); RESC(); ROT();
  }
  STEP(pB0,pB1,pA0,pA1,NT-1,false,false,false); RESC();
  { float sacc=pB0[0]+pB0[1]; _Pragma("unroll") for(int r=2;r<16;++r)sacc+=pB0[r]; _Pragma("unroll") for(int r=0;r<16;++r)sacc+=pB1[r]; l_reg+=sacc;
    pw0=(u32x4){PKW(pB0,0),PKW(pB0,2),PKW(pB0,4),PKW(pB0,6)};pw1=(u32x4){PKW(pB0,8),PKW(pB0,10),PKW(pB0,12),PKW(pB0,14)};pw2=(u32x4){PKW(pB1,0),PKW(pB1,2),PKW(pB1,4),PKW(pB1,6)};pw3=(u32x4){PKW(pB1,8),PKW(pB1,10),PKW(pB1,12),PKW(pB1,14)};
    SBAR(); pv(o,vb0+sl_cur,PAF(0),PAF(1),PAF(2),PAF(3)); }
  #undef PKW
  #undef PAF
  #undef VFR
  #undef PIN
  #undef MX3
  #undef GAPA
  #undef GAPB
  #undef EX
  #undef VRD
  #undef KRD
  #undef STEP
  #undef ENDW
  {auto rr=__builtin_amdgcn_permlane32_swap(__float_as_uint(l_reg),__float_as_uint(l_reg),false,false);l_reg=__uint_as_float(rr[0])+__uint_as_float(rr[1]);}
  if(hi==0)wsf[32+r32]=l_reg;asm volatile("s_waitcnt lgkmcnt(0)":::"memory");
  float rli[16];
  #pragma unroll
  for(int r=0;r<16;++r)rli[r]=__builtin_amdgcn_rcpf(wsf[32+crow(r,hi)]);
  bf16*Ow=O+(rowbase+q0+wid*QBLK)*DMO+h*D;
  { bf16*stg=(bf16*)(shm+LDS_OST)+wid*2048;
    #pragma unroll
    for(int r=0;r<16;++r){const int orow=crow(r,hi);
      #pragma unroll
      for(int d0=0;d0<2;++d0)stg[orow*64+d0*32+r32]=__float2bfloat16(o[d0][r]*rli[r]);}
    asm volatile("s_waitcnt lgkmcnt(0)":::"memory");
    #pragma unroll
    for(int i=0;i<4;++i){const int row=i*8+(lane>>3),ch=lane&7; const u32x4 v=*(const u32x4*)(stg+row*64+ch*8); ATTN_STORE16(Ow+(long)row*DMO+ch*8,v);} }
  asm volatile("s_waitcnt lgkmcnt(0)\n\ts_barrier":::"memory");
  #undef NBIAS
  #undef DMA_K
  #undef DMA_V
  #undef CMASK
  #undef START
  #undef RESC
  #undef ROT
}
constexpr int ATTN_LDS_BYTES=LDS_BYTES;
struct AttnTensors { const bf16* Q; const bf16* K; const bf16* V; bf16* O; const float* KB; };
struct AttnUnit { int bh; int qb; };
struct StaticOrder {
  int vcu;
  __device__ __forceinline__ explicit StaticOrder(int grid,int block):vcu((block%8)*(grid/8)+block/8){}
  __device__ __forceinline__ bool next(int i,AttnUnit&u)const{ if(i>=4)return false; const int s=vcu&7; u.bh=vcu>>3; u.qb=(i==0)?s:(i==1)?15-s:(i==2)?16+s:31-s; return true; }
  __device__ __forceinline__ void a_ready(const AttnUnit&)const{}
  __device__ __forceinline__ void done(const AttnUnit&)const{}
};
template<class Sched,int THRL=8> __device__ __forceinline__ void attn_phase(char*lds,const AttnTensors&T,const Sched&S){
  AttnUnit u;
  for(int i=0;S.next(i,u);++i){ S.a_ready(u); attn_unit<THRL>(u.bh/NHEAD,u.bh%NHEAD,u.qb,T.Q,T.K,T.V,T.O,T.KB,lds); S.done(u); }
}
#undef SBAR
#undef WAIT_BAR
}

#define GAS __attribute__((address_space(1)))
#define LAS __attribute__((address_space(3)))
typedef unsigned short bf16;
typedef unsigned v4u __attribute__((ext_vector_type(4)));
typedef float f32x4 __attribute__((ext_vector_type(4)));
typedef short bf16x8 __attribute__((ext_vector_type(8)));
typedef GAS unsigned gu32;
typedef GAS unsigned long long gu64;
#define RLX_AGENT __ATOMIC_RELAXED, __HIP_MEMORY_SCOPE_AGENT
#define LDS_WAIT() asm volatile("s_waitcnt lgkmcnt(0)" ::: "memory")
#define VM_WAIT() asm volatile("s_waitcnt vmcnt(0)" ::: "memory")
__device__ __forceinline__ unsigned long long rt() { return __builtin_amdgcn_s_memrealtime(); }
__device__ __forceinline__ unsigned f2bf(float f) { unsigned u = __builtin_bit_cast(unsigned, f); return (u + 0x7fffu + ((u >> 16) & 1u)) >> 16; }
__device__ __forceinline__ unsigned pk2(float lo, float hi) { return f2bf(lo) | (f2bf(hi) << 16); }

#define XB_TMO      128
#define XB_XCNT(j)  (256  + 64 * (j))
#define XB_XSUB(j)  (1280 + 64 * (j))
#define XB_XGEN(j)  (2304 + 64 * (j))
#define XB_TOP      3328
#define XB_TOPGEN   3392
#define XCD_BAR_WORDS 3456
#define XB_SPIN_CAP (1u << 18)

__device__ __forceinline__ unsigned xb_ld(unsigned* p)              { return __hip_atomic_load(p, __ATOMIC_RELAXED, __HIP_MEMORY_SCOPE_AGENT); }
__device__ __forceinline__ unsigned xb_add(unsigned* p, unsigned v) { return __hip_atomic_fetch_add(p, v, __ATOMIC_RELAXED, __HIP_MEMORY_SCOPE_AGENT); }
__device__ __forceinline__ unsigned xb_xcc_id() { return (unsigned)__builtin_amdgcn_s_getreg((3 << 11) | 20) & 0xFu; }
#define XB_SPIN(cond, bar) do { unsigned _sp = 0; while (cond) { __builtin_amdgcn_s_sleep(1); \
    if ((++_sp & 255u) == 0u) { if (xb_ld(&(bar)[XB_TMO])) break; if (_sp > XB_SPIN_CAP) { atomicAdd(&(bar)[XB_TMO], 1u); break; } } } } while (0)

struct XcdBarrier {
    unsigned* bar; unsigned x;
    volatile LAS unsigned* st;
};

__device__ __forceinline__ XcdBarrier xcd_barrier_post(unsigned* bar, volatile LAS unsigned* st) {
    XcdBarrier b; b.bar = bar; b.x = xb_xcc_id(); b.st = st;
    if (ltid() == 0) (void)xb_add(&bar[XB_XCNT(b.x)], 1u);
    return b;
}
__device__ __forceinline__ void xcd_barrier_complete(unsigned* bar, unsigned x, unsigned& nloc, unsigned& nx) {
    const unsigned G = lgrid();
    unsigned sum, cnt, mine, sp = 0u;
    for (;;) {
        sum = 0u; cnt = 0u; mine = 0u;
#pragma unroll
        for (unsigned j = 0; j < 16; ++j) { const unsigned c = xb_ld(&bar[XB_XCNT(j)]); sum += c; cnt += (c > 0u) ? 1u : 0u; mine = (j == x) ? c : mine; }
        if (sum == G) break;
        __builtin_amdgcn_s_sleep(1);
        if ((++sp & 255u) == 0u) { if (xb_ld(&bar[XB_TMO])) break; if (sp > XB_SPIN_CAP) { atomicAdd(&bar[XB_TMO], 1u); break; } }
    }
    nloc = mine > 0u ? mine : 1u; nx = cnt > 0u ? cnt : 1u;
}

__device__ __forceinline__ void xcd_barrier(const XcdBarrier& b) {
    asm volatile("s_waitcnt vmcnt(0)" ::: "memory");
    __syncthreads();
    if (ltid() == 0) {
        unsigned* bar = b.bar;
        __builtin_amdgcn_s_waitcnt(0);
        unsigned nloc = b.st[0], nx = b.st[1];
        if (nloc == 0u) { xcd_barrier_complete(bar, b.x, nloc, nx); b.st[0] = nloc; b.st[1] = nx; }
        const unsigned old = xb_add(&bar[XB_XSUB(b.x)], 1u);
        const unsigned gen = old / nloc;
        if (old + 1u == (gen + 1u) * nloc) {
            __builtin_amdgcn_fence(__ATOMIC_RELEASE, "agent");
            asm volatile("s_waitcnt vmcnt(0)" ::: "memory");
            const unsigned og = xb_add(&bar[XB_TOP], 1u);
            const unsigned tg = og / nx;
            if (og + 1u == (tg + 1u) * nx) xb_add(&bar[XB_TOPGEN], 1u);
            else XB_SPIN(xb_ld(&bar[XB_TOPGEN]) == tg, bar);
            __builtin_amdgcn_fence(__ATOMIC_ACQUIRE, "agent");
            xb_add(&bar[XB_XGEN(b.x)], 1u);
            asm volatile("s_waitcnt vmcnt(0)" ::: "memory");
        } else {
            XB_SPIN(xb_ld(&bar[XB_XGEN(b.x)]) == gen, bar);
            __builtin_amdgcn_fence(__ATOMIC_ACQUIRE, "agent");
            asm volatile("s_waitcnt vmcnt(0)" ::: "memory");
        }
    }
    __syncthreads();
}

constexpr int NWAVES = 8;
#ifndef MK_REP_MASK
#define MK_REP_MASK 0
#endif
#ifndef MK_REP_CLASS
#define MK_REP_CLASS 0
#endif
#ifndef MK_SN
#define MK_SN 9
#endif
#ifndef MK_WGM_IN
#define MK_WGM_IN 2
#endif
#ifndef MK_WGM_UP
#define MK_WGM_UP 4
#endif
#ifndef MK_PER_PHASE
#define MK_PER_PHASE 0
#endif
namespace P {
constexpr int BATCH = 8, SEQ = 2048, DM = 1024, DEPTH = 2, DECB = 32, DECS = 4, PAST = 8192, PAGE = 128, NPAGES = 64, NPOOL = 2560;
constexpr int NH = 4, HD = 64, DG = 256, GDK = 32, GDV = 64, RANK = 16, DFF = 2688, CW = 31, DIN = 2580;
constexpr int MPR = BATCH * SEQ, MS = DECB * DECS, MREAL = MPR + MS, MP = 16640;
constexpr int NIN = 2816, NUP = 2 * DFF;
constexpr int HC_AQ = 0, HC_AK = 128, HC_AV = 256, HC_AG = 512, HC_BU = 768, HC_BV = 1024, HC_CQ = 1280, HC_CK = 1536, HC_CV = 1792, HC_D1 = 2048, HC_D2 = 2304, HC_LR = 2560, HC_CF = 2576;
constexpr float ALPHA = 1.4142135623730951f;
constexpr float EPS = 1e-5f, LOG2E = 1.4426950408889634f;
constexpr float QSCALE = 0.125f * 1.4426950408889634f;
constexpr size_t O_YP = 0, O_YS = O_YP + (size_t)MPR * DM, O_PFK = O_YS + (size_t)MS * DM, O_PFV = O_PFK + (size_t)DEPTH * MPR * 256, O_PFL = O_PFV + (size_t)DEPTH * MPR * 256,
    O_PGLA = O_PFL + (size_t)DEPTH * MPR * 4, O_PCONV = O_PGLA + (size_t)DEPTH * BATCH * NH * GDK * GDV, O_PFFN = O_PCONV + (size_t)DEPTH * BATCH * 30 * DG,
    O_SFK = O_PFFN + (size_t)DEPTH * BATCH * 2 * DFF, O_SFV = O_SFK + (size_t)DEPTH * MS * 256, O_SFL = O_SFV + (size_t)DEPTH * MS * 256, O_SGLA = O_SFL + (size_t)DEPTH * MS * 4,
    O_SCONV = O_SGLA + (size_t)DEPTH * DECB * NH * GDK * GDV, O_SFFN = O_SCONV + (size_t)DEPTH * DECB * 30 * DG, O_SSGU = O_SFFN + (size_t)DEPTH * DECB * 2 * DFF,
    O_END = O_SSGU + (size_t)DEPTH * MS * DG;
static_assert(O_END == 35714048, "output size");
enum { I_XP = 0, I_XS, I_CK, I_CV, I_CL, I_SGLA, I_SCONV, I_SFFN, I_PT, I_WIN, I_GWA, I_GBA, I_GNG, I_SLG, I_SLB, I_SW, I_SB, I_FBF, I_CVW, I_CVB, I_CNG, I_CNB, I_WO, I_L1G, I_L1B,
       I_WUP, I_FCW, I_FCB, I_WDN, I_L2G, I_L2B, N_IN };
constexpr size_t MiB = 1u << 20;
constexpr size_t WS_CTL = 0, CTL_ZERO_BYTES = 1 * MiB;
constexpr size_t WS_WIN = 2 * MiB, SZ_WIN = (size_t)NIN * DM * 2;
constexpr size_t WS_WO = WS_WIN + 2 * SZ_WIN, SZ_WO = (size_t)DM * DM * 2;
constexpr size_t WS_WUP = WS_WO + 2 * SZ_WO, SZ_WUP = (size_t)NUP * DM * 2;
constexpr size_t WS_WDN = WS_WUP + 2 * SZ_WUP, SZ_WDN = (size_t)DM * DFF * 2;
constexpr size_t WS_PS = WS_WDN + 2 * SZ_WDN;
constexpr size_t WS_LRF = WS_PS + 1 * MiB;
constexpr size_t WS_LOGF = WS_LRF + 3 * MiB;
constexpr size_t WS_KBIAS = WS_LOGF + 1 * MiB;
constexpr size_t WS_DELTA = WS_KBIAS + 1 * MiB;
constexpr size_t WS_GAMMA = WS_DELTA + 8 * MiB;
constexpr size_t WS_GBUF = WS_GAMMA + 1 * MiB;
constexpr size_t WS_PART = WS_GBUF + 8 * MiB;
constexpr size_t WS_ML = WS_PART + 8 * MiB;
constexpr size_t WS_PZ = WS_ML + 1 * MiB;
constexpr size_t WS_XF = WS_PZ + 4 * MiB, SZ_F32 = (size_t)MP * DM * 4, SZ_B16 = (size_t)MP * DM * 2;
constexpr size_t WS_XB = WS_XF + SZ_F32;
constexpr size_t WS_H = WS_XB + SZ_B16;
constexpr size_t WS_Y = WS_H + (size_t)MP * NIN * 2;
constexpr size_t WS_Z = WS_Y + SZ_B16;
constexpr size_t WS_X1F = WS_Z + SZ_F32;
constexpr size_t WS_X1B = WS_X1F + SZ_F32;
constexpr size_t WS_G = WS_X1B + SZ_B16;
constexpr size_t WS_HALO = WS_G;
constexpr size_t WS_FG = WS_HALO + 2 * MiB, WS_FV = WS_FG + 2 * MiB;
constexpr size_t WS_ACT = WS_FV + 2 * MiB;
constexpr size_t WS_END = WS_ACT + (size_t)MP * DFF * 2;
static_assert(WS_PS % 256 == 0 && WS_XF % 256 == 0 && WS_H % 256 == 0 && WS_G % 256 == 0 && WS_ACT % 256 == 0, "alignment");
constexpr int CW_BAR = 4096;
constexpr int CW_Q = 16384;
constexpr int PH_PER_LAYER = 8, N_PHASES = 1 + DEPTH * PH_PER_LAYER;
constexpr int RING_BYTES = 131072, MISC_OFF = RING_BYTES + 320, HALO_OFF = RING_BYTES + 2048  , LDS_BYTES = 147456;
}

struct Args { const float* p[P::N_IN + 2]; int ph_lo, ph_hi, qoff, pad; };
#define AIN(k) (A.p[(k) + z])
#define AOUT ((float*)A.p[P::N_IN + z])
#define AWS ((unsigned char*)A.p[P::N_IN + 1 + z])
#define OPAQUE_ZERO() ({ int z_ = 0; asm volatile("" : "+s"(z_)); z_; })
static_assert(sizeof(Args) == (P::N_IN + 2) * 8 + 16, "Args has no padding");

struct Frame {
    LAS unsigned char* lds; volatile LAS unsigned* MISC; gu32* ctl; int tid, lane, wave, vcu, G;
};

__device__ __forceinline__ float bflo(unsigned u) { return __uint_as_float(u << 16); }
__device__ __forceinline__ float bfhi(unsigned u) { return __uint_as_float(u & 0xffff0000u); }
__device__ __forceinline__ float bf1(bf16 v) { return __uint_as_float((unsigned)v << 16); }
__device__ __forceinline__ void unpack8(const v4u w, float (&f)[8]) { f[0] = bflo(w.x); f[1] = bfhi(w.x); f[2] = bflo(w.y); f[3] = bfhi(w.y); f[4] = bflo(w.z); f[5] = bfhi(w.z); f[6] = bflo(w.w); f[7] = bfhi(w.w); }
__device__ __forceinline__ v4u pack8(const float (&f)[8]) { v4u w; w.x = pk2(f[0], f[1]); w.y = pk2(f[2], f[3]); w.z = pk2(f[4], f[5]); w.w = pk2(f[6], f[7]); return w; }
__device__ __forceinline__ float logsig(float x) { return fminf(x, 0.f) - log1pf(expf(-fabsf(x))); }
__device__ __forceinline__ float sigm(float x) { return 1.f / (1.f + expf(-x)); }
__device__ __forceinline__ float silu(float x) { return x / (1.f + expf(-x)); }
#define DPP_F(v, ctrl) __builtin_bit_cast(float, __builtin_amdgcn_mov_dpp(__builtin_bit_cast(int, (v)), (ctrl), 0xF, 0xF, true))
__device__ __forceinline__ float sum4(float v) { v += DPP_F(v, 0xB1); v += DPP_F(v, 0x4E); return v; }
__device__ __forceinline__ float sum8(float v) { v = sum4(v); v += DPP_F(v, 0x141); return v; }
__device__ __forceinline__ float sum16(float v) { v = sum8(v); v += DPP_F(v, 0x140); return v; }
__device__ __forceinline__ float wave_sum(float v) { v = sum16(v);
    return (__builtin_bit_cast(float, __builtin_amdgcn_readlane(__builtin_bit_cast(int, v), 0)) + __builtin_bit_cast(float, __builtin_amdgcn_readlane(__builtin_bit_cast(int, v), 16)))
         + (__builtin_bit_cast(float, __builtin_amdgcn_readlane(__builtin_bit_cast(int, v), 32)) + __builtin_bit_cast(float, __builtin_amdgcn_readlane(__builtin_bit_cast(int, v), 48))); }
#define LBAR() do { asm volatile("s_waitcnt lgkmcnt(0)" ::: "memory"); __builtin_amdgcn_s_barrier(); asm volatile("" ::: "memory"); } while (0)
struct TeamBar { volatile LAS unsigned* ctr; unsigned ep; unsigned nw; };
__device__ __forceinline__ void tbar(TeamBar& tb, int lane) {
    asm volatile("s_waitcnt lgkmcnt(0)" ::: "memory");
    tb.ep += tb.nw;
    if (lane == 0) (void)__hip_atomic_fetch_add((LAS unsigned*)tb.ctr, 1u, __ATOMIC_RELAXED, __HIP_MEMORY_SCOPE_WORKGROUP);
    while ((int)(*tb.ctr - tb.ep) < 0) __builtin_amdgcn_s_sleep(0);
    asm volatile("" ::: "memory");
}
#define IBAR() do { if constexpr (TEAM) tbar(tb, F.lane); else LBAR(); } while (0)
__device__ __forceinline__ int q_next(Frame& F, gu32* head) {
    __syncthreads();
    if (F.tid == 0) F.MISC[0] = __hip_atomic_fetch_add(head, 1u, RLX_AGENT);
    __syncthreads();
    return (int)F.MISC[0];
}

__device__ __forceinline__ int win_src(int n) {
    if (n < 768) return n;
    if (n < 2048) return n + 16;
    if (n < 2560) return n + 20;
    if (n < 2576) return n - 1792;
    if (n < 2580) return n - 512;
    return -1;
}
template <int MODE>
__device__ __forceinline__ void p0_transpose_item(const float* W, int K, int N, int NT, bf16* WT, LAS float* scr, int item, int lane) {
    const int nblk = NT / 32, kb = item / nblk, nb = item % nblk, k0 = 64 * kb, n0 = 32 * nb;
    const int ncol = n0 + (lane & 31); const int src = MODE == 1 ? win_src(ncol) : (MODE == 2 ? ((ncol & 255) < 128 ? (ncol >> 8) * 128 + (ncol & 127) : P::DFF + (ncol >> 8) * 128 + (ncol & 127)) : ncol);
    float wv[32];
#pragma unroll
    for (int i = 0; i < 32; ++i) { const int kk = 2 * i + (lane >> 5); wv[i] = src >= 0 ? __builtin_nontemporal_load(W + (size_t)(k0 + kk) * N + src) : 0.f; }
#pragma unroll
    for (int i = 0; i < 32; ++i) { const int kk = 2 * i + (lane >> 5); scr[kk * 33 + (lane & 31)] = wv[i]; }
    LDS_WAIT(); asm volatile("" ::: "memory");
    const int c = lane & 7;
#pragma unroll
    for (int j = 0; j < 4; ++j) { const int n = (lane >> 3) + 8 * j; const LAS float* s = scr + (8 * c) * 33 + n;
        v4u o; o.x = pk2(s[0 * 33], s[1 * 33]); o.y = pk2(s[2 * 33], s[3 * 33]); o.z = pk2(s[4 * 33], s[5 * 33]); o.w = pk2(s[6 * 33], s[7 * 33]);
        *(GAS v4u*)(WT + (size_t)(n0 + n) * K + k0 + 8 * c) = o; }
    LDS_WAIT(); asm volatile("" ::: "memory");
}
namespace WC { using namespace P; constexpr int I_IN = (DM / 64) * (NIN / 32), I_O = (DM / 64) * (DM / 32), I_UP = (DM / 64) * (NUP / 32), I_DN = (DFF / 64) * (DM / 32), I_LAYER = I_IN + I_O + I_UP + I_DN, I_ALL = DEPTH * I_LAYER; }
__device__ __forceinline__ void wconv_wave_item(const Args& A, const int z, Frame& F, int it) {
    using namespace P; using namespace WC;
    LAS float* scr = (LAS float*)(F.lds + F.wave * 16384);
    int lane_ = F.lane; asm volatile("" : "+v"(lane_));
    const int l = it / I_LAYER; int r = it % I_LAYER;
    if (r < I_IN) { p0_transpose_item<1>(AIN(I_WIN) + (size_t)l * DM * DIN, DM, DIN, NIN, (bf16*)(AWS + WS_WIN + l * SZ_WIN), scr, r, lane_); return; } r -= I_IN;
    if (r < I_O) { p0_transpose_item<0>(AIN(I_WO) + (size_t)l * DM * DM, DM, DM, DM, (bf16*)(AWS + WS_WO + l * SZ_WO), scr, r, lane_); return; } r -= I_O;
    if (r < I_UP) { p0_transpose_item<2>(AIN(I_WUP) + (size_t)l * DM * NUP, DM, NUP, NUP, (bf16*)(AWS + WS_WUP + l * SZ_WUP), scr, r, lane_); return; } r -= I_UP;
    p0_transpose_item<0>(AIN(I_WDN) + (size_t)l * DFF * DM, DFF, DM, DM, (bf16*)(AWS + WS_WDN + l * SZ_WDN), scr, r, lane_);
}
__device__ __forceinline__ void p0_prologue(const Args& A, const int z, Frame& F) {
    using namespace P;
    const int gw = F.vcu * NWAVES + F.wave, NGW = F.G * NWAVES;
    for (int it = gw; it < WC::I_IN; it += NGW) wconv_wave_item(A, z, F, it);
    bf16* XB = (bf16*)(AWS + WS_XB);
    for (int m = gw; m < MP; m += NGW) {
        const float* src = m < MPR ? AIN(I_XP) + (size_t)m * DM : (m < MREAL ? AIN(I_XS) + (size_t)(m - MPR) * DM : nullptr);
#pragma unroll
        for (int j = 0; j < 4; ++j) { const int c = 4 * F.lane + 256 * j; f32x4 v = src ? __builtin_nontemporal_load((const GAS f32x4*)(src + c)) : (f32x4){0.f, 0.f, 0.f, 0.f};
            *(GAS unsigned long long*)(XB + (size_t)m * DM + c) = (unsigned long long)pk2(v.x, v.y) | ((unsigned long long)pk2(v.z, v.w) << 32); }
    }
    float* PS = (float*)(AWS + WS_PS); const int* pt = (const int*)AIN(I_PT);
    for (int it = gw; it < DEPTH * DECB * NPAGES; it += NGW) {
        const int l = it / (DECB * NPAGES), bp = it % (DECB * NPAGES); const int page = pt[bp];
        const float* Lp = AIN(I_CL) + ((size_t)(l * NPOOL + page) * PAGE) * 4;
        f32x4 a = *(const GAS f32x4*)(Lp + 4 * F.lane), b = *(const GAS f32x4*)(Lp + 4 * (F.lane + 64)); a = a + b;
        a.x = wave_sum(a.x); a.y = wave_sum(a.y); a.z = wave_sum(a.z); a.w = wave_sum(a.w);
        if (F.lane == 0) *(GAS f32x4*)(PS + (size_t)it * 4) = a;
    }
}

namespace GL {
constexpr int G = 0, T = G + 64 * 33, WA = T + 256, BA = WA + 512, LR = BA + 32, QT = LR + 64 * 16  , KT = QT + 64 * 33, VV = KT + 32 * 68, SS = VV + 64 * 64, AT = SS + 32 * 64, END = AT + 64 * 68;
static_assert(END * 4 <= P::RING_BYTES && LR % 4 == 0 && QT % 4 == 0 && KT % 4 == 0 && VV % 4 == 0 && SS % 4 == 0, "GLA LDS");
}
template <int NI>
__device__ __forceinline__ void gla_local_items(const Args& A, const int z, Frame& F, int l, int item0) {
    using namespace P;
    LAS float* L = (LAS float*)F.lds; const bf16* H = (const bf16*)(AWS + WS_H);
    const int bh = item0 >> 5, b = bh >> 2, h = bh & 3;
    const int s = F.tid >> 3, d4 = (F.tid & 7) * 4, e8 = (F.tid & 7) * 8;
    const float wa = AIN(I_GWA)[(size_t)l * RANK * 128 + (F.tid >> 5) * 128 + 32 * h + (F.tid & 31)];
    const float ba = AIN(I_GBA)[l * 128 + 32 * h + (F.tid & 31)];
    unsigned long long kw[NI]; v4u vw[NI]; f32x4 lr4[NI];
#pragma unroll
    for (int q = 0; q < NI; ++q) { const int m0 = b * SEQ + 64 * ((item0 + q) & 31);
        kw[q] = *(const GAS unsigned long long*)(H + (size_t)(m0 + s) * NIN + HC_AK + 32 * h + d4); vw[q] = *(const GAS v4u*)(H + (size_t)(m0 + s) * NIN + HC_AV + 64 * h + e8);
        lr4[q] = (f32x4){0.f, 0.f, 0.f, 0.f}; if (F.tid < 256) lr4[q] = *(const GAS f32x4*)((const float*)(AWS + WS_LRF) + (size_t)(m0 + (F.tid >> 2)) * 32 + 4 * (F.tid & 3)); }
    L[GL::WA + F.tid] = wa; if (F.tid < 32) L[GL::BA + F.tid] = ba;
#pragma unroll
    for (int q = 0; q < NI; ++q) { const int item = item0 + q;
    if (q) LBAR();
    if (F.tid < 256) *(LAS f32x4*)(L + GL::LR + (F.tid >> 2) * 16 + 4 * (F.tid & 3)) = lr4[q];
    { LAS unsigned char* VT = (LAS unsigned char*)(L + GL::VV); const unsigned vv[4] = {vw[q].x, vw[q].y, vw[q].z, vw[q].w};
#pragma unroll
      for (int i = 0; i < 4; ++i) { *(LAS bf16*)(VT + (e8 + 2 * i) * 144 + 2 * s) = (bf16)(vv[i] & 0xffffu); *(LAS bf16*)(VT + (e8 + 2 * i + 1) * 144 + 2 * s) = (bf16)(vv[i] >> 16); } }
    LBAR();
    float loc[8]; const int d = F.tid & 31, seg = (F.tid >> 5) & 7;
    if (F.tid < 256) {
        float run = 0.f;
#pragma unroll
        for (int i = 0; i < 8; ++i) { const LAS float* lr = L + GL::LR + (8 * seg + i) * 16; float sacc = L[GL::BA + d];
#pragma unroll
            for (int r = 0; r < 16; ++r) sacc += lr[r] * L[GL::WA + r * 32 + d];
            run += logsig(sacc) * (1.f / 16.f); loc[i] = run; }
        L[GL::T + seg * 32 + d] = run;
    }
    LBAR();
    if (F.tid < 256) {
        float off = 0.f;
        for (int p = 0; p < seg; ++p) off += L[GL::T + p * 32 + d];
#pragma unroll
        for (int i = 0; i < 8; ++i) L[GL::G + (8 * seg + i) * 33 + d] = off + loc[i];
    }
    LBAR();
    { const unsigned lo = (unsigned)kw[q], hi = (unsigned)(kw[q] >> 32); const float kv[4] = {bflo(lo), bfhi(lo), bflo(hi), bfhi(hi)}; f32x4 g4;
#pragma unroll
      for (int i = 0; i < 4; ++i) { const float g = L[GL::G + s * 33 + d4 + i]; g4[i] = g; *(LAS bf16*)((LAS unsigned char*)(L + GL::QT) + (d4 + i) * 144 + 2 * s) = (bf16)f2bf(kv[i] * expf(L[GL::G + 63 * 33 + d4 + i] - g)); }
      *(GAS f32x4*)((float*)(AWS + WS_GBUF) + (size_t)item * 2048 + s * 32 + d4) = g4; }
    LBAR();
    { typedef short s8v __attribute__((ext_vector_type(8)));
      const LAS unsigned char* KT = (const LAS unsigned char*)(L + GL::QT); const LAS unsigned char* VT = (const LAS unsigned char*)(L + GL::VV);
      const int fi = F.lane & 15, kq = F.lane >> 4, d0 = 16 * (F.wave & 1), e0 = 16 * (F.wave >> 1); f32x4 acc = {0.f, 0.f, 0.f, 0.f};
#pragma unroll
      for (int ks = 0; ks < 2; ++ks) { const s8v af = *(const LAS s8v*)(KT + (d0 + fi) * 144 + 64 * ks + 16 * kq), bfr = *(const LAS s8v*)(VT + (e0 + fi) * 144 + 64 * ks + 16 * kq);
          acc = __builtin_amdgcn_mfma_f32_16x16x32_bf16(af, bfr, acc, 0, 0, 0); }
      float* DLo = (float*)(AWS + WS_DELTA) + (size_t)item * 2048;
#pragma unroll
      for (int r = 0; r < 4; ++r) DLo[(d0 + 4 * kq + r) * 64 + e0 + fi] = acc[r]; }
    if (F.tid < 32) ((float*)(AWS + WS_GAMMA))[(size_t)item * 32 + F.tid] = expf(L[GL::G + 63 * 33 + F.tid]);
    }
}
namespace GO {
constexpr int QB = 0, QP = 80, KB = QB + 64 * QP, PB = KB + 64 * QP, PP = 144, VT = PB + 64 * PP, ST = VT + 64 * PP, AG = ST + 64 * QP, AP = 144, SSQ = AG + 64 * AP, END = SSQ + 64 * 8;
static_assert(END <= P::RING_BYTES, "GLA out LDS");
}
__device__ __forceinline__ void gla_out_item(const Args& A, const int z, Frame& F, int l, int item) {
    using namespace P;
    typedef short s8v __attribute__((ext_vector_type(8)));
    LAS unsigned char* L = F.lds; const bf16* H = (const bf16*)(AWS + WS_H); bf16* Y = (bf16*)(AWS + WS_Y);
    const int bh = item >> 5, c = item & 31, b = bh >> 2, h = bh & 3, m0 = b * SEQ + 64 * c;
    const int s = F.tid >> 3, d4 = (F.tid & 7) * 4, e8 = (F.tid & 7) * 8, d = F.tid >> 4, e4 = (F.tid & 15) * 4;
    const f32x4 g4 = *(const GAS f32x4*)((const float*)(AWS + WS_GBUF) + (size_t)item * 2048 + s * 32 + d4);
    const unsigned long long wq = *(const GAS unsigned long long*)(H + (size_t)(m0 + s) * NIN + HC_AQ + 32 * h + d4);
    const unsigned long long wk = *(const GAS unsigned long long*)(H + (size_t)(m0 + s) * NIN + HC_AK + 32 * h + d4);
    const v4u vw = *(const GAS v4u*)(H + (size_t)(m0 + s) * NIN + HC_AV + 64 * h + e8);
    const v4u gw = *(const GAS v4u*)(H + (size_t)(m0 + s) * NIN + HC_AG + 64 * h + e8);
    const float* DL = (const float*)(AWS + WS_DELTA) + (size_t)(bh * 32) * 2048 + d * 64 + e4; const float* GM = (const float*)(AWS + WS_GAMMA) + (size_t)(bh * 32) * 32 + d;
    f32x4 S = {0.f, 0.f, 0.f, 0.f};
    for (int j0 = 0; j0 < c; j0 += 16) { float gm[16]; f32x4 dl[16];
#pragma unroll
        for (int j = 0; j < 16; ++j) { gm[j] = GM[(j0 + j) * 32]; dl[j] = *(const GAS f32x4*)(DL + (size_t)(j0 + j) * 2048); }
#pragma unroll
        for (int j = 0; j < 16; ++j) if (j0 + j < c) S = S * gm[j] + dl[j]; }
    if (c == 31) { const float gm = GM[31 * 32]; const f32x4 dl = *(const GAS f32x4*)(DL + (size_t)31 * 2048); const f32x4 Sf = S * gm + dl;
        *(GAS f32x4*)(AOUT + O_PGLA + ((size_t)(l * BATCH + b) * NH + h) * 2048 + d * 64 + e4) = Sf; }
#pragma unroll
    for (int i = 0; i < 4; ++i) *(LAS bf16*)(L + GO::ST + (e4 + i) * GO::QP + 2 * d) = (bf16)f2bf(S[i]);
    { const float qv[4] = {bflo((unsigned)wq), bfhi((unsigned)wq), bflo((unsigned)(wq >> 32)), bfhi((unsigned)(wq >> 32))};
      const float kv[4] = {bflo((unsigned)wk), bfhi((unsigned)wk), bflo((unsigned)(wk >> 32)), bfhi((unsigned)(wk >> 32))};
      float qt[4], kt[4];
#pragma unroll
      for (int i = 0; i < 4; ++i) { qt[i] = qv[i] * 0.17677669529663687f * expf(g4[i]); kt[i] = kv[i] * expf(-g4[i]); }
      *(LAS unsigned long long*)(L + GO::QB + s * GO::QP + 2 * d4) = (unsigned long long)pk2(qt[0], qt[1]) | ((unsigned long long)pk2(qt[2], qt[3]) << 32);
      *(LAS unsigned long long*)(L + GO::KB + s * GO::QP + 2 * d4) = (unsigned long long)pk2(kt[0], kt[1]) | ((unsigned long long)pk2(kt[2], kt[3]) << 32);
      const unsigned vv[4] = {vw.x, vw.y, vw.z, vw.w};
#pragma unroll
      for (int i = 0; i < 4; ++i) { *(LAS bf16*)(L + GO::VT + (e8 + 2 * i) * GO::PP + 2 * s) = (bf16)(vv[i] & 0xffffu); *(LAS bf16*)(L + GO::VT + (e8 + 2 * i + 1) * GO::PP + 2 * s) = (bf16)(vv[i] >> 16); }
      *(LAS v4u*)(L + GO::AG + s * GO::AP + 2 * e8) = gw; }
    LBAR();
    const int fi = F.lane & 15, kq = F.lane >> 4;
    { const int t0 = 16 * (F.wave >> 1); const s8v af = *(const LAS s8v*)(L + GO::QB + (t0 + fi) * GO::QP + 16 * kq);
#pragma unroll
      for (int k = 0; k < 2; ++k) { const int s0 = 16 * (2 * (F.wave & 1) + k); const s8v bfr = *(const LAS s8v*)(L + GO::KB + (s0 + fi) * GO::QP + 16 * kq);
          f32x4 acc = {0.f, 0.f, 0.f, 0.f}; acc = __builtin_amdgcn_mfma_f32_16x16x32_bf16(af, bfr, acc, 0, 0, 0);
#pragma unroll
          for (int r = 0; r < 4; ++r) { const int t = t0 + 4 * kq + r, sc = s0 + fi; *(LAS bf16*)(L + GO::PB + t * GO::PP + 2 * sc) = (bf16)f2bf(sc <= t ? acc[r] : 0.f); } } }
    LBAR();
    { const int t0 = 16 * (F.wave & 3), eb = 32 * (F.wave >> 2);
      const s8v a0 = *(const LAS s8v*)(L + GO::PB + (t0 + fi) * GO::PP + 16 * kq), a1 = *(const LAS s8v*)(L + GO::PB + (t0 + fi) * GO::PP + 64 + 16 * kq), a2 = *(const LAS s8v*)(L + GO::QB + (t0 + fi) * GO::QP + 16 * kq);
      f32x4 o[2]; float ssq[4] = {0.f, 0.f, 0.f, 0.f};
#pragma unroll
      for (int k = 0; k < 2; ++k) { const int e0 = eb + 16 * k;
          const s8v b0 = *(const LAS s8v*)(L + GO::VT + (e0 + fi) * GO::PP + 16 * kq), b1 = *(const LAS s8v*)(L + GO::VT + (e0 + fi) * GO::PP + 64 + 16 * kq), b2 = *(const LAS s8v*)(L + GO::ST + (e0 + fi) * GO::QP + 16 * kq);
          f32x4 acc = {0.f, 0.f, 0.f, 0.f};
          acc = __builtin_amdgcn_mfma_f32_16x16x32_bf16(a0, b0, acc, 0, 0, 0); acc = __builtin_amdgcn_mfma_f32_16x16x32_bf16(a1, b1, acc, 0, 0, 0); acc = __builtin_amdgcn_mfma_f32_16x16x32_bf16(a2, b2, acc, 0, 0, 0);
          o[k] = acc;
#pragma unroll
          for (int r = 0; r < 4; ++r) ssq[r] += acc[r] * acc[r]; }
#pragma unroll
      for (int r = 0; r < 4; ++r) { ssq[r] = sum16(ssq[r]); if (fi == 0) *(LAS float*)(L + GO::SSQ + ((t0 + 4 * kq + r) * 2 + (F.wave >> 2)) * 4) = ssq[r]; }
      LBAR();
#pragma unroll
      for (int r = 0; r < 4; ++r) { const int t = t0 + 4 * kq + r; const float tot = *(const LAS float*)(L + GO::SSQ + (t * 2) * 4) + *(const LAS float*)(L + GO::SSQ + (t * 2 + 1) * 4);
          const float rn = 1.f / sqrtf(tot * (1.f / 64.f) + EPS);
#pragma unroll
          for (int k = 0; k < 2; ++k) { const int e = eb + 16 * k + fi; const float ag = bf1(*(const LAS bf16*)(L + GO::AG + t * GO::AP + 2 * e));
              Y[(size_t)(m0 + t) * DM + 64 * h + e] = (bf16)f2bf(o[k][r] * rn * AIN(I_GNG)[l * 256 + 64 * h + e] * silu(ag)); } } }
}

__device__ __forceinline__ void fox_cumsum_wave(const Args& A, const int z, Frame& F, int l, int b) {
    using namespace P;
    const float* LG = (const float*)(AWS + WS_LOGF) + ((size_t)b * SEQ + 32 * F.lane) * 4; float* KB = (float*)(AWS + WS_KBIAS);
    f32x4 lf[32]; f32x4 run = {0.f, 0.f, 0.f, 0.f};
#pragma unroll
    for (int i = 0; i < 32; ++i) lf[i] = *(const GAS f32x4*)(LG + 4 * i);
#pragma unroll
    for (int i = 0; i < 32; ++i) { run = run + lf[i]; lf[i] = run; }
    f32x4 off;
#pragma unroll
    for (int c = 0; c < 4; ++c) { float incl = run[c];
        incl += DPP_F(incl, 0x111); incl += DPP_F(incl, 0x112); incl += DPP_F(incl, 0x114); incl += DPP_F(incl, 0x118);
        const float t0 = __builtin_bit_cast(float, __builtin_amdgcn_readlane(__builtin_bit_cast(int, incl), 15)), t1 = __builtin_bit_cast(float, __builtin_amdgcn_readlane(__builtin_bit_cast(int, incl), 31)), t2 = __builtin_bit_cast(float, __builtin_amdgcn_readlane(__builtin_bit_cast(int, incl), 47));
        incl += (F.lane >= 16 ? t0 : 0.f) + (F.lane >= 32 ? t1 : 0.f) + (F.lane >= 48 ? t2 : 0.f);
        off[c] = incl - run[c]; }
#pragma unroll
    for (int c = 0; c < 4; ++c) { float* kb = KB + ((size_t)(b * NH + c)) * SEQ + 32 * F.lane;
#pragma unroll
        for (int i = 0; i < 32; i += 4) *(GAS f32x4*)(kb + i) = (f32x4){-(off[c] + lf[i][c]) * LOG2E, -(off[c] + lf[i + 1][c]) * LOG2E, -(off[c] + lf[i + 2][c]) * LOG2E, -(off[c] + lf[i + 3][c]) * LOG2E}; }
}

template <bool TEAM>
__device__ __forceinline__ void conv_item(const Args& A, const int z, Frame& F, int l, int item, TeamBar& tb) {
    using namespace P;
    constexpr int NT = TEAM ? 256 : 512, R = 512 / NT;
    LAS float* GLU = (LAS float*)F.lds;
    const bf16* H = (const bf16*)(AWS + WS_H); bf16* Y = (bf16*)(AWS + WS_Y);
    const int b = item >> 6, t0 = (item & 63) * 32;
    v4u d1w[4 * R], d2w[4 * R];
#pragma unroll
    for (int j = 0; j < 4 * R; ++j) { int idx = F.tid + NT * j; idx = idx < 62 * 32 ? idx : 62 * 32 - 1; const int rr = idx >> 5, c8 = (idx & 31) * 8; int t = t0 - 30 + rr; t = t < 0 ? 0 : t;
        const size_t m = (size_t)b * SEQ + t; d1w[j] = *(const GAS v4u*)(H + m * NIN + HC_D1 + c8); d2w[j] = *(const GAS v4u*)(H + m * NIN + HC_D2 + c8); }
    const int c = F.tid & 255, half = F.tid >> 8; float w[31]; const float* cw = AIN(I_CVW) + (size_t)l * CW * DG + c;
#pragma unroll
    for (int j = 0; j < 31; ++j) w[j] = cw[j * DG];
    const float cb = AIN(I_CVB)[l * DG + c], ng = AIN(I_CNG)[l * DG + c], nb = AIN(I_CNB)[l * DG + c];
#pragma unroll
    for (int j = 0; j < 4 * R; ++j) { const int idx = F.tid + NT * j;
        if (idx < 62 * 32) { const int rr = idx >> 5, c8 = (idx & 31) * 8, t = t0 - 30 + rr; float g[8];
            if (t >= 0) { float d1[8], d2[8]; unpack8(d1w[j], d1); unpack8(d2w[j], d2);
#pragma unroll
                for (int i = 0; i < 8; ++i) g[i] = d1[i] * sigm(d2[i]);
                if (t >= SEQ - 30) { float* o = AOUT + O_PCONV + ((size_t)(l * BATCH + b) * 30 + (t - (SEQ - 30))) * DG + c8; *(GAS f32x4*)o = (f32x4){g[0], g[1], g[2], g[3]}; *(GAS f32x4*)(o + 4) = (f32x4){g[4], g[5], g[6], g[7]}; }
            } else {
#pragma unroll
                for (int i = 0; i < 8; ++i) g[i] = 0.f; }
            *(LAS f32x4*)(GLU + rr * 256 + c8) = (f32x4){g[0], g[1], g[2], g[3]}; *(LAS f32x4*)(GLU + rr * 256 + c8 + 4) = (f32x4){g[4], g[5], g[6], g[7]}; } }
    IBAR();
#pragma unroll
    for (int hb = 0; hb < R; ++hb) { const int tb0 = (TEAM ? hb : half) * 16; float win[46];
#pragma unroll
        for (int j = 0; j < 46; ++j) win[j] = GLU[(tb0 + j) * 256 + c];
#pragma unroll
        for (int i = 0; i < 16; ++i) { float s = cb;
#pragma unroll
            for (int j = 0; j < 31; ++j) s += w[j] * win[i + j];
            const float mean = wave_sum(s) * (1.f / 64.f); const float dx = s - mean; const float var = wave_sum(dx * dx) * (1.f / 64.f);
            const float yv = dx * (1.f / sqrtf(var + EPS)) * ng + nb;
            Y[(size_t)(b * SEQ + t0 + tb0 + i) * DM + 768 + c] = (bf16)f2bf(silu(yv)); } }
}

template <int NI>
__device__ __forceinline__ void conv_items(const Args& A, const int z, Frame& F, int l, int item0, int istride) {
    using namespace P;
    LAS float* GLU = (LAS float*)F.lds; LAS float* CO = GLU + 62 * 256;
    const bf16* H = (const bf16*)(AWS + WS_H); bf16* Y = (bf16*)(AWS + WS_Y);
    v4u d1w[NI][4], d2w[NI][4];
#pragma unroll
    for (int q = 0; q < NI; ++q) { const int item = item0 + q * istride, b = item >> 6, t0 = (item & 63) * 32;
#pragma unroll
        for (int j = 0; j < 4; ++j) { int idx = F.tid + 512 * j; idx = idx < 62 * 32 ? idx : 62 * 32 - 1; const int rr = idx >> 5, c8 = (idx & 31) * 8; int t = t0 - 30 + rr; t = t < 0 ? 0 : t;
            const size_t m = (size_t)b * SEQ + t; d1w[q][j] = *(const GAS v4u*)(H + m * NIN + HC_D1 + c8); d2w[q][j] = *(const GAS v4u*)(H + m * NIN + HC_D2 + c8); } }
    const int c = F.tid & 255, half = F.tid >> 8; float w[31]; const float* cw = AIN(I_CVW) + (size_t)l * CW * DG + c;
#pragma unroll
    for (int j = 0; j < 31; ++j) w[j] = cw[j * DG];
    const float cb = AIN(I_CVB)[l * DG + c];
    const f32x4 g4 = *(const GAS f32x4*)(AIN(I_CNG) + l * DG + 4 * F.lane), b4 = *(const GAS f32x4*)(AIN(I_CNB) + l * DG + 4 * F.lane);
#pragma unroll
    for (int q = 0; q < NI; ++q) { const int item = item0 + q * istride, b = item >> 6, t0 = (item & 63) * 32;
    if (q) LBAR();
#pragma unroll
    for (int j = 0; j < 4; ++j) { const int idx = F.tid + 512 * j;
        if (idx < 62 * 32) { const int rr = idx >> 5, c8 = (idx & 31) * 8, t = t0 - 30 + rr; float g[8];
            if (t >= 0) { float d1[8], d2[8]; unpack8(d1w[q][j], d1); unpack8(d2w[q][j], d2);
#pragma unroll
                for (int i = 0; i < 8; ++i) g[i] = d1[i] * sigm(d2[i]);
                if (t >= SEQ - 30) { float* o = AOUT + O_PCONV + ((size_t)(l * BATCH + b) * 30 + (t - (SEQ - 30))) * DG + c8; *(GAS f32x4*)o = (f32x4){g[0], g[1], g[2], g[3]}; *(GAS f32x4*)(o + 4) = (f32x4){g[4], g[5], g[6], g[7]}; }
            } else {
#pragma unroll
                for (int i = 0; i < 8; ++i) g[i] = 0.f; }
            *(LAS f32x4*)(GLU + rr * 256 + c8) = (f32x4){g[0], g[1], g[2], g[3]}; *(LAS f32x4*)(GLU + rr * 256 + c8 + 4) = (f32x4){g[4], g[5], g[6], g[7]}; } }
    LBAR();
    { float win[46];
#pragma unroll
      for (int j = 0; j < 46; ++j) win[j] = GLU[(half * 16 + j) * 256 + c];
#pragma unroll
      for (int i = 0; i < 16; ++i) { float s = cb;
#pragma unroll
          for (int j = 0; j < 31; ++j) s += w[j] * win[i + j];
          CO[(half * 16 + i) * 256 + c] = s; } }
    LBAR();
#pragma unroll
    for (int k = 0; k < 4; ++k) { const int tok = 4 * F.wave + k; const f32x4 x = *(const LAS f32x4*)(CO + tok * 256 + 4 * F.lane);
        const float s = sum16((x.x + x.y) + (x.z + x.w));
        const float mean = s * (1.f / 64.f); const f32x4 dx = x - mean; const float qq = sum16((dx.x * dx.x + dx.y * dx.y) + (dx.z * dx.z + dx.w * dx.w));
        const float rstd = 1.f / sqrtf(qq * (1.f / 64.f) + EPS); const f32x4 yv = dx * rstd * g4 + b4;
        *(GAS unsigned long long*)(Y + (size_t)(b * SEQ + t0 + tok) * DM + 768 + 4 * F.lane) = (unsigned long long)pk2(silu(yv.x), silu(yv.y)) | ((unsigned long long)pk2(silu(yv.z), silu(yv.w)) << 32); }
    }
}

namespace SG { constexpr int WB = 0, WP = 272  , VT = WB + 128 * WP, VP = 272, END = VT + 64 * VP; static_assert(END <= P::RING_BYTES, "SGU LDS"); }
template <int NI>
__device__ __forceinline__ void sgu_items(const Args& A, const int z, Frame& F, int l, int item0, int istride) {
    using namespace P;
    typedef short s8v __attribute__((ext_vector_type(8)));
    LAS unsigned char* L = F.lds;
    const bf16* H = (const bf16*)(AWS + WS_H); bf16* Y = (bf16*)(AWS + WS_Y);
    const int g = item0 & 3;
    const int tv = F.tid >> 2, qv = F.tid & 3, fi = F.lane & 15, kq = F.lane >> 4, t0 = 16 * F.wave;
    v4u va[NI], vb[NI]; bf16 uu[NI][4][4]; float bsv[4];
#pragma unroll
    for (int q = 0; q < NI; ++q) { const int bn = (item0 + q * istride) >> 2, m0 = (bn >> 4) * SEQ + 128 * (bn & 15);
        const bf16* vsrc = H + (size_t)(m0 + tv) * NIN + HC_BV + 64 * g + 16 * qv; va[q] = *(const GAS v4u*)vsrc; vb[q] = *(const GAS v4u*)(vsrc + 8);
#pragma unroll
        for (int r = 0; r < 4; ++r)
#pragma unroll
            for (int k = 0; k < 4; ++k) uu[q][r][k] = H[(size_t)(m0 + t0 + 4 * kq + r) * NIN + HC_BU + 64 * g + 16 * k + fi]; }
#pragma unroll
    for (int r = 0; r < 4; ++r) bsv[r] = AIN(I_SB)[(size_t)(l * NH + g) * 128 + t0 + 4 * kq + r];
    f32x4 lg[4], lb[4];
#pragma unroll
    for (int j = 0; j < 4; ++j) { lg[j] = *(const GAS f32x4*)(AIN(I_SLG) + l * DG + 64 * g + 16 * qv + 4 * j); lb[j] = *(const GAS f32x4*)(AIN(I_SLB) + l * DG + 64 * g + 16 * qv + 4 * j); }
    { const float* Wg = AIN(I_SW) + ((size_t)(l * NH + g)) * 128 * 128; f32x4 w[8];
#pragma unroll
      for (int j = 0; j < 8; ++j) { const int idx = F.tid + 512 * j; w[j] = *(const GAS f32x4*)(Wg + (idx >> 5) * 128 + (idx & 31) * 4); }
#pragma unroll
      for (int j = 0; j < 8; ++j) { const int idx = F.tid + 512 * j, tt = idx >> 5, s4 = (idx & 31) * 4;
          *(LAS unsigned long long*)(L + SG::WB + tt * SG::WP + 2 * s4) = (unsigned long long)pk2(s4 + 0 <= tt ? w[j].x : 0.f, s4 + 1 <= tt ? w[j].y : 0.f) | ((unsigned long long)pk2(s4 + 2 <= tt ? w[j].z : 0.f, s4 + 3 <= tt ? w[j].w : 0.f) << 32); } }
#pragma unroll
    for (int q = 0; q < NI; ++q) { const int bn = (item0 + q * istride) >> 2, m0 = (bn >> 4) * SEQ + 128 * (bn & 15);
    if (q) LBAR();
    { float x[16]; { float a[8], c[8]; unpack8(va[q], a); unpack8(vb[q], c);
#pragma unroll
        for (int i = 0; i < 8; ++i) { x[i] = a[i]; x[8 + i] = c[i]; } }
      float s = 0.f;
#pragma unroll
      for (int i = 0; i < 16; ++i) s += x[i];
      s = sum4(s); const float mean = s * (1.f / 64.f); float qq = 0.f;
#pragma unroll
      for (int i = 0; i < 16; ++i) { x[i] -= mean; qq += x[i] * x[i]; }
      qq = sum4(qq); const float rstd = 1.f / sqrtf(qq * (1.f / 64.f) + EPS);
#pragma unroll
      for (int i = 0; i < 16; ++i) *(LAS bf16*)(L + SG::VT + (16 * qv + i) * SG::VP + 2 * tv) = (bf16)f2bf(x[i] * rstd * lg[i >> 2][i & 3] + lb[i >> 2][i & 3]); }
    LBAR();
    { f32x4 acc[4];
#pragma unroll
      for (int k = 0; k < 4; ++k) acc[k] = (f32x4){0.f, 0.f, 0.f, 0.f};
      const int nks = (t0 + 16 + 31) >> 5;
      for (int ks = 0; ks < nks; ++ks) { const s8v af = *(const LAS s8v*)(L + SG::WB + (t0 + fi) * SG::WP + 64 * ks + 16 * kq);
#pragma unroll
          for (int k = 0; k < 4; ++k) { const s8v bfr = *(const LAS s8v*)(L + SG::VT + (16 * k + fi) * SG::VP + 64 * ks + 16 * kq); acc[k] = __builtin_amdgcn_mfma_f32_16x16x32_bf16(af, bfr, acc[k], 0, 0, 0); } }
#pragma unroll
      for (int r = 0; r < 4; ++r) { const int t = t0 + 4 * kq + r;
#pragma unroll
          for (int k = 0; k < 4; ++k) Y[(size_t)(m0 + t) * DM + 256 + 64 * g + 16 * k + fi] = (bf16)f2bf(bf1(uu[q][r][k]) * (acc[k][r] + bsv[r])); } }
    }
}

__device__ __forceinline__ float row16_sum(float v) {
    v += __builtin_bit_cast(float, __builtin_amdgcn_mov_dpp(__builtin_bit_cast(int, v), 0xB1, 0xF, 0xF, true));
    v += __builtin_bit_cast(float, __builtin_amdgcn_mov_dpp(__builtin_bit_cast(int, v), 0x4E, 0xF, 0xF, true));
    v += __builtin_bit_cast(float, __builtin_amdgcn_mov_dpp(__builtin_bit_cast(int, v), 0x141, 0xF, 0xF, true));
    v += __builtin_bit_cast(float, __builtin_amdgcn_mov_dpp(__builtin_bit_cast(int, v), 0x140, 0xF, 0xF, true));
    return v;
}
__device__ __forceinline__ void fox_page_wave(const Args& A, const int z, Frame& F, int l, int unit) {
    using namespace P;
    int lane_ = F.lane; asm volatile("" : "+v"(lane_));
    const int b = unit >> 6, pg = unit & 63, hh = lane_ >> 4, ds = lane_ & 15;
    const bf16* H = (const bf16*)(AWS + WS_H); const int* pt = (const int*)AIN(I_PT);
    const int page = __builtin_amdgcn_readfirstlane(pt[b * NPAGES + pg]);
    const __amdgpu_buffer_rsrc_t rK = __builtin_amdgcn_make_buffer_rsrc((void*)(AIN(I_CK) + ((size_t)(l * NPOOL + page) * PAGE) * 256), 0, PAGE * 1024, 0x00020000);
    const __amdgpu_buffer_rsrc_t rV = __builtin_amdgcn_make_buffer_rsrc((void*)(AIN(I_CV) + ((size_t)(l * NPOOL + page) * PAGE) * 256), 0, PAGE * 1024, 0x00020000);
    const __amdgpu_buffer_rsrc_t rL = __builtin_amdgcn_make_buffer_rsrc((void*)(AIN(I_CL) + ((size_t)(l * NPOOL + page) * PAGE) * 4), 0, PAGE * 16, 0x00020000);
    const int vo16 = 16 * lane_, vo4 = 4 * hh;
    f32x4 kA[4], vA[4], kB[4], vB[4], kC[4], vC[4]; float lfA[4], lfB[4], lfC[4];
#define PG_LOAD(K4, V4, LF, r0) do { _Pragma("unroll") for (int i = 0; i < 4; ++i) { K4[i] = __builtin_bit_cast(f32x4, __builtin_amdgcn_raw_buffer_load_b128(rK, vo16, ((r0) + i) * 1024, 2)); \
        V4[i] = __builtin_bit_cast(f32x4, __builtin_amdgcn_raw_buffer_load_b128(rV, vo16, ((r0) + i) * 1024, 2)); LF[i] = __builtin_bit_cast(float, __builtin_amdgcn_raw_buffer_load_b32(rL, vo4, ((r0) + i) * 16, 0)); } } while (0)
    PG_LOAD(kA, vA, lfA, PAGE - 4); PG_LOAD(kB, vB, lfB, PAGE - 8); PG_LOAD(kC, vC, lfC, PAGE - 12);
    f32x4 q4[4];
#pragma unroll
    for (int t = 0; t < 4; ++t) { const unsigned long long w = *(const GAS unsigned long long*)(H + (size_t)(MPR + 4 * b + t) * NIN + HC_CQ + 64 * hh + 4 * ds);
        q4[t] = (f32x4){bflo((unsigned)w), bfhi((unsigned)w), bflo((unsigned)(w >> 32)), bfhi((unsigned)(w >> 32))}; }
    float run;
    { const f32x4 ps = *(const GAS f32x4*)((const float*)(AWS + WS_PS) + ((size_t)(l * DECB + b) * NPAGES + lane_) * 4); const bool later = lane_ > pg;
      const float r0 = wave_sum(later ? ps.x : 0.f), r1 = wave_sum(later ? ps.y : 0.f), r2 = wave_sum(later ? ps.z : 0.f), r3 = wave_sum(later ? ps.w : 0.f);
      run = hh == 0 ? r0 : (hh == 1 ? r1 : (hh == 2 ? r2 : r3)); }
    float mx[4], ls[4]; f32x4 O[4];
#pragma unroll
    for (int t = 0; t < 4; ++t) { mx[t] = -1e30f; ls[t] = 0.f; O[t] = (f32x4){0.f, 0.f, 0.f, 0.f}; }
#define PG_STEP(K4, V4, LF, o) do { float bias[4]; \
        _Pragma("unroll") for (int i = 3; i >= 0; --i) { bias[i] = run * LOG2E; run += LF[(o) + i]; } \
        _Pragma("unroll") for (int t = 0; t < 4; ++t) { float s[4]; \
            _Pragma("unroll") for (int i = 0; i < 4; ++i) { \
                typedef float f2_ __attribute__((ext_vector_type(2))); f2_ a_ = __builtin_shufflevector(K4[(o) + i], K4[(o) + i], 0, 1) * __builtin_shufflevector(q4[t], q4[t], 0, 1); \
                a_ = __builtin_shufflevector(K4[(o) + i], K4[(o) + i], 2, 3) * __builtin_shufflevector(q4[t], q4[t], 2, 3) + a_; s[i] = sum16(a_.x + a_.y) + bias[i]; } \
            const float mb = fmaxf(fmaxf(s[0], s[1]), fmaxf(s[2], s[3])), mn = fmaxf(mx[t], mb), corr = exp2f(mx[t] - mn); \
            const float p0 = exp2f(s[0] - mn), p1 = exp2f(s[1] - mn), p2 = exp2f(s[2] - mn), p3 = exp2f(s[3] - mn); \
            ls[t] = ls[t] * corr + ((p0 + p1) + (p2 + p3)); O[t] = O[t] * corr + V4[(o)] * p0 + V4[(o) + 1] * p1 + V4[(o) + 2] * p2 + V4[(o) + 3] * p3; mx[t] = mn; __builtin_amdgcn_sched_barrier(0); } } while (0)
#define PG_ROT(K4, V4, LF, r0_) do { PG_STEP(K4, V4, LF, 0); asm volatile("" ::: "memory"); __builtin_amdgcn_sched_barrier(0); PG_LOAD(K4, V4, LF, (r0_) - 12);   asm volatile("" ::: "memory"); __builtin_amdgcn_sched_barrier(0); } while (0)
#pragma unroll 1
    for (int r0 = PAGE - 4; r0 >= 12; r0 -= 12) { PG_ROT(kA, vA, lfA, r0); PG_ROT(kB, vB, lfB, r0 - 4); PG_ROT(kC, vC, lfC, r0 - 8); }
    PG_ROT(kA, vA, lfA, 4); PG_ROT(kB, vB, lfB, 0);
#undef PG_ROT
#undef PG_LOAD
#undef PG_STEP
    float* PART = (float*)(AWS + WS_PART); float* ML = (float*)(AWS + WS_ML);
#pragma unroll
    for (int t = 0; t < 4; ++t) { const size_t o = ((size_t)(unit * 4 + hh) * 4 + t); *(GAS f32x4*)(PART + o * 64 + 4 * ds) = O[t]; if (ds == 0) { ML[o * 2] = mx[t]; ML[o * 2 + 1] = ls[t]; } }
}

__device__ __forceinline__ void fox_page_dma(const Args& A, const int z, Frame& F, int l, int unit, int ring_off) {
    using namespace P;
    int lane_ = F.lane; asm volatile("" : "+v"(lane_));
    const int b = unit >> 6, pg = unit & 63, hh = lane_ >> 4, ds = lane_ & 15;
    const bf16* H = (const bf16*)(AWS + WS_H); const int* pt = (const int*)AIN(I_PT);
    const int page = __builtin_amdgcn_readfirstlane(pt[b * NPAGES + pg]);
    const char* Kg = (const char*)(AIN(I_CK) + ((size_t)(l * NPOOL + page) * PAGE) * 256) + 16 * lane_;
    const char* Vg = (const char*)(AIN(I_CV) + ((size_t)(l * NPOOL + page) * PAGE) * 256) + 16 * lane_;
    const float* Lg = AIN(I_CL) + ((size_t)(l * NPOOL + page) * PAGE) * 4 + 8 * lane_;
    const f32x4 lfa = *(const GAS f32x4*)Lg, lfb = *(const GAS f32x4*)(Lg + 4);
    const f32x4 ps = *(const GAS f32x4*)((const float*)(AWS + WS_PS) + ((size_t)(l * DECB + b) * NPAGES + lane_) * 4);
    f32x4 q4[4];
#pragma unroll
    for (int t = 0; t < 4; ++t) { const unsigned long long w = *(const GAS unsigned long long*)(H + (size_t)(MPR + 4 * b + t) * NIN + HC_CQ + 64 * hh + 4 * ds);
        q4[t] = (f32x4){bflo((unsigned)w), bfhi((unsigned)w), bflo((unsigned)(w >> 32)), bfhi((unsigned)(w >> 32))}; }
    f32x4 bhi, blo;
#pragma unroll
    for (int c = 0; c < 4; ++c) { const float lat = wave_sum(lane_ > pg ? ps[c] : 0.f); const float s = lfa[c] + lfb[c]; float incl = s;
        incl += DPP_F(incl, 0x111); incl += DPP_F(incl, 0x112); incl += DPP_F(incl, 0x114); incl += DPP_F(incl, 0x118);
        const float t0 = __builtin_bit_cast(float, __builtin_amdgcn_readlane(__builtin_bit_cast(int, incl), 15)), t1 = __builtin_bit_cast(float, __builtin_amdgcn_readlane(__builtin_bit_cast(int, incl), 31)), t2 = __builtin_bit_cast(float, __builtin_amdgcn_readlane(__builtin_bit_cast(int, incl), 47)), t3 = __builtin_bit_cast(float, __builtin_amdgcn_readlane(__builtin_bit_cast(int, incl), 63));
        incl += (lane_ >= 16 ? t0 : 0.f) + (lane_ >= 32 ? t1 : 0.f) + (lane_ >= 48 ? t2 : 0.f);
        const float tot = (t0 + t1) + (t2 + t3), after = tot - incl;
        bhi[c] = (lat + after) * LOG2E; blo[c] = (lat + after + lfb[c]) * LOG2E; }
    float mx[4], ls[4]; f32x4 O[4];
#pragma unroll
    for (int t = 0; t < 4; ++t) { mx[t] = -1e30f; ls[t] = 0.f; O[t] = (f32x4){0.f, 0.f, 0.f, 0.f}; }
    const unsigned rb = (unsigned)(uintptr_t)(F.lds + ring_off);
    const LAS unsigned char* rl = F.lds + ring_off + 16 * lane_;
    asm volatile("s_waitcnt vmcnt(0) lgkmcnt(0)" ::: "memory");
#define PD_DMA(j) do { const int r_ = 127 - (j); const unsigned d_ = (unsigned)__builtin_amdgcn_readfirstlane(rb + (((j) & 7) << 11)); attn_body::glds16(Kg + (size_t)r_ * 1024, d_); attn_body::glds16(Vg + (size_t)r_ * 1024, d_ + 1024u); } while (0)
#define PD_ROW(j, NV, bias_) do { asm volatile("s_waitcnt vmcnt(" #NV ")" ::: "memory"); \
        const f32x4 k4 = *(const LAS f32x4*)(rl + (((j) & 7) << 11)), v4 = *(const LAS f32x4*)(rl + (((j) & 7) << 11) + 1024); \
        asm volatile("s_waitcnt lgkmcnt(0)" ::: "memory"); \
        if ((j) + 7 < 128) PD_DMA((j) + 7); \
        _Pragma("unroll") for (int t = 0; t < 4; ++t) { typedef float f2_ __attribute__((ext_vector_type(2))); \
            f2_ a_ = __builtin_shufflevector(k4, k4, 0, 1) * __builtin_shufflevector(q4[t], q4[t], 0, 1); a_ = __builtin_shufflevector(k4, k4, 2, 3) * __builtin_shufflevector(q4[t], q4[t], 2, 3) + a_; \
            const float s = sum16(a_.x + a_.y) + (bias_); const float mn = fmaxf(mx[t], s), corr = exp2f(mx[t] - mn), p = exp2f(s - mn); \
            ls[t] = ls[t] * corr + p; O[t] = O[t] * corr + v4 * p; mx[t] = mn; } } while (0)
#define PD_BIAS(vec, L) (hh == 0 ? __builtin_bit_cast(float, __builtin_amdgcn_readlane(__builtin_bit_cast(int, vec[0]), (L))) : hh == 1 ? __builtin_bit_cast(float, __builtin_amdgcn_readlane(__builtin_bit_cast(int, vec[1]), (L))) : \
                         hh == 2 ? __builtin_bit_cast(float, __builtin_amdgcn_readlane(__builtin_bit_cast(int, vec[2]), (L))) : __builtin_bit_cast(float, __builtin_amdgcn_readlane(__builtin_bit_cast(int, vec[3]), (L))))
    PD_DMA(0); PD_DMA(1); PD_DMA(2); PD_DMA(3); PD_DMA(4); PD_DMA(5); PD_DMA(6);
#pragma unroll 1
    for (int i = 0; i < 60; ++i) { const int j = 2 * i, L = 63 - i;
        const float b1 = PD_BIAS(bhi, L), b0 = PD_BIAS(blo, L);
        PD_ROW(j, 12, b1); PD_ROW(j + 1, 12, b0); }
    { const float b1 = PD_BIAS(bhi, 3), b0 = PD_BIAS(blo, 3); PD_ROW(120, 12, b1); PD_ROW(121, 12, b0); }
    { const float b1 = PD_BIAS(bhi, 2), b0 = PD_BIAS(blo, 2); PD_ROW(122, 10, b1); PD_ROW(123, 8, b0); }
    { const float b1 = PD_BIAS(bhi, 1), b0 = PD_BIAS(blo, 1); PD_ROW(124, 6, b1); PD_ROW(125, 4, b0); }
    { const float b1 = PD_BIAS(bhi, 0), b0 = PD_BIAS(blo, 0); PD_ROW(126, 2, b1); PD_ROW(127, 0, b0); }
#undef PD_DMA
#undef PD_ROW
#undef PD_BIAS
    float* PART = (float*)(AWS + WS_PART); float* ML = (float*)(AWS + WS_ML);
#pragma unroll
    for (int t = 0; t < 4; ++t) { const size_t o = ((size_t)(unit * 4 + hh) * 4 + t); *(GAS f32x4*)(PART + o * 64 + 4 * ds) = O[t]; if (ds == 0) { ML[o * 2] = mx[t]; ML[o * 2 + 1] = ls[t]; } }
    asm volatile("s_waitcnt vmcnt(0)" ::: "memory");
}

__device__ __forceinline__ void sample_fox_item(const Args& A, const int z, Frame& F, int l, int b) {
    using namespace P;
    LAS float* L = (LAS float*)F.lds; LAS float* SC = L; LAS float* DN = L + 64;
    const bf16* H = (const bf16*)(AWS + WS_H); bf16* Y = (bf16*)(AWS + WS_Y); const float* LRF = (const float*)(AWS + WS_LRF);
    const int mrow = MPR + 4 * b;
    const int hh = F.tid >> 7, t = (F.tid >> 5) & 3, dp = F.tid & 31;
    const float* ML = (const float*)(AWS + WS_ML) + ((size_t)(b * NPAGES * 4 + hh) * 4 + t) * 2; const float* PART = (const float*)(AWS + WS_PART) + ((size_t)(b * NPAGES * 4 + hh) * 4 + t) * 64 + 2 * dp;
    float2 ml[16]; float M = -1e30f; asm volatile("" : "+v"(M));
    if (F.tid < 4) { const int h2 = F.tid; const float bf = AIN(I_FBF)[l * 4 + h2]; float run = 0.f;
        for (int tt = 0; tt < 4; ++tt) { const float lf = logsig(LRF[(size_t)(mrow + tt) * 32 + 16 + h2] + bf); AOUT[O_SFL + ((size_t)l * MS + 4 * b + tt) * 4 + h2] = lf; run += lf; DN[tt * 4 + h2] = run; } }
    LBAR();
    if (F.tid < 64) { const int h2 = F.tid >> 4, tt = (F.tid >> 2) & 3, j = F.tid & 3; float s = 0.f;
        const bf16* qp = H + (size_t)(mrow + tt) * NIN + HC_CQ + 64 * h2; const bf16* kp = H + (size_t)(mrow + j) * NIN + HC_CK + 64 * h2;
#pragma unroll
        for (int d8 = 0; d8 < 8; ++d8) { float qf[8], kf[8]; unpack8(*(const GAS v4u*)(qp + 8 * d8), qf); unpack8(*(const GAS v4u*)(kp + 8 * d8), kf);
#pragma unroll
            for (int i = 0; i < 8; ++i) s += qf[i] * kf[i]; }
        float l2e = LOG2E; asm volatile("" : "+v"(l2e));
        SC[F.tid] = (j <= tt) ? s - DN[j * 4 + h2] * l2e : -INFINITY; }
    LBAR();
    float Ls = 0.f, o0 = 0.f, o1 = 0.f;
    for (int p0 = 0; p0 < NPAGES; p0 += 16) {
#pragma unroll
        for (int p = 0; p < 16; ++p) ml[p] = *(const float2*)(ML + (size_t)(p0 + p) * 32);
#pragma unroll
        for (int p = 0; p < 16; ++p) M = fmaxf(M, ml[p].x); }
#pragma unroll
    for (int j = 0; j < 4; ++j) M = fmaxf(M, SC[(hh * 4 + t) * 4 + j]);
    for (int p0 = 0; p0 < NPAGES; p0 += 16) { float2 pv[16];
#pragma unroll
        for (int p = 0; p < 16; ++p) { ml[p] = *(const float2*)(ML + (size_t)(p0 + p) * 32); pv[p] = *(const float2*)(PART + (size_t)(p0 + p) * 1024); }
#pragma unroll
        for (int p = 0; p < 16; ++p) { const float w = exp2f(ml[p].x - M); Ls += ml[p].y * w; o0 += pv[p].x * w; o1 += pv[p].y * w; } }
#pragma unroll
    for (int j = 0; j < 4; ++j) { const float w = exp2f(SC[(hh * 4 + t) * 4 + j] - M); Ls += w; const bf16* vp = H + (size_t)(mrow + j) * NIN + HC_CV + 64 * hh + 2 * dp; o0 += w * bf1(vp[0]); o1 += w * bf1(vp[1]); }
    const float inv = 1.f / Ls;
    *(GAS unsigned*)(Y + (size_t)(mrow + t) * DM + 512 + 64 * hh + 2 * dp) = pk2(o0 * inv, o1 * inv);
}
__device__ __forceinline__ void sample_gs_item(const Args& A, const int z, Frame& F, int l, int b) {
    using namespace P;
    LAS float* L = (LAS float*)F.lds; LAS float* LA = L; LAS float* QK = L + 512;
    const bf16* H = (const bf16*)(AWS + WS_H); bf16* Y = (bf16*)(AWS + WS_Y); const float* LRF = (const float*)(AWS + WS_LRF);
    const int mrow = MPR + 4 * b;
    { const int t = F.tid >> 7, j = F.tid & 127; const float* lr = LRF + (size_t)(mrow + t) * 32; float s = AIN(I_GBA)[l * 128 + j]; float wv[16]; f32x4 l4[4];
#pragma unroll
      for (int r = 0; r < 16; ++r) wv[r] = AIN(I_GWA)[(size_t)l * RANK * 128 + r * 128 + j];
#pragma unroll
      for (int r = 0; r < 4; ++r) l4[r] = *(const GAS f32x4*)(lr + 4 * r);
#pragma unroll
      for (int r = 0; r < 16; ++r) s += l4[r >> 2][r & 3] * wv[r];
      LA[t * 128 + j] = logsig(s) * (1.f / 16.f); }
    if (F.tid < 128) { const int t = F.tid >> 5, j8 = (F.tid & 31) * 8; float qf[8]; unpack8(*(const GAS v4u*)(H + (size_t)(mrow + t) * NIN + HC_AQ + j8), qf);
#pragma unroll
        for (int i = 0; i < 8; ++i) QK[t * 256 + j8 + i] = qf[i]; }
    if (F.tid < 256) {
        int e = F.tid & 63; asm volatile("" : "+v"(e)); const int hh = F.tid >> 6; float S[32];
        const float* S0 = AIN(I_SGLA) + ((size_t)((l * DECB + b) * NH + hh)) * 2048 + e;
#pragma unroll
        for (int d = 0; d < 32; ++d) S[d] = S0[d * 64];
        float vv[4], ag[4];
#pragma unroll
        for (int t = 0; t < 4; ++t) { vv[t] = bf1(H[(size_t)(mrow + t) * NIN + HC_AV + 64 * hh + e]); ag[t] = bf1(H[(size_t)(mrow + t) * NIN + HC_AG + 64 * hh + e]); }
        const float ng = AIN(I_GNG)[l * 256 + 64 * hh + e];
        LBAR();
#pragma unroll
        for (int t = 0; t < 4; ++t) { float o = 0.f;
#pragma unroll
            for (int d = 0; d < 32; ++d) { S[d] = expf(LA[t * 128 + 32 * hh + d]) * S[d] + QK[t * 256 + 128 + 32 * hh + d] * vv[t]; o += QK[t * 256 + 32 * hh + d] * 0.17677669529663687f * S[d]; }
            const float ms = wave_sum(o * o) * (1.f / 64.f); const float rn = 1.f / sqrtf(ms + EPS);
            Y[(size_t)(mrow + t) * DM + 64 * hh + e] = (bf16)f2bf(o * rn * ng * silu(ag[t])); }
        float* So = AOUT + O_SGLA + ((size_t)((l * DECB + b) * NH + hh)) * 2048 + e;
#pragma unroll
        for (int d = 0; d < 32; ++d) So[d * 64] = S[d];
    } else {
        int c = F.tid - 256; asm volatile("" : "+v"(c)); const int g = c >> 6; float xv[4], uv[4], wv[10], bsv[4];
#pragma unroll
        for (int t = 0; t < 4; ++t) { xv[t] = bf1(H[(size_t)(mrow + t) * NIN + HC_BV + c]); uv[t] = bf1(H[(size_t)(mrow + t) * NIN + HC_BU + c]); }
        const float* Wg = AIN(I_SW) + ((size_t)(l * NH + g)) * 128 * 128; const float* bs = AIN(I_SB) + (size_t)(l * NH + g) * 128;
        { int k = 0;
#pragma unroll
          for (int t = 0; t < 4; ++t) { bsv[t] = bs[t];
#pragma unroll
              for (int s = 0; s <= t; ++s) wv[k++] = Wg[t * 128 + s]; } }
        const float lgv = AIN(I_SLG)[l * DG + c], lbv = AIN(I_SLB)[l * DG + c];
        LBAR();
        float vl[4];
#pragma unroll
        for (int t = 0; t < 4; ++t) { const float mean = wave_sum(xv[t]) * (1.f / 64.f); const float dx = xv[t] - mean;
            const float var = wave_sum(dx * dx) * (1.f / 64.f); vl[t] = dx * (1.f / sqrtf(var + EPS)) * lgv + lbv;
            AOUT[O_SSGU + ((size_t)l * MS + 4 * b + t) * DG + c] = vl[t]; }
        { int k = 0;
#pragma unroll
          for (int t = 0; t < 4; ++t) { float mix = bsv[t];
#pragma unroll
              for (int s = 0; s <= t; ++s) mix += wv[k++] * vl[s];
              Y[(size_t)(mrow + t) * DM + 256 + c] = (bf16)f2bf(uv[t] * mix); } }
    }
}
__device__ __forceinline__ void sample_conv_item(const Args& A, const int z, Frame& F, int l, int b) {
    using namespace P;
    const bf16* H = (const bf16*)(AWS + WS_H); bf16* Y = (bf16*)(AWS + WS_Y);
    const int mrow = MPR + 4 * b;
    if (F.tid < 256) {
        int c = F.tid; asm volatile("" : "+v"(c)); float xx[34], w[31], d1[4], d2[4];
        const float* st = AIN(I_SCONV) + ((size_t)(l * DECB + b) * 30) * DG + c;
#pragma unroll
        for (int j = 0; j < 30; ++j) xx[j] = st[j * DG];
#pragma unroll
        for (int t = 0; t < 4; ++t) { d1[t] = bf1(H[(size_t)(mrow + t) * NIN + HC_D1 + c]); d2[t] = bf1(H[(size_t)(mrow + t) * NIN + HC_D2 + c]); }
        const float* cw = AIN(I_CVW) + (size_t)l * CW * DG + c; const float cb = AIN(I_CVB)[l * DG + c];
#pragma unroll
        for (int j = 0; j < 31; ++j) w[j] = cw[j * DG];
        const float ngv = AIN(I_CNG)[l * DG + c], nbv = AIN(I_CNB)[l * DG + c];
#pragma unroll
        for (int t = 0; t < 4; ++t) xx[30 + t] = d1[t] * sigm(d2[t]);
        float* so = AOUT + O_SCONV + ((size_t)(l * DECB + b) * 30) * DG + c;
#pragma unroll
        for (int j = 0; j < 30; ++j) so[j * DG] = xx[4 + j];
        float co[4] = {cb, cb, cb, cb};
#pragma unroll
        for (int j = 0; j < 31; ++j)
#pragma unroll
            for (int t = 0; t < 4; ++t) co[t] += w[j] * xx[t + j];
#pragma unroll
        for (int t = 0; t < 4; ++t) { const float mean = wave_sum(co[t]) * (1.f / 64.f); const float dx = co[t] - mean; const float var = wave_sum(dx * dx) * (1.f / 64.f);
            const float yv = dx * (1.f / sqrtf(var + EPS)) * ngv + nbv;
            Y[(size_t)(mrow + t) * DM + 768 + c] = (bf16)f2bf(silu(yv)); }
    }
}

struct LnIo { const bf16* Z; const bf16* res; const float* pz; int nsl; const float* g; const float* b; float* of32_p; float* of32_s; bf16* obf; };
__device__ __forceinline__ void ln_finish(Frame& F, float (&v)[16], const LnIo& io, int m) {
    using namespace P;
    float s = 0.f;
#pragma unroll
    for (int i = 0; i < 16; ++i) s += v[i];
    const float mean = wave_sum(s) * (1.f / 1024.f); float s2 = 0.f;
#pragma unroll
    for (int i = 0; i < 16; ++i) { v[i] -= mean; s2 += v[i] * v[i]; }
    const float rstd = 1.f / sqrtf(wave_sum(s2) * (1.f / 1024.f) + EPS);
    float y0[8], y1[8];
#pragma unroll
    for (int h = 0; h < 2; ++h) { const f32x4 ga = *(const GAS f32x4*)(io.g + 8 * F.lane + 4 * h), ba = *(const GAS f32x4*)(io.b + 8 * F.lane + 4 * h), gc = *(const GAS f32x4*)(io.g + 512 + 8 * F.lane + 4 * h), bc = *(const GAS f32x4*)(io.b + 512 + 8 * F.lane + 4 * h);
#pragma unroll
        for (int i = 0; i < 4; ++i) { y0[4 * h + i] = v[4 * h + i] * rstd * ga[i] + ba[i]; y1[4 * h + i] = v[8 + 4 * h + i] * rstd * gc[i] + bc[i]; } }
    if (io.obf) { bf16* o = io.obf + (size_t)m * DM; *(GAS v4u*)(o + 8 * F.lane) = pack8(y0); *(GAS v4u*)(o + 512 + 8 * F.lane) = pack8(y1); }
    float* of = m < MPR ? (io.of32_p ? io.of32_p + (size_t)m * DM : nullptr) : (io.of32_s ? io.of32_s + (size_t)(m - MPR) * DM : nullptr);
    if (of) { *(GAS f32x4*)(of + 8 * F.lane) = (f32x4){y0[0], y0[1], y0[2], y0[3]}; *(GAS f32x4*)(of + 8 * F.lane + 4) = (f32x4){y0[4], y0[5], y0[6], y0[7]};
        *(GAS f32x4*)(of + 512 + 8 * F.lane) = (f32x4){y1[0], y1[1], y1[2], y1[3]}; *(GAS f32x4*)(of + 512 + 8 * F.lane + 4) = (f32x4){y1[4], y1[5], y1[6], y1[7]}; }
}
__device__ __forceinline__ void ln_phase(Frame& F, const LnIo& io) {
    using namespace P;
    constexpr int NR = 4;
    const int gw = F.vcu * NWAVES + F.wave, ngw = F.G * NWAVES;
    const bool xmap = F.G == 256; const int xg = F.vcu >> 5, wl = (F.vcu & 31) * NWAVES + F.wave;
    for (int it_ = 0; it_ < (xmap ? 2 : (MPR / NR + ngw - 1) / ngw); ++it_) { const int m0 = xmap ? 2048 * xg + NR * wl + 1024 * it_ : (gw + ngw * it_) * NR; if (m0 >= MPR) break;
        v4u za[NR], zb[NR];
#pragma unroll
        for (int r = 0; r < NR; ++r) { za[r] = *(const GAS v4u*)(io.Z + (size_t)(m0 + r) * DM + 8 * F.lane); zb[r] = *(const GAS v4u*)(io.Z + (size_t)(m0 + r) * DM + 512 + 8 * F.lane); }
#pragma unroll
        for (int r = 0; r < NR; ++r) { float v[16]; float r0[8], r1[8]; unpack8(za[r], r0); unpack8(zb[r], r1);
#pragma unroll
            for (int i = 0; i < 8; ++i) { v[i] = r0[i]; v[8 + i] = r1[i]; }
            ln_finish(F, v, io, m0 + r); }
    }
    for (int m = MPR + gw; m < MREAL; m += ngw) {
        const bf16* res = io.res + (size_t)m * DM; const float* pz = io.pz + (size_t)(m - MPR) * DM; float v[16];
        float r0[8], r1[8]; unpack8(*(const GAS v4u*)(res + 8 * F.lane), r0); unpack8(*(const GAS v4u*)(res + 512 + 8 * F.lane), r1);
#pragma unroll
        for (int i = 0; i < 8; ++i) { v[i] = r0[i] * ALPHA; v[8 + i] = r1[i] * ALPHA; }
        for (int k = 0; k < io.nsl; ++k) { const float* p = pz + (size_t)k * 128 * 1024 + 8 * F.lane;
            const f32x4 a0 = *(const GAS f32x4*)p, a1 = *(const GAS f32x4*)(p + 4), c0 = *(const GAS f32x4*)(p + 512), c1 = *(const GAS f32x4*)(p + 516);
#pragma unroll
            for (int i = 0; i < 4; ++i) { v[i] += a0[i]; v[4 + i] += a1[i]; v[8 + i] += c0[i]; v[12 + i] += c1[i]; } }
        ln_finish(F, v, io, m);
    }
}

__device__ __forceinline__ void act_fixup(const Args& A, const int z, Frame& F, int l, int pm) {
    using namespace P;
    if (pm >= MPR / 256 || (pm & 7) == 0) return;
    if (F.tid < DFF / 8) {
        const int f0 = 8 * F.tid; bf16* ACT = (bf16*)(AWS + WS_ACT);
        const float* hg = (const float*)(AWS + WS_HALO) + (size_t)((pm - 1) * 2) * DFF + f0; const float* fg = (const float*)(AWS + WS_FG) + (size_t)(pm * 2) * DFF + f0; const float* fv = (const float*)(AWS + WS_FV) + (size_t)(pm * 2) * DFF + f0;
        const float* fw = AIN(I_FCW) + (size_t)l * 3 * DFF + f0; const float* fb = AIN(I_FCB) + l * DFF + f0;
        float y0[8], y1[8];
#pragma unroll
        for (int h = 0; h < 2; ++h) { const int o = 4 * h;
            const f32x4 m2 = *(const GAS f32x4*)(hg + o), m1 = *(const GAS f32x4*)(hg + DFF + o), g0 = *(const GAS f32x4*)(fg + o), g1 = *(const GAS f32x4*)(fg + DFF + o), v0 = *(const GAS f32x4*)(fv + o), v1 = *(const GAS f32x4*)(fv + DFF + o);
            const f32x4 a = *(const GAS f32x4*)(fw + o), b = *(const GAS f32x4*)(fw + DFF + o), c = *(const GAS f32x4*)(fw + 2 * DFF + o), d = *(const GAS f32x4*)(fb + o);
#pragma unroll
            for (int i = 0; i < 4; ++i) { y0[o + i] = silu(a[i] * m2[i] + b[i] * m1[i] + c[i] * g0[i] + d[i]) * v0[i]; y1[o + i] = silu(a[i] * m1[i] + b[i] * g0[i] + c[i] * g1[i] + d[i]) * v1[i]; } }
        *(GAS v4u*)(ACT + (size_t)(pm * 256) * DFF + f0) = pack8(y0); *(GAS v4u*)(ACT + (size_t)(pm * 256 + 1) * DFF + f0) = pack8(y1);
    }
    asm volatile("s_waitcnt vmcnt(0)" ::: "memory"); __syncthreads();
}

namespace pg8 {
__device__ __forceinline__ float dpp_ror1(float v) { return __builtin_bit_cast(float, __builtin_amdgcn_mov_dpp(__builtin_bit_cast(int, v), 0x121, 0xF, 0xF, true)); }
__device__ __forceinline__ float dpp_ror2(float v) { return __builtin_bit_cast(float, __builtin_amdgcn_mov_dpp(__builtin_bit_cast(int, v), 0x122, 0xF, 0xF, true)); }
__device__ __forceinline__ float fast_silu(float x) { return x * __builtin_amdgcn_rcpf(1.0f + __builtin_amdgcn_exp2f(-1.4426950408889634f * x)); }
struct EpiUpAct {
    static constexpr bool PERM = true, AFTER_DRAIN = false;
    const Args& A; int z; int layer;
    static constexpr int DFF = 2688, PM_S = 64; static constexpr size_t O_PFFN = P::O_PFFN, O_SFFN = P::O_SFFN;
    __device__ __forceinline__ void operator()(const f32x4 (&acc)[2][2][4][2], const Unit& u, int wr, int wc, int fr, int fq) const {
        asm volatile("" : "+v"(fr), "+v"(fq));
        const int lc = wc * 32 + 8 * fq, col = u.pn * 128 + lc;
        unsigned char* const ws = AWS; float* const out = AOUT; bf16_t* const ACT = (bf16_t*)(ws + P::WS_ACT); float* const halo_g = (float*)(ws + P::WS_HALO); float* const first_g = (float*)(ws + P::WS_FG); float* const first_v = (float*)(ws + P::WS_FV);
        const float* const cw = AIN(P::I_FCW) + (size_t)layer * 3 * DFF; const float* const cb = AIN(P::I_FCB) + layer * DFF; const float* const st = AIN(P::I_SFFN) + (size_t)layer * P::DECB * 2 * DFF;
        extern __shared__ __attribute__((aligned(16))) unsigned char lds_dyn_[]; PG8_LAS float* const lh = (PG8_LAS float*)((PG8_LAS unsigned char*)lds_dyn_ + P::HALO_OFF);
        f32x4 w0[2], w1[2], w2[2], cbv[2];
#pragma unroll
        for (int n = 0; n < 2; ++n) { w0[n] = *(const f32x4*)(cw + col + 4 * n); w1[n] = *(const f32x4*)(cw + DFF + col + 4 * n); w2[n] = *(const f32x4*)(cw + 2 * DFF + col + 4 * n); cbv[n] = *(const f32x4*)(cb + col + 4 * n); }
        if (fr >= 14) {
#pragma unroll
            for (int ai = 0; ai < 2; ++ai)
#pragma unroll
                for (int n = 0; n < 2; ++n) *(PG8_LAS f32x4*)(lh + (((ai * 2 + wr) * 2 + (fr - 14)) * 128 + lc + 4 * n)) = acc[ai][0][3][n];
            if (wr == 1) {
#pragma unroll
                for (int n = 0; n < 2; ++n) *(f32x4*)(halo_g + (size_t)(u.pm * 2 + (fr - 14)) * DFF + col + 4 * n) = acc[1][0][3][n];
                if (u.pm < PM_S && (u.pm & 7) == 7) {
#pragma unroll
                    for (int n = 0; n < 2; ++n) *(f32x4*)(out + O_PFFN + (size_t)((layer * 8 + (u.pm >> 3)) * 2 + (fr - 14)) * DFF + col + 4 * n) = acc[1][0][3][n]; }
            }
        }
        asm volatile("s_waitcnt lgkmcnt(0)" ::: "memory"); __builtin_amdgcn_s_barrier(); asm volatile("" ::: "memory");
        const bool sample = u.pm >= PM_S;
#pragma unroll
        for (int ai = 0; ai < 2; ++ai) {
            f32x4 pv[2];
            if (wr == 1 || ai == 1) { const int pai = (wr == 1) ? ai : 0, pwr = (wr == 1) ? 0 : 1; const PG8_LAS float* hp = lh + (((pai * 2 + pwr) * 2 + ((fr == 15) ? 1 : 0)) * 128 + lc);
                pv[0] = *(const PG8_LAS f32x4*)hp; pv[1] = *(const PG8_LAS f32x4*)(hp + 4); }
            else { pv[0] = (f32x4){0.f, 0.f, 0.f, 0.f}; pv[1] = pv[0]; }
#pragma unroll
            for (int m = 0; m < 4; ++m) {
                const int lrow = ai * HALF + wr * 64 + m * 16 + fr;
                f32x4 s0[2], s1[2];
                const int sidx = fr & 3;
                if (sample && ai == 0 && sidx <= 1) { const float* sp = st + (size_t)(lrow >> 2) * 2 * DFF + col;
#pragma unroll
                    for (int n = 0; n < 2; ++n) { s0[n] = *(const f32x4*)(sp + 4 * n); s1[n] = *(const f32x4*)(sp + DFF + 4 * n); } }
                else {
#pragma unroll
                    for (int n = 0; n < 2; ++n) { s0[n] = (f32x4){0.f, 0.f, 0.f, 0.f}; s1[n] = s0[n]; } }
                float y[8]; float gk[8], vk[8];
#pragma unroll
                for (int n = 0; n < 2; ++n)
#pragma unroll
                    for (int i = 0; i < 4; ++i) {
                        const float g = acc[ai][0][m][n][i], gp = (m == 0) ? pv[n][i] : acc[ai][0][m == 0 ? 0 : m - 1][n][i];
                        const float a1 = dpp_ror1(g), a2 = dpp_ror2(g), b1 = dpp_ror1(gp), b2 = dpp_ror2(gp);
                        float h1 = fr >= 1 ? a1 : b1, h2 = fr >= 2 ? a2 : b2;
                        if (sample && ai == 0) { if (sidx == 0) { h1 = s1[n][i]; h2 = s0[n][i]; } else if (sidx == 1) { h2 = s1[n][i]; } }
                        const float gc = w0[n][i] * h2 + w1[n][i] * h1 + w2[n][i] * g + cbv[n][i];
                        y[4 * n + i] = fast_silu(gc) * acc[ai][1][m][n][i]; gk[4 * n + i] = g; vk[4 * n + i] = acc[ai][1][m][n][i];
                    }
                const bool defer = !sample && lrow < 2 && (u.pm & 7) != 0;
                if (defer) {
                    float* fg = first_g + (size_t)(u.pm * 2 + lrow) * DFF + col; float* fv = first_v + (size_t)(u.pm * 2 + lrow) * DFF + col;
                    *(f32x4*)fg = (f32x4){gk[0], gk[1], gk[2], gk[3]}; *(f32x4*)(fg + 4) = (f32x4){gk[4], gk[5], gk[6], gk[7]};
                    *(f32x4*)fv = (f32x4){vk[0], vk[1], vk[2], vk[3]}; *(f32x4*)(fv + 4) = (f32x4){vk[4], vk[5], vk[6], vk[7]};
                } else {
                    u32x4 w; w.x = cvt_pk_bf16(y[0], y[1]); w.y = cvt_pk_bf16(y[2], y[3]); w.z = cvt_pk_bf16(y[4], y[5]); w.w = cvt_pk_bf16(y[6], y[7]);
                    *(u32x4*)(ACT + (size_t)(u.pm * BM + lrow) * DFF + col) = w;
                }
                if (sample && ai == 0 && sidx >= 2) { float* o = out + O_SFFN + (size_t)((layer * 32 + (lrow >> 2)) * 2 + (sidx - 2)) * DFF + col;
                    *(f32x4*)o = (f32x4){gk[0], gk[1], gk[2], gk[3]}; *(f32x4*)(o + 4) = (f32x4){gk[4], gk[5], gk[6], gk[7]}; }
            }
        }
    }
};
}

struct AttnOrder {
    int start, step;
    __device__ __forceinline__ bool next(int i, attn_body::AttnUnit& u) const { const int idx = start + i * step; if (idx >= 256) return false; u.bh = idx >> 3; u.qb = idx & 7; return true; }
    __device__ __forceinline__ void a_ready(const attn_body::AttnUnit&) const {}
    __device__ __forceinline__ void done(const attn_body::AttnUnit&) const {}
};

__global__ void __launch_bounds__(NWAVES * 64, 2) hybrid_fwd(Args A) {
    using namespace P;
    extern __shared__ __attribute__((aligned(16))) unsigned char lds[];
#define MKFRAME() Frame F; { F.lds = (LAS unsigned char*)lds; F.MISC = (volatile LAS unsigned*)(F.lds + MISC_OFF); F.tid = ltid(); F.lane = F.tid & 63; F.wave = __builtin_amdgcn_readfirstlane(F.tid >> 6); \
        F.G = lgrid(); const int bx_ = lbid(); F.vcu = (F.G % 8 == 0) ? (bx_ % 8) * (F.G / 8) + bx_ / 8 : bx_; F.ctl = (gu32*)(AWS + WS_CTL); }
    XcdBarrier bar;
    { for (int u = threadIdx.x; u < (LDS_BYTES - RING_BYTES) / 4; u += NWAVES * 64) ((LAS unsigned*)((LAS unsigned char*)lds + RING_BYTES))[u] = 0u;
      __syncthreads();
      if ((threadIdx.x & 63) == 0) ((LAS int*)((LAS unsigned char*)lds + LTID_TABLE_OFF))[hw_wave_slot()] = (int)(threadIdx.x >> 6);
      __syncthreads(); }
    { const int z = OPAQUE_ZERO(); MKFRAME();
      bar.bar = (unsigned*)(F.ctl + CW_BAR); bar.x = 0; bar.st = nullptr;
      if (!MK_PER_PHASE) bar = xcd_barrier_post((unsigned*)(F.ctl + CW_BAR), F.MISC + 8); }
    const int lo = A.ph_lo, hi = A.ph_hi;
#define IN(k) (lo <= (k) && (k) < hi)
#define SEAM(k) do { if (!MK_PER_PHASE && (k) + 1 < N_PHASES) xcd_barrier(bar); } while (0)
#define CLS(c) (!MK_PER_PHASE || A.pad == 0 || A.pad == 1 + (c))
#define GW() (F.vcu * NWAVES + F.wave)
#define NGW() (F.G * NWAVES)

    if (IN(0)) { const int z = OPAQUE_ZERO(); MKFRAME(); p0_prologue(A, z, F); SEAM(0); }

    for (int l = 0; l < DEPTH; ++l) {
        const int pb = 1 + PH_PER_LAYER * l;
        if (IN(pb + 0)) {
            const int z = OPAQUE_ZERO(); MKFRAME(); unsigned char* const ws = AWS; float* const out = AOUT;
            pg8::Gemm g{(const bf16*)(ws + WS_XB), (const bf16*)(ws + WS_WIN + l * SZ_WIN), MP, NIN, DM, DM}; pg8::StaticOrder S; S.init(MP, NIN, F.G, (int)lbid(), MK_WGM_IN);
            const float* fb_ = AIN(I_FBF) + 4 * l; pg8::EpiIn E{(bf16*)(ws + WS_H), (float*)(ws + WS_LRF), out, l, (float*)(ws + WS_LOGF), (pg8::f32x4){fb_[0], fb_[1], fb_[2], fb_[3]}};
            pg8::gemm_phase<pg8::EpiIn, pg8::StaticOrder, true, true>(F.lds, g, S, E);
            SEAM(pb + 0);
        }
        if (IN(pb + 1)) {
            constexpr int N_GL = 1024, N_SG = 512, N_CV = 512, N_CS = BATCH;
            { const int z = OPAQUE_ZERO(); MKFRAME();
              if (CLS(0)) for (int unit = F.vcu * NWAVES + F.wave; unit < DECB * NPAGES; unit += F.G * NWAVES) fox_page_wave(A, z, F, l, unit); }
            { const int z = OPAQUE_ZERO(); MKFRAME();
              if (CLS(4) && F.wave == 0) for (int unit = F.vcu; unit < N_CS; unit += F.G) fox_cumsum_wave(A, z, F, l, unit); }
            { const int z = OPAQUE_ZERO(); MKFRAME(); TeamBar tb{F.MISC + 16, 0u, 8u};
              if (CLS(1)) for (int it = 4 * F.vcu; it < N_GL; it += 4 * F.G) { LBAR(); gla_local_items<4>(A, z, F, l, it); }
              if (F.G == 256) {
                  if (CLS(2)) { LBAR(); sgu_items<2>(A, z, F, l, F.vcu, 256); }
                  if (CLS(3)) { LBAR(); conv_items<2>(A, z, F, l, F.vcu, 256); }
              } else {
                  if (CLS(2)) for (int it = F.vcu; it < N_SG; it += F.G) { LBAR(); sgu_items<1>(A, z, F, l, it, 0); }
                  if (CLS(3)) for (int it = F.vcu; it < N_CV; it += F.G) { LBAR(); conv_items<1>(A, z, F, l, it, 0); }
              } }
            SEAM(pb + 1);
        }
        if (IN(pb + 2)) {
            { const int z = OPAQUE_ZERO(); MKFRAME(); unsigned char* const ws = AWS; const bf16* Hb = (const bf16*)(ws + WS_H);
              const attn_body::AttnTensors AT{(const attn_body::bf16*)(Hb + HC_CQ), (const attn_body::bf16*)(Hb + HC_CK), (const attn_body::bf16*)(Hb + HC_CV), (attn_body::bf16*)(ws + WS_Y) + 512, (const float*)(ws + WS_KBIAS)};
              const AttnOrder S{F.vcu, F.G};
              if (CLS(0)) attn_body::attn_phase<AttnOrder>((char*)lds, AT, S); }
            const int z = OPAQUE_ZERO(); MKFRAME();
            const int shard = (int)lbid() & 7; gu32* head = F.ctl + CW_Q + 64 * (8 * (2 * l + A.qoff) + shard);
            const int nwc = l == 0 ? (WC::I_ALL - WC::I_IN + 63) / 64 * 8 : 0;
            const int nq = (3 * DECB + 1024 + nwc) / 8;
            int j = q_next(F, head);
            while (j < nq) {
                unsigned pend = 0u; if (F.tid == 0) pend = __hip_atomic_fetch_add(head, 1u, RLX_AGENT);
                int it = 8 * j + shard;
                if (it < 1024) { if (CLS(2)) gla_out_item(A, z, F, l, it); }
                else if ((it -= 1024) < DECB) { if (CLS(1)) sample_fox_item(A, z, F, l, it); }
                else if ((it -= DECB) < DECB) { if (CLS(1)) sample_gs_item(A, z, F, l, it); }
                else if ((it -= DECB) < DECB) { if (CLS(1)) sample_conv_item(A, z, F, l, it); }
                else { it -= DECB; const int wi = WC::I_IN + it * 8 + F.wave; if (wi < WC::I_ALL) wconv_wave_item(A, z, F, wi); }
                __syncthreads();
                if (F.tid == 0) F.MISC[0] = pend;
                __syncthreads();
                j = (int)F.MISC[0];
            }
            SEAM(pb + 2);
        }
        if (IN(pb + 3)) {
            const int z = OPAQUE_ZERO(); MKFRAME(); unsigned char* const ws = AWS;
            { pg8::Gemm g{(const bf16*)(ws + WS_Y), (const bf16*)(ws + WS_WO + l * SZ_WO), MPR, DM, DM, DM}; pg8::StaticOrder S; S.init(MPR, DM, F.G, (int)lbid());
              pg8::EpiRes E{(const bf16*)(ws + WS_XB), (bf16*)(ws + WS_Z), DM, ALPHA};
              pg8::gemm_phase<pg8::EpiRes, pg8::StaticOrder, true, true>(F.lds, g, S, E); }
            { pg8::Gemm g{(const bf16*)(ws + WS_Y), (const bf16*)(ws + WS_WO + l * SZ_WO), MP, DM, 128, DM}; const pg8::SliceOrder S{MPR / 256, DM / 256, 8, 128, F.G, (int)lbid()};
              pg8::EpiPart E{(float*)(ws + WS_PZ), DM, 128};
              pg8::gemm_phase<pg8::EpiPart, pg8::SliceOrder, true, true>(F.lds, g, S, E); }
            SEAM(pb + 3);
        }
        if (IN(pb + 4)) {
            const int z = OPAQUE_ZERO(); MKFRAME(); unsigned char* const ws = AWS;
            const LnIo io{(const bf16*)(ws + WS_Z), (const bf16*)(ws + WS_XB), (const float*)(ws + WS_PZ), 8, AIN(I_L1G) + l * DM, AIN(I_L1B) + l * DM, nullptr, nullptr, (bf16*)(ws + WS_X1B)};
            ln_phase(F, io);
            SEAM(pb + 4);
        }
        if (IN(pb + 5)) {
            const int z = OPAQUE_ZERO(); MKFRAME(); unsigned char* const ws = AWS;
            pg8::Gemm g{(const bf16*)(ws + WS_X1B), (const bf16*)(ws + WS_WUP + l * SZ_WUP), MP, NUP, DM, DM}; pg8::StaticOrder S; S.init(MP, NUP, F.G, (int)lbid(), MK_WGM_UP);
            pg8::EpiUpAct E{A, z, l};
            pg8::gemm_phase<pg8::EpiUpAct, pg8::StaticOrder, true, true>(F.lds, g, S, E);
            SEAM(pb + 5);
        }
        if (IN(pb + 6)) {
            const int z = OPAQUE_ZERO(); MKFRAME(); unsigned char* const ws = AWS;
            { pg8::Gemm g{(const bf16*)(ws + WS_ACT), (const bf16*)(ws + WS_WDN + l * SZ_WDN), MPR, DM, DFF, DFF}; pg8::StaticOrder S; S.init(MPR, DM, F.G, (int)lbid());
              { pg8::Unit u_; for (int i = 0; S.next(i, u_); ++i) act_fixup(A, z, F, l, u_.pm); }
              pg8::EpiRes E{(const bf16*)(ws + WS_X1B), (bf16*)(ws + WS_Z), DM, ALPHA};
              pg8::gemm_phase<pg8::EpiRes, pg8::StaticOrder, true, true>(F.lds, g, S, E); }
            { pg8::Gemm g{(const bf16*)(ws + WS_ACT), (const bf16*)(ws + WS_WDN + l * SZ_WDN), MP, DM, 384, DFF}; const pg8::SliceOrder S{MPR / 256, DM / 256, 7, 384, F.G, (int)lbid()};
              pg8::EpiPart E{(float*)(ws + WS_PZ), DM, 384};
              pg8::gemm_phase<pg8::EpiPart, pg8::SliceOrder, true, true>(F.lds, g, S, E); }
            SEAM(pb + 6);
        }
        if (IN(pb + 7)) {
            const int z = OPAQUE_ZERO(); MKFRAME(); unsigned char* const ws = AWS; float* const out = AOUT; const bool last = l + 1 == DEPTH;
            const LnIo io{(const bf16*)(ws + WS_Z), (const bf16*)(ws + WS_X1B), (const float*)(ws + WS_PZ), 7, AIN(I_L2G) + l * DM, AIN(I_L2B) + l * DM, last ? out + O_YP : nullptr, last ? out + O_YS : nullptr, last ? nullptr : (bf16*)(ws + WS_XB)};
            ln_phase(F, io);
            SEAM(pb + 7);
        }
    }
#undef IN
#undef SEAM
#undef GW
#undef NGW
#undef CLS
#undef MKFRAME
}

extern "C" void kernel_launch(void* const* d_in, const int* in_sizes, int n_in, void* d_out, int out_size, void* d_ws, size_t ws_size, hipStream_t stream) {
    using namespace P;
    static int grid = 0;
    if (grid == 0) {
        if (n_in != N_IN || (size_t)out_size != O_END || ws_size < WS_END) { fprintf(stderr, "kernel_launch: unexpected shapes: n_in %d out %d ws %zu (need %zu)\n", n_in, out_size, ws_size, (size_t)WS_END); grid = -1; return; }
        int dev = 0, cus = 0, per_cu = 0;
        if (hipGetDevice(&dev) != hipSuccess || hipDeviceGetAttribute(&cus, hipDeviceAttributeMultiprocessorCount, dev) != hipSuccess) { grid = -1; return; }
        if (hipFuncSetAttribute((const void*)hybrid_fwd, hipFuncAttributeMaxDynamicSharedMemorySize, LDS_BYTES) != hipSuccess) { fprintf(stderr, "kernel_launch: hipFuncSetAttribute failed\n"); grid = -1; return; }
        if (hipOccupancyMaxActiveBlocksPerMultiprocessor(&per_cu, (const void*)hybrid_fwd, NWAVES * 64, LDS_BYTES) != hipSuccess || per_cu < 1)
            fprintf(stderr, "kernel_launch: note: occupancy query reports %d workgroups per CU\n", per_cu);
        (void)hipGetLastError();
        grid = cus;
    }
    if (grid < 0) return;
    if (hipMemsetAsync((char*)d_ws + WS_CTL, 0, CTL_ZERO_BYTES, stream) != hipSuccess) { fprintf(stderr, "kernel_launch: memset failed\n"); return; }
    Args a{};
    for (int i = 0; i < N_IN; ++i) a.p[i] = (const float*)d_in[i];
    a.p[N_IN] = (const float*)d_out; a.p[N_IN + 1] = (const float*)d_ws;
#if MK_PER_PHASE
    for (int p = 0; p < N_PHASES; ++p) { const int type = p == 0 ? 0 : 1 + (p - 1) % PH_PER_LAYER; const int reps = 1 + ((MK_REP_MASK >> type) & 1);
        for (int r = 0; r < reps; ++r) { a.ph_lo = p; a.ph_hi = p + 1; a.qoff = r; a.pad = r ? MK_REP_CLASS : 0; hipLaunchKernelGGL(hybrid_fwd, dim3(grid), dim3(NWAVES * 64), LDS_BYTES, stream, a); } }
#else
    a.ph_lo = 0; a.ph_hi = N_PHASES;
    hipLaunchKernelGGL(hybrid_fwd, dim3(grid), dim3(NWAVES * 64), LDS_BYTES, stream, a);
#endif
    const hipError_t le = hipPeekAtLastError();
    if (le != hipSuccess) fprintf(stderr, "kernel_launch: launch failed: %s\n", hipGetErrorName(le));
}
```

```cpp
#include <hip/hip_runtime.h>
#include <cstdio>
#include <cstdint>
#define LTID_TABLE_OFF (131072 + 1024)
__device__ __forceinline__ unsigned hw_wave_slot() { return (unsigned)__builtin_amdgcn_s_getreg((5 << 11) | 4) & 63u; }
__device__ __forceinline__ int ltid() {
    extern __shared__ __attribute__((aligned(16))) unsigned char lds[];
    const int w = __builtin_amdgcn_readfirstlane(((const __attribute__((address_space(3))) int*)((__attribute__((address_space(3))) unsigned char*)lds + LTID_TABLE_OFF))[hw_wave_slot()]);
    int lane; asm volatile("v_mbcnt_lo_u32_b32 %0, -1, 0\n\tv_mbcnt_hi_u32_b32 %0, -1, %0" : "=v"(lane));
    return w * 64 + lane; }
__device__ __forceinline__ int lbid() { int t = blockIdx.x; asm volatile("" : "+s"(t)); return t; }
__device__ __forceinline__ int lgrid() { int t = gridDim.x; asm volatile("" : "+s"(t)); return t; }
namespace pg8 {
#define PG8_LAS __attribute__((address_space(3)))
typedef unsigned short bf16_t;
typedef short bf16x8 __attribute__((ext_vector_type(8)));
typedef float f32x4 __attribute__((ext_vector_type(4)));
typedef unsigned u32x4 __attribute__((ext_vector_type(4)));
constexpr int BM = 256, BK = 64, HALF = 128, HTB = HALF * BK * 2  , STAGE_BYTES = 8 * HTB, NXCD = 8, WGM = 4;

__host__ __device__ __forceinline__ int lds_byte(int r, int c) { const int st = (r >> 4) * 2 + (c >> 5), rr = r & 15, cc = c & 31, ob = rr * 64 + cc * 2; return st * 1024 + (ob ^ (((ob >> 9) & 1) << 5)); }
__host__ __device__ __forceinline__ void stage_rc(int b, int& R, int& C) { const int st = b / 1024, sb = b % 1024, swz = sb ^ (((sb >> 9) & 1) << 5); R = (st >> 1) * 16 + swz / 64; C = (st & 1) * 32 + (swz % 64) / 2; }
__host__ __device__ __forceinline__ int perm32(int rho) { const int n = rho >> 4, i = rho & 15; return 8 * (i >> 2) + 4 * n + (i & 3); }

struct Unit { int pm, pn, k0, nt; };
struct Gemm { const bf16_t* A; const bf16_t* Bt; int M, N, K, ld; };

struct StaticOrder {
    int nM, nN, nwg, G, c, wgm;
    __host__ __device__ __forceinline__ void init(int M, int N, int G_, int c_, int wgm_ = WGM) { nM = M / BM; nN = N / BM; nwg = nM * nN; G = G_; c = c_; wgm = wgm_; }
    __host__ __device__ __forceinline__ bool next(int i, Unit& u) const {
        const long L = (long)i * G + c; if (L >= nwg) return false;
        int wgid = (int)L; { const int q = nwg / NXCD, r = nwg % NXCD, xcd = wgid % NXCD, off = wgid / NXCD; wgid = (xcd < r ? xcd * (q + 1) : r * (q + 1) + (xcd - r) * q) + off; }
        const int nig = wgm * nN, gid = wgid / nig, fm = gid * wgm, gsz = (nM - fm) < wgm ? (nM - fm) : wgm;
        u.pm = fm + ((wgid % nig) % gsz); u.pn = (wgid % nig) / gsz; u.k0 = 0; u.nt = 0; return true;
    }
    __device__ __forceinline__ void a_ready(const Unit&) const {}
    __device__ __forceinline__ void done(const Unit&) const {}
};

struct SliceOrder {
    int pm, nN, nS, kslice, G, c;
    __host__ __device__ __forceinline__ bool next(int i, Unit& u) const { const int L = i * G + c; if (L >= nN * nS) return false; u.pm = pm; u.pn = L % nN; u.k0 = (L / nN) * kslice; u.nt = 0; return true; }
    __device__ __forceinline__ void a_ready(const Unit&) const {}
    __device__ __forceinline__ void done(const Unit&) const {}
};

struct ComboOrder {
    StaticOrder Pm; int pmS, nN, nS, kslice;
    __host__ __device__ __forceinline__ bool next(int i, Unit& u) const {
        if (i == 0) return Pm.next(0, u);
        if (i == 1) { const int L = Pm.c; if (L >= nN * nS) return false; u.pm = pmS; u.pn = L % nN; u.k0 = (L / nN) * kslice; u.nt = kslice / BK; return true; }
        return false; }
    __device__ __forceinline__ void a_ready(const Unit&) const {}
    __device__ __forceinline__ void done(const Unit&) const {}
};

__device__ __forceinline__ unsigned cvt_pk_bf16(float lo, float hi) { unsigned r; asm volatile("v_cvt_pk_bf16_f32 %0, %1, %2" : "=v"(r) : "v"(lo), "v"(hi)); return r; }
typedef float f32x2 __attribute__((ext_vector_type(2)));

struct EpiBf16 {
    static constexpr bool PERM = true, AFTER_DRAIN = false;
    bf16_t* O; int ldc;
    __device__ __forceinline__ void operator()(const f32x4 (&acc)[2][2][4][2], const Unit& u, int wr, int wc, int fr, int fq) const {
        const int row0 = u.pm * BM + wr * 64 + fr; const int col0 = u.pn * BM + wc * 32 + 8 * fq;
#pragma unroll
        for (int ai = 0; ai < 2; ++ai)
#pragma unroll
            for (int m = 0; m < 4; ++m) { bf16_t* rowp = O + (size_t)(row0 + ai * HALF + m * 16) * ldc + col0;
#pragma unroll
                for (int bj = 0; bj < 2; ++bj) { const f32x4 v0 = acc[ai][bj][m][0], v1 = acc[ai][bj][m][1];
                    u32x4 w; w.x = cvt_pk_bf16(v0[0], v0[1]); w.y = cvt_pk_bf16(v0[2], v0[3]); w.z = cvt_pk_bf16(v1[0], v1[1]); w.w = cvt_pk_bf16(v1[2], v1[3]);
                    *(u32x4*)(rowp + bj * HALF) = w; } }
    }
};
struct EpiIn {
    static constexpr bool PERM = true, AFTER_DRAIN = false;
    bf16_t* H; float* lrf; float* out; int layer; float* logf; f32x4 fbf;
    static constexpr int ldc = 2816, pm_sample = 64; static constexpr float qscale = 0.125f * 1.4426950408889634f;
    static constexpr size_t O_PFK = 16908288, O_PFV = O_PFK + 8388608, O_PFL = O_PFV + 8388608, O_SFK = 34156544, O_SFV = O_SFK + 65536;
    __device__ __forceinline__ void operator()(const f32x4 (&acc)[2][2][4][2], const Unit& u, int wr, int wc, int fr, int fq) const {
        const int row0 = u.pm * BM + wr * 64 + fr; const int col0 = u.pn * BM + wc * 32 + 8 * fq;
        const float sc = (u.pn == 5) ? qscale : 1.f;
#pragma unroll
        for (int ai = 0; ai < 2; ++ai)
#pragma unroll
            for (int m = 0; m < 4; ++m) { bf16_t* rowp = H + (size_t)(row0 + ai * HALF + m * 16) * ldc + col0;
#pragma unroll
                for (int bj = 0; bj < 2; ++bj) { const f32x4 v0 = acc[ai][bj][m][0] * sc, v1 = acc[ai][bj][m][1] * sc;
                    u32x4 w; w.x = cvt_pk_bf16(v0[0], v0[1]); w.y = cvt_pk_bf16(v0[2], v0[3]); w.z = cvt_pk_bf16(v1[0], v1[1]); w.w = cvt_pk_bf16(v1[2], v1[3]);
                    *(u32x4*)(rowp + bj * HALF) = w; } }
        if (u.pn == 6 || u.pn == 7) {
            const int lcol0 = wc * 32 + 8 * fq;
#pragma unroll
            for (int ai = 0; ai < 2; ++ai) {
                float* dst; int rbase;
                if (u.pm < pm_sample) { dst = out + ((u.pn == 6) ? O_PFK : O_PFV) + (size_t)layer * (16384 * 256); rbase = u.pm * BM; }
                else { if (ai == 1) continue; dst = out + ((u.pn == 6) ? O_SFK : O_SFV) + (size_t)layer * (128 * 256); rbase = 0; }
#pragma unroll
                for (int m = 0; m < 4; ++m) { float* rowp = dst + (size_t)(rbase + wr * 64 + fr + ai * HALF + m * 16) * 256 + lcol0;
#pragma unroll
                    for (int bj = 0; bj < 2; ++bj) { *(f32x4*)(rowp + bj * HALF) = acc[ai][bj][m][0]; *(f32x4*)(rowp + bj * HALF + 4) = acc[ai][bj][m][1]; } }
            }
        }
        if (u.pn == 10 && wc == 0) {
#pragma unroll
            for (int ai = 0; ai < 2; ++ai)
#pragma unroll
                for (int m = 0; m < 4; ++m) { const int row = row0 + ai * HALF + m * 16; float* rowp = lrf + (size_t)row * 32 + 8 * fq;
                    *(f32x4*)(rowp) = acc[ai][0][m][0]; *(f32x4*)(rowp + 4) = acc[ai][0][m][1];
                    if (fq == 2 && row < 16384) {
                        f32x4 lf;
#pragma unroll
                        for (int i = 0; i < 4; ++i) { const float x = acc[ai][0][m][0][i] + fbf[i]; lf[i] = fminf(x, 0.f) - log1pf(expf(-fabsf(x))); }
                        *(f32x4*)(logf + (size_t)row * 4) = lf; *(f32x4*)(out + O_PFL + ((size_t)layer * 16384 + row) * 4) = lf; } }
        }
    }
};
struct EpiRes {
    static constexpr bool PERM = true, AFTER_DRAIN = false;
    const bf16_t* R; bf16_t* Z; int ldc; float alpha;
    __device__ __forceinline__ void operator()(const f32x4 (&acc)[2][2][4][2], const Unit& u, int wr, int wc, int fr, int fq) const {
        const int row0 = u.pm * BM + wr * 64 + fr; const int col0 = u.pn * BM + wc * 32 + 8 * fq;
#pragma unroll
        for (int ai = 0; ai < 2; ++ai)
#pragma unroll
            for (int m = 0; m < 4; ++m) { const size_t off = (size_t)(row0 + ai * HALF + m * 16) * ldc + col0;
#pragma unroll
                for (int bj = 0; bj < 2; ++bj) { const u32x4 r = *(const u32x4*)(R + off + bj * HALF); const f32x4 a0 = acc[ai][bj][m][0], a1 = acc[ai][bj][m][1];
                    u32x4 w; w.x = cvt_pk_bf16(__uint_as_float(r.x << 16) * alpha + a0[0], __uint_as_float(r.x & 0xffff0000u) * alpha + a0[1]); w.y = cvt_pk_bf16(__uint_as_float(r.y << 16) * alpha + a0[2], __uint_as_float(r.y & 0xffff0000u) * alpha + a0[3]);
                    w.z = cvt_pk_bf16(__uint_as_float(r.z << 16) * alpha + a1[0], __uint_as_float(r.z & 0xffff0000u) * alpha + a1[1]); w.w = cvt_pk_bf16(__uint_as_float(r.w << 16) * alpha + a1[2], __uint_as_float(r.w & 0xffff0000u) * alpha + a1[3]);
                    *(u32x4*)(Z + off + bj * HALF) = w; } }
    }
};
struct EpiPart {
    static constexpr bool PERM = false, AFTER_DRAIN = false;
    float* PZ; int ldc, kslice;
    __device__ __forceinline__ void operator()(const f32x4 (&acc)[2][2][4][2], const Unit& u, int wr, int wc, int fr, int fq) const {
        const int col0 = u.pn * BM + wc * 32 + 4 * fq; float* base = PZ + (size_t)(u.k0 / kslice) * 128 * ldc;
#pragma unroll
        for (int m = 0; m < 4; ++m) { const size_t off = (size_t)(wr * 64 + m * 16 + fr) * ldc + col0;
#pragma unroll
            for (int bj = 0; bj < 2; ++bj)
#pragma unroll
                for (int n = 0; n < 2; ++n) *(f32x4*)(base + off + bj * HALF + n * 16) = acc[0][bj][m][n]; }
    }
};
struct EpiResPart {
    static constexpr bool PERM = true, AFTER_DRAIN = false;
    EpiRes R; float* PZ; int kslice;
    __device__ __forceinline__ void operator()(const f32x4 (&acc)[2][2][4][2], const Unit& u, int wr, int wc, int fr, int fq) const {
        if (u.nt == 0) { R(acc, u, wr, wc, fr, fq); return; }
        const int col0 = u.pn * BM + wc * 32 + 8 * fq; float* base = PZ + (size_t)(u.k0 / kslice) * 128 * R.ldc;
#pragma unroll
        for (int m = 0; m < 4; ++m) { const size_t off = (size_t)(wr * 64 + m * 16 + fr) * R.ldc + col0;
#pragma unroll
            for (int bj = 0; bj < 2; ++bj) { *(f32x4*)(base + off + bj * HALF) = acc[0][bj][m][0]; *(f32x4*)(base + off + bj * HALF + 4) = acc[0][bj][m][1]; } }
    }
};

template <class Epi, class Sched, bool ALIGN_EPI = false, bool SP2 = false>
__device__ __forceinline__ void gemm_phase(PG8_LAS unsigned char* lds, const Gemm g, const Sched& S, const Epi& E) {
    const int tid = ltid(), wid = __builtin_amdgcn_readfirstlane(tid >> 6), lane = tid & 63, wr = wid >> 2, wc = wid & 3, fr = lane & 15, fq = lane >> 4;
    const int K = g.K, nt = K / BK, LD = g.ld;
    unsigned voffA[2], voffB[2];
#pragma unroll
    for (int i = 0; i < 2; ++i) { int R, C; stage_rc(tid * 16 + i * 8192, R, C); const int Rb = Epi::PERM ? ((R & ~31) + perm32(R & 31)) : R;
        voffA[i] = (unsigned)(R * LD + C) * 2u; voffB[i] = (unsigned)(Rb * LD + C) * 2u; }
    const size_t kstep = (size_t)(BK * 2);
    const size_t hstep = (size_t)HALF * LD * 2;
    const size_t tstep = 2 * hstep;
    const unsigned ldsw = (unsigned)wid * 1024u;
    const int aoff = lds_byte(wr * 64 + fr, fq * 8), boff = lds_byte(wc * 32 + fr, fq * 8);
#define PG8_SA(b, h) (((b) * 2 + (h)) * HTB)
#define PG8_SB(b, h) ((4 + (b) * 2 + (h)) * HTB)
#define PG8_STAGE(bufoff, gbase, voff) do { _Pragma("unroll") for (int _i = 0; _i < 2; ++_i) \
        __builtin_amdgcn_global_load_lds((const unsigned*)((const char*)(gbase) + (voff)[_i]), (PG8_LAS unsigned*)(lds + (bufoff) + ldsw + _i * 8192), 16, 0, 0); } while (0)
#define PG8_LDA(dst, b, h) do { _Pragma("unroll") for (int m = 0; m < 4; ++m) _Pragma("unroll") for (int k = 0; k < 2; ++k) dst[m][k] = *(const PG8_LAS bf16x8*)(lds + PG8_SA(b, h) + aoff + m * 2048 + k * 1024); } while (0)
#define PG8_LDB(dst, b, h) do { _Pragma("unroll") for (int n = 0; n < 2; ++n) _Pragma("unroll") for (int k = 0; k < 2; ++k) dst[n][k] = *(const PG8_LAS bf16x8*)(lds + PG8_SB(b, h) + boff + n * 2048 + k * 1024); } while (0)
#define PG8_MMA(ai, bj, At, Bt) do { __builtin_amdgcn_s_setprio(1); _Pragma("unroll") for (int m = 0; m < 4; ++m) _Pragma("unroll") for (int n = 0; n < 2; ++n) _Pragma("unroll") for (int k = 0; k < 2; ++k) \
        acc[ai][bj][m][n] = __builtin_amdgcn_mfma_f32_16x16x32_bf16(Bt[n][k], At[m][k], acc[ai][bj][m][n], 0, 0, 0); __builtin_amdgcn_s_setprio(0); } while (0)
#define PG8_WAIT_V(n) asm volatile("s_waitcnt vmcnt(" #n ")" ::: "memory")
#define PG8_WAIT_L(n) asm volatile("s_waitcnt lgkmcnt(" #n ")" ::: "memory")
#define PG8_BAR __builtin_amdgcn_s_barrier()
#define PG8_SCHED __builtin_amdgcn_sched_barrier(0)
    Unit cur, nxt; int ui = 0;
    if (!S.next(0, cur)) return;
    f32x4 acc[2][2][4][2];
#pragma unroll
    for (int a = 0; a < 2; ++a)
#pragma unroll
        for (int b = 0; b < 2; ++b)
#pragma unroll
            for (int m = 0; m < 4; ++m)
#pragma unroll
                for (int n = 0; n < 2; ++n) acc[a][b][m][n] = (f32x4){0.f, 0.f, 0.f, 0.f};
    bf16x8 At[4][2], B0[2][2], B1[2][2];
    const char* cA = (const char*)g.A + (size_t)cur.pm * tstep + (size_t)cur.k0 * 2; const char* cB = (const char*)g.Bt + (size_t)cur.pn * tstep + (size_t)cur.k0 * 2;
    S.a_ready(cur);
    if constexpr (SP2) {
        PG8_STAGE(PG8_SB(0, 0), cB, voffB); PG8_STAGE(PG8_SB(0, 1), cB + hstep, voffB); PG8_STAGE(PG8_SA(0, 0), cA, voffA); PG8_STAGE(PG8_SA(0, 1), cA + hstep, voffA);
        if (wr == 1) PG8_BAR;
        PG8_WAIT_V(2); PG8_BAR;
        PG8_STAGE(PG8_SB(1, 0), cB + kstep, voffB); PG8_STAGE(PG8_SA(1, 0), cA + kstep, voffA); PG8_STAGE(PG8_SB(1, 1), cB + hstep + kstep, voffB);
        PG8_WAIT_V(6); PG8_BAR;
    } else {
        PG8_STAGE(PG8_SB(0, 0), cB, voffB); PG8_STAGE(PG8_SA(0, 0), cA, voffA); PG8_STAGE(PG8_SB(0, 1), cB + hstep, voffB); PG8_STAGE(PG8_SA(0, 1), cA + hstep, voffA);
        if (wr == 1) PG8_BAR;
        PG8_WAIT_V(4); PG8_BAR;
        PG8_STAGE(PG8_SB(1, 0), cB + kstep, voffB); PG8_STAGE(PG8_SA(1, 0), cA + kstep, voffA); PG8_STAGE(PG8_SB(1, 1), cB + hstep + kstep, voffB);
        PG8_WAIT_V(6); PG8_BAR;
    }
    for (;;) {
        const bool has_next = S.next(ui + 1, nxt);
        const char* nA = has_next ? (const char*)g.A + (size_t)nxt.pm * tstep + (size_t)nxt.k0 * 2 : cA; const char* nB = has_next ? (const char*)g.Bt + (size_t)nxt.pn * tstep + (size_t)nxt.k0 * 2 : cB;
        const int cnt = cur.nt > 0 ? cur.nt : nt;
        for (int t = 0; t < cnt; t += 2) {
            const bool last = (t == cnt - 2);
            const char* a1 = cA + (size_t)(t + 1) * kstep;
            const char* a2 = last ? nA : cA + (size_t)(t + 2) * kstep; const char* b2 = last ? nB : cB + (size_t)(t + 2) * kstep;
            const char* a3 = a2 + kstep; const char* b3 = b2 + kstep;
            if (last && has_next) S.a_ready(nxt);
            if constexpr (SP2) {
            PG8_LDB(B0, 0, 0); PG8_LDB(B1, 0, 1); PG8_SCHED; PG8_LDA(At, 0, 0); PG8_STAGE(PG8_SA(1, 1), a1 + hstep, voffA);
            PG8_WAIT_V(8); PG8_WAIT_L(0); PG8_BAR; PG8_MMA(0, 0, At, B0); PG8_MMA(0, 1, At, B1); PG8_BAR; PG8_SCHED;
            PG8_LDA(At, 0, 1); PG8_STAGE(PG8_SB(0, 0), b2, voffB); PG8_STAGE(PG8_SB(0, 1), b2 + hstep, voffB); PG8_STAGE(PG8_SA(0, 0), a2, voffA);
            PG8_WAIT_V(8); PG8_WAIT_L(0); PG8_BAR; PG8_MMA(1, 0, At, B0); PG8_MMA(1, 1, At, B1); PG8_BAR; PG8_SCHED;
            PG8_LDB(B0, 1, 0); PG8_LDB(B1, 1, 1); PG8_SCHED; PG8_LDA(At, 1, 0); PG8_STAGE(PG8_SA(0, 1), a2 + hstep, voffA);
            PG8_WAIT_V(8); PG8_WAIT_L(0); PG8_BAR; PG8_MMA(0, 0, At, B0); PG8_MMA(0, 1, At, B1); PG8_BAR; PG8_SCHED;
            PG8_LDA(At, 1, 1); PG8_STAGE(PG8_SB(1, 0), b3, voffB); PG8_STAGE(PG8_SB(1, 1), b3 + hstep, voffB); PG8_STAGE(PG8_SA(1, 0), a3, voffA);
            PG8_WAIT_V(8); PG8_WAIT_L(0); PG8_BAR; PG8_MMA(1, 0, At, B0); PG8_MMA(1, 1, At, B1); PG8_BAR; PG8_SCHED;
            } else {
            PG8_LDB(B0, 0, 0); PG8_SCHED; PG8_LDA(At, 0, 0); PG8_STAGE(PG8_SA(1, 1), a1 + hstep, voffA);
            PG8_WAIT_L(8); PG8_BAR; PG8_WAIT_L(0); PG8_MMA(0, 0, At, B0); PG8_BAR; PG8_SCHED;
            PG8_LDB(B1, 0, 1); PG8_STAGE(PG8_SB(0, 0), b2, voffB);
            PG8_BAR; PG8_WAIT_L(0); PG8_MMA(0, 1, At, B1); PG8_BAR;
            PG8_LDA(At, 0, 1); PG8_STAGE(PG8_SA(0, 0), a2, voffA);
            PG8_BAR; PG8_WAIT_L(0); PG8_MMA(1, 0, At, B0); PG8_BAR; PG8_SCHED;
            PG8_STAGE(PG8_SB(0, 1), b2 + hstep, voffB);
            PG8_WAIT_V(6); PG8_BAR; PG8_MMA(1, 1, At, B1); PG8_BAR;
            PG8_LDB(B0, 1, 0); PG8_SCHED; PG8_LDA(At, 1, 0); PG8_STAGE(PG8_SA(0, 1), a2 + hstep, voffA);
            PG8_WAIT_L(8); PG8_BAR; PG8_WAIT_L(0); PG8_MMA(0, 0, At, B0); PG8_BAR; PG8_SCHED;
            PG8_LDB(B1, 1, 1); PG8_STAGE(PG8_SB(1, 0), b3, voffB);
            PG8_BAR; PG8_WAIT_L(0); PG8_MMA(0, 1, At, B1); PG8_BAR;
            PG8_LDA(At, 1, 1); PG8_STAGE(PG8_SA(1, 0), a3, voffA);
            PG8_BAR; PG8_WAIT_L(0); PG8_MMA(1, 0, At, B0); PG8_BAR; PG8_SCHED;
            PG8_STAGE(PG8_SB(1, 1), b3 + hstep, voffB);
            PG8_WAIT_V(6); PG8_BAR; PG8_MMA(1, 1, At, B1); PG8_BAR;
            }
        }
        if constexpr (ALIGN_EPI) { if (wr == 0) PG8_BAR; }
        if constexpr (!Epi::AFTER_DRAIN) { E(acc, cur, wr, wc, fr, fq); S.done(cur); }
        if (!has_next) break;
#pragma unroll
        for (int a = 0; a < 2; ++a)
#pragma unroll
            for (int b = 0; b < 2; ++b)
#pragma unroll
                for (int m = 0; m < 4; ++m)
#pragma unroll
                    for (int n = 0; n < 2; ++n) acc[a][b][m][n] = (f32x4){0.f, 0.f, 0.f, 0.f};
        cur = nxt; cA = nA; cB = nB; ++ui;
        if constexpr (ALIGN_EPI) { if (wr == 1) PG8_BAR; }
    }
    PG8_WAIT_V(0);
    if constexpr (!ALIGN_EPI) { if (wr == 0) PG8_BAR; }
    PG8_BAR;
    if constexpr (Epi::AFTER_DRAIN) { E.fused(acc, cur, wr, wc, fr, fq, lds, wid, lane); S.done(cur); }
#undef PG8_SA
#undef PG8_SB
#undef PG8_STAGE
#undef PG8_LDA
#undef PG8_LDB
#undef PG8_MMA
#undef PG8_WAIT_V
#undef PG8_WAIT_L
#undef PG8_BAR
#undef PG8_SCHED
}
}

#ifndef PG8_SP2
#define PG8_SP2 true
#endif

#include <hip/hip_bf16.h>
#include <cmath>
namespace attn_body {
using bf16=__hip_bfloat16;
using bf16x8=__attribute__((ext_vector_type(8)))short;
using s16x4=__attribute__((ext_vector_type(4)))short;
using f32x16=__attribute__((ext_vector_type(16)))float;
using u32x4=__attribute__((ext_vector_type(4)))unsigned;
constexpr int BATCH=8,NHEAD=4,SEQ=2048,D=64,DM=2816,DMO=1024;
constexpr int NW=8,QBLK=32,QB=QBLK*NW,KVBLK=64,NQB=SEQ/QB;
constexpr int ATTN_PITCH=DM, ATTN_UNIT_ROWS=QB;
__device__ __forceinline__ int crow(int r,int hi){return (r&3)+8*(r>>2)+4*hi;}
#define SBAR() __builtin_amdgcn_sched_barrier(0)
__device__ __forceinline__ void cmask(f32x16&p0,f32x16&p1,int jb,int qrel,int hi){
  const float NEG=-INFINITY; int kb=64*jb+4*hi;
  #pragma unroll
  for(int r=0;r<16;++r){int kv=kb+(r&3)+8*(r>>2); if(kv>qrel)p0[r]=NEG; if(kv+32>qrel)p1[r]=NEG;}
}

constexpr int NSLOT=3, SLOTB=8192;
constexpr int LDS_K=0, LDS_V=NSLOT*SLOTB, LDS_WS=2*NSLOT*SLOTB, LDS_OST=LDS_WS+NW*64*4, LDS_KB=LDS_OST+NW*4096, LDS_BYTES=LDS_KB+SEQ*4;
constexpr float C2=0.125f*1.4426950408889634f;
__device__ __forceinline__ void glds16(const void*gsrc,unsigned lds_dst){unsigned keep;
  asm volatile("s_mov_b32 %0, m0\n\ts_mov_b32 m0, %2\n\ts_nop 0\n\tglobal_load_lds_dwordx4 %1, off\n\ts_mov_b32 m0, %0":"=&s"(keep):"v"(gsrc),"s"(lds_dst):"memory");}
__device__ __forceinline__ float max3f(float a,float b,float c){float r;asm("v_max3_f32 %0, %1, %2, %3":"=v"(r):"v"(a),"v"(b),"v"(c));return r;}
__device__ __forceinline__ float max2f(float a,float b){float r;asm("v_max_f32_e32 %0, %1, %2":"=v"(r):"v"(a),"v"(b));return r;}
__device__ __forceinline__ float fadd_s(float a,float b){float r;asm("v_add_f32_e32 %0, %1, %2":"=v"(r):"v"(a),"v"(b));return r;}
__device__ __forceinline__ float fsub_s(float a,float b){float r;asm("v_sub_f32_e32 %0, %1, %2":"=v"(r):"v"(a),"v"(b));return r;}
typedef float f32x2_t __attribute__((ext_vector_type(2))); typedef __bf16 bf16x2_t __attribute__((ext_vector_type(2)));
__device__ __forceinline__ unsigned cvtpk_s(float lo,float hi){f32x2_t v={lo,hi};bf16x2_t b=__builtin_convertvector(v,bf16x2_t);return __builtin_bit_cast(unsigned,b);}
#define WAIT_BAR(N) asm volatile("s_waitcnt vmcnt(" #N ") lgkmcnt(0)\n\ts_barrier":::"memory")

__device__ __forceinline__ void qkt(f32x16&p0,f32x16&p1,const char*Kslot,const bf16x8*qr,const f32x16&c0,const f32x16&c1,int r32,int hi){
  const char*kb=Kslot+hi*1024+r32*16;
  #pragma unroll
  for(int d0=0;d0<4;++d0){
    const bf16x8 b0=*reinterpret_cast<const bf16x8*>(kb+d0*2048);
    const bf16x8 b1=*reinterpret_cast<const bf16x8*>(kb+d0*2048+512);
    if(d0==0){p0=__builtin_amdgcn_mfma_f32_32x32x16_bf16(b0,qr[0],c0,0,0,0);p1=__builtin_amdgcn_mfma_f32_32x32x16_bf16(b1,qr[0],c1,0,0,0);}
    else{p0=__builtin_amdgcn_mfma_f32_32x32x16_bf16(b0,qr[d0],p0,0,0,0);p1=__builtin_amdgcn_mfma_f32_32x32x16_bf16(b1,qr[d0],p1,0,0,0);}}
}
typedef __attribute__((address_space(3))) const char* lds_cptr;
typedef short v4i16_t __attribute__((ext_vector_type(4)));
__device__ __forceinline__ void kload8(bf16x8*kf,lds_cptr kp){
  kf[0]=*(const __attribute__((address_space(3))) bf16x8*)(kp);      kf[1]=*(const __attribute__((address_space(3))) bf16x8*)(kp+512);
  kf[2]=*(const __attribute__((address_space(3))) bf16x8*)(kp+2048); kf[3]=*(const __attribute__((address_space(3))) bf16x8*)(kp+2560);
  kf[4]=*(const __attribute__((address_space(3))) bf16x8*)(kp+4096); kf[5]=*(const __attribute__((address_space(3))) bf16x8*)(kp+4608);
  kf[6]=*(const __attribute__((address_space(3))) bf16x8*)(kp+6144); kf[7]=*(const __attribute__((address_space(3))) bf16x8*)(kp+6656);
}
__device__ __forceinline__ void kload2(bf16x8*kf,lds_cptr kp,int j){ kf[2*j]=*(const __attribute__((address_space(3))) bf16x8*)(kp+j*2048); kf[2*j+1]=*(const __attribute__((address_space(3))) bf16x8*)(kp+j*2048+512); }
__device__ __forceinline__ s16x4 vtr(lds_cptr p){ return __builtin_bit_cast(s16x4,__builtin_amdgcn_ds_read_tr16_b64_v4i16((__attribute__((address_space(3))) v4i16_t*)p)); }
__device__ __forceinline__ float rowmax(const f32x16&p0,const f32x16&p1){
  float a=max3f(p0[0],p0[1],p1[0]),b=max3f(p0[2],p0[3],p1[1]);a=max3f(a,p1[2],p1[3]);
  #pragma unroll
  for(int r=4;r<16;r+=4){a=max3f(a,p0[r],p0[r+1]);b=max3f(b,p0[r+2],p0[r+3]);a=max3f(a,p1[r],p1[r+1]);b=max3f(b,p1[r+2],p1[r+3]);}
  const float m=max2f(a,b);
  auto rr=__builtin_amdgcn_permlane32_swap(__float_as_uint(m),__float_as_uint(m),false,false);
  return max2f(__uint_as_float(rr[0]),__uint_as_float(rr[1]));
}
__device__ __forceinline__ void pv(f32x16*o,int vb,bf16x8 pa0,bf16x8 pa1,bf16x8 pa2,bf16x8 pa3){
  #pragma unroll
  for(int d0=0;d0<2;++d0){s16x4 lo[4],hi[4];
    #pragma unroll
    for(int ks=0;ks<4;++ks){
      asm volatile("ds_read_b64_tr_b16 %0,%1 offset:%c2":"=&v"(lo[ks]):"v"(vb),"i"(d0*4096+ks*1024):"memory");
      asm volatile("ds_read_b64_tr_b16 %0,%1 offset:%c2":"=&v"(hi[ks]):"v"(vb),"i"(d0*4096+ks*1024+512):"memory");}
    asm volatile("s_waitcnt lgkmcnt(0)":::"memory");SBAR();
    #define PK(k) (bf16x8){lo[k][0],lo[k][1],lo[k][2],lo[k][3],hi[k][0],hi[k][1],hi[k][2],hi[k][3]}
    o[d0]=__builtin_amdgcn_mfma_f32_32x32x16_bf16(pa0,PK(0),o[d0],0,0,0);
    o[d0]=__builtin_amdgcn_mfma_f32_32x32x16_bf16(pa1,PK(1),o[d0],0,0,0);
    o[d0]=__builtin_amdgcn_mfma_f32_32x32x16_bf16(pa2,PK(2),o[d0],0,0,0);
    o[d0]=__builtin_amdgcn_mfma_f32_32x32x16_bf16(pa3,PK(3),o[d0],0,0,0);
    #undef PK
  }
}

#ifndef ATTN_STORE16
#define ATTN_STORE16(p,v) (*(u32x4*)(p)=(v))
#endif
template<int THRL> __device__ __forceinline__ void attn_unit(int b,int h,int qb,const bf16*Q,const bf16*__restrict__ K,const bf16*__restrict__ V,bf16*O,const float*__restrict__ KBg,char*shm){
  const int tid=ltid(),lane=tid&63,r32=lane&31,hi=lane>>5; const int wid=__builtin_amdgcn_readfirstlane(tid>>6);
  const long rowbase=(long)b*SEQ; const int q0=qb*QB;
  const bf16*Qw=Q+(rowbase+q0+wid*QBLK)*DM+h*D;
  const bf16*Kh=K+rowbase*DM+h*D,*Vh=V+rowbase*DM+h*D;
  const lds_cptr shm3=(lds_cptr)shm;
  const unsigned lds0=(unsigned)(uintptr_t)shm;
  float*wsf=(float*)(shm+LDS_WS)+wid*64;
  const bf16*ksrc=Kh+(long)lane*DM+wid*8;
  const bf16*vsrc=Vh+(long)(16*(wid&3)+(lane>>2))*DM+(wid>>2)*32+(lane&3)*8;
  const unsigned kdst=lds0+LDS_K+wid*1024, vdst=lds0+LDS_V+wid*1024;
  #define DMA_K(t,slot) glds16(ksrc+(long)(t)*KVBLK*DM,(unsigned)__builtin_amdgcn_readfirstlane(kdst+(slot)))
  #define DMA_V(t,slot) glds16(vsrc+(long)(t)*KVBLK*DM,(unsigned)__builtin_amdgcn_readfirstlane(vdst+(slot)))
  const int vb0=(int)(lds0+LDS_V)+((lane>>4)&1)*32+(lane&3)*8+(4*hi+((lane&15)>>2))*64;
  const char*Kbase=shm+LDS_K; bf16x8 kf[8];
  const lds_cptr kp0=shm3+LDS_K+hi*1024+r32*16; const lds_cptr vp0=shm3+LDS_V+((lane>>4)&1)*32+(lane&3)*8+(4*hi+((lane&15)>>2))*64;
  const int NT=(q0+QB)/KVBLK;
  { typedef float f32x4_t __attribute__((ext_vector_type(4))); const int i4=tid*4; if(i4<q0+QB){ const f32x4_t kv=*(const f32x4_t*)(KBg+((long)(b*NHEAD+h))*SEQ+i4); *(__attribute__((address_space(3))) f32x4_t*)((lds_cptr)shm+LDS_KB+i4*4)=kv; } }
  typedef float kb4_t __attribute__((ext_vector_type(4))); const __attribute__((address_space(3))) kb4_t* kbp=(const __attribute__((address_space(3))) kb4_t*)(shm3+LDS_KB)+hi;
  DMA_K(0,0);DMA_V(0,0);DMA_K(1,SLOTB);
  bf16x8 qr[4];
  #pragma unroll
  for(int d0=0;d0<4;++d0)qr[d0]=*reinterpret_cast<const bf16x8*>(&Qw[(long)r32*DM+d0*16+hi*8]);
  float mhat=0.f,l_reg=0.f;f32x16 o[2];o[0]=f32x16{};o[1]=f32x16{};float nm=0.f;asm volatile("":"+v"(nm));
  #define NBIAS(N0,N1,t) do{ _Pragma("unroll") for(int g_=0;g_<4;++g_){ const kb4_t a_=kbp[16*(t)+2*g_], b_=kbp[16*(t)+2*g_+8]; \
      _Pragma("unroll") for(int i_=0;i_<4;++i_){ N0[4*g_+i_]=a_[i_]+nm; N1[4*g_+i_]=b_[i_]+nm; } } }while(0)
  const int qrel=wid*QBLK+r32;
  #define CMASK(P0,P1,t) do{int jb_=(t)-(NT-4); if(jb_>=0)cmask(P0,P1,jb_,qrel,hi);}while(0)
  bool resc=false;
  #define START(P0,P1) do{ const float rm=rowmax(P0,P1); resc=false; \
    { const float dl=rm; mhat=fadd_s(mhat,dl); \
      _Pragma("unroll") for(int r=0;r<16;++r){P0[r]=fsub_s(P0[r],dl);P1[r]=fsub_s(P1[r],dl);} \
      nm=-mhat; asm volatile("":"+v"(nm)); } \
    _Pragma("unroll") for(int r=0;r<16;++r)P0[r]=__builtin_amdgcn_exp2f(P0[r]); }while(0)
  #define RESC() do{ if(resc){ asm volatile("s_waitcnt lgkmcnt(0)":::"memory"); \
      _Pragma("unroll") for(int d_=0;d_<2;++d_) _Pragma("unroll") for(int r=0;r<16;++r)o[d_][r]*=wsf[crow(r,hi)]; } }while(0)
  f32x16 pA0,pA1,pB0,pB1;
  int sl_prev=0,sl_cur=0,sl_next=SLOTB;
  #define ROT() do{sl_prev=sl_cur;sl_cur=sl_next;sl_next=(sl_next==(NSLOT-1)*SLOTB)?0:sl_next+SLOTB;}while(0)
  DMA_K(2,2*SLOTB);
  WAIT_BAR(3);
  { f32x16 c0_,c1_; NBIAS(c0_,c1_,0); qkt(pA0,pA1,Kbase,qr,c0_,c1_,r32,hi); } asm volatile("s_nop 15\n\ts_nop 7":"+v"(pA0),"+v"(pA1));CMASK(pA0,pA1,0);
  START(pA0,pA1);
  _Pragma("unroll") for(int r=0;r<16;++r)pA1[r]=__builtin_amdgcn_exp2f(pA1[r]);
  WAIT_BAR(0);
  DMA_K(3,0);DMA_V(1,SLOTB);
  ROT();
  kload8(kf,kp0+sl_cur);
  WAIT_BAR(2);
  s16x4 vlo[8],vhi[8]; u32x4 pw0,pw1,pw2,pw3;
  #define PKW(P,B) cvtpk_s(P[B],P[B+1])
  #define PAF(k) __builtin_bit_cast(bf16x8,pw##k)
  #define VFR(i) (bf16x8){vlo[i][0],vlo[i][1],vlo[i][2],vlo[i][3],vhi[i][0],vhi[i][1],vhi[i][2],vhi[i][3]}
  #define PIN(x) asm volatile("":"+v"(x))
  #define MX3(a,b,c) __builtin_fmaxf(__builtin_fmaxf((a),(b)),(c))
  #define GAPA(MF,A0,A1,A2,A3,W0,W1,PW) do{ MF; sacc+=A0; sacc+=A1; sacc+=A2; sacc+=A3; PIN(sacc); W0; W1; PIN(PW); SBAR(); }while(0)
  #define EX(v) __builtin_amdgcn_exp2f(v)
  #define GAPB(MF,X,B) do{ MF; X[B]=EX(X[B]); X[B+1]=EX(X[B+1]); X[B+2]=EX(X[B+2]); X[B+3]=EX(X[B+3]); PIN(X); SBAR(); }while(0)
  #define VRD(i) do{ vlo[i]=vtr(vp_+(((i)>>2)*4096+((i)&3)*1024)); vhi[i]=vtr(vp_+(((i)>>2)*4096+((i)&3)*1024+512)); }while(0)
  #define KRD(G,j) do{ if(G){ kload2(kf,kp0+sl_next,j); SBAR(); } }while(0)
  #define STEP(C0,C1,P0,P1,t,GK,GV,GL) do{ SBAR(); \
    const lds_cptr vp_=vp0+sl_prev; \
    NBIAS(C0,C1,t); SBAR(); \
    VRD(0); SBAR(); float sacc=(P0[0]+P0[1]); \
    GAPA(C0=__builtin_amdgcn_mfma_f32_32x32x16_bf16(kf[0],qr[0],C0,0,0,0), P0[2],P0[3],P0[4],P0[5],     pw0[0]=PKW(P0,0), pw0[1]=PKW(P0,2), pw0); \
    VRD(4); SBAR(); GAPA(C1=__builtin_amdgcn_mfma_f32_32x32x16_bf16(kf[1],qr[0],C1,0,0,0), P0[6],P0[7],P0[8],P0[9],     pw0[2]=PKW(P0,4), pw0[3]=PKW(P0,6), pw0); \
    VRD(1); SBAR(); GAPA(C0=__builtin_amdgcn_mfma_f32_32x32x16_bf16(kf[2],qr[1],C0,0,0,0),   P0[10],P0[11],P0[12],P0[13], pw1[0]=PKW(P0,8), pw1[1]=PKW(P0,10), pw1); \
    VRD(5); SBAR(); GAPA(C1=__builtin_amdgcn_mfma_f32_32x32x16_bf16(kf[3],qr[1],C1,0,0,0),   P0[14],P0[15],P1[0],P1[1],   pw1[2]=PKW(P0,12),pw1[3]=PKW(P0,14), pw1); \
    VRD(2); SBAR(); GAPA(C0=__builtin_amdgcn_mfma_f32_32x32x16_bf16(kf[4],qr[2],C0,0,0,0),   P1[2],P1[3],P1[4],P1[5],     pw2[0]=PKW(P1,0), pw2[1]=PKW(P1,2), pw2); \
    VRD(6); SBAR(); GAPA(C1=__builtin_amdgcn_mfma_f32_32x32x16_bf16(kf[5],qr[2],C1,0,0,0),   P1[6],P1[7],P1[8],P1[9],     pw2[2]=PKW(P1,4), pw2[3]=PKW(P1,6), pw2); \
    VRD(3); SBAR(); GAPA(C0=__builtin_amdgcn_mfma_f32_32x32x16_bf16(kf[6],qr[3],C0,0,0,0),   P1[10],P1[11],P1[12],P1[13], pw3[0]=PKW(P1,8), pw3[1]=PKW(P1,10), pw3); \
    VRD(7); SBAR(); GAPA(C1=__builtin_amdgcn_mfma_f32_32x32x16_bf16(kf[7],qr[3],C1,0,0,0),   P1[14],P1[15],0.f,0.f,       pw3[2]=PKW(P1,12),pw3[3]=PKW(P1,14), pw3); \
    l_reg+=sacc; \
    if(GK){DMA_K((t)+3,sl_cur);} if(GV){DMA_V((t)+1,sl_next);} \
    CMASK(C0,C1,t); \
    { float a=MX3(C0[0],C0[1],C1[0]),b=MX3(C0[2],C0[3],C1[1]); a=MX3(a,C1[2],C1[3]); \
      _Pragma("unroll") for(int r=4;r<16;r+=4){a=MX3(a,C0[r],C0[r+1]);b=MX3(b,C0[r+2],C0[r+3]);a=MX3(a,C1[r],C1[r+1]);b=MX3(b,C1[r+2],C1[r+3]);} \
      float rm=__builtin_fmaxf(a,b); { auto rr=__builtin_amdgcn_permlane32_swap(__float_as_uint(rm),__float_as_uint(rm),false,false); rm=__builtin_fmaxf(__uint_as_float(rr[0]),__uint_as_float(rr[1])); } \
      resc=false; \
      if(__builtin_expect(__any(rm>(float)THRL),0)){ const float dl=__builtin_fmaxf(rm,0.f); mhat+=dl; \
        _Pragma("unroll") for(int r=0;r<16;++r){C0[r]-=dl;C1[r]-=dl;} \
        nm=-mhat; asm volatile("":"+v"(nm)); \
        const float f=__builtin_amdgcn_exp2f(-dl); l_reg*=f; if(hi==0)wsf[r32]=f; resc=true; } } \
    SBAR(); \
    GAPB(o[0]=__builtin_amdgcn_mfma_f32_32x32x16_bf16(PAF(0),VFR(0),o[0],0,0,0), C0,0); \
    GAPB(o[1]=__builtin_amdgcn_mfma_f32_32x32x16_bf16(PAF(0),VFR(4),o[1],0,0,0), C0,4); \
    KRD(GL,0); GAPB(o[0]=__builtin_amdgcn_mfma_f32_32x32x16_bf16(PAF(1),VFR(1),o[0],0,0,0), C0,8); \
    KRD(GL,1); GAPB(o[1]=__builtin_amdgcn_mfma_f32_32x32x16_bf16(PAF(1),VFR(5),o[1],0,0,0), C0,12); \
    KRD(GL,2); GAPB(o[0]=__builtin_amdgcn_mfma_f32_32x32x16_bf16(PAF(2),VFR(2),o[0],0,0,0), C1,0); \
    KRD(GL,3); GAPB(o[1]=__builtin_amdgcn_mfma_f32_32x32x16_bf16(PAF(2),VFR(6),o[1],0,0,0), C1,4); \
    GAPB(o[0]=__builtin_amdgcn_mfma_f32_32x32x16_bf16(PAF(3),VFR(3),o[0],0,0,0), C1,8); \
    GAPB(o[1]=__builtin_amdgcn_mfma_f32_32x32x16_bf16(PAF(3),VFR(7),o[1],0,0,0), C1,12); \
    }while(0)
  int t=1;
  #undef CMASK
  #define CMASK(P0,P1,t) do{}while(0)
  for(;t+5<NT;t+=2){
    STEP(pB0,pB1,pA0,pA1,t,true,true,true);     WAIT_BAR(2); RESC(); ROT();
    STEP(pA0,pA1,pB0,pB1,t+1,true,true,true);   WAIT_BAR(2); RESC(); ROT();
  }
  #undef CMASK
  #define CMASK(P0,P1,t) do{int jb_=(t)-(NT-4); if(jb_>=0)cmask(P0,P1,jb_,qrel,hi);}while(0)
  #define ENDW(tt) do{ if((tt)+3<NT){WAIT_BAR(2);} else if((tt)+2<NT){WAIT_BAR(1);} else {WAIT_BAR(0);} }while(0)
  for(;t+1<NT;t+=2){
    STEP(pB0,pB1,pA0,pA1,t,(t+3<NT),(t+1<NT),(t+1<NT));       ENDW(t);   RESC(); ROT();
    STEP(pA0,pA1,pB0,pB1,t+1,(t+4<NT),(t+2<NT),(t+2<NT));     ENDW(t+1); RESC(); ROT();
  }
  STEP(pB0,pB1,pA0,pA1,NT-1,false,false,false); RESC();
  { float sacc=pB0[0]+pB0[1]; _Pragma("unroll") for(int r=2;r<16;++r)sacc+=pB0[r]; _Pragma("unroll") for(int r=0;r<16;++r)sacc+=pB1[r]; l_reg+=sacc;
    pw0=(u32x4){PKW(pB0,0),PKW(pB0,2),PKW(pB0,4),PKW(pB0,6)};pw1=(u32x4){PKW(pB0,8),PKW(pB0,10),PKW(pB0,12),PKW(pB0,14)};pw2=(u32x4){PKW(pB1,0),PKW(pB1,2),PKW(pB1,4),PKW(pB1,6)};pw3=(u32x4){PKW(pB1,8),PKW(pB1,10),PKW(pB1,12),PKW(pB1,14)};
    SBAR(); pv(o,vb0+sl_cur,PAF(0),PAF(1),PAF(2),PAF(3)); }
  #undef PKW
  #undef PAF
  #undef VFR
  #undef PIN
  #undef MX3
  #undef GAPA
  #undef GAPB
  #undef EX
  #undef VRD
  #undef KRD
  #undef STEP
  #undef ENDW
  {auto rr=__builtin_amdgcn_permlane32_swap(__float_as_uint(l_reg),__float_as_uint(l_reg),false,false);l_reg=__uint_as_float(rr[0])+__uint_as_float(rr[1]);}
  if(hi==0)wsf[32+r32]=l_reg;asm volatile("s_waitcnt lgkmcnt(0)":::"memory");
  float rli[16];
  #pragma unroll
  for(int r=0;r<16;++r)rli[r]=__builtin_amdgcn_rcpf(wsf[32+crow(r,hi)]);
  bf16*Ow=O+(rowbase+q0+wid*QBLK)*DMO+h*D;
  { bf16*stg=(bf16*)(shm+LDS_OST)+wid*2048;
    #pragma unroll
    for(int r=0;r<16;++r){const int orow=crow(r,hi);
      #pragma unroll
      for(int d0=0;d0<2;++d0)stg[orow*64+d0*32+r32]=__float2bfloat16(o[d0][r]*rli[r]);}
    asm volatile("s_waitcnt lgkmcnt(0)":::"memory");
    #pragma unroll
    for(int i=0;i<4;++i){const int row=i*8+(lane>>3),ch=lane&7; const u32x4 v=*(const u32x4*)(stg+row*64+ch*8); ATTN_STORE16(Ow+(long)row*DMO+ch*8,v);} }
  asm volatile("s_waitcnt lgkmcnt(0)\n\ts_barrier":::"memory");
  #undef NBIAS
  #undef DMA_K
  #undef DMA_V
  #undef CMASK
  #undef START
  #undef RESC
  #undef ROT
}
constexpr int ATTN_LDS_BYTES=LDS_BYTES;
struct AttnTensors { const bf16* Q; const bf16* K; const bf16* V; bf16* O; const float* KB; };
struct AttnUnit { int bh; int qb; };
struct StaticOrder {
  int vcu;
  __device__ __forceinline__ explicit StaticOrder(int grid,int block):vcu((block%8)*(grid/8)+block/8){}
  __device__ __forceinline__ bool next(int i,AttnUnit&u)const{ if(i>=4)return false; const int s=vcu&7; u.bh=vcu>>3; u.qb=(i==0)?s:(i==1)?15-s:(i==2)?16+s:31-s; return true; }
  __device__ __forceinline__ void a_ready(const AttnUnit&)const{}
  __device__ __forceinline__ void done(const AttnUnit&)const{}
};
template<class Sched,int THRL=8> __device__ __forceinline__ void attn_phase(char*lds,const AttnTensors&T,const Sched&S){
  AttnUnit u;
  for(int i=0;S.next(i,u);++i){ S.a_ready(u); attn_unit<THRL>(u.bh/NHEAD,u.bh%NHEAD,u.qb,T.Q,T.K,T.V,T.O,T.KB,lds); S.done(u); }
}
#undef SBAR
#undef WAIT_BAR
}

#define GAS __attribute__((address_space(1)))
#define LAS __attribute__((address_space(3)))
typedef unsigned short bf16;
typedef unsigned v4u __attribute__((ext_vector_type(4)));
typedef float f32x4 __attribute__((ext_vector_type(4)));
typedef short bf16x8 __attribute__((ext_vector_type(8)));
typedef GAS unsigned gu32;
typedef GAS unsigned long long gu64;
#define RLX_AGENT __ATOMIC_RELAXED, __HIP_MEMORY_SCOPE_AGENT
#define LDS_WAIT() asm volatile("s_waitcnt lgkmcnt(0)" ::: "memory")
#define VM_WAIT() asm volatile("s_waitcnt vmcnt(0)" ::: "memory")
__device__ __forceinline__ unsigned long long rt() { return __builtin_amdgcn_s_memrealtime(); }
__device__ __forceinline__ unsigned f2bf(float f) { unsigned u = __builtin_bit_cast(unsigned, f); return (u + 0x7fffu + ((u >> 16) & 1u)) >> 16; }
__device__ __forceinline__ unsigned pk2(float lo, float hi) { return f2bf(lo) | (f2bf(hi) << 16); }

#define XB_TMO      128
#define XB_XCNT(j)  (256  + 64 * (j))
#define XB_XSUB(j)  (1280 + 64 * (j))
#define XB_XGEN(j)  (2304 + 64 * (j))
#define XB_TOP      3328
#define XB_TOPGEN   3392
#define XCD_BAR_WORDS 3456
#define XB_SPIN_CAP (1u << 18)

__device__ __forceinline__ unsigned xb_ld(unsigned* p)              { return __hip_atomic_load(p, __ATOMIC_RELAXED, __HIP_MEMORY_SCOPE_AGENT); }
__device__ __forceinline__ unsigned xb_add(unsigned* p, unsigned v) { return __hip_atomic_fetch_add(p, v, __ATOMIC_RELAXED, __HIP_MEMORY_SCOPE_AGENT); }
__device__ __forceinline__ unsigned xb_xcc_id() { return (unsigned)__builtin_amdgcn_s_getreg((3 << 11) | 20) & 0xFu; }
#define XB_SPIN(cond, bar) do { unsigned _sp = 0; while (cond) { __builtin_amdgcn_s_sleep(1); \
    if ((++_sp & 255u) == 0u) { if (xb_ld(&(bar)[XB_TMO])) break; if (_sp > XB_SPIN_CAP) { atomicAdd(&(bar)[XB_TMO], 1u); break; } } } } while (0)

struct XcdBarrier {
    unsigned* bar; unsigned x;
    volatile LAS unsigned* st;
};

__device__ __forceinline__ XcdBarrier xcd_barrier_post(unsigned* bar, volatile LAS unsigned* st) {
    XcdBarrier b; b.bar = bar; b.x = xb_xcc_id(); b.st = st;
    if (ltid() == 0) (void)xb_add(&bar[XB_XCNT(b.x)], 1u);
    return b;
}
__device__ __forceinline__ void xcd_barrier_complete(unsigned* bar, unsigned x, unsigned& nloc, unsigned& nx) {
    const unsigned G = lgrid();
    unsigned sum, cnt, mine, sp = 0u;
    for (;;) {
        sum = 0u; cnt = 0u; mine = 0u;
#pragma unroll
        for (unsigned j = 0; j < 16; ++j) { const unsigned c = xb_ld(&bar[XB_XCNT(j)]); sum += c; cnt += (c > 0u) ? 1u : 0u; mine = (j == x) ? c : mine; }
        if (sum == G) break;
        __builtin_amdgcn_s_sleep(1);
        if ((++sp & 255u) == 0u) { if (xb_ld(&bar[XB_TMO])) break; if (sp > XB_SPIN_CAP) { atomicAdd(&bar[XB_TMO], 1u); break; } }
    }
    nloc = mine > 0u ? mine : 1u; nx = cnt > 0u ? cnt : 1u;
}

__device__ __forceinline__ void xcd_barrier(const XcdBarrier& b) {
    asm volatile("s_waitcnt vmcnt(0)" ::: "memory");
    __syncthreads();
    if (ltid() == 0) {
        unsigned* bar = b.bar;
        __builtin_amdgcn_s_waitcnt(0);
        unsigned nloc = b.st[0], nx = b.st[1];
        if (nloc == 0u) { xcd_barrier_complete(bar, b.x, nloc, nx); b.st[0] = nloc; b.st[1] = nx; }
        const unsigned old = xb_add(&bar[XB_XSUB(b.x)], 1u);
        const unsigned gen = old / nloc;
        if (old + 1u == (gen + 1u) * nloc) {
            __builtin_amdgcn_fence(__ATOMIC_RELEASE, "agent");
            asm volatile("s_waitcnt vmcnt(0)" ::: "memory");
            const unsigned og = xb_add(&bar[XB_TOP], 1u);
            const unsigned tg = og / nx;
            if (og + 1u == (tg + 1u) * nx) xb_add(&bar[XB_TOPGEN], 1u);
            else XB_SPIN(xb_ld(&bar[XB_TOPGEN]) == tg, bar);
            __builtin_amdgcn_fence(__ATOMIC_ACQUIRE, "agent");
            xb_add(&bar[XB_XGEN(b.x)], 1u);
            asm volatile("s_waitcnt vmcnt(0)" ::: "memory");
        } else {
            XB_SPIN(xb_ld(&bar[XB_XGEN(b.x)]) == gen, bar);
            __builtin_amdgcn_fence(__ATOMIC_ACQUIRE, "agent");
            asm volatile("s_waitcnt vmcnt(0)" ::: "memory");
        }
    }
    __syncthreads();
}

constexpr int NWAVES = 8;
#ifndef MK_REP_MASK
#define MK_REP_MASK 0
#endif
#ifndef MK_REP_CLASS
#define MK_REP_CLASS 0
#endif
#ifndef MK_SN
#define MK_SN 9
#endif
#ifndef MK_WGM_IN
#define MK_WGM_IN 2
#endif
#ifndef MK_WGM_UP
#define MK_WGM_UP 5
#endif
#ifndef MK_GQ
#define MK_GQ 2
#endif
#ifndef MK_PER_PHASE
#define MK_PER_PHASE 0
#endif
namespace P {
constexpr int BATCH = 8, SEQ = 2048, DM = 1024, DEPTH = 2, DECB = 32, DECS = 4, PAST = 8192, PAGE = 128, NPAGES = 64, NPOOL = 2560;
constexpr int NH = 4, HD = 64, DG = 256, GDK = 32, GDV = 64, RANK = 16, DFF = 2688, CW = 31, DIN = 2580;
constexpr int MPR = BATCH * SEQ, MS = DECB * DECS, MREAL = MPR + MS, MP = 16640;
constexpr int NIN = 2816, NUP = 2 * DFF;
constexpr int HC_AQ = 0, HC_AK = 128, HC_AV = 256, HC_AG = 512, HC_BU = 768, HC_BV = 1024, HC_CQ = 1280, HC_CK = 1536, HC_CV = 1792, HC_D1 = 2048, HC_D2 = 2304, HC_LR = 2560, HC_CF = 2576;
constexpr float ALPHA = 1.4142135623730951f;
constexpr float EPS = 1e-5f, LOG2E = 1.4426950408889634f;
constexpr float QSCALE = 0.125f * 1.4426950408889634f;
constexpr size_t O_YP = 0, O_YS = O_YP + (size_t)MPR * DM, O_PFK = O_YS + (size_t)MS * DM, O_PFV = O_PFK + (size_t)DEPTH * MPR * 256, O_PFL = O_PFV + (size_t)DEPTH * MPR * 256,
    O_PGLA = O_PFL + (size_t)DEPTH * MPR * 4, O_PCONV = O_PGLA + (size_t)DEPTH * BATCH * NH * GDK * GDV, O_PFFN = O_PCONV + (size_t)DEPTH * BATCH * 30 * DG,
    O_SFK = O_PFFN + (size_t)DEPTH * BATCH * 2 * DFF, O_SFV = O_SFK + (size_t)DEPTH * MS * 256, O_SFL = O_SFV + (size_t)DEPTH * MS * 256, O_SGLA = O_SFL + (size_t)DEPTH * MS * 4,
    O_SCONV = O_SGLA + (size_t)DEPTH * DECB * NH * GDK * GDV, O_SFFN = O_SCONV + (size_t)DEPTH * DECB * 30 * DG, O_SSGU = O_SFFN + (size_t)DEPTH * DECB * 2 * DFF,
    O_END = O_SSGU + (size_t)DEPTH * MS * DG;
static_assert(O_END == 35714048, "output size");
enum { I_XP = 0, I_XS, I_CK, I_CV, I_CL, I_SGLA, I_SCONV, I_SFFN, I_PT, I_WIN, I_GWA, I_GBA, I_GNG, I_SLG, I_SLB, I_SW, I_SB, I_FBF, I_CVW, I_CVB, I_CNG, I_CNB, I_WO, I_L1G, I_L1B,
       I_WUP, I_FCW, I_FCB, I_WDN, I_L2G, I_L2B, N_IN };
constexpr size_t MiB = 1u << 20;
constexpr size_t WS_CTL = 0, CTL_ZERO_BYTES = 128 * 1024;
constexpr size_t WS_WIN = 2 * MiB, SZ_WIN = (size_t)NIN * DM * 2;
constexpr size_t WS_WO = WS_WIN + 2 * SZ_WIN, SZ_WO = (size_t)DM * DM * 2;
constexpr size_t WS_WUP = WS_WO + 2 * SZ_WO, SZ_WUP = (size_t)NUP * DM * 2;
constexpr size_t WS_WDN = WS_WUP + 2 * SZ_WUP, SZ_WDN = (size_t)DM * DFF * 2;
constexpr size_t WS_PS = WS_WDN + 2 * SZ_WDN;
constexpr size_t WS_LRF = WS_PS + 1 * MiB;
constexpr size_t WS_LOGF = WS_LRF + 3 * MiB;
constexpr size_t WS_KBIAS = WS_LOGF + 1 * MiB;
constexpr size_t WS_DELTA = WS_KBIAS + 1 * MiB;
constexpr size_t WS_GAMMA = WS_DELTA + 8 * MiB;
constexpr size_t WS_GBUF = WS_GAMMA + 1 * MiB;
constexpr size_t WS_PART = WS_GBUF + 8 * MiB;
constexpr size_t WS_ML = WS_PART + 8 * MiB;
constexpr size_t WS_PZ = WS_ML + 1 * MiB;
constexpr size_t WS_XF = WS_PZ + 4 * MiB, SZ_F32 = (size_t)MP * DM * 4, SZ_B16 = (size_t)MP * DM * 2;
constexpr size_t WS_XB = WS_XF + SZ_F32;
constexpr size_t WS_H = WS_XB + SZ_B16;
constexpr size_t WS_Y = WS_H + (size_t)MP * NIN * 2;
constexpr size_t WS_Z = WS_Y + SZ_B16;
constexpr size_t WS_X1F = WS_Z + SZ_F32;
constexpr size_t WS_X1B = WS_X1F + SZ_F32;
constexpr size_t WS_G = WS_X1B + SZ_B16;
constexpr size_t WS_HALO = WS_G;
constexpr size_t WS_FG = WS_HALO + 2 * MiB, WS_FV = WS_FG + 2 * MiB;
constexpr size_t WS_ACT = WS_FV + 2 * MiB;
constexpr size_t WS_END = WS_ACT + (size_t)MP * DFF * 2;
static_assert(WS_PS % 256 == 0 && WS_XF % 256 == 0 && WS_H % 256 == 0 && WS_G % 256 == 0 && WS_ACT % 256 == 0, "alignment");
constexpr int CW_BAR = 4096;
constexpr int CW_Q = 16384;
constexpr int PH_PER_LAYER = 8, N_PHASES = 1 + DEPTH * PH_PER_LAYER;
constexpr int RING_BYTES = 131072, MISC_OFF = RING_BYTES + 320, HALO_OFF = RING_BYTES + 2048  , LDS_BYTES = 147456;
}

struct Args { const float* p[P::N_IN + 2]; int ph_lo, ph_hi, qoff, pad; };
#define AIN(k) (A.p[(k) + z])
#define AOUT ((float*)A.p[P::N_IN + z])
#define AWS ((unsigned char*)A.p[P::N_IN + 1 + z])
#define OPAQUE_ZERO() ({ int z_ = 0; asm volatile("" : "+s"(z_)); z_; })
static_assert(sizeof(Args) == (P::N_IN + 2) * 8 + 16, "Args has no padding");

struct Frame {
    LAS unsigned char* lds; volatile LAS unsigned* MISC; gu32* ctl; int tid, lane, wave, vcu, G;
};

__device__ __forceinline__ float bflo(unsigned u) { return __uint_as_float(u << 16); }
__device__ __forceinline__ float bfhi(unsigned u) { return __uint_as_float(u & 0xffff0000u); }
__device__ __forceinline__ float bf1(bf16 v) { return __uint_as_float((unsigned)v << 16); }
__device__ __forceinline__ void unpack8(const v4u w, float (&f)[8]) { f[0] = bflo(w.x); f[1] = bfhi(w.x); f[2] = bflo(w.y); f[3] = bfhi(w.y); f[4] = bflo(w.z); f[5] = bfhi(w.z); f[6] = bflo(w.w); f[7] = bfhi(w.w); }
__device__ __forceinline__ v4u pack8(const float (&f)[8]) { v4u w; w.x = pk2(f[0], f[1]); w.y = pk2(f[2], f[3]); w.z = pk2(f[4], f[5]); w.w = pk2(f[6], f[7]); return w; }
__device__ __forceinline__ float logsig(float x) { return fminf(x, 0.f) - log1pf(expf(-fabsf(x))); }
__device__ __forceinline__ float sigm(float x) { return 1.f / (1.f + expf(-x)); }
__device__ __forceinline__ float silu(float x) { return x / (1.f + expf(-x)); }
#define DPP_F(v, ctrl) __builtin_bit_cast(float, __builtin_amdgcn_mov_dpp(__builtin_bit_cast(int, (v)), (ctrl), 0xF, 0xF, true))
__device__ __forceinline__ float sum4(float v) { v += DPP_F(v, 0xB1); v += DPP_F(v, 0x4E); return v; }
__device__ __forceinline__ float sum8(float v) { v = sum4(v); v += DPP_F(v, 0x141); return v; }
__device__ __forceinline__ float sum16(float v) { v = sum8(v); v += DPP_F(v, 0x140); return v; }
__device__ __forceinline__ float wave_sum(float v) { v = sum16(v);
    return (__builtin_bit_cast(float, __builtin_amdgcn_readlane(__builtin_bit_cast(int, v), 0)) + __builtin_bit_cast(float, __builtin_amdgcn_readlane(__builtin_bit_cast(int, v), 16)))
         + (__builtin_bit_cast(float, __builtin_amdgcn_readlane(__builtin_bit_cast(int, v), 32)) + __builtin_bit_cast(float, __builtin_amdgcn_readlane(__builtin_bit_cast(int, v), 48))); }
#define LBAR() do { asm volatile("s_waitcnt lgkmcnt(0)" ::: "memory"); __builtin_amdgcn_s_barrier(); asm volatile("" ::: "memory"); } while (0)
struct TeamBar { volatile LAS unsigned* ctr; unsigned ep; unsigned nw; };
__device__ __forceinline__ void tbar(TeamBar& tb, int lane) {
    asm volatile("s_waitcnt lgkmcnt(0)" ::: "memory");
    tb.ep += tb.nw;
    if (lane == 0) (void)__hip_atomic_fetch_add((LAS unsigned*)tb.ctr, 1u, __ATOMIC_RELAXED, __HIP_MEMORY_SCOPE_WORKGROUP);
    while ((int)(*tb.ctr - tb.ep) < 0) __builtin_amdgcn_s_sleep(0);
    asm volatile("" ::: "memory");
}
#define IBAR() do { if constexpr (TEAM) tbar(tb, F.lane); else LBAR(); } while (0)
__device__ __forceinline__ int q_next(Frame& F, gu32* head) {
    __syncthreads();
    if (F.tid == 0) F.MISC[0] = __hip_atomic_fetch_add(head, 1u, RLX_AGENT);
    __syncthreads();
    return (int)F.MISC[0];
}

__device__ __forceinline__ int win_src(int n) {
    if (n < 768) return n;
    if (n < 2048) return n + 16;
    if (n < 2560) return n + 20;
    if (n < 2576) return n - 1792;
    if (n < 2580) return n - 512;
    return -1;
}
template <int MODE>
__device__ __forceinline__ void p0_transpose_item(const float* W, int K, int N, int NT, bf16* WT, LAS float* scr, int item, int lane) {
    const int nblk = NT / 32, kb = item / nblk, nb = item % nblk, k0 = 64 * kb, n0 = 32 * nb;
    const int ncol = n0 + (lane & 31); const int src = MODE == 1 ? win_src(ncol) : (MODE == 2 ? ((ncol & 255) < 128 ? (ncol >> 8) * 128 + (ncol & 127) : P::DFF + (ncol >> 8) * 128 + (ncol & 127)) : ncol);
    float wv[32];
#pragma unroll
    for (int i = 0; i < 32; ++i) { const int kk = 2 * i + (lane >> 5); wv[i] = src >= 0 ? __builtin_nontemporal_load(W + (size_t)(k0 + kk) * N + src) : 0.f; }
#pragma unroll
    for (int i = 0; i < 32; ++i) { const int kk = 2 * i + (lane >> 5); scr[kk * 33 + (lane & 31)] = wv[i]; }
    LDS_WAIT(); asm volatile("" ::: "memory");
    const int c = lane & 7;
#pragma unroll
    for (int j = 0; j < 4; ++j) { const int n = (lane >> 3) + 8 * j; const LAS float* s = scr + (8 * c) * 33 + n;
        v4u o; o.x = pk2(s[0 * 33], s[1 * 33]); o.y = pk2(s[2 * 33], s[3 * 33]); o.z = pk2(s[4 * 33], s[5 * 33]); o.w = pk2(s[6 * 33], s[7 * 33]);
        *(GAS v4u*)(WT + (size_t)(n0 + n) * K + k0 + 8 * c) = o; }
    LDS_WAIT(); asm volatile("" ::: "memory");
}
namespace WC { using namespace P; constexpr int I_IN = (DM / 64) * (NIN / 32), I_O = (DM / 64) * (DM / 32), I_UP = (DM / 64) * (NUP / 32), I_DN = (DFF / 64) * (DM / 32), I_LAYER = I_IN + I_O + I_UP + I_DN, I_ALL = DEPTH * I_LAYER; }
__device__ __forceinline__ void wconv_wave_item(const Args& A, const int z, Frame& F, int it) {
    using namespace P; using namespace WC;
    LAS float* scr = (LAS float*)(F.lds + F.wave * 16384);
    int lane_ = F.lane; asm volatile("" : "+v"(lane_));
    const int l = it / I_LAYER; int r = it % I_LAYER;
    if (r < I_IN) { p0_transpose_item<1>(AIN(I_WIN) + (size_t)l * DM * DIN, DM, DIN, NIN, (bf16*)(AWS + WS_WIN + l * SZ_WIN), scr, r, lane_); return; } r -= I_IN;
    if (r < I_O) { p0_transpose_item<0>(AIN(I_WO) + (size_t)l * DM * DM, DM, DM, DM, (bf16*)(AWS + WS_WO + l * SZ_WO), scr, r, lane_); return; } r -= I_O;
    if (r < I_UP) { p0_transpose_item<2>(AIN(I_WUP) + (size_t)l * DM * NUP, DM, NUP, NUP, (bf16*)(AWS + WS_WUP + l * SZ_WUP), scr, r, lane_); return; } r -= I_UP;
    p0_transpose_item<0>(AIN(I_WDN) + (size_t)l * DFF * DM, DFF, DM, DM, (bf16*)(AWS + WS_WDN + l * SZ_WDN), scr, r, lane_);
}
__device__ __forceinline__ void p0_prologue(const Args& A, const int z, Frame& F) {
    using namespace P;
    const int gw = F.vcu * NWAVES + F.wave, NGW = F.G * NWAVES;
    for (int it = gw; it < WC::I_IN; it += NGW) wconv_wave_item(A, z, F, it);
    bf16* XB = (bf16*)(AWS + WS_XB);
    static_assert(MP % 4 == 0, "row batches");
    for (int m0 = 4 * (NGW - 1 - gw); m0 < MP; m0 += 4 * NGW) {
        f32x4 v[4][4];
#pragma unroll
        for (int r = 0; r < 4; ++r) { const int m = m0 + r; const float* src = m < MPR ? AIN(I_XP) + (size_t)m * DM : (m < MREAL ? AIN(I_XS) + (size_t)(m - MPR) * DM : nullptr);
#pragma unroll
            for (int j = 0; j < 4; ++j) v[r][j] = src ? __builtin_nontemporal_load((const GAS f32x4*)(src + 4 * F.lane + 256 * j)) : (f32x4){0.f, 0.f, 0.f, 0.f}; }
#pragma unroll
        for (int r = 0; r < 4; ++r)
#pragma unroll
            for (int j = 0; j < 4; ++j) *(GAS unsigned long long*)(XB + (size_t)(m0 + r) * DM + 4 * F.lane + 256 * j) = (unsigned long long)pk2(v[r][j].x, v[r][j].y) | ((unsigned long long)pk2(v[r][j].z, v[r][j].w) << 32);
    }
    float* PS = (float*)(AWS + WS_PS); const int* pt = (const int*)AIN(I_PT);
    constexpr int NPS = DEPTH * DECB * NPAGES;
    for (int it = gw; it < NPS; it += 2 * NGW) {
        const int it2 = it + NGW < NPS ? it + NGW : it;
        const int pa = pt[it % (DECB * NPAGES)], pb = pt[it2 % (DECB * NPAGES)];
        const float* La = AIN(I_CL) + ((size_t)((it / (DECB * NPAGES)) * NPOOL + pa) * PAGE) * 4; const float* Lb = AIN(I_CL) + ((size_t)((it2 / (DECB * NPAGES)) * NPOOL + pb) * PAGE) * 4;
        f32x4 a = *(const GAS f32x4*)(La + 4 * F.lane), a2 = *(const GAS f32x4*)(La + 4 * (F.lane + 64)), b = *(const GAS f32x4*)(Lb + 4 * F.lane), b2 = *(const GAS f32x4*)(Lb + 4 * (F.lane + 64)); a = a + a2; b = b + b2;
        a.x = wave_sum(a.x); a.y = wave_sum(a.y); a.z = wave_sum(a.z); a.w = wave_sum(a.w); b.x = wave_sum(b.x); b.y = wave_sum(b.y); b.z = wave_sum(b.z); b.w = wave_sum(b.w);
        if (F.lane == 0) { *(GAS f32x4*)(PS + (size_t)it * 4) = a; if (it2 != it) *(GAS f32x4*)(PS + (size_t)it2 * 4) = b; }
    }
}

namespace GL {
constexpr int G = 0, T = G + 64 * 33, WA = T + 256, BA = WA + 512, LR = BA + 32, QT = LR + 64 * 16  , KT = QT + 64 * 33, VV = KT + 32 * 68, SS = VV + 64 * 64, AT = SS + 32 * 64, END = AT + 64 * 68;
static_assert(END * 4 <= P::RING_BYTES && LR % 4 == 0 && QT % 4 == 0 && KT % 4 == 0 && VV % 4 == 0 && SS % 4 == 0, "GLA LDS");
}
template <int NI>
__device__ __forceinline__ void gla_local_items(const Args& A, const int z, Frame& F, int l, int item0) {
    using namespace P;
    LAS float* L = (LAS float*)F.lds; const bf16* H = (const bf16*)(AWS + WS_H);
    const int bh = item0 >> 5, b = bh >> 2, h = bh & 3;
    const int s = F.tid >> 3, d4 = (F.tid & 7) * 4, e8 = (F.tid & 7) * 8;
    const float wa = AIN(I_GWA)[(size_t)l * RANK * 128 + (F.tid >> 5) * 128 + 32 * h + (F.tid & 31)];
    const float ba = AIN(I_GBA)[l * 128 + 32 * h + (F.tid & 31)];
    unsigned long long kw[NI]; v4u vw[NI]; f32x4 lr4[NI];
#pragma unroll
    for (int q = 0; q < NI; ++q) { const int m0 = b * SEQ + 64 * ((item0 + q) & 31);
        kw[q] = *(const GAS unsigned long long*)(H + (size_t)(m0 + s) * NIN + HC_AK + 32 * h + d4); vw[q] = *(const GAS v4u*)(H + (size_t)(m0 + s) * NIN + HC_AV + 64 * h + e8);
        lr4[q] = (f32x4){0.f, 0.f, 0.f, 0.f}; if (F.tid < 256) lr4[q] = *(const GAS f32x4*)((const float*)(AWS + WS_LRF) + (size_t)(m0 + (F.tid >> 2)) * 32 + 4 * (F.tid & 3)); }
    L[GL::WA + F.tid] = wa; if (F.tid < 32) L[GL::BA + F.tid] = ba;
#pragma unroll
    for (int q = 0; q < NI; ++q) { const int item = item0 + q;
    if (q) LBAR();
    if (F.tid < 256) *(LAS f32x4*)(L + GL::LR + (F.tid >> 2) * 16 + 4 * (F.tid & 3)) = lr4[q];
    { LAS unsigned char* VT = (LAS unsigned char*)(L + GL::VV); const unsigned vv[4] = {vw[q].x, vw[q].y, vw[q].z, vw[q].w};
#pragma unroll
      for (int i = 0; i < 4; ++i) { *(LAS bf16*)(VT + (e8 + 2 * i) * 144 + 2 * s) = (bf16)(vv[i] & 0xffffu); *(LAS bf16*)(VT + (e8 + 2 * i + 1) * 144 + 2 * s) = (bf16)(vv[i] >> 16); } }
    LBAR();
    float loc[8]; const int d = F.tid & 31, seg = (F.tid >> 5) & 7;
    if (F.tid < 256) {
        float run = 0.f;
#pragma unroll
        for (int i = 0; i < 8; ++i) { const LAS float* lr = L + GL::LR + (8 * seg + i) * 16; float sacc = L[GL::BA + d];
#pragma unroll
            for (int r = 0; r < 16; ++r) sacc += lr[r] * L[GL::WA + r * 32 + d];
            run += logsig(sacc) * (1.f / 16.f); loc[i] = run; }
        L[GL::T + seg * 32 + d] = run;
    }
    LBAR();
    if (F.tid < 256) {
        float off = 0.f;
        for (int p = 0; p < seg; ++p) off += L[GL::T + p * 32 + d];
#pragma unroll
        for (int i = 0; i < 8; ++i) L[GL::G + (8 * seg + i) * 33 + d] = off + loc[i];
    }
    LBAR();
    { const unsigned lo = (unsigned)kw[q], hi = (unsigned)(kw[q] >> 32); const float kv[4] = {bflo(lo), bfhi(lo), bflo(hi), bfhi(hi)}; f32x4 g4;
#pragma unroll
      for (int i = 0; i < 4; ++i) { const float g = L[GL::G + s * 33 + d4 + i]; g4[i] = g; *(LAS bf16*)((LAS unsigned char*)(L + GL::QT) + (d4 + i) * 144 + 2 * s) = (bf16)f2bf(kv[i] * expf(L[GL::G + 63 * 33 + d4 + i] - g)); }
      *(GAS f32x4*)((float*)(AWS + WS_GBUF) + (size_t)item * 2048 + s * 32 + d4) = g4; }
    LBAR();
    { typedef short s8v __attribute__((ext_vector_type(8)));
      const LAS unsigned char* KT = (const LAS unsigned char*)(L + GL::QT); const LAS unsigned char* VT = (const LAS unsigned char*)(L + GL::VV);
      const int fi = F.lane & 15, kq = F.lane >> 4, d0 = 16 * (F.wave & 1), e0 = 16 * (F.wave >> 1); f32x4 acc = {0.f, 0.f, 0.f, 0.f};
#pragma unroll
      for (int ks = 0; ks < 2; ++ks) { const s8v af = *(const LAS s8v*)(KT + (d0 + fi) * 144 + 64 * ks + 16 * kq), bfr = *(const LAS s8v*)(VT + (e0 + fi) * 144 + 64 * ks + 16 * kq);
          acc = __builtin_amdgcn_mfma_f32_16x16x32_bf16(af, bfr, acc, 0, 0, 0); }
      float* DLo = (float*)(AWS + WS_DELTA) + (size_t)item * 2048;
#pragma unroll
      for (int r = 0; r < 4; ++r) DLo[(d0 + 4 * kq + r) * 64 + e0 + fi] = acc[r]; }
    if (F.tid < 32) ((float*)(AWS + WS_GAMMA))[(size_t)item * 32 + F.tid] = expf(L[GL::G + 63 * 33 + F.tid]);
    }
}
namespace GO {
constexpr int QB = 0, QP = 80, KB = QB + 64 * QP, PB = KB + 64 * QP, PP = 144, VT = PB + 64 * PP, ST = VT + 64 * PP, AG = ST + 64 * QP, AP = 144, SSQ = AG + 64 * AP, END = SSQ + 64 * 8;
static_assert(END <= P::RING_BYTES, "GLA out LDS");
}
template <int NQ>
__device__ __forceinline__ void gla_out_multi(const Args& A, const int z, Frame& F, int l, int grp) {
    using namespace P;
    typedef short s8v __attribute__((ext_vector_type(8)));
    LAS unsigned char* L = F.lds; const bf16* H = (const bf16*)(AWS + WS_H); bf16* Y = (bf16*)(AWS + WS_Y);
    const int item0 = NQ * grp, bh = item0 >> 5, c0 = item0 & 31, b = bh >> 2, h = bh & 3;
    const int s = F.tid >> 3, d4 = (F.tid & 7) * 4, e8 = (F.tid & 7) * 8, d = F.tid >> 4, e4 = (F.tid & 15) * 4;
    f32x4 g4q[NQ]; unsigned long long wqq[NQ], wkq[NQ]; v4u vwq[NQ], gwq[NQ];
#pragma unroll
    for (int q = 0; q < NQ; ++q) { const int m0 = b * SEQ + 64 * (c0 + q);
        g4q[q] = *(const GAS f32x4*)((const float*)(AWS + WS_GBUF) + (size_t)(item0 + q) * 2048 + s * 32 + d4);
        wqq[q] = *(const GAS unsigned long long*)(H + (size_t)(m0 + s) * NIN + HC_AQ + 32 * h + d4);
        wkq[q] = *(const GAS unsigned long long*)(H + (size_t)(m0 + s) * NIN + HC_AK + 32 * h + d4);
        vwq[q] = *(const GAS v4u*)(H + (size_t)(m0 + s) * NIN + HC_AV + 64 * h + e8);
        gwq[q] = *(const GAS v4u*)(H + (size_t)(m0 + s) * NIN + HC_AG + 64 * h + e8); }
    const float* DL = (const float*)(AWS + WS_DELTA) + (size_t)(bh * 32) * 2048 + d * 64 + e4; const float* GM = (const float*)(AWS + WS_GAMMA) + (size_t)(bh * 32) * 32 + d;
    float gm_st[NQ]; f32x4 dl_st[NQ];
#pragma unroll
    for (int q = 0; q + 1 < NQ; ++q) { gm_st[q] = GM[(c0 + q) * 32]; dl_st[q] = *(const GAS f32x4*)(DL + (size_t)(c0 + q) * 2048); }
    f32x4 S = {0.f, 0.f, 0.f, 0.f};
    constexpr int SB = NQ >= 4 ? 8 : 16;
    for (int j0 = 0; j0 < c0; j0 += SB) { float gm[SB]; f32x4 dl[SB];
#pragma unroll
        for (int j = 0; j < SB; ++j) { gm[j] = GM[(j0 + j) * 32]; dl[j] = *(const GAS f32x4*)(DL + (size_t)(j0 + j) * 2048); }
#pragma unroll
        for (int j = 0; j < SB; ++j) if (j0 + j < c0) S = S * gm[j] + dl[j]; }
#pragma unroll
    for (int q = 0; q < NQ; ++q) { const int c = c0 + q, m0 = b * SEQ + 64 * c; const f32x4 g4 = g4q[q]; const unsigned long long wq = wqq[q], wk = wkq[q]; const v4u vw = vwq[q], gw = gwq[q];
    if (q) { S = S * gm_st[q - 1] + dl_st[q - 1]; LBAR(); }
    if (c == 31) { const float gm = GM[31 * 32]; const f32x4 dl = *(const GAS f32x4*)(DL + (size_t)31 * 2048); const f32x4 Sf = S * gm + dl;
        *(GAS f32x4*)(AOUT + O_PGLA + ((size_t)(l * BATCH + b) * NH + h) * 2048 + d * 64 + e4) = Sf; }
#pragma unroll
    for (int i = 0; i < 4; ++i) *(LAS bf16*)(L + GO::ST + (e4 + i) * GO::QP + 2 * d) = (bf16)f2bf(S[i]);
    { const float qv[4] = {bflo((unsigned)wq), bfhi((unsigned)wq), bflo((unsigned)(wq >> 32)), bfhi((unsigned)(wq >> 32))};
      const float kv[4] = {bflo((unsigned)wk), bfhi((unsigned)wk), bflo((unsigned)(wk >> 32)), bfhi((unsigned)(wk >> 32))};
      float qt[4], kt[4];
#pragma unroll
      for (int i = 0; i < 4; ++i) { qt[i] = qv[i] * 0.17677669529663687f * expf(g4[i]); kt[i] = kv[i] * expf(-g4[i]); }
      *(LAS unsigned long long*)(L + GO::QB + s * GO::QP + 2 * d4) = (unsigned long long)pk2(qt[0], qt[1]) | ((unsigned long long)pk2(qt[2], qt[3]) << 32);
      *(LAS unsigned long long*)(L + GO::KB + s * GO::QP + 2 * d4) = (unsigned long long)pk2(kt[0], kt[1]) | ((unsigned long long)pk2(kt[2], kt[3]) << 32);
      const unsigned vv[4] = {vw.x, vw.y, vw.z, vw.w};
#pragma unroll
      for (int i = 0; i < 4; ++i) { *(LAS bf16*)(L + GO::VT + (e8 + 2 * i) * GO::PP + 2 * s) = (bf16)(vv[i] & 0xffffu); *(LAS bf16*)(L + GO::VT + (e8 + 2 * i + 1) * GO::PP + 2 * s) = (bf16)(vv[i] >> 16); }
      *(LAS v4u*)(L + GO::AG + s * GO::AP + 2 * e8) = gw; }
    LBAR();
    const int fi = F.lane & 15, kq = F.lane >> 4;
    { const int t0 = 16 * (F.wave >> 1); const s8v af = *(const LAS s8v*)(L + GO::QB + (t0 + fi) * GO::QP + 16 * kq);
#pragma unroll
      for (int k = 0; k < 2; ++k) { const int s0 = 16 * (2 * (F.wave & 1) + k); const s8v bfr = *(const LAS s8v*)(L + GO::KB + (s0 + fi) * GO::QP + 16 * kq);
          f32x4 acc = {0.f, 0.f, 0.f, 0.f}; acc = __builtin_amdgcn_mfma_f32_16x16x32_bf16(af, bfr, acc, 0, 0, 0);
#pragma unroll
          for (int r = 0; r < 4; ++r) { const int t = t0 + 4 * kq + r, sc = s0 + fi; *(LAS bf16*)(L + GO::PB + t * GO::PP + 2 * sc) = (bf16)f2bf(sc <= t ? acc[r] : 0.f); } } }
    LBAR();
    { const int t0 = 16 * (F.wave & 3), eb = 32 * (F.wave >> 2);
      const s8v a0 = *(const LAS s8v*)(L + GO::PB + (t0 + fi) * GO::PP + 16 * kq), a1 = *(const LAS s8v*)(L + GO::PB + (t0 + fi) * GO::PP + 64 + 16 * kq), a2 = *(const LAS s8v*)(L + GO::QB + (t0 + fi) * GO::QP + 16 * kq);
      f32x4 o[2]; float ssq[4] = {0.f, 0.f, 0.f, 0.f};
#pragma unroll
      for (int k = 0; k < 2; ++k) { const int e0 = eb + 16 * k;
          const s8v b0 = *(const LAS s8v*)(L + GO::VT + (e0 + fi) * GO::PP + 16 * kq), b1 = *(const LAS s8v*)(L + GO::VT + (e0 + fi) * GO::PP + 64 + 16 * kq), b2 = *(const LAS s8v*)(L + GO::ST + (e0 + fi) * GO::QP + 16 * kq);
          f32x4 acc = {0.f, 0.f, 0.f, 0.f};
          acc = __builtin_amdgcn_mfma_f32_16x16x32_bf16(a0, b0, acc, 0, 0, 0); acc = __builtin_amdgcn_mfma_f32_16x16x32_bf16(a1, b1, acc, 0, 0, 0); acc = __builtin_amdgcn_mfma_f32_16x16x32_bf16(a2, b2, acc, 0, 0, 0);
          o[k] = acc;
#pragma unroll
          for (int r = 0; r < 4; ++r) ssq[r] += acc[r] * acc[r]; }
#pragma unroll
      for (int r = 0; r < 4; ++r) { ssq[r] = sum16(ssq[r]); if (fi == 0) *(LAS float*)(L + GO::SSQ + ((t0 + 4 * kq + r) * 2 + (F.wave >> 2)) * 4) = ssq[r]; }
      LBAR();
#pragma unroll
      for (int r = 0; r < 4; ++r) { const int t = t0 + 4 * kq + r; const float tot = *(const LAS float*)(L + GO::SSQ + (t * 2) * 4) + *(const LAS float*)(L + GO::SSQ + (t * 2 + 1) * 4);
          const float rn = 1.f / sqrtf(tot * (1.f / 64.f) + EPS);
#pragma unroll
          for (int k = 0; k < 2; ++k) { const int e = eb + 16 * k + fi; const float ag = bf1(*(const LAS bf16*)(L + GO::AG + t * GO::AP + 2 * e));
              Y[(size_t)(m0 + t) * DM + 64 * h + e] = (bf16)f2bf(o[k][r] * rn * AIN(I_GNG)[l * 256 + 64 * h + e] * silu(ag)); } } }
    }
}

__device__ __forceinline__ void fox_cumsum_wave(const Args& A, const int z, Frame& F, int l, int b) {
    using namespace P;
    const float* LG = (const float*)(AWS + WS_LOGF) + ((size_t)b * SEQ + 32 * F.lane) * 4; float* KB = (float*)(AWS + WS_KBIAS);
    f32x4 lf[32]; f32x4 run = {0.f, 0.f, 0.f, 0.f};
#pragma unroll
    for (int i = 0; i < 32; ++i) lf[i] = *(const GAS f32x4*)(LG + 4 * i);
#pragma unroll
    for (int i = 0; i < 32; ++i) { run = run + lf[i]; lf[i] = run; }
    f32x4 off;
#pragma unroll
    for (int c = 0; c < 4; ++c) { float incl = run[c];
        incl += DPP_F(incl, 0x111); incl += DPP_F(incl, 0x112); incl += DPP_F(incl, 0x114); incl += DPP_F(incl, 0x118);
        const float t0 = __builtin_bit_cast(float, __builtin_amdgcn_readlane(__builtin_bit_cast(int, incl), 15)), t1 = __builtin_bit_cast(float, __builtin_amdgcn_readlane(__builtin_bit_cast(int, incl), 31)), t2 = __builtin_bit_cast(float, __builtin_amdgcn_readlane(__builtin_bit_cast(int, incl), 47));
        incl += (F.lane >= 16 ? t0 : 0.f) + (F.lane >= 32 ? t1 : 0.f) + (F.lane >= 48 ? t2 : 0.f);
        off[c] = incl - run[c]; }
#pragma unroll
    for (int c = 0; c < 4; ++c) { float* kb = KB + ((size_t)(b * NH + c)) * SEQ + 32 * F.lane;
#pragma unroll
        for (int i = 0; i < 32; i += 4) *(GAS f32x4*)(kb + i) = (f32x4){-(off[c] + lf[i][c]) * LOG2E, -(off[c] + lf[i + 1][c]) * LOG2E, -(off[c] + lf[i + 2][c]) * LOG2E, -(off[c] + lf[i + 3][c]) * LOG2E}; }
}

template <bool TEAM>
__device__ __forceinline__ void conv_item(const Args& A, const int z, Frame& F, int l, int item, TeamBar& tb) {
    using namespace P;
    constexpr int NT = TEAM ? 256 : 512, R = 512 / NT;
    LAS float* GLU = (LAS float*)F.lds;
    const bf16* H = (const bf16*)(AWS + WS_H); bf16* Y = (bf16*)(AWS + WS_Y);
    const int b = item >> 6, t0 = (item & 63) * 32;
    v4u d1w[4 * R], d2w[4 * R];
#pragma unroll
    for (int j = 0; j < 4 * R; ++j) { int idx = F.tid + NT * j; idx = idx < 62 * 32 ? idx : 62 * 32 - 1; const int rr = idx >> 5, c8 = (idx & 31) * 8; int t = t0 - 30 + rr; t = t < 0 ? 0 : t;
        const size_t m = (size_t)b * SEQ + t; d1w[j] = *(const GAS v4u*)(H + m * NIN + HC_D1 + c8); d2w[j] = *(const GAS v4u*)(H + m * NIN + HC_D2 + c8); }
    const int c = F.tid & 255, half = F.tid >> 8; float w[31]; const float* cw = AIN(I_CVW) + (size_t)l * CW * DG + c;
#pragma unroll
    for (int j = 0; j < 31; ++j) w[j] = cw[j * DG];
    const float cb = AIN(I_CVB)[l * DG + c], ng = AIN(I_CNG)[l * DG + c], nb = AIN(I_CNB)[l * DG + c];
#pragma unroll
    for (int j = 0; j < 4 * R; ++j) { const int idx = F.tid + NT * j;
        if (idx < 62 * 32) { const int rr = idx >> 5, c8 = (idx & 31) * 8, t = t0 - 30 + rr; float g[8];
            if (t >= 0) { float d1[8], d2[8]; unpack8(d1w[j], d1); unpack8(d2w[j], d2);
#pragma unroll
                for (int i = 0; i < 8; ++i) g[i] = d1[i] * sigm(d2[i]);
                if (t >= SEQ - 30) { float* o = AOUT + O_PCONV + ((size_t)(l * BATCH + b) * 30 + (t - (SEQ - 30))) * DG + c8; *(GAS f32x4*)o = (f32x4){g[0], g[1], g[2], g[3]}; *(GAS f32x4*)(o + 4) = (f32x4){g[4], g[5], g[6], g[7]}; }
            } else {
#pragma unroll
                for (int i = 0; i < 8; ++i) g[i] = 0.f; }
            *(LAS f32x4*)(GLU + rr * 256 + c8) = (f32x4){g[0], g[1], g[2], g[3]}; *(LAS f32x4*)(GLU + rr * 256 + c8 + 4) = (f32x4){g[4], g[5], g[6], g[7]}; } }
    IBAR();
#pragma unroll
    for (int hb = 0; hb < R; ++hb) { const int tb0 = (TEAM ? hb : half) * 16; float win[46];
#pragma unroll
        for (int j = 0; j < 46; ++j) win[j] = GLU[(tb0 + j) * 256 + c];
#pragma unroll
        for (int i = 0; i < 16; ++i) { float s = cb;
#pragma unroll
            for (int j = 0; j < 31; ++j) s += w[j] * win[i + j];
            const float mean = wave_sum(s) * (1.f / 64.f); const float dx = s - mean; const float var = wave_sum(dx * dx) * (1.f / 64.f);
            const float yv = dx * (1.f / sqrtf(var + EPS)) * ng + nb;
            Y[(size_t)(b * SEQ + t0 + tb0 + i) * DM + 768 + c] = (bf16)f2bf(silu(yv)); } }
}

template <int NI>
__device__ __forceinline__ void conv_items(const Args& A, const int z, Frame& F, int l, int item0, int istride) {
    using namespace P;
    LAS float* GLU = (LAS float*)F.lds; LAS float* CO = GLU + 62 * 256;
    const bf16* H = (const bf16*)(AWS + WS_H); bf16* Y = (bf16*)(AWS + WS_Y);
    v4u d1w[NI][4], d2w[NI][4];
#pragma unroll
    for (int q = 0; q < NI; ++q) { const int item = item0 + q * istride, b = item >> 6, t0 = (item & 63) * 32;
#pragma unroll
        for (int j = 0; j < 4; ++j) { int idx = F.tid + 512 * j; idx = idx < 62 * 32 ? idx : 62 * 32 - 1; const int rr = idx >> 5, c8 = (idx & 31) * 8; int t = t0 - 30 + rr; t = t < 0 ? 0 : t;
            const size_t m = (size_t)b * SEQ + t; d1w[q][j] = *(const GAS v4u*)(H + m * NIN + HC_D1 + c8); d2w[q][j] = *(const GAS v4u*)(H + m * NIN + HC_D2 + c8); } }
    const int c = F.tid & 255, half = F.tid >> 8; float w[31]; const float* cw = AIN(I_CVW) + (size_t)l * CW * DG + c;
#pragma unroll
    for (int j = 0; j < 31; ++j) w[j] = cw[j * DG];
    const float cb = AIN(I_CVB)[l * DG + c];
    const f32x4 g4 = *(const GAS f32x4*)(AIN(I_CNG) + l * DG + 4 * F.lane), b4 = *(const GAS f32x4*)(AIN(I_CNB) + l * DG + 4 * F.lane);
#pragma unroll
    for (int q = 0; q < NI; ++q) { const int item = item0 + q * istride, b = item >> 6, t0 = (item & 63) * 32;
    if (q) LBAR();
#pragma unroll
    for (int j = 0; j < 4; ++j) { const int idx = F.tid + 512 * j;
        if (idx < 62 * 32) { const int rr = idx >> 5, c8 = (idx & 31) * 8, t = t0 - 30 + rr; float g[8];
            if (t >= 0) { float d1[8], d2[8]; unpack8(d1w[q][j], d1); unpack8(d2w[q][j], d2);
#pragma unroll
                for (int i = 0; i < 8; ++i) g[i] = d1[i] * sigm(d2[i]);
                if (t >= SEQ - 30) { float* o = AOUT + O_PCONV + ((size_t)(l * BATCH + b) * 30 + (t - (SEQ - 30))) * DG + c8; *(GAS f32x4*)o = (f32x4){g[0], g[1], g[2], g[3]}; *(GAS f32x4*)(o + 4) = (f32x4){g[4], g[5], g[6], g[7]}; }
            } else {
#pragma unroll
                for (int i = 0; i < 8; ++i) g[i] = 0.f; }
            *(LAS f32x4*)(GLU + rr * 256 + c8) = (f32x4){g[0], g[1], g[2], g[3]}; *(LAS f32x4*)(GLU + rr * 256 + c8 + 4) = (f32x4){g[4], g[5], g[6], g[7]}; } }
    LBAR();
    { float win[46];
#pragma unroll
      for (int j = 0; j < 46; ++j) win[j] = GLU[(half * 16 + j) * 256 + c];
#pragma unroll
      for (int i = 0; i < 16; ++i) { float s = cb;
#pragma unroll
          for (int j = 0; j < 31; ++j) s += w[j] * win[i + j];
          CO[(half * 16 + i) * 256 + c] = s; } }
    LBAR();
#pragma unroll
    for (int k = 0; k < 4; ++k) { const int tok = 4 * F.wave + k; const f32x4 x = *(const LAS f32x4*)(CO + tok * 256 + 4 * F.lane);
        const float s = sum16((x.x + x.y) + (x.z + x.w));
        const float mean = s * (1.f / 64.f); const f32x4 dx = x - mean; const float qq = sum16((dx.x * dx.x + dx.y * dx.y) + (dx.z * dx.z + dx.w * dx.w));
        const float rstd = 1.f / sqrtf(qq * (1.f / 64.f) + EPS); const f32x4 yv = dx * rstd * g4 + b4;
        *(GAS unsigned long long*)(Y + (size_t)(b * SEQ + t0 + tok) * DM + 768 + 4 * F.lane) = (unsigned long long)pk2(silu(yv.x), silu(yv.y)) | ((unsigned long long)pk2(silu(yv.z), silu(yv.w)) << 32); }
    }
}

namespace SG { constexpr int WB = 0, WP = 272  , VT = WB + 128 * WP, VP = 272, END = VT + 64 * VP; static_assert(END <= P::RING_BYTES, "SGU LDS"); }
template <int NI>
__device__ __forceinline__ void sgu_items(const Args& A, const int z, Frame& F, int l, int item0, int istride) {
    using namespace P;
    typedef short s8v __attribute__((ext_vector_type(8)));
    LAS unsigned char* L = F.lds;
    const bf16* H = (const bf16*)(AWS + WS_H); bf16* Y = (bf16*)(AWS + WS_Y);
    const int g = item0 & 3;
    const int tv = F.tid >> 2, qv = F.tid & 3, fi = F.lane & 15, kq = F.lane >> 4, t0 = 16 * F.wave;
    v4u va[NI], vb[NI]; bf16 uu[NI][4][4]; float bsv[4];
#pragma unroll
    for (int q = 0; q < NI; ++q) { const int bn = (item0 + q * istride) >> 2, m0 = (bn >> 4) * SEQ + 128 * (bn & 15);
        const bf16* vsrc = H + (size_t)(m0 + tv) * NIN + HC_BV + 64 * g + 16 * qv; va[q] = *(const GAS v4u*)vsrc; vb[q] = *(const GAS v4u*)(vsrc + 8);
#pragma unroll
        for (int r = 0; r < 4; ++r)
#pragma unroll
            for (int k = 0; k < 4; ++k) uu[q][r][k] = H[(size_t)(m0 + t0 + 4 * kq + r) * NIN + HC_BU + 64 * g + 16 * k + fi]; }
#pragma unroll
    for (int r = 0; r < 4; ++r) bsv[r] = AIN(I_SB)[(size_t)(l * NH + g) * 128 + t0 + 4 * kq + r];
    f32x4 lg[4], lb[4];
#pragma unroll
    for (int j = 0; j < 4; ++j) { lg[j] = *(const GAS f32x4*)(AIN(I_SLG) + l * DG + 64 * g + 16 * qv + 4 * j); lb[j] = *(const GAS f32x4*)(AIN(I_SLB) + l * DG + 64 * g + 16 * qv + 4 * j); }
    { const float* Wg = AIN(I_SW) + ((size_t)(l * NH + g)) * 128 * 128; f32x4 w[8];
#pragma unroll
      for (int j = 0; j < 8; ++j) { const int idx = F.tid + 512 * j; w[j] = *(const GAS f32x4*)(Wg + (idx >> 5) * 128 + (idx & 31) * 4); }
#pragma unroll
      for (int j = 0; j < 8; ++j) { const int idx = F.tid + 512 * j, tt = idx >> 5, s4 = (idx & 31) * 4;
          *(LAS unsigned long long*)(L + SG::WB + tt * SG::WP + 2 * s4) = (unsigned long long)pk2(s4 + 0 <= tt ? w[j].x : 0.f, s4 + 1 <= tt ? w[j].y : 0.f) | ((unsigned long long)pk2(s4 + 2 <= tt ? w[j].z : 0.f, s4 + 3 <= tt ? w[j].w : 0.f) << 32); } }
#pragma unroll
    for (int q = 0; q < NI; ++q) { const int bn = (item0 + q * istride) >> 2, m0 = (bn >> 4) * SEQ + 128 * (bn & 15);
    if (q) LBAR();
    { float x[16]; { float a[8], c[8]; unpack8(va[q], a); unpack8(vb[q], c);
#pragma unroll
        for (int i = 0; i < 8; ++i) { x[i] = a[i]; x[8 + i] = c[i]; } }
      float s = 0.f;
#pragma unroll
      for (int i = 0; i < 16; ++i) s += x[i];
      s = sum4(s); const float mean = s * (1.f / 64.f); float qq = 0.f;
#pragma unroll
      for (int i = 0; i < 16; ++i) { x[i] -= mean; qq += x[i] * x[i]; }
      qq = sum4(qq); const float rstd = 1.f / sqrtf(qq * (1.f / 64.f) + EPS);
#pragma unroll
      for (int i = 0; i < 16; ++i) *(LAS bf16*)(L + SG::VT + (16 * qv + i) * SG::VP + 2 * tv) = (bf16)f2bf(x[i] * rstd * lg[i >> 2][i & 3] + lb[i >> 2][i & 3]); }
    LBAR();
    { f32x4 acc[4];
#pragma unroll
      for (int k = 0; k < 4; ++k) acc[k] = (f32x4){0.f, 0.f, 0.f, 0.f};
      const int nks = (t0 + 16 + 31) >> 5;
      for (int ks = 0; ks < nks; ++ks) { const s8v af = *(const LAS s8v*)(L + SG::WB + (t0 + fi) * SG::WP + 64 * ks + 16 * kq);
#pragma unroll
          for (int k = 0; k < 4; ++k) { const s8v bfr = *(const LAS s8v*)(L + SG::VT + (16 * k + fi) * SG::VP + 64 * ks + 16 * kq); acc[k] = __builtin_amdgcn_mfma_f32_16x16x32_bf16(af, bfr, acc[k], 0, 0, 0); } }
#pragma unroll
      for (int r = 0; r < 4; ++r) { const int t = t0 + 4 * kq + r;
#pragma unroll
          for (int k = 0; k < 4; ++k) Y[(size_t)(m0 + t) * DM + 256 + 64 * g + 16 * k + fi] = (bf16)f2bf(bf1(uu[q][r][k]) * (acc[k][r] + bsv[r])); } }
    }
}

__device__ __forceinline__ float row16_sum(float v) {
    v += __builtin_bit_cast(float, __builtin_amdgcn_mov_dpp(__builtin_bit_cast(int, v), 0xB1, 0xF, 0xF, true));
    v += __builtin_bit_cast(float, __builtin_amdgcn_mov_dpp(__builtin_bit_cast(int, v), 0x4E, 0xF, 0xF, true));
    v += __builtin_bit_cast(float, __builtin_amdgcn_mov_dpp(__builtin_bit_cast(int, v), 0x141, 0xF, 0xF, true));
    v += __builtin_bit_cast(float, __builtin_amdgcn_mov_dpp(__builtin_bit_cast(int, v), 0x140, 0xF, 0xF, true));
    return v;
}
__device__ __forceinline__ void fox_page_wave(const Args& A, const int z, Frame& F, int l, int unit) {
    using namespace P;
    int lane_ = F.lane; asm volatile("" : "+v"(lane_));
    const int b = unit >> 6, pg = unit & 63, hh = lane_ >> 4, ds = lane_ & 15;
    const bf16* H = (const bf16*)(AWS + WS_H); const int* pt = (const int*)AIN(I_PT);
    const int page = __builtin_amdgcn_readfirstlane(pt[b * NPAGES + pg]);
    const __amdgpu_buffer_rsrc_t rK = __builtin_amdgcn_make_buffer_rsrc((void*)(AIN(I_CK) + ((size_t)(l * NPOOL + page) * PAGE) * 256), 0, PAGE * 1024, 0x00020000);
    const __amdgpu_buffer_rsrc_t rV = __builtin_amdgcn_make_buffer_rsrc((void*)(AIN(I_CV) + ((size_t)(l * NPOOL + page) * PAGE) * 256), 0, PAGE * 1024, 0x00020000);
    const __amdgpu_buffer_rsrc_t rL = __builtin_amdgcn_make_buffer_rsrc((void*)(AIN(I_CL) + ((size_t)(l * NPOOL + page) * PAGE) * 4), 0, PAGE * 16, 0x00020000);
    const int vo16 = 16 * lane_, vo4 = 4 * hh;
    f32x4 kA[4], vA[4], kB[4], vB[4], kC[4], vC[4]; float lfA[4], lfB[4], lfC[4];
#define PG_LOAD(K4, V4, LF, r0) do { _Pragma("unroll") for (int i = 0; i < 4; ++i) { K4[i] = __builtin_bit_cast(f32x4, __builtin_amdgcn_raw_buffer_load_b128(rK, vo16, ((r0) + i) * 1024, 2)); \
        V4[i] = __builtin_bit_cast(f32x4, __builtin_amdgcn_raw_buffer_load_b128(rV, vo16, ((r0) + i) * 1024, 2)); LF[i] = __builtin_bit_cast(float, __builtin_amdgcn_raw_buffer_load_b32(rL, vo4, ((r0) + i) * 16, 0)); } } while (0)
    PG_LOAD(kA, vA, lfA, PAGE - 4); PG_LOAD(kB, vB, lfB, PAGE - 8); PG_LOAD(kC, vC, lfC, PAGE - 12);
    f32x4 q4[4];
#pragma unroll
    for (int t = 0; t < 4; ++t) { const unsigned long long w = *(const GAS unsigned long long*)(H + (size_t)(MPR + 4 * b + t) * NIN + HC_CQ + 64 * hh + 4 * ds);
        q4[t] = (f32x4){bflo((unsigned)w), bfhi((unsigned)w), bflo((unsigned)(w >> 32)), bfhi((unsigned)(w >> 32))}; }
    float run;
    { const f32x4 ps = *(const GAS f32x4*)((const float*)(AWS + WS_PS) + ((size_t)(l * DECB + b) * NPAGES + lane_) * 4); const bool later = lane_ > pg;
      const float r0 = wave_sum(later ? ps.x : 0.f), r1 = wave_sum(later ? ps.y : 0.f), r2 = wave_sum(later ? ps.z : 0.f), r3 = wave_sum(later ? ps.w : 0.f);
      run = hh == 0 ? r0 : (hh == 1 ? r1 : (hh == 2 ? r2 : r3)); }
    float mx[4], ls[4]; f32x4 O[4];
#pragma unroll
    for (int t = 0; t < 4; ++t) { mx[t] = -1e30f; ls[t] = 0.f; O[t] = (f32x4){0.f, 0.f, 0.f, 0.f}; }
#define PG_STEP(K4, V4, LF, o) do { float bias[4]; \
        _Pragma("unroll") for (int i = 3; i >= 0; --i) { bias[i] = run * LOG2E; run += LF[(o) + i]; } \
        _Pragma("unroll") for (int t = 0; t < 4; ++t) { float s[4]; \
            _Pragma("unroll") for (int i = 0; i < 4; ++i) { \
                typedef float f2_ __attribute__((ext_vector_type(2))); f2_ a_ = __builtin_shufflevector(K4[(o) + i], K4[(o) + i], 0, 1) * __builtin_shufflevector(q4[t], q4[t], 0, 1); \
                a_ = __builtin_shufflevector(K4[(o) + i], K4[(o) + i], 2, 3) * __builtin_shufflevector(q4[t], q4[t], 2, 3) + a_; s[i] = sum16(a_.x + a_.y) + bias[i]; } \
            const float mb = fmaxf(fmaxf(s[0], s[1]), fmaxf(s[2], s[3])), mn = fmaxf(mx[t], mb), corr = exp2f(mx[t] - mn); \
            const float p0 = exp2f(s[0] - mn), p1 = exp2f(s[1] - mn), p2 = exp2f(s[2] - mn), p3 = exp2f(s[3] - mn); \
            ls[t] = ls[t] * corr + ((p0 + p1) + (p2 + p3)); O[t] = O[t] * corr + V4[(o)] * p0 + V4[(o) + 1] * p1 + V4[(o) + 2] * p2 + V4[(o) + 3] * p3; mx[t] = mn; __builtin_amdgcn_sched_barrier(0); } } while (0)
#define PG_ROT(K4, V4, LF, r0_) do { PG_STEP(K4, V4, LF, 0); asm volatile("" ::: "memory"); __builtin_amdgcn_sched_barrier(0); PG_LOAD(K4, V4, LF, (r0_) - 12);   asm volatile("" ::: "memory"); __builtin_amdgcn_sched_barrier(0); } while (0)
#pragma unroll 1
    for (int r0 = PAGE - 4; r0 >= 12; r0 -= 12) { PG_ROT(kA, vA, lfA, r0); PG_ROT(kB, vB, lfB, r0 - 4); PG_ROT(kC, vC, lfC, r0 - 8); }
    PG_ROT(kA, vA, lfA, 4); PG_ROT(kB, vB, lfB, 0);
#undef PG_ROT
#undef PG_LOAD
#undef PG_STEP
    float* PART = (float*)(AWS + WS_PART); float* ML = (float*)(AWS + WS_ML);
#pragma unroll
    for (int t = 0; t < 4; ++t) { const size_t o = ((size_t)(unit * 4 + hh) * 4 + t); *(GAS f32x4*)(PART + o * 64 + 4 * ds) = O[t]; if (ds == 0) { ML[o * 2] = mx[t]; ML[o * 2 + 1] = ls[t]; } }
}

__device__ __forceinline__ void fox_page_dma(const Args& A, const int z, Frame& F, int l, int unit, int ring_off) {
    using namespace P;
    int lane_ = F.lane; asm volatile("" : "+v"(lane_));
    const int b = unit >> 6, pg = unit & 63, hh = lane_ >> 4, ds = lane_ & 15;
    const bf16* H = (const bf16*)(AWS + WS_H); const int* pt = (const int*)AIN(I_PT);
    const int page = __builtin_amdgcn_readfirstlane(pt[b * NPAGES + pg]);
    const char* Kg = (const char*)(AIN(I_CK) + ((size_t)(l * NPOOL + page) * PAGE) * 256) + 16 * lane_;
    const char* Vg = (const char*)(AIN(I_CV) + ((size_t)(l * NPOOL + page) * PAGE) * 256) + 16 * lane_;
    const float* Lg = AIN(I_CL) + ((size_t)(l * NPOOL + page) * PAGE) * 4 + 8 * lane_;
    const f32x4 lfa = *(const GAS f32x4*)Lg, lfb = *(const GAS f32x4*)(Lg + 4);
    const f32x4 ps = *(const GAS f32x4*)((const float*)(AWS + WS_PS) + ((size_t)(l * DECB + b) * NPAGES + lane_) * 4);
    f32x4 q4[4];
#pragma unroll
    for (int t = 0; t < 4; ++t) { const unsigned long long w = *(const GAS unsigned long long*)(H + (size_t)(MPR + 4 * b + t) * NIN + HC_CQ + 64 * hh + 4 * ds);
        q4[t] = (f32x4){bflo((unsigned)w), bfhi((unsigned)w), bflo((unsigned)(w >> 32)), bfhi((unsigned)(w >> 32))}; }
    f32x4 bhi, blo;
#pragma unroll
    for (int c = 0; c < 4; ++c) { const float lat = wave_sum(lane_ > pg ? ps[c] : 0.f); const float s = lfa[c] + lfb[c]; float incl = s;
        incl += DPP_F(incl, 0x111); incl += DPP_F(incl, 0x112); incl += DPP_F(incl, 0x114); incl += DPP_F(incl, 0x118);
        const float t0 = __builtin_bit_cast(float, __builtin_amdgcn_readlane(__builtin_bit_cast(int, incl), 15)), t1 = __builtin_bit_cast(float, __builtin_amdgcn_readlane(__builtin_bit_cast(int, incl), 31)), t2 = __builtin_bit_cast(float, __builtin_amdgcn_readlane(__builtin_bit_cast(int, incl), 47)), t3 = __builtin_bit_cast(float, __builtin_amdgcn_readlane(__builtin_bit_cast(int, incl), 63));
        incl += (lane_ >= 16 ? t0 : 0.f) + (lane_ >= 32 ? t1 : 0.f) + (lane_ >= 48 ? t2 : 0.f);
        const float tot = (t0 + t1) + (t2 + t3), after = tot - incl;
        bhi[c] = (lat + after) * LOG2E; blo[c] = (lat + after + lfb[c]) * LOG2E; }
    float mx[4], ls[4]; f32x4 O[4];
#pragma unroll
    for (int t = 0; t < 4; ++t) { mx[t] = -1e30f; ls[t] = 0.f; O[t] = (f32x4){0.f, 0.f, 0.f, 0.f}; }
    const unsigned rb = (unsigned)(uintptr_t)(F.lds + ring_off);
    const LAS unsigned char* rl = F.lds + ring_off + 16 * lane_;
    asm volatile("s_waitcnt vmcnt(0) lgkmcnt(0)" ::: "memory");
#define PD_DMA(j) do { const int r_ = 127 - (j); const unsigned d_ = (unsigned)__builtin_amdgcn_readfirstlane(rb + (((j) & 7) << 11)); attn_body::glds16(Kg + (size_t)r_ * 1024, d_); attn_body::glds16(Vg + (size_t)r_ * 1024, d_ + 1024u); } while (0)
#define PD_ROW(j, NV, bias_) do { asm volatile("s_waitcnt vmcnt(" #NV ")" ::: "memory"); \
        const f32x4 k4 = *(const LAS f32x4*)(rl + (((j) & 7) << 11)), v4 = *(const LAS f32x4*)(rl + (((j) & 7) << 11) + 1024); \
        asm volatile("s_waitcnt lgkmcnt(0)" ::: "memory"); \
        if ((j) + 7 < 128) PD_DMA((j) + 7); \
        _Pragma("unroll") for (int t = 0; t < 4; ++t) { typedef float f2_ __attribute__((ext_vector_type(2))); \
            f2_ a_ = __builtin_shufflevector(k4, k4, 0, 1) * __builtin_shufflevector(q4[t], q4[t], 0, 1); a_ = __builtin_shufflevector(k4, k4, 2, 3) * __builtin_shufflevector(q4[t], q4[t], 2, 3) + a_; \
            const float s = sum16(a_.x + a_.y) + (bias_); const float mn = fmaxf(mx[t], s), corr = exp2f(mx[t] - mn), p = exp2f(s - mn); \
            ls[t] = ls[t] * corr + p; O[t] = O[t] * corr + v4 * p; mx[t] = mn; } } while (0)
#define PD_BIAS(vec, L) (hh == 0 ? __builtin_bit_cast(float, __builtin_amdgcn_readlane(__builtin_bit_cast(int, vec[0]), (L))) : hh == 1 ? __builtin_bit_cast(float, __builtin_amdgcn_readlane(__builtin_bit_cast(int, vec[1]), (L))) : \
                         hh == 2 ? __builtin_bit_cast(float, __builtin_amdgcn_readlane(__builtin_bit_cast(int, vec[2]), (L))) : __builtin_bit_cast(float, __builtin_amdgcn_readlane(__builtin_bit_cast(int, vec[3]), (L))))
    PD_DMA(0); PD_DMA(1); PD_DMA(2); PD_DMA(3); PD_DMA(4); PD_DMA(5); PD_DMA(6);
#pragma unroll 1
    for (int i = 0; i < 60; ++i) { const int j = 2 * i, L = 63 - i;
        const float b1 = PD_BIAS(bhi, L), b0 = PD_BIAS(blo, L);
        PD_ROW(j, 12, b1); PD_ROW(j + 1, 12, b0); }
    { const float b1 = PD_BIAS(bhi, 3), b0 = PD_BIAS(blo, 3); PD_ROW(120, 12, b1); PD_ROW(121, 12, b0); }
    { const float b1 = PD_BIAS(bhi, 2), b0 = PD_BIAS(blo, 2); PD_ROW(122, 10, b1); PD_ROW(123, 8, b0); }
    { const float b1 = PD_BIAS(bhi, 1), b0 = PD_BIAS(blo, 1); PD_ROW(124, 6, b1); PD_ROW(125, 4, b0); }
    { const float b1 = PD_BIAS(bhi, 0), b0 = PD_BIAS(blo, 0); PD_ROW(126, 2, b1); PD_ROW(127, 0, b0); }
#undef PD_DMA
#undef PD_ROW
#undef PD_BIAS
    float* PART = (float*)(AWS + WS_PART); float* ML = (float*)(AWS + WS_ML);
#pragma unroll
    for (int t = 0; t < 4; ++t) { const size_t o = ((size_t)(unit * 4 + hh) * 4 + t); *(GAS f32x4*)(PART + o * 64 + 4 * ds) = O[t]; if (ds == 0) { ML[o * 2] = mx[t]; ML[o * 2 + 1] = ls[t]; } }
    asm volatile("s_waitcnt vmcnt(0)" ::: "memory");
}

__device__ __forceinline__ void sample_fox_item(const Args& A, const int z, Frame& F, int l, int b) {
    using namespace P;
    LAS float* L = (LAS float*)F.lds; LAS float* SC = L; LAS float* DN = L + 64;
    const bf16* H = (const bf16*)(AWS + WS_H); bf16* Y = (bf16*)(AWS + WS_Y); const float* LRF = (const float*)(AWS + WS_LRF);
    const int mrow = MPR + 4 * b;
    const int hh = F.tid >> 7, t = (F.tid >> 5) & 3, dp = F.tid & 31;
    const float* ML = (const float*)(AWS + WS_ML) + ((size_t)(b * NPAGES * 4 + hh) * 4 + t) * 2; const float* PART = (const float*)(AWS + WS_PART) + ((size_t)(b * NPAGES * 4 + hh) * 4 + t) * 64 + 2 * dp;
    float2 ml[16]; float M = -1e30f; asm volatile("" : "+v"(M));
    if (F.tid < 4) { const int h2 = F.tid; const float bf = AIN(I_FBF)[l * 4 + h2]; float run = 0.f;
        for (int tt = 0; tt < 4; ++tt) { const float lf = logsig(LRF[(size_t)(mrow + tt) * 32 + 16 + h2] + bf); AOUT[O_SFL + ((size_t)l * MS + 4 * b + tt) * 4 + h2] = lf; run += lf; DN[tt * 4 + h2] = run; } }
    LBAR();
    if (F.tid < 64) { const int h2 = F.tid >> 4, tt = (F.tid >> 2) & 3, j = F.tid & 3; float s = 0.f;
        const bf16* qp = H + (size_t)(mrow + tt) * NIN + HC_CQ + 64 * h2; const bf16* kp = H + (size_t)(mrow + j) * NIN + HC_CK + 64 * h2;
#pragma unroll
        for (int d8 = 0; d8 < 8; ++d8) { float qf[8], kf[8]; unpack8(*(const GAS v4u*)(qp + 8 * d8), qf); unpack8(*(const GAS v4u*)(kp + 8 * d8), kf);
#pragma unroll
            for (int i = 0; i < 8; ++i) s += qf[i] * kf[i]; }
        float l2e = LOG2E; asm volatile("" : "+v"(l2e));
        SC[F.tid] = (j <= tt) ? s - DN[j * 4 + h2] * l2e : -INFINITY; }
    LBAR();
    float Ls = 0.f, o0 = 0.f, o1 = 0.f;
    for (int p0 = 0; p0 < NPAGES; p0 += 16) {
#pragma unroll
        for (int p = 0; p < 16; ++p) ml[p] = *(const float2*)(ML + (size_t)(p0 + p) * 32);
#pragma unroll
        for (int p = 0; p < 16; ++p) M = fmaxf(M, ml[p].x); }
#pragma unroll
    for (int j = 0; j < 4; ++j) M = fmaxf(M, SC[(hh * 4 + t) * 4 + j]);
    for (int p0 = 0; p0 < NPAGES; p0 += 16) { float2 pv[16];
#pragma unroll
        for (int p = 0; p < 16; ++p) { ml[p] = *(const float2*)(ML + (size_t)(p0 + p) * 32); pv[p] = *(const float2*)(PART + (size_t)(p0 + p) * 1024); }
#pragma unroll
        for (int p = 0; p < 16; ++p) { const float w = exp2f(ml[p].x - M); Ls += ml[p].y * w; o0 += pv[p].x * w; o1 += pv[p].y * w; } }
#pragma unroll
    for (int j = 0; j < 4; ++j) { const float w = exp2f(SC[(hh * 4 + t) * 4 + j] - M); Ls += w; const bf16* vp = H + (size_t)(mrow + j) * NIN + HC_CV + 64 * hh + 2 * dp; o0 += w * bf1(vp[0]); o1 += w * bf1(vp[1]); }
    const float inv = 1.f / Ls;
    *(GAS unsigned*)(Y + (size_t)(mrow + t) * DM + 512 + 64 * hh + 2 * dp) = pk2(o0 * inv, o1 * inv);
}
__device__ __forceinline__ void sample_gs_item(const Args& A, const int z, Frame& F, int l, int b) {
    using namespace P;
    LAS float* L = (LAS float*)F.lds; LAS float* LA = L; LAS float* QK = L + 512;
    const bf16* H = (const bf16*)(AWS + WS_H); bf16* Y = (bf16*)(AWS + WS_Y); const float* LRF = (const float*)(AWS + WS_LRF);
    const int mrow = MPR + 4 * b;
    { const int t = F.tid >> 7, j = F.tid & 127; const float* lr = LRF + (size_t)(mrow + t) * 32; float s = AIN(I_GBA)[l * 128 + j]; float wv[16]; f32x4 l4[4];
#pragma unroll
      for (int r = 0; r < 16; ++r) wv[r] = AIN(I_GWA)[(size_t)l * RANK * 128 + r * 128 + j];
#pragma unroll
      for (int r = 0; r < 4; ++r) l4[r] = *(const GAS f32x4*)(lr + 4 * r);
#pragma unroll
      for (int r = 0; r < 16; ++r) s += l4[r >> 2][r & 3] * wv[r];
      LA[t * 128 + j] = logsig(s) * (1.f / 16.f); }
    if (F.tid < 128) { const int t = F.tid >> 5, j8 = (F.tid & 31) * 8; float qf[8]; unpack8(*(const GAS v4u*)(H + (size_t)(mrow + t) * NIN + HC_AQ + j8), qf);
#pragma unroll
        for (int i = 0; i < 8; ++i) QK[t * 256 + j8 + i] = qf[i]; }
    if (F.tid < 256) {
        int e = F.tid & 63; asm volatile("" : "+v"(e)); const int hh = F.tid >> 6; float S[32];
        const float* S0 = AIN(I_SGLA) + ((size_t)((l * DECB + b) * NH + hh)) * 2048 + e;
#pragma unroll
        for (int d = 0; d < 32; ++d) S[d] = S0[d * 64];
        float vv[4], ag[4];
#pragma unroll
        for (int t = 0; t < 4; ++t) { vv[t] = bf1(H[(size_t)(mrow + t) * NIN + HC_AV + 64 * hh + e]); ag[t] = bf1(H[(size_t)(mrow + t) * NIN + HC_AG + 64 * hh + e]); }
        const float ng = AIN(I_GNG)[l * 256 + 64 * hh + e];
        LBAR();
#pragma unroll
        for (int t = 0; t < 4; ++t) { float o = 0.f;
#pragma unroll
            for (int d = 0; d < 32; ++d) { S[d] = expf(LA[t * 128 + 32 * hh + d]) * S[d] + QK[t * 256 + 128 + 32 * hh + d] * vv[t]; o += QK[t * 256 + 32 * hh + d] * 0.17677669529663687f * S[d]; }
            const float ms = wave_sum(o * o) * (1.f / 64.f); const float rn = 1.f / sqrtf(ms + EPS);
            Y[(size_t)(mrow + t) * DM + 64 * hh + e] = (bf16)f2bf(o * rn * ng * silu(ag[t])); }
        float* So = AOUT + O_SGLA + ((size_t)((l * DECB + b) * NH + hh)) * 2048 + e;
#pragma unroll
        for (int d = 0; d < 32; ++d) So[d * 64] = S[d];
    } else {
        int c = F.tid - 256; asm volatile("" : "+v"(c)); const int g = c >> 6; float xv[4], uv[4], wv[10], bsv[4];
#pragma unroll
        for (int t = 0; t < 4; ++t) { xv[t] = bf1(H[(size_t)(mrow + t) * NIN + HC_BV + c]); uv[t] = bf1(H[(size_t)(mrow + t) * NIN + HC_BU + c]); }
        const float* Wg = AIN(I_SW) + ((size_t)(l * NH + g)) * 128 * 128; const float* bs = AIN(I_SB) + (size_t)(l * NH + g) * 128;
        { int k = 0;
#pragma unroll
          for (int t = 0; t < 4; ++t) { bsv[t] = bs[t];
#pragma unroll
              for (int s = 0; s <= t; ++s) wv[k++] = Wg[t * 128 + s]; } }
        const float lgv = AIN(I_SLG)[l * DG + c], lbv = AIN(I_SLB)[l * DG + c];
        LBAR();
        float vl[4];
#pragma unroll
        for (int t = 0; t < 4; ++t) { const float mean = wave_sum(xv[t]) * (1.f / 64.f); const float dx = xv[t] - mean;
            const float var = wave_sum(dx * dx) * (1.f / 64.f); vl[t] = dx * (1.f / sqrtf(var + EPS)) * lgv + lbv;
            AOUT[O_SSGU + ((size_t)l * MS + 4 * b + t) * DG + c] = vl[t]; }
        { int k = 0;
#pragma unroll
          for (int t = 0; t < 4; ++t) { float mix = bsv[t];
#pragma unroll
              for (int s = 0; s <= t; ++s) mix += wv[k++] * vl[s];
              Y[(size_t)(mrow + t) * DM + 256 + c] = (bf16)f2bf(uv[t] * mix); } }
    }
}
__device__ __forceinline__ void sample_conv_item(const Args& A, const int z, Frame& F, int l, int b) {
    using namespace P;
    const bf16* H = (const bf16*)(AWS + WS_H); bf16* Y = (bf16*)(AWS + WS_Y);
    const int mrow = MPR + 4 * b;
    if (F.tid < 256) {
        int c = F.tid; asm volatile("" : "+v"(c)); float xx[34], w[31], d1[4], d2[4];
        const float* st = AIN(I_SCONV) + ((size_t)(l * DECB + b) * 30) * DG + c;
#pragma unroll
        for (int j = 0; j < 30; ++j) xx[j] = st[j * DG];
#pragma unroll
        for (int t = 0; t < 4; ++t) { d1[t] = bf1(H[(size_t)(mrow + t) * NIN + HC_D1 + c]); d2[t] = bf1(H[(size_t)(mrow + t) * NIN + HC_D2 + c]); }
        const float* cw = AIN(I_CVW) + (size_t)l * CW * DG + c; const float cb = AIN(I_CVB)[l * DG + c];
#pragma unroll
        for (int j = 0; j < 31; ++j) w[j] = cw[j * DG];
        const float ngv = AIN(I_CNG)[l * DG + c], nbv = AIN(I_CNB)[l * DG + c];
#pragma unroll
        for (int t = 0; t < 4; ++t) xx[30 + t] = d1[t] * sigm(d2[t]);
        float* so = AOUT + O_SCONV + ((size_t)(l * DECB + b) * 30) * DG + c;
#pragma unroll
        for (int j = 0; j < 30; ++j) so[j * DG] = xx[4 + j];
        float co[4] = {cb, cb, cb, cb};
#pragma unroll
        for (int j = 0; j < 31; ++j)
#pragma unroll
            for (int t = 0; t < 4; ++t) co[t] += w[j] * xx[t + j];
#pragma unroll
        for (int t = 0; t < 4; ++t) { const float mean = wave_sum(co[t]) * (1.f / 64.f); const float dx = co[t] - mean; const float var = wave_sum(dx * dx) * (1.f / 64.f);
            const float yv = dx * (1.f / sqrtf(var + EPS)) * ngv + nbv;
            Y[(size_t)(mrow + t) * DM + 768 + c] = (bf16)f2bf(silu(yv)); }
    }
}

struct LnIo { const bf16* Z; const bf16* res; const float* pz; int nsl; const float* g; const float* b; float* of32_p; float* of32_s; bf16* obf; };
__device__ __forceinline__ void ln_finish(Frame& F, float (&v)[16], const LnIo& io, int m) {
    using namespace P;
    float s = 0.f;
#pragma unroll
    for (int i = 0; i < 16; ++i) s += v[i];
    const float mean = wave_sum(s) * (1.f / 1024.f); float s2 = 0.f;
#pragma unroll
    for (int i = 0; i < 16; ++i) { v[i] -= mean; s2 += v[i] * v[i]; }
    const float rstd = 1.f / sqrtf(wave_sum(s2) * (1.f / 1024.f) + EPS);
    float y0[8], y1[8];
#pragma unroll
    for (int h = 0; h < 2; ++h) { const f32x4 ga = *(const GAS f32x4*)(io.g + 8 * F.lane + 4 * h), ba = *(const GAS f32x4*)(io.b + 8 * F.lane + 4 * h), gc = *(const GAS f32x4*)(io.g + 512 + 8 * F.lane + 4 * h), bc = *(const GAS f32x4*)(io.b + 512 + 8 * F.lane + 4 * h);
#pragma unroll
        for (int i = 0; i < 4; ++i) { y0[4 * h + i] = v[4 * h + i] * rstd * ga[i] + ba[i]; y1[4 * h + i] = v[8 + 4 * h + i] * rstd * gc[i] + bc[i]; } }
    if (io.obf) { bf16* o = io.obf + (size_t)m * DM; *(GAS v4u*)(o + 8 * F.lane) = pack8(y0); *(GAS v4u*)(o + 512 + 8 * F.lane) = pack8(y1); }
    float* of = m < MPR ? (io.of32_p ? io.of32_p + (size_t)m * DM : nullptr) : (io.of32_s ? io.of32_s + (size_t)(m - MPR) * DM : nullptr);
    if (of) { *(GAS f32x4*)(of + 8 * F.lane) = (f32x4){y0[0], y0[1], y0[2], y0[3]}; *(GAS f32x4*)(of + 8 * F.lane + 4) = (f32x4){y0[4], y0[5], y0[6], y0[7]};
        *(GAS f32x4*)(of + 512 + 8 * F.lane) = (f32x4){y1[0], y1[1], y1[2], y1[3]}; *(GAS f32x4*)(of + 512 + 8 * F.lane + 4) = (f32x4){y1[4], y1[5], y1[6], y1[7]}; }
}
__device__ __forceinline__ void ln_phase(Frame& F, const LnIo& io) {
    using namespace P;
    constexpr int NR = 8;
    const int gw = F.vcu * NWAVES + F.wave, ngw = F.G * NWAVES;
    const bool xmap = F.G == 256; const int xg = F.vcu >> 5, wl = (F.vcu & 31) * NWAVES + F.wave;
    for (int it_ = 0; it_ < (xmap ? 1 : (MPR / NR + ngw - 1) / ngw); ++it_) { const int m0 = xmap ? 2048 * xg + NR * wl : (gw + ngw * it_) * NR; if (m0 >= MPR) break;
        v4u za[NR], zb[NR];
#pragma unroll
        for (int r = 0; r < NR; ++r) { za[r] = *(const GAS v4u*)(io.Z + (size_t)(m0 + r) * DM + 8 * F.lane); zb[r] = *(const GAS v4u*)(io.Z + (size_t)(m0 + r) * DM + 512 + 8 * F.lane); }
#pragma unroll
        for (int r = 0; r < NR; ++r) { float v[16]; float r0[8], r1[8]; unpack8(za[r], r0); unpack8(zb[r], r1);
#pragma unroll
            for (int i = 0; i < 8; ++i) { v[i] = r0[i]; v[8 + i] = r1[i]; }
            ln_finish(F, v, io, m0 + r); }
    }
    for (int m = MPR + gw; m < MREAL; m += ngw) {
        const bf16* res = io.res + (size_t)m * DM; const float* pz = io.pz + (size_t)(m - MPR) * DM; float v[16];
        float r0[8], r1[8]; unpack8(*(const GAS v4u*)(res + 8 * F.lane), r0); unpack8(*(const GAS v4u*)(res + 512 + 8 * F.lane), r1);
#pragma unroll
        for (int i = 0; i < 8; ++i) { v[i] = r0[i] * ALPHA; v[8 + i] = r1[i] * ALPHA; }
        for (int k = 0; k < io.nsl; ++k) { const float* p = pz + (size_t)k * 128 * 1024 + 8 * F.lane;
            const f32x4 a0 = *(const GAS f32x4*)p, a1 = *(const GAS f32x4*)(p + 4), c0 = *(const GAS f32x4*)(p + 512), c1 = *(const GAS f32x4*)(p + 516);
#pragma unroll
            for (int i = 0; i < 4; ++i) { v[i] += a0[i]; v[4 + i] += a1[i]; v[8 + i] += c0[i]; v[12 + i] += c1[i]; } }
        ln_finish(F, v, io, m);
    }
}

__device__ __forceinline__ void act_fixup(const Args& A, const int z, Frame& F, int l, int pm) {
    using namespace P;
    if (pm >= MPR / 256 || (pm & 7) == 0) return;
    if (F.tid < DFF / 8) {
        const int f0 = 8 * F.tid; bf16* ACT = (bf16*)(AWS + WS_ACT);
        const float* hg = (const float*)(AWS + WS_HALO) + (size_t)((pm - 1) * 2) * DFF + f0; const float* fg = (const float*)(AWS + WS_FG) + (size_t)(pm * 2) * DFF + f0; const float* fv = (const float*)(AWS + WS_FV) + (size_t)(pm * 2) * DFF + f0;
        const float* fw = AIN(I_FCW) + (size_t)l * 3 * DFF + f0; const float* fb = AIN(I_FCB) + l * DFF + f0;
        float y0[8], y1[8];
#pragma unroll
        for (int h = 0; h < 2; ++h) { const int o = 4 * h;
            const f32x4 m2 = *(const GAS f32x4*)(hg + o), m1 = *(const GAS f32x4*)(hg + DFF + o), g0 = *(const GAS f32x4*)(fg + o), g1 = *(const GAS f32x4*)(fg + DFF + o), v0 = *(const GAS f32x4*)(fv + o), v1 = *(const GAS f32x4*)(fv + DFF + o);
            const f32x4 a = *(const GAS f32x4*)(fw + o), b = *(const GAS f32x4*)(fw + DFF + o), c = *(const GAS f32x4*)(fw + 2 * DFF + o), d = *(const GAS f32x4*)(fb + o);
#pragma unroll
            for (int i = 0; i < 4; ++i) { y0[o + i] = silu(a[i] * m2[i] + b[i] * m1[i] + c[i] * g0[i] + d[i]) * v0[i]; y1[o + i] = silu(a[i] * m1[i] + b[i] * g0[i] + c[i] * g1[i] + d[i]) * v1[i]; } }
        *(GAS v4u*)(ACT + (size_t)(pm * 256) * DFF + f0) = pack8(y0); *(GAS v4u*)(ACT + (size_t)(pm * 256 + 1) * DFF + f0) = pack8(y1);
    }
    asm volatile("s_waitcnt vmcnt(0)" ::: "memory"); __syncthreads();
}

namespace pg8 {
__device__ __forceinline__ float dpp_ror1(float v) { return __builtin_bit_cast(float, __builtin_amdgcn_mov_dpp(__builtin_bit_cast(int, v), 0x121, 0xF, 0xF, true)); }
__device__ __forceinline__ float dpp_ror2(float v) { return __builtin_bit_cast(float, __builtin_amdgcn_mov_dpp(__builtin_bit_cast(int, v), 0x122, 0xF, 0xF, true)); }
__device__ __forceinline__ float fast_silu(float x) { return x * __builtin_amdgcn_rcpf(1.0f + __builtin_amdgcn_exp2f(-1.4426950408889634f * x)); }
struct EpiUpAct {
    static constexpr bool PERM = true, AFTER_DRAIN = false;
    const Args& A; int z; int layer;
    static constexpr int DFF = 2688, PM_S = 64; static constexpr size_t O_PFFN = P::O_PFFN, O_SFFN = P::O_SFFN;
    __device__ __forceinline__ void operator()(const f32x4 (&acc)[2][2][4][2], const Unit& u, int wr, int wc, int fr, int fq) const { if (u.pm >= PM_S) run<true>(acc, u, wr, wc, fr, fq); else run<false>(acc, u, wr, wc, fr, fq); }
    template <bool SAMPLE>
    __device__ __forceinline__ void run(const f32x4 (&acc)[2][2][4][2], const Unit& u, int wr, int wc, int fr, int fq) const {
        asm volatile("" : "+v"(fr), "+v"(fq));
        const int lc = wc * 32 + 8 * fq, col = u.pn * 128 + lc;
        unsigned char* const ws = AWS; float* const out = AOUT; bf16_t* const ACT = (bf16_t*)(ws + P::WS_ACT); float* const halo_g = (float*)(ws + P::WS_HALO); float* const first_g = (float*)(ws + P::WS_FG); float* const first_v = (float*)(ws + P::WS_FV);
        const float* const cw = AIN(P::I_FCW) + (size_t)layer * 3 * DFF; const float* const cb = AIN(P::I_FCB) + layer * DFF; const float* const st = AIN(P::I_SFFN) + (size_t)layer * P::DECB * 2 * DFF;
        extern __shared__ __attribute__((aligned(16))) unsigned char lds_dyn_[]; PG8_LAS float* const lh = (PG8_LAS float*)((PG8_LAS unsigned char*)lds_dyn_ + P::HALO_OFF);
        f32x4 w0[2], w1[2], w2[2], cbv[2];
#pragma unroll
        for (int n = 0; n < 2; ++n) { w0[n] = *(const f32x4*)(cw + col + 4 * n); w1[n] = *(const f32x4*)(cw + DFF + col + 4 * n); w2[n] = *(const f32x4*)(cw + 2 * DFF + col + 4 * n); cbv[n] = *(const f32x4*)(cb + col + 4 * n); }
        if (fr >= 14) {
#pragma unroll
            for (int ai = 0; ai < 2; ++ai)
#pragma unroll
                for (int n = 0; n < 2; ++n) *(PG8_LAS f32x4*)(lh + (((ai * 2 + wr) * 2 + (fr - 14)) * 128 + lc + 4 * n)) = acc[ai][0][3][n];
            if (wr == 1) {
#pragma unroll
                for (int n = 0; n < 2; ++n) *(f32x4*)(halo_g + (size_t)(u.pm * 2 + (fr - 14)) * DFF + col + 4 * n) = acc[1][0][3][n];
                if (!SAMPLE && (u.pm & 7) == 7) {
#pragma unroll
                    for (int n = 0; n < 2; ++n) *(f32x4*)(out + O_PFFN + (size_t)((layer * 8 + (u.pm >> 3)) * 2 + (fr - 14)) * DFF + col + 4 * n) = acc[1][0][3][n]; }
            }
        }
        asm volatile("s_waitcnt lgkmcnt(0)" ::: "memory"); __builtin_amdgcn_s_barrier(); asm volatile("" ::: "memory");
        constexpr bool sample = SAMPLE;
#pragma unroll
        for (int ai = 0; ai < 2; ++ai) {
            f32x4 pv[2];
            if (wr == 1 || ai == 1) { const int pai = (wr == 1) ? ai : 0, pwr = (wr == 1) ? 0 : 1; const PG8_LAS float* hp = lh + (((pai * 2 + pwr) * 2 + ((fr == 15) ? 1 : 0)) * 128 + lc);
                pv[0] = *(const PG8_LAS f32x4*)hp; pv[1] = *(const PG8_LAS f32x4*)(hp + 4); }
            else { pv[0] = (f32x4){0.f, 0.f, 0.f, 0.f}; pv[1] = pv[0]; }
#pragma unroll
            for (int m = 0; m < 4; ++m) {
                const int lrow = ai * HALF + wr * 64 + m * 16 + fr;
                f32x4 s0[2], s1[2];
                const int sidx = fr & 3;
                if (sample && ai == 0 && sidx <= 1) { const float* sp = st + (size_t)(lrow >> 2) * 2 * DFF + col;
#pragma unroll
                    for (int n = 0; n < 2; ++n) { s0[n] = *(const f32x4*)(sp + 4 * n); s1[n] = *(const f32x4*)(sp + DFF + 4 * n); } }
                else {
#pragma unroll
                    for (int n = 0; n < 2; ++n) { s0[n] = (f32x4){0.f, 0.f, 0.f, 0.f}; s1[n] = s0[n]; } }
                float y[8]; float gk[8], vk[8];
#pragma unroll
                for (int n = 0; n < 2; ++n)
#pragma unroll
                    for (int i = 0; i < 4; ++i) {
                        const float g = acc[ai][0][m][n][i], gp = (m == 0) ? pv[n][i] : acc[ai][0][m == 0 ? 0 : m - 1][n][i];
                        float h1 = dpp_ror1(fr == 15 ? gp : g), h2 = dpp_ror2(fr >= 14 ? gp : g);
                        if (sample && ai == 0) { if (sidx == 0) { h1 = s1[n][i]; h2 = s0[n][i]; } else if (sidx == 1) { h2 = s1[n][i]; } }
                        const float gc = w0[n][i] * h2 + w1[n][i] * h1 + w2[n][i] * g + cbv[n][i];
                        y[4 * n + i] = fast_silu(gc) * acc[ai][1][m][n][i]; gk[4 * n + i] = g; vk[4 * n + i] = acc[ai][1][m][n][i];
                    }
                const bool defer = !sample && lrow < 2 && (u.pm & 7) != 0;
                if (defer) {
                    float* fg = first_g + (size_t)(u.pm * 2 + lrow) * DFF + col; float* fv = first_v + (size_t)(u.pm * 2 + lrow) * DFF + col;
                    *(f32x4*)fg = (f32x4){gk[0], gk[1], gk[2], gk[3]}; *(f32x4*)(fg + 4) = (f32x4){gk[4], gk[5], gk[6], gk[7]};
                    *(f32x4*)fv = (f32x4){vk[0], vk[1], vk[2], vk[3]}; *(f32x4*)(fv + 4) = (f32x4){vk[4], vk[5], vk[6], vk[7]};
                } else {
                    u32x4 w; w.x = cvt_pk_bf16(y[0], y[1]); w.y = cvt_pk_bf16(y[2], y[3]); w.z = cvt_pk_bf16(y[4], y[5]); w.w = cvt_pk_bf16(y[6], y[7]);
                    *(u32x4*)(ACT + (size_t)(u.pm * BM + lrow) * DFF + col) = w;
                }
                if (sample && ai == 0 && sidx >= 2) { float* o = out + O_SFFN + (size_t)((layer * 32 + (lrow >> 2)) * 2 + (sidx - 2)) * DFF + col;
                    *(f32x4*)o = (f32x4){gk[0], gk[1], gk[2], gk[3]}; *(f32x4*)(o + 4) = (f32x4){gk[4], gk[5], gk[6], gk[7]}; }
            }
        }
    }
};
}

struct AttnOrder {
    int start, step;
    __device__ __forceinline__ bool next(int i, attn_body::AttnUnit& u) const { const int idx = start + i * step; if (idx >= 256) return false; u.bh = idx >> 3; u.qb = idx & 7; return true; }
    __device__ __forceinline__ void a_ready(const attn_body::AttnUnit&) const {}
    __device__ __forceinline__ void done(const attn_body::AttnUnit&) const {}
};

__global__ void __launch_bounds__(NWAVES * 64, 2) hybrid_fwd(Args A) {
    using namespace P;
    extern __shared__ __attribute__((aligned(16))) unsigned char lds[];
#define MKFRAME() Frame F; { F.lds = (LAS unsigned char*)lds; F.MISC = (volatile LAS unsigned*)(F.lds + MISC_OFF); F.tid = ltid(); F.lane = F.tid & 63; F.wave = __builtin_amdgcn_readfirstlane(F.tid >> 6); \
        F.G = lgrid(); const int bx_ = lbid(); F.vcu = (F.G % 8 == 0) ? (bx_ % 8) * (F.G / 8) + bx_ / 8 : bx_; F.ctl = (gu32*)(AWS + WS_CTL); }
    XcdBarrier bar;
    { for (int u = threadIdx.x; u < (LDS_BYTES - RING_BYTES) / 4; u += NWAVES * 64) ((LAS unsigned*)((LAS unsigned char*)lds + RING_BYTES))[u] = 0u;
      __syncthreads();
      if ((threadIdx.x & 63) == 0) ((LAS int*)((LAS unsigned char*)lds + LTID_TABLE_OFF))[hw_wave_slot()] = (int)(threadIdx.x >> 6);
      __syncthreads(); }
    { const int z = OPAQUE_ZERO(); MKFRAME();
      bar.bar = (unsigned*)(F.ctl + CW_BAR); bar.x = 0; bar.st = nullptr;
      if (!MK_PER_PHASE) bar = xcd_barrier_post((unsigned*)(F.ctl + CW_BAR), F.MISC + 8); }
    const int lo = A.ph_lo, hi = A.ph_hi;
#define IN(k) (lo <= (k) && (k) < hi)
#define SEAM(k) do { if (!MK_PER_PHASE && (k) + 1 < N_PHASES) xcd_barrier(bar); } while (0)
#define CLS(c) (!MK_PER_PHASE || A.pad == 0 || A.pad == 1 + (c))
#define GW() (F.vcu * NWAVES + F.wave)
#define NGW() (F.G * NWAVES)

    if (IN(0)) { const int z = OPAQUE_ZERO(); MKFRAME(); p0_prologue(A, z, F); SEAM(0); }

    for (int l = 0; l < DEPTH; ++l) {
        const int pb = 1 + PH_PER_LAYER * l;
        if (IN(pb + 0)) {
            const int z = OPAQUE_ZERO(); MKFRAME(); unsigned char* const ws = AWS; float* const out = AOUT;
            pg8::Gemm g{(const bf16*)(ws + WS_XB), (const bf16*)(ws + WS_WIN + l * SZ_WIN), MP, NIN, DM, DM}; pg8::StaticOrder S; S.init(MP, NIN, F.G, (int)lbid(), MK_WGM_IN);
            const float* fb_ = AIN(I_FBF) + 4 * l; pg8::EpiIn E{(bf16*)(ws + WS_H), (float*)(ws + WS_LRF), out, l, (float*)(ws + WS_LOGF), (pg8::f32x4){fb_[0], fb_[1], fb_[2], fb_[3]}};
            pg8::gemm_phase<pg8::EpiIn, pg8::StaticOrder, true, true>(F.lds, g, S, E);
            SEAM(pb + 0);
        }
        if (IN(pb + 1)) {
            constexpr int N_GL = 1024, N_SG = 512, N_CV = 512, N_CS = BATCH;
            { const int z = OPAQUE_ZERO(); MKFRAME();
              if (CLS(0)) for (int unit = F.vcu * NWAVES + F.wave; unit < DECB * NPAGES; unit += F.G * NWAVES) fox_page_wave(A, z, F, l, unit); }
            { const int z = OPAQUE_ZERO(); MKFRAME();
              if (CLS(4) && F.wave == 0) for (int unit = F.vcu; unit < N_CS; unit += F.G) fox_cumsum_wave(A, z, F, l, unit); }
            { const int z = OPAQUE_ZERO(); MKFRAME(); TeamBar tb{F.MISC + 16, 0u, 8u};
              if (CLS(1)) for (int it = 4 * F.vcu; it < N_GL; it += 4 * F.G) { LBAR(); gla_local_items<4>(A, z, F, l, it); }
              if (F.G == 256) {
                  if (CLS(2)) { LBAR(); sgu_items<2>(A, z, F, l, F.vcu, 256); }
                  if (CLS(3)) { LBAR(); conv_items<2>(A, z, F, l, F.vcu, 256); }
              } else {
                  if (CLS(2)) for (int it = F.vcu; it < N_SG; it += F.G) { LBAR(); sgu_items<1>(A, z, F, l, it, 0); }
                  if (CLS(3)) for (int it = F.vcu; it < N_CV; it += F.G) { LBAR(); conv_items<1>(A, z, F, l, it, 0); }
              } }
            SEAM(pb + 1);
        }
        if (IN(pb + 2)) {
            { const int z = OPAQUE_ZERO(); MKFRAME(); unsigned char* const ws = AWS; const bf16* Hb = (const bf16*)(ws + WS_H);
              const attn_body::AttnTensors AT{(const attn_body::bf16*)(Hb + HC_CQ), (const attn_body::bf16*)(Hb + HC_CK), (const attn_body::bf16*)(Hb + HC_CV), (attn_body::bf16*)(ws + WS_Y) + 512, (const float*)(ws + WS_KBIAS)};
              const AttnOrder S{F.vcu, F.G};
              if (CLS(0)) attn_body::attn_phase<AttnOrder>((char*)lds, AT, S); }
            const int z = OPAQUE_ZERO(); MKFRAME();
            const int shard = (int)lbid() & 7; gu32* head = F.ctl + CW_Q + 64 * (8 * (2 * l + A.qoff) + shard);
            const int wc_hi = (F.G == 256) ? WC::I_LAYER : WC::I_ALL;
            const int nwc = l == 0 ? (wc_hi - WC::I_IN + 63) / 64 * 8 : 0;
            constexpr int GQ = MK_GQ, NGO = 1024 / GQ;
            const int nq = (3 * DECB + NGO + nwc) / 8;
            int j = q_next(F, head);
            while (j < nq) {
                unsigned pend = 0u; if (F.tid == 0) pend = __hip_atomic_fetch_add(head, 1u, RLX_AGENT);
                int it = 8 * j + shard;
                if (it < NGO) { if (CLS(2)) gla_out_multi<GQ>(A, z, F, l, it); }
                else if ((it -= NGO) < DECB) { if (CLS(1)) sample_fox_item(A, z, F, l, it); }
                else if ((it -= DECB) < DECB) { if (CLS(1)) sample_gs_item(A, z, F, l, it); }
                else if ((it -= DECB) < DECB) { if (CLS(1)) sample_conv_item(A, z, F, l, it); }
                else { it -= DECB; const int wi = WC::I_IN + it * 8 + F.wave; if (wi < wc_hi) wconv_wave_item(A, z, F, wi); }
                __syncthreads();
                if (F.tid == 0) F.MISC[0] = pend;
                __syncthreads();
                j = (int)F.MISC[0];
            }
            SEAM(pb + 2);
        }
        if (IN(pb + 3)) {
            const int z = OPAQUE_ZERO(); MKFRAME(); unsigned char* const ws = AWS;
            if (F.G == 256) {
              pg8::Gemm g{(const bf16*)(ws + WS_Y), (const bf16*)(ws + WS_WO + l * SZ_WO), MP, DM, DM, DM}; pg8::ComboOrder S; S.Pm.init(MPR, DM, F.G, (int)lbid()); S.pmS = MPR / 256; S.nN = DM / 256; S.nS = 8; S.kslice = 128;
              pg8::EpiResPart E{pg8::EpiRes{(const bf16*)(ws + WS_XB), (bf16*)(ws + WS_Z), DM, ALPHA}, (float*)(ws + WS_PZ), 128};
              pg8::gemm_phase<pg8::EpiResPart, pg8::ComboOrder, true, true>(F.lds, g, S, E);
            } else {
            { pg8::Gemm g{(const bf16*)(ws + WS_Y), (const bf16*)(ws + WS_WO + l * SZ_WO), MPR, DM, DM, DM}; pg8::StaticOrder S; S.init(MPR, DM, F.G, (int)lbid());
              pg8::EpiRes E{(const bf16*)(ws + WS_XB), (bf16*)(ws + WS_Z), DM, ALPHA};
              pg8::gemm_phase<pg8::EpiRes, pg8::StaticOrder, true, true>(F.lds, g, S, E); }
            { pg8::Gemm g{(const bf16*)(ws + WS_Y), (const bf16*)(ws + WS_WO + l * SZ_WO), MP, DM, 128, DM}; const pg8::SliceOrder S{MPR / 256, DM / 256, 8, 128, F.G, (int)lbid()};
              pg8::EpiPart E{(float*)(ws + WS_PZ), DM, 128};
              pg8::gemm_phase<pg8::EpiPart, pg8::SliceOrder, true, true>(F.lds, g, S, E); } }
            SEAM(pb + 3);
        }
        if (IN(pb + 4)) {
            const int z = OPAQUE_ZERO(); MKFRAME(); unsigned char* const ws = AWS;
            const LnIo io{(const bf16*)(ws + WS_Z), (const bf16*)(ws + WS_XB), (const float*)(ws + WS_PZ), 8, AIN(I_L1G) + l * DM, AIN(I_L1B) + l * DM, nullptr, nullptr, (bf16*)(ws + WS_X1B)};
            ln_phase(F, io);
            SEAM(pb + 4);
        }
        if (IN(pb + 5)) {
            const int z = OPAQUE_ZERO(); MKFRAME(); unsigned char* const ws = AWS;
            pg8::Gemm g{(const bf16*)(ws + WS_X1B), (const bf16*)(ws + WS_WUP + l * SZ_WUP), MP, NUP, DM, DM}; pg8::StaticOrder S; S.init(MP, NUP, F.G, (int)lbid(), MK_WGM_UP);
            pg8::EpiUpAct E{A, z, l};
            pg8::gemm_phase<pg8::EpiUpAct, pg8::StaticOrder, true, true>(F.lds, g, S, E);
            if (l == 0 && F.G == 256) {
                constexpr int NBUSY = (MP / 256) * (NUP / 256) - 5 * 256; const int c_ = (int)lbid();
                if (c_ >= NBUSY) { __syncthreads(); for (int wi = WC::I_LAYER + (c_ - NBUSY) * NWAVES + F.wave; wi < WC::I_ALL; wi += (256 - NBUSY) * NWAVES) wconv_wave_item(A, z, F, wi); } }
            SEAM(pb + 5);
        }
        if (IN(pb + 6)) {
            const int z = OPAQUE_ZERO(); MKFRAME(); unsigned char* const ws = AWS;
            { pg8::Gemm g{(const bf16*)(ws + WS_ACT), (const bf16*)(ws + WS_WDN + l * SZ_WDN), MPR, DM, DFF, DFF}; pg8::StaticOrder S; S.init(MPR, DM, F.G, (int)lbid());
              { pg8::Unit u_; for (int i = 0; S.next(i, u_); ++i) act_fixup(A, z, F, l, u_.pm); }
              if (F.G == 256) {
              pg8::Gemm g2{(const bf16*)(ws + WS_ACT), (const bf16*)(ws + WS_WDN + l * SZ_WDN), MP, DM, DFF, DFF}; pg8::ComboOrder S2; S2.Pm = S; S2.pmS = MPR / 256; S2.nN = DM / 256; S2.nS = 7; S2.kslice = 384;
              pg8::EpiResPart E{pg8::EpiRes{(const bf16*)(ws + WS_X1B), (bf16*)(ws + WS_Z), DM, ALPHA}, (float*)(ws + WS_PZ), 384};
              pg8::gemm_phase<pg8::EpiResPart, pg8::ComboOrder, true, true>(F.lds, g2, S2, E);
              } else {
              pg8::EpiRes E{(const bf16*)(ws + WS_X1B), (bf16*)(ws + WS_Z), DM, ALPHA};
              pg8::gemm_phase<pg8::EpiRes, pg8::StaticOrder, true, true>(F.lds, g, S, E); } }
            if (F.G != 256) { pg8::Gemm g{(const bf16*)(ws + WS_ACT), (const bf16*)(ws + WS_WDN + l * SZ_WDN), MP, DM, 384, DFF}; const pg8::SliceOrder S{MPR / 256, DM / 256, 7, 384, F.G, (int)lbid()};
              pg8::EpiPart E{(float*)(ws + WS_PZ), DM, 384};
              pg8::gemm_phase<pg8::EpiPart, pg8::SliceOrder, true, true>(F.lds, g, S, E); }
            SEAM(pb + 6);
        }
        if (IN(pb + 7)) {
            const int z = OPAQUE_ZERO(); MKFRAME(); unsigned char* const ws = AWS; float* const out = AOUT; const bool last = l + 1 == DEPTH;
            const LnIo io{(const bf16*)(ws + WS_Z), (const bf16*)(ws + WS_X1B), (const float*)(ws + WS_PZ), 7, AIN(I_L2G) + l * DM, AIN(I_L2B) + l * DM, last ? out + O_YP : nullptr, last ? out + O_YS : nullptr, last ? nullptr : (bf16*)(ws + WS_XB)};
            ln_phase(F, io);
            SEAM(pb + 7);
        }
    }
#undef IN
#undef SEAM
#undef GW
#undef NGW
#undef CLS
#undef MKFRAME
}

extern "C" void kernel_launch(void* const* d_in, const int* in_sizes, int n_in, void* d_out, int out_size, void* d_ws, size_t ws_size, hipStream_t stream) {
    using namespace P;
    static int grid = 0;
    if (grid == 0) {
        if (n_in != N_IN || (size_t)out_size != O_END || ws_size < WS_END) { fprintf(stderr, "kernel_launch: unexpected shapes: n_in %d out %d ws %zu (need %zu)\n", n_in, out_size, ws_size, (size_t)WS_END); grid = -1; return; }
        int dev = 0, cus = 0, per_cu = 0;
        if (hipGetDevice(&dev) != hipSuccess || hipDeviceGetAttribute(&cus, hipDeviceAttributeMultiprocessorCount, dev) != hipSuccess) { grid = -1; return; }
        if (hipFuncSetAttribute((const void*)hybrid_fwd, hipFuncAttributeMaxDynamicSharedMemorySize, LDS_BYTES) != hipSuccess) { fprintf(stderr, "kernel_launch: hipFuncSetAttribute failed\n"); grid = -1; return; }
        if (hipOccupancyMaxActiveBlocksPerMultiprocessor(&per_cu, (const void*)hybrid_fwd, NWAVES * 64, LDS_BYTES) != hipSuccess || per_cu < 1)
            fprintf(stderr, "kernel_launch: note: occupancy query reports %d workgroups per CU\n", per_cu);
        (void)hipGetLastError();
        grid = cus;
    }
    if (grid < 0) return;
    if (hipMemsetAsync((char*)d_ws + WS_CTL, 0, CTL_ZERO_BYTES, stream) != hipSuccess) { fprintf(stderr, "kernel_launch: memset failed\n"); return; }
    Args a{};
    for (int i = 0; i < N_IN; ++i) a.p[i] = (const float*)d_in[i];
    a.p[N_IN] = (const float*)d_out; a.p[N_IN + 1] = (const float*)d_ws;
#if MK_PER_PHASE
    for (int p = 0; p < N_PHASES; ++p) { const int type = p == 0 ? 0 : 1 + (p - 1) % PH_PER_LAYER; const int reps = 1 + ((MK_REP_MASK >> type) & 1);
        for (int r = 0; r < reps; ++r) { a.ph_lo = p; a.ph_hi = p + 1; a.qoff = r; a.pad = r ? MK_REP_CLASS : 0; hipLaunchKernelGGL(hybrid_fwd, dim3(grid), dim3(NWAVES * 64), LDS_BYTES, stream, a); } }
#else
    a.ph_lo = 0; a.ph_hi = N_PHASES;
    hipLaunchKernelGGL(hybrid_fwd, dim3(grid), dim3(NWAVES * 64), LDS_BYTES, stream, a);
#endif
    const hipError_t le = hipPeekAtLastError();
    if (le != hipSuccess) fprintf(stderr, "kernel_launch: launch failed: %s\n", hipGetErrorName(le));
}
```
